# Optimizing an MI355X kernel written in HIP

```python
import math
import jax, jax.numpy as jnp
from jax import lax
import numpy as np

D_MODEL = 2048
BATCH = 2
SEQ = 8192
DEPTH = 2

QBLK = 128
ROPE_THETA = 500000.0
EPS = 1e-6
TINY = 1e-30
BIG = 1e9

SB_HEADS = 8
SB_DIM = 128
MLA_HEADS = 8
MLA_Q_RANK = 512
MLA_KV_RANK = 256
MLA_NOPE = 128
MLA_ROPE = 64
MLA_V = 128
NSA_HEADS = 16
NSA_GROUPS = 2
NSA_DIM = 128
ROT_DIM = NSA_DIM // 4
CMP_BLK = 32
CMP_STRIDE = 16
CMP_HIDDEN = 256
SLC_BLK = 64
SLC_TOPK = 16
WINDOW = 512
PEER_HEADS = 8
PEER_KEYS = 128
PEER_DKEY = 256
PEER_TOPK = 16
N_EXPERTS = PEER_KEYS * PEER_KEYS
PEER_CHUNK = 64

N_EVEN = (DEPTH + 1) // 2
N_ODD = DEPTH // 2
SBMLA_IN = 3 * SB_HEADS * SB_DIM + MLA_Q_RANK + MLA_KV_RANK + MLA_ROPE
SBMLA_OUT = SB_HEADS * SB_DIM + MLA_HEADS * MLA_V
NSA_IN = NSA_HEADS * NSA_DIM + 6 * NSA_GROUPS * NSA_DIM + 3 * NSA_HEADS

kernel_name = "hybrid_sb_mla_nsa_peer_adaln"


def rmsnorm(x, g):
    xf = x.astype(jnp.float32)
    y = xf * lax.rsqrt(jnp.mean(xf * xf, axis=-1, keepdims=True) + EPS)
    return (y * g.astype(jnp.float32)).astype(x.dtype)


def rope(x, pos, rot_dim):
    half = rot_dim // 2
    inv = ROPE_THETA ** (-jnp.arange(half, dtype=jnp.float32) / half)
    ang = pos.astype(jnp.float32)[..., None] * inv
    cos = jnp.cos(ang)[:, :, None, :]
    sin = jnp.sin(ang)[:, :, None, :]
    x1 = x[..., :half].astype(jnp.float32)
    x2 = x[..., half:rot_dim].astype(jnp.float32)
    r1 = (x1 * cos - x2 * sin).astype(x.dtype)
    r2 = (x2 * cos + x1 * sin).astype(x.dtype)
    return jnp.concatenate([r1, r2, x[..., rot_dim:]], axis=-1)


def masked_softmax(z, mask):
    z = jnp.where(mask, z, -jnp.inf)
    m = jnp.max(z, axis=-1, keepdims=True)
    m = jnp.where(jnp.isfinite(m), m, 0.0)
    e = jnp.exp(z - m)
    return e / jnp.maximum(jnp.sum(e, axis=-1, keepdims=True), TINY)


def modulation(c, w, b):
    m = jax.nn.silu(c) @ w + b
    shift, scale, gate = jnp.split(m, 3, axis=-1)
    return shift[:, None, :], scale[:, None, :], gate[:, None, :]


def sweep(fn, block, *arrs):
    n = arrs[0].shape[1] // block
    def body(s0):
        return fn(s0, *[lax.dynamic_slice_in_dim(a, s0, block, axis=1) for a in arrs])
    out = lax.map(body, jnp.arange(n, dtype=jnp.int32) * block)
    out = jnp.moveaxis(out, 0, 1)
    return out.reshape((out.shape[0], n * block) + out.shape[3:])


def stick_breaking(q, k, v):
    S = q.shape[1]
    scale = 1.0 / math.sqrt(SB_DIM)
    kpos = jnp.arange(S)
    def blk(q0, qb):
        z = jnp.einsum('bqhd,bkhd->bhqk', qb, k).astype(jnp.float32) * scale
        t = q0 + jnp.arange(QBLK)
        strict = kpos[None, :] < t[:, None]
        log_1m = jnp.where(strict, jax.nn.log_sigmoid(-z), 0.0)
        cs = jnp.cumsum(log_1m, axis=-1)
        suffix = cs[..., -1:] - cs
        a = jnp.where(strict, jnp.exp(jax.nn.log_sigmoid(z) + suffix), 0.0)
        return jnp.einsum('bhqk,bkhd->bqhd', a.astype(v.dtype), v)
    return sweep(blk, QBLK, q)


def mla(c_q, c_kv, k_r, pos, q_norm, w_uq, kv_norm, w_ukv):
    B, S, _ = c_q.shape
    q = (rmsnorm(c_q, q_norm) @ w_uq).reshape(B, S, MLA_HEADS, MLA_NOPE + MLA_ROPE)
    q_nope = q[..., :MLA_NOPE]
    q_rope = rope(q[..., MLA_NOPE:], pos, MLA_ROPE)
    kv = (rmsnorm(c_kv, kv_norm) @ w_ukv).reshape(B, S, MLA_HEADS, MLA_NOPE + MLA_V)
    k_nope, v = kv[..., :MLA_NOPE], kv[..., MLA_NOPE:]
    k_rope = rope(k_r[:, :, None, :], pos, MLA_ROPE)[:, :, 0, :]
    scale = 1.0 / math.sqrt(MLA_NOPE + MLA_ROPE)
    kpos = jnp.arange(S)
    def blk(q0, qn, qr):
        t = q0 + jnp.arange(QBLK)
        z = (jnp.einsum('bqhd,bkhd->bhqk', qn, k_nope)
             + jnp.einsum('bqhr,bkr->bhqk', qr, k_rope)).astype(jnp.float32) * scale
        p = masked_softmax(z, kpos[None, :] <= t[:, None])
        return jnp.einsum('bhqk,bkhd->bqhd', p.astype(v.dtype), v)
    return sweep(blk, QBLK, q_nope, q_rope)


def sb_mla_mixer(h, pos, w_in, q_norm, w_uq, kv_norm, w_ukv, w_out):
    B, S, _ = h.shape
    sbw = SB_HEADS * SB_DIM
    splits = np.cumsum([sbw, sbw, sbw, MLA_Q_RANK, MLA_KV_RANK]).tolist()
    q_sb, k_sb, v_sb, c_q, c_kv, k_r = jnp.split(h @ w_in, splits, axis=-1)
    shp = (B, S, SB_HEADS, SB_DIM)
    o_a = stick_breaking(q_sb.reshape(shp), k_sb.reshape(shp), v_sb.reshape(shp))
    o_b = mla(c_q, c_kv, k_r, pos, q_norm, w_uq, kv_norm, w_ukv)
    o = jnp.concatenate([o_a.reshape(B, S, -1), o_b.reshape(B, S, -1)], axis=-1)
    return o @ w_out


def nsa_mixer(h, pos, w_in, pe_k, pe_v, w1_k, w2_k, w1_v, w2_v, w_out):
    B, S, _ = h.shape
    G, R, d = NSA_GROUPS, NSA_HEADS // NSA_GROUPS, NSA_DIM
    kvw = G * d
    splits = np.cumsum([NSA_HEADS * d, kvw, kvw, kvw, kvw, kvw, kvw]).tolist()
    q, kc, vc, ks, vs, kw, vw, gl = jnp.split(h @ w_in, splits, axis=-1)
    q = rope(q.reshape(B, S, NSA_HEADS, d), pos, ROT_DIM).reshape(B, S, G, R, d)
    kc = rope(kc.reshape(B, S, G, d), pos, ROT_DIM)
    ks = rope(ks.reshape(B, S, G, d), pos, ROT_DIM)
    kw = rope(kw.reshape(B, S, G, d), pos, ROT_DIM)
    vc, vs, vw = (a.reshape(B, S, G, d) for a in (vc, vs, vw))
    gates = jax.nn.sigmoid(gl.reshape(B, S, G, R, 3))

    n_cmp = (S - CMP_BLK) // CMP_STRIDE + 1
    cidx = np.arange(n_cmp)[:, None] * CMP_STRIDE + np.arange(CMP_BLK)[None, :]
    def compress(t, pe, w1, w2):
        blk = t[:, cidx] + pe[None, None, :, None, :]
        blk = blk.transpose(0, 1, 3, 2, 4).reshape(B, n_cmp, G, CMP_BLK * d)
        return jax.nn.gelu(blk @ w1) @ w2
    kc_c = compress(kc, pe_k, w1_k, w2_k)
    vc_c = compress(vc, pe_v, w1_v, w2_v)
    cmp_end = jnp.asarray(cidx[:, -1])

    n_slc = S // SLC_BLK
    slc_k = min(SLC_TOPK, n_slc)
    c_s = np.arange(n_cmp) * CMP_STRIDE
    s_s = np.arange(n_slc) * SLC_BLK
    overlap = np.clip(np.minimum(c_s[:, None] + CMP_BLK, s_s[None, :] + SLC_BLK)
                      - np.maximum(c_s[:, None], s_s[None, :]), 0, None)
    overlap = jnp.asarray(overlap.astype(np.float32))
    ks_b = ks.reshape(B, n_slc, SLC_BLK, G, d).transpose(0, 3, 1, 2, 4)
    vs_b = vs.reshape(B, n_slc, SLC_BLK, G, d).transpose(0, 3, 1, 2, 4)
    blk_id = jnp.arange(n_slc)
    bi = jnp.arange(B)[:, None, None, None]
    gi = jnp.arange(G)[None, :, None, None]

    kw_p = jnp.pad(kw, ((0, 0), (WINDOW, 0), (0, 0), (0, 0)))
    vw_p = jnp.pad(vw, ((0, 0), (WINDOW, 0), (0, 0), (0, 0)))
    scale = 1.0 / math.sqrt(d)

    def blk(q0, qb, gb):
        t = q0 + jnp.arange(QBLK)
        zc = jnp.einsum('bqgrd,bngd->bgrqn', qb, kc_c).astype(jnp.float32) * scale
        pc = masked_softmax(zc, cmp_end[None, :] <= t[:, None])
        oc = jnp.einsum('bgrqn,bngd->bqgrd', pc.astype(vc_c.dtype), vc_c)
        imp = jnp.einsum('bgrqn,nj->bgqj', pc.astype(jnp.float32), overlap)
        cur = t // SLC_BLK
        forced = (blk_id[None, :] == 0) | (blk_id[None, :] == cur[:, None]) | (blk_id[None, :] == cur[:, None] - 1)
        valid = blk_id[None, :] * SLC_BLK <= t[:, None]
        score = jnp.where(forced, BIG, jnp.where(valid, imp, -BIG))
        _, sel = lax.top_k(score, slc_k)
        kg = ks_b[bi, gi, sel]
        vg = vs_b[bi, gi, sel]
        zs = jnp.einsum('bqgrd,bgqkld->bgrqkl', qb, kg).astype(jnp.float32) * scale
        kpos = sel[..., None] * SLC_BLK + jnp.arange(SLC_BLK)
        smask = (kpos <= t[:, None, None])[:, :, None].reshape(B, G, 1, QBLK, slc_k * SLC_BLK)
        ps = masked_softmax(zs.reshape(B, G, R, QBLK, slc_k * SLC_BLK), smask)
        ps = ps.reshape(B, G, R, QBLK, slc_k, SLC_BLK)
        osl = jnp.einsum('bgrqkl,bgqkld->bqgrd', ps.astype(vg.dtype), vg)
        kwb = lax.dynamic_slice_in_dim(kw_p, q0, WINDOW + QBLK, axis=1)
        vwb = lax.dynamic_slice_in_dim(vw_p, q0, WINDOW + QBLK, axis=1)
        wpos = q0 - WINDOW + jnp.arange(WINDOW + QBLK)
        wmask = (wpos[None, :] <= t[:, None]) & (wpos[None, :] > t[:, None] - WINDOW) & (wpos[None, :] >= 0)
        zw = jnp.einsum('bqgrd,bkgd->bgrqk', qb, kwb).astype(jnp.float32) * scale
        pw = masked_softmax(zw, wmask)
        ow = jnp.einsum('bgrqk,bkgd->bqgrd', pw.astype(vwb.dtype), vwb)
        return gb[..., 0:1] * oc + gb[..., 1:2] * osl + gb[..., 2:3] * ow

    o = sweep(blk, QBLK, q, gates)
    return o.reshape(B, S, NSA_HEADS * d) @ w_out


def peer(h, w_q, k1, k2, u, v):
    B, S, D = h.shape
    half = PEER_DKEY // 2
    q = (h @ w_q).reshape(B, S, PEER_HEADS, 2, half).astype(jnp.float32)
    s1 = jnp.einsum('bshd,nd->bshn', q[..., 0, :], k1.astype(jnp.float32))
    s2 = jnp.einsum('bshd,nd->bshn', q[..., 1, :], k2.astype(jnp.float32))
    v1, i1 = lax.top_k(s1, PEER_TOPK)
    v2, i2 = lax.top_k(s2, PEER_TOPK)
    cand = (v1[..., :, None] + v2[..., None, :]).reshape(B, S, PEER_HEADS, PEER_TOPK * PEER_TOPK)
    cidx = (i1[..., :, None] * PEER_KEYS + i2[..., None, :]).reshape(B, S, PEER_HEADS, PEER_TOPK * PEER_TOPK)
    top, pos = lax.top_k(cand, PEER_TOPK)
    experts = jnp.take_along_axis(cidx, pos, axis=-1)
    g = jax.nn.softmax(top, axis=-1).astype(h.dtype)
    def chunk(s0, hb, eb, gb):
        act = jax.nn.gelu(jnp.einsum('bqd,bqhkd->bqhk', hb, u[eb]))
        return jnp.einsum('bqhk,bqhkd->bqd', gb * act, v[eb])
    return sweep(chunk, PEER_CHUNK, h, experts, g)


def setup_inputs(seed: int = 0) -> dict:
    key = jax.random.key(seed)
    ks = iter(jax.random.split(key, 40))
    def nrm(shape, std):
        return jax.random.normal(next(ks), shape, jnp.float32) * std
    def gain(shape):
        return 1.0 + nrm(shape, 0.05)
    D = D_MODEL
    x = nrm((BATCH, SEQ, D), 1.0)
    c = nrm((BATCH, D), 1.0)
    offset = jax.random.randint(next(ks), (BATCH, 1), 0, 1024, dtype=jnp.int32)
    positions = offset + jnp.arange(SEQ, dtype=jnp.int32)[None, :]
    return {
        "x": x,
        "c": c,
        "positions": positions,
        "norm_mix": gain((DEPTH, D)),
        "ada_mix_w": nrm((DEPTH, D, 3 * D), 0.5 * D ** -0.5),
        "ada_mix_b": nrm((DEPTH, 3 * D), 0.02),
        "sbmla_w_in": nrm((N_EVEN, D, SBMLA_IN), D ** -0.5),
        "mla_q_norm": gain((N_EVEN, MLA_Q_RANK)),
        "mla_w_uq": nrm((N_EVEN, MLA_Q_RANK, MLA_HEADS * (MLA_NOPE + MLA_ROPE)), MLA_Q_RANK ** -0.5),
        "mla_kv_norm": gain((N_EVEN, MLA_KV_RANK)),
        "mla_w_ukv": nrm((N_EVEN, MLA_KV_RANK, MLA_HEADS * (MLA_NOPE + MLA_V)), MLA_KV_RANK ** -0.5),
        "sbmla_w_out": nrm((N_EVEN, SBMLA_OUT, D), SBMLA_OUT ** -0.5),
        "nsa_w_in": nrm((N_ODD, D, NSA_IN), D ** -0.5),
        "nsa_pe_k": nrm((N_ODD, CMP_BLK, NSA_DIM), 0.1),
        "nsa_pe_v": nrm((N_ODD, CMP_BLK, NSA_DIM), 0.1),
        "nsa_w1_k": nrm((N_ODD, CMP_BLK * NSA_DIM, CMP_HIDDEN), (CMP_BLK * NSA_DIM) ** -0.5),
        "nsa_w2_k": nrm((N_ODD, CMP_HIDDEN, NSA_DIM), CMP_HIDDEN ** -0.5),
        "nsa_w1_v": nrm((N_ODD, CMP_BLK * NSA_DIM, CMP_HIDDEN), (CMP_BLK * NSA_DIM) ** -0.5),
        "nsa_w2_v": nrm((N_ODD, CMP_HIDDEN, NSA_DIM), CMP_HIDDEN ** -0.5),
        "nsa_w_out": nrm((N_ODD, NSA_HEADS * NSA_DIM, D), (NSA_HEADS * NSA_DIM) ** -0.5),
        "norm_ffn": gain((DEPTH, D)),
        "ada_ffn_w": nrm((DEPTH, D, 3 * D), 0.5 * D ** -0.5),
        "ada_ffn_b": nrm((DEPTH, 3 * D), 0.02),
        "peer_w_q": nrm((DEPTH, D, PEER_HEADS * PEER_DKEY), D ** -0.5),
        "peer_k1": nrm((DEPTH, PEER_KEYS, PEER_DKEY // 2), (PEER_DKEY // 2) ** -0.5),
        "peer_k2": nrm((DEPTH, PEER_KEYS, PEER_DKEY // 2), (PEER_DKEY // 2) ** -0.5),
        "peer_u": nrm((DEPTH, N_EXPERTS, D), D ** -0.5),
        "peer_v": nrm((DEPTH, N_EXPERTS, D), PEER_HEADS ** -0.5),
        "final_norm": gain((D,)),
    }


def reference(x, c, positions, norm_mix, ada_mix_w, ada_mix_b, sbmla_w_in, mla_q_norm, mla_w_uq,
              mla_kv_norm, mla_w_ukv, sbmla_w_out, nsa_w_in, nsa_pe_k, nsa_pe_v, nsa_w1_k, nsa_w2_k,
              nsa_w1_v, nsa_w2_v, nsa_w_out, norm_ffn, ada_ffn_w, ada_ffn_b, peer_w_q, peer_k1, peer_k2,
              peer_u, peer_v, final_norm):
    for layer in range(DEPTH):
        i = layer // 2
        shift, scale, gate = modulation(c, ada_mix_w[layer], ada_mix_b[layer])
        h = rmsnorm(x, norm_mix[layer]) * (1.0 + scale) + shift
        if layer % 2 == 0:
            y = sb_mla_mixer(h, positions, sbmla_w_in[i], mla_q_norm[i], mla_w_uq[i],
                             mla_kv_norm[i], mla_w_ukv[i], sbmla_w_out[i])
        else:
            y = nsa_mixer(h, positions, nsa_w_in[i], nsa_pe_k[i], nsa_pe_v[i], nsa_w1_k[i],
                          nsa_w2_k[i], nsa_w1_v[i], nsa_w2_v[i], nsa_w_out[i])
        x = x + gate * y
        shift, scale, gate = modulation(c, ada_ffn_w[layer], ada_ffn_b[layer])
        h = rmsnorm(x, norm_ffn[layer]) * (1.0 + scale) + shift
        x = x + gate * peer(h, peer_w_q[layer], peer_k1[layer], peer_k2[layer], peer_u[layer], peer_v[layer])
    return rmsnorm(x, final_norm)
```

```cpp
#define NAIVE_GATHER 1
#define MK_ONE_LAUNCH 1
#include <hip/hip_runtime.h>
#include <stdint.h>
#include <stdio.h>

typedef unsigned short bf16_t;
typedef short bf16x8 __attribute__((ext_vector_type(8)));
typedef short s16x4 __attribute__((ext_vector_type(4)));
typedef float f32x16 __attribute__((ext_vector_type(16)));
typedef float f32x4 __attribute__((ext_vector_type(4)));
typedef float f32x2 __attribute__((ext_vector_type(2)));
typedef unsigned u32x4 __attribute__((ext_vector_type(4)));
typedef unsigned u32x2 __attribute__((ext_vector_type(2)));
typedef __bf16 bf16x2_t __attribute__((ext_vector_type(2)));
#define LAS __attribute__((address_space(3)))

constexpr int D_MODEL = 2048, BATCH = 2, SEQ = 8192, T = BATCH * SEQ;
constexpr float EPS = 1e-6f;
constexpr int SBMLA_IN = 3904, SBMLA_IN_PAD = 3968;
constexpr int NSA_IN = 3632, NSA_IN_PAD = 3712;
constexpr int NCMP = 511, NCMP_PAD = 512;
constexpr int NTHREADS = 512, NWAVES = 8;
constexpr int KVM_LD = 2112;

constexpr size_t al256(size_t x) { return (x + 255) & ~(size_t)255; }
constexpr size_t WS_CTL   = 0;
constexpr size_t WS_MOD   = 16384;
constexpr size_t WS_BIASP = WS_MOD + al256((size_t)4 * 2 * 6144 * 4);
constexpr size_t WS_ROPE64 = WS_BIASP + al256((size_t)2 * 32 * 256 * 4);
constexpr size_t WS_ROPE32 = WS_ROPE64 + (size_t)T * 32 * 8;
constexpr size_t WS_WIN0  = WS_ROPE32 + (size_t)T * 16 * 8;
constexpr size_t WS_WUQ   = WS_WIN0 + (size_t)SBMLA_IN_PAD * 2048 * 2;
constexpr size_t WS_WUKV  = WS_WUQ + (size_t)1536 * 512 * 2;
constexpr size_t WS_WOUT0 = WS_WUKV + (size_t)2048 * 256 * 2;
constexpr size_t WS_WNSAIN = WS_WOUT0 + (size_t)2048 * 2048 * 2;
constexpr size_t WS_W1K   = WS_WNSAIN + (size_t)NSA_IN_PAD * 2048 * 2;
constexpr size_t WS_W1V   = WS_W1K + (size_t)256 * 4096 * 2;
constexpr size_t WS_W2K   = WS_W1V + (size_t)256 * 4096 * 2;
constexpr size_t WS_W2V   = WS_W2K + (size_t)128 * 256 * 2;
constexpr size_t WS_WNSAOUT = WS_W2V + (size_t)128 * 256 * 2;
constexpr size_t WS_WPQ   = WS_WNSAOUT + (size_t)2048 * 2048 * 2;
constexpr size_t WS_K12   = WS_WPQ + (size_t)2 * 2048 * 2048 * 2;
constexpr size_t WS_PU    = WS_K12 + (size_t)4 * 128 * 128 * 2;
constexpr size_t WS_PV    = WS_PU + (size_t)2 * 16384 * 2048 * 2;
constexpr size_t WS_H     = WS_PV + (size_t)2 * 16384 * 2048 * 2;
constexpr size_t WS_BIG   = WS_H + (size_t)T * 2048 * 2;
constexpr size_t WS_O     = WS_BIG + (size_t)T * SBMLA_IN * 2;
constexpr size_t WS_XA    = WS_O + (size_t)T * 2048 * 2;
constexpr size_t WS_XB    = WS_XA + (size_t)T * 2048 * 4;
constexpr size_t WS_CQN   = WS_XA;
constexpr size_t WS_CKVN  = WS_CQN + (size_t)T * 512 * 2;
constexpr size_t WS_OACC  = WS_XA;
constexpr size_t WS_QM    = WS_XB;
constexpr size_t WS_KVM   = WS_QM + (size_t)T * 1536 * 2;
constexpr size_t WS_PQ    = WS_XB;
static_assert((size_t)T * 1536 * 2 + (size_t)T * KVM_LD * 2 <= (size_t)T * 2048 * 4, "QM + KVM must fit the XB region");
constexpr size_t WS_EXI   = WS_XB + (size_t)T * 2048 * 4;
constexpr size_t WS_EXG   = WS_EXI + (size_t)T * 128 * 4;
constexpr size_t WS_HID   = WS_EXG + (size_t)T * 128 * 4;
constexpr size_t WS_KCC   = WS_HID + (size_t)2 * 2048 * 256 * 2;
constexpr size_t WS_VCC   = WS_KCC + (size_t)BATCH * NCMP_PAD * 2 * 128 * 2;
constexpr size_t WS_END   = WS_VCC + (size_t)BATCH * NCMP_PAD * 2 * 128 * 2;

struct Args {
    const float* in[29];
    float* out;
    unsigned char* ws;
    int ph_lo, ph_hi;
};

__device__ __forceinline__ unsigned cvtpk(float lo, float hi) {
    bf16x2_t v = {(__bf16)lo, (__bf16)hi};
    return __builtin_bit_cast(unsigned, v);
}
__device__ __forceinline__ float bf2f(unsigned short h) { return __uint_as_float(((unsigned)h) << 16); }
__device__ __forceinline__ float bflo(unsigned w) { return __uint_as_float(w << 16); }
__device__ __forceinline__ float bfhi(unsigned w) { return __uint_as_float(w & 0xFFFF0000u); }
__device__ __forceinline__ int crow(int r, int hi) { return (r & 3) + 8 * (r >> 2) + 4 * hi; }
__device__ __forceinline__ float wave_sum(float v) {
#pragma unroll
    for (int o = 32; o >= 1; o >>= 1) v += __shfl_xor(v, o);
    return v;
}
__device__ __forceinline__ float gelu_tanh(float x) {
    const float u = 0.7978845608028654f * (x + 0.044715f * x * x * x);
    const float e = __expf(2.f * u);
    const float th = 1.f - 2.f / (e + 1.f);
    return 0.5f * x * (1.f + th);
}
__device__ __forceinline__ int opaque_tid() { int t = threadIdx.x; asm volatile("" : "+v"(t)); return t; }
__device__ __forceinline__ unsigned char* WSP(const Args& A) {
    unsigned lo = (unsigned)(uintptr_t)A.ws, hi = (unsigned)((uintptr_t)A.ws >> 32);
    asm volatile("" : "+v"(lo), "+v"(hi));
    lo = (unsigned)__builtin_amdgcn_readfirstlane((int)lo); hi = (unsigned)__builtin_amdgcn_readfirstlane((int)hi);
    return (unsigned char*)(((uintptr_t)hi << 32) | lo);
}
#ifndef ABL_SB
#define ABL_SB 1.f
#endif
#ifndef ABL_MLA
#define ABL_MLA 1.f
#endif
#ifndef ABL_NC
#define ABL_NC 1.f
#endif
#ifndef ABL_NS
#define ABL_NS 1.f
#endif
#ifndef ABL_NW
#define ABL_NW 1.f
#endif
#define XB_TMO      128
#define XB_XCNT(j)  (256  + 64 * (j))
#define XB_XSUB(j)  (1280 + 64 * (j))
#define XB_XGEN(j)  (2304 + 64 * (j))
#define XB_TOP      3328
#define XB_TOPGEN   3392
#define XCD_BAR_WORDS 3456
#define XB_SPIN_CAP (1u << 18)
#define LAS __attribute__((address_space(3)))

__device__ __forceinline__ unsigned xb_ld(unsigned* p)              { return __hip_atomic_load(p, __ATOMIC_RELAXED, __HIP_MEMORY_SCOPE_AGENT); }
__device__ __forceinline__ unsigned xb_add(unsigned* p, unsigned v) { return __hip_atomic_fetch_add(p, v, __ATOMIC_RELAXED, __HIP_MEMORY_SCOPE_AGENT); }
__device__ __forceinline__ unsigned xb_xcc_id() { return (unsigned)__builtin_amdgcn_s_getreg((3 << 11) | 20) & 0xFu; }
#define XB_SPIN(cond, bar) do { unsigned _sp = 0; while (cond) { __builtin_amdgcn_s_sleep(1); \
    if ((++_sp & 255u) == 0u) { if (xb_ld(&(bar)[XB_TMO])) break; if (_sp > XB_SPIN_CAP) { atomicAdd(&(bar)[XB_TMO], 1u); break; } } } } while (0)

struct XcdBarrier {
    unsigned* bar; unsigned x;
    volatile LAS unsigned* st;
};

__device__ __forceinline__ XcdBarrier xcd_barrier_post(unsigned* bar, volatile LAS unsigned* st) {
    XcdBarrier b; b.bar = bar; b.x = xb_xcc_id(); b.st = st;
    if (threadIdx.x == 0) (void)xb_add(&bar[XB_XCNT(b.x)], 1u);
    return b;
}
__device__ __forceinline__ void xcd_barrier_complete(unsigned* bar, unsigned x, unsigned& nloc, unsigned& nx) {
    const unsigned G = gridDim.x * gridDim.y * gridDim.z;
    unsigned sum, cnt, mine, sp = 0u;
    for (;;) {
        sum = 0u; cnt = 0u; mine = 0u;
#pragma unroll
        for (unsigned j = 0; j < 16; ++j) { const unsigned c = xb_ld(&bar[XB_XCNT(j)]); sum += c; cnt += (c > 0u) ? 1u : 0u; mine = (j == x) ? c : mine; }
        if (sum == G) break;
        __builtin_amdgcn_s_sleep(1);
        if ((++sp & 255u) == 0u) { if (xb_ld(&bar[XB_TMO])) break; if (sp > XB_SPIN_CAP) { atomicAdd(&bar[XB_TMO], 1u); break; } }
    }
    nloc = mine > 0u ? mine : 1u; nx = cnt > 0u ? cnt : 1u;
}

__device__ __forceinline__ void xcd_barrier(const XcdBarrier& b) {
    asm volatile("s_waitcnt vmcnt(0)" ::: "memory");
    __syncthreads();
    if (threadIdx.x == 0) {
        unsigned* bar = b.bar;
        __builtin_amdgcn_s_waitcnt(0);
        unsigned nloc = b.st[0], nx = b.st[1];
        if (nloc == 0u) { xcd_barrier_complete(bar, b.x, nloc, nx); b.st[0] = nloc; b.st[1] = nx; }
        const unsigned old = xb_add(&bar[XB_XSUB(b.x)], 1u);
        const unsigned gen = old / nloc;
        if (old + 1u == (gen + 1u) * nloc) {
            __builtin_amdgcn_fence(__ATOMIC_RELEASE, "agent");
            asm volatile("s_waitcnt vmcnt(0)" ::: "memory");
            const unsigned og = xb_add(&bar[XB_TOP], 1u);
            const unsigned tg = og / nx;
            if (og + 1u == (tg + 1u) * nx) xb_add(&bar[XB_TOPGEN], 1u);
            else XB_SPIN(xb_ld(&bar[XB_TOPGEN]) == tg, bar);
            __builtin_amdgcn_fence(__ATOMIC_ACQUIRE, "agent");
            xb_add(&bar[XB_XGEN(b.x)], 1u);
            asm volatile("s_waitcnt vmcnt(0)" ::: "memory");
        } else {
            XB_SPIN(xb_ld(&bar[XB_XGEN(b.x)]) == gen, bar);
            __builtin_amdgcn_fence(__ATOMIC_ACQUIRE, "agent");
            asm volatile("s_waitcnt vmcnt(0)" ::: "memory");
        }
    }
    __syncthreads();
}
constexpr int U0_MOD = 192, U0_TR = 8784, U0_PEER = 2048, U0_ROPE = 192, U0_BIAS = 64, U0_K12 = 8, U0_ZERO = 8;
constexpr int U0_TOTAL = U0_MOD + U0_TR + U0_PEER + U0_ROPE + U0_BIAS + U0_K12 + U0_ZERO;

struct TrDesc { int in_idx; size_t in_off; int K, N, Npad; size_t ws_off; int ntiles; };
__device__ __forceinline__ TrDesc tr_desc(int m) {
    switch (m) {
        case 0:  return TrDesc{6, 0, 2048, 3904, 3968, WS_WIN0, 1984};
        case 1:  return TrDesc{8, 0, 512, 1536, 1536, WS_WUQ, 192};
        case 2:  return TrDesc{10, 0, 256, 2048, 2048, WS_WUKV, 128};
        case 3:  return TrDesc{11, 0, 2048, 2048, 2048, WS_WOUT0, 1024};
        case 4:  return TrDesc{12, 0, 2048, 3632, 3712, WS_WNSAIN, 1856};
        case 5:  return TrDesc{15, 0, 4096, 256, 256, WS_W1K, 256};
        case 6:  return TrDesc{17, 0, 4096, 256, 256, WS_W1V, 256};
        case 7:  return TrDesc{16, 0, 256, 128, 128, WS_W2K, 8};
        case 8:  return TrDesc{18, 0, 256, 128, 128, WS_W2V, 8};
        case 9:  return TrDesc{19, 0, 2048, 2048, 2048, WS_WNSAOUT, 1024};
        case 10: return TrDesc{23, 0, 2048, 2048, 2048, WS_WPQ, 1024};
        default: return TrDesc{23, (size_t)2048 * 2048, 2048, 2048, 2048, WS_WPQ + (size_t)2048 * 2048 * 2, 1024};
    }
}

__device__ __forceinline__ void p0_mod_unit(const Args& A, unsigned char* lds, int u) {
    const int tid = opaque_tid();
    float* sc = (float*)lds;
    float* red = (float*)(lds + 16384);
    const int set = u / 48, cc = u % 48;
    const int layer = set >> 1, kind = set & 1;
    const float* w = (kind ? A.in[21] : A.in[4]) + (size_t)layer * 2048 * 6144;
    const float* bias = (kind ? A.in[22] : A.in[5]) + (size_t)layer * 6144;
    const float* c = A.in[1];
    for (int i = tid; i < 4096; i += NTHREADS) { const float v = c[i]; sc[i] = v / (1.f + __expf(-v)); }
    __syncthreads();
    const int l32 = tid & 31, kg = tid >> 5;
    const int col = cc * 128 + l32 * 4;
    float a0[4] = {0, 0, 0, 0}, a1[4] = {0, 0, 0, 0};
    const float* wp = w + (size_t)(kg * 128) * 6144 + col;
#pragma unroll 8
    for (int i = 0; i < 128; ++i) {
        const f32x4 wv = *(const f32x4*)(wp + (size_t)i * 6144);
        const float s0 = sc[kg * 128 + i], s1 = sc[2048 + kg * 128 + i];
#pragma unroll
        for (int j = 0; j < 4; ++j) { a0[j] += s0 * wv[j]; a1[j] += s1 * wv[j]; }
    }
#pragma unroll
    for (int j = 0; j < 4; ++j) { red[(kg * 2 + 0) * 128 + l32 * 4 + j] = a0[j]; red[(kg * 2 + 1) * 128 + l32 * 4 + j] = a1[j]; }
    __syncthreads();
    if (tid < 256) {
        const int b = tid >> 7, cl = tid & 127;
        float s = 0;
#pragma unroll
        for (int g = 0; g < 16; ++g) s += red[(g * 2 + b) * 128 + cl];
        float* mod = (float*)(WSP(A) + WS_MOD);
        mod[(size_t)(set * 2 + b) * 6144 + cc * 128 + cl] = s + bias[cc * 128 + cl];
    }
    __syncthreads();
}

__device__ __forceinline__ void p0_tr_unit(const Args& A, unsigned char* lds, int u) {
    const int tid = opaque_tid();
    int m = 0, tile = u;
    TrDesc d = tr_desc(0);
    while (tile >= d.ntiles) { tile -= d.ntiles; ++m; d = tr_desc(m); }
    const int nNt = d.Npad / 64;
    const int kt = tile / nNt, nt = tile % nNt;
    const float* src = A.in[d.in_idx] + d.in_off;
    bf16_t* dst = (bf16_t*)(WSP(A) + d.ws_off);
    float* ts = (float*)lds;
    {
        const int r = tid >> 3, cg = tid & 7;
        const int k = kt * 64 + r, n = nt * 64 + cg * 8;
        f32x4 v0 = {0, 0, 0, 0}, v1 = {0, 0, 0, 0};
        if (n < d.N) { const float* p = src + (size_t)k * d.N + n; v0 = *(const f32x4*)p; v1 = *(const f32x4*)(p + 4); }
#pragma unroll
        for (int j = 0; j < 4; ++j) { ts[r * 65 + cg * 8 + j] = v0[j]; ts[r * 65 + cg * 8 + 4 + j] = v1[j]; }
    }
    __syncthreads();
    {
        const int n = tid >> 3, kg = tid & 7;
        float v[8];
#pragma unroll
        for (int j = 0; j < 8; ++j) v[j] = ts[(kg * 8 + j) * 65 + n];
        u32x4 w = {cvtpk(v[0], v[1]), cvtpk(v[2], v[3]), cvtpk(v[4], v[5]), cvtpk(v[6], v[7])};
        *(u32x4*)(dst + (size_t)(nt * 64 + n) * d.K + kt * 64 + kg * 8) = w;
    }
    __syncthreads();
}

__device__ __forceinline__ void p0_peer_unit(const Args& A, int u) {
    const int tid = opaque_tid();
    const bool isv = u >= 1024;
    const int pu = isv ? u - 1024 : u;
    const float* src = (isv ? A.in[27] : A.in[26]) + (size_t)pu * 65536;
    bf16_t* dst = (bf16_t*)(WSP(A) + (isv ? WS_PV : WS_PU)) + (size_t)pu * 65536;
#pragma unroll 4
    for (int it = 0; it < 16; ++it) {
        const int e = (it * NTHREADS + tid) * 8;
        const f32x4 v0 = *(const f32x4*)(src + e), v1 = *(const f32x4*)(src + e + 4);
        u32x4 w = {cvtpk(v0[0], v0[1]), cvtpk(v0[2], v0[3]), cvtpk(v1[0], v1[1]), cvtpk(v1[2], v1[3])};
        *(u32x4*)(dst + e) = w;
    }
}

__device__ __forceinline__ void p0_rope_unit(const Args& A, int u) {
    const int tid = opaque_tid();
    const int* pos = (const int*)A.in[2];
#pragma unroll 1
    for (int it = 0; it < 8; ++it) {
        const int e = u * 4096 + it * NTHREADS + tid;
        if (e < T * 32) {
            const int t = e >> 5, j = e & 31;
            const float inv = powf(500000.0f, -(float)j / 32.0f);
            const float ang = (float)pos[t] * inv;
            float s, c; sincosf(ang, &s, &c);
            ((f32x2*)(WSP(A) + WS_ROPE64))[e] = f32x2{c, s};
        } else {
            const int e2 = e - T * 32;
            const int t = e2 >> 4, j = e2 & 15;
            const float inv = powf(500000.0f, -(float)j / 16.0f);
            const float ang = (float)pos[t] * inv;
            float s, c; sincosf(ang, &s, &c);
            ((f32x2*)(WSP(A) + WS_ROPE32))[e2] = f32x2{c, s};
        }
    }
}

__device__ __forceinline__ void p0_bias_unit(const Args& A, unsigned char* lds, int u) {
    const int tid = opaque_tid();
    const int mat = u >> 5, chunk = u & 31;
    const float* pe = A.in[mat ? 14 : 13];
    const float* w1 = A.in[mat ? 17 : 15];
    const int col = tid & 255, half = tid >> 8;
    float acc = 0;
    const int r0 = chunk * 128 + half * 64;
#pragma unroll 8
    for (int i = 0; i < 64; ++i) acc += pe[r0 + i] * w1[(size_t)(r0 + i) * 256 + col];
    float* red = (float*)lds;
    if (half) red[col] = acc;
    __syncthreads();
    if (!half) ((float*)(WSP(A) + WS_BIASP))[(mat * 32 + chunk) * 256 + col] = acc + red[col];
    __syncthreads();
}

__device__ __forceinline__ void p0_k12_unit(const Args& A, int u) {
    const int tid = opaque_tid();
    bf16_t* dst = (bf16_t*)(WSP(A) + WS_K12);
#pragma unroll
    for (int it = 0; it < 2; ++it) {
        const int e = u * 8192 + (it * NTHREADS + tid) * 8;
        const int layer = e >> 15, which = (e >> 14) & 1, rem = e & 16383;
        const float* src = A.in[which ? 25 : 24] + layer * 16384 + rem;
        const f32x4 v0 = *(const f32x4*)src, v1 = *(const f32x4*)(src + 4);
        u32x4 w = {cvtpk(v0[0], v0[1]), cvtpk(v0[2], v0[3]), cvtpk(v1[0], v1[1]), cvtpk(v1[2], v1[3])};
        *(u32x4*)(dst + e) = w;
    }
}

__device__ __forceinline__ void phase_prologue(const Args& A, unsigned char* lds, int bid, int nb) {
    for (int u = bid; u < U0_TOTAL; u += nb) {
        int v = u;
        if (v < U0_MOD) { p0_mod_unit(A, lds, v); continue; }
        v -= U0_MOD;
        if (v < U0_TR) { p0_tr_unit(A, lds, v); continue; }
        v -= U0_TR;
        if (v < U0_PEER) { p0_peer_unit(A, v); continue; }
        v -= U0_PEER;
        if (v < U0_ROPE) { p0_rope_unit(A, v); continue; }
        v -= U0_ROPE;
        if (v < U0_BIAS) { p0_bias_unit(A, lds, v); continue; }
        v -= U0_BIAS;
        if (v < U0_K12) { p0_k12_unit(A, v); continue; }
        v -= U0_K12;
        {
            u32x4* z = (u32x4*)(WSP(A) + WS_KCC) + (size_t)v * 8192;
            for (int i = opaque_tid(); i < 8192; i += NTHREADS) z[i] = u32x4{0u, 0u, 0u, 0u};
        }
    }
}

__device__ __forceinline__ void modnorm_row(const float* xr, const float* gain, const float* mod  , bf16_t* hr, int lane) {
    f32x4 v[8];
    float ss = 0;
#pragma unroll
    for (int i = 0; i < 8; ++i) { v[i] = *(const f32x4*)(xr + i * 256 + lane * 4); ss += v[i][0] * v[i][0] + v[i][1] * v[i][1] + v[i][2] * v[i][2] + v[i][3] * v[i][3]; }
    ss = wave_sum(ss);
    const float rinv = rsqrtf(ss * (1.0f / 2048.0f) + EPS);
#pragma unroll
    for (int i = 0; i < 8; ++i) {
        const int col = i * 256 + lane * 4;
        const f32x4 g = *(const f32x4*)(gain + col), sh = *(const f32x4*)(mod + col), scl = *(const f32x4*)(mod + 2048 + col);
        float y[4];
#pragma unroll
        for (int j = 0; j < 4; ++j) y[j] = v[i][j] * rinv * g[j] * (1.f + scl[j]) + sh[j];
        u32x2 w = {cvtpk(y[0], y[1]), cvtpk(y[2], y[3])};
        *(u32x2*)(hr + col) = w;
    }
}
__device__ __forceinline__ void phase_modnorm(const Args& A, const float* xin, const float* gain, int set, int bid, int nb) {
    const int tid = opaque_tid(), lane = tid & 63, wave = tid >> 6;
    const float* mod = (const float*)(WSP(A) + WS_MOD) + (size_t)set * 2 * 6144;
    bf16_t* H = (bf16_t*)(WSP(A) + WS_H);
    for (int u = bid; u < T / NWAVES; u += nb) {
        const int row = u * NWAVES + wave;
        modnorm_row(xin + (size_t)row * 2048, gain, mod + (row >> 13) * 6144, H + (size_t)row * 2048, lane);
    }
}

struct ALoadPlain {
    const bf16_t* A; int lda;
    __device__ __forceinline__ const bf16_t* ptr(int row, int k) const { return A + (size_t)row * lda + k; }
};
struct ALoadCmp {
    const bf16_t* base; int ld; int colbase;
    __device__ __forceinline__ const bf16_t* ptr(int row, int k) const {
        int r = row < 2 * BATCH * NCMP ? row : 2 * BATCH * NCMP - 1;
        const int g = r & 1; r >>= 1;
        const int b = r / NCMP, n = r - b * NCMP;
        const int l = k >> 7, d = k & 127;
        return base + (size_t)(b * SEQ + 16 * n + l) * ld + colbase + g * 128 + d;
    }
};

constexpr int GEMM_LDS = 98304;
template <class AL, class Epi>
__device__ __forceinline__ void gemm_phase(unsigned char* lds, const AL al, const bf16_t* __restrict__ Bt, int ldb, int M, int Npad, int K, const Epi epi, int bid, int nb) {
    const int tid = opaque_tid(), lane = tid & 63, wave = tid >> 6, l31 = lane & 31, hi = lane >> 5;
    const int wm = wave >> 1, wn = wave & 1;
    const int nNt = Npad / 128, nU = (M / 256) * nNt, nk = K / 64;
    const int swz = (l31 >> 1) & 7;
    for (int u = bid; u < nU; u += nb) {
        const int mt = u / nNt, nt = u - mt * nNt;
        const int m0 = mt * 256, n0 = nt * 128;
        f32x16 acc[2][2];
#pragma unroll
        for (int i = 0; i < 2; ++i)
#pragma unroll
            for (int j = 0; j < 2; ++j)
#pragma unroll
                for (int r = 0; r < 16; ++r) acc[i][j][r] = 0.f;
        u32x4 ra[4], rb[2];
        auto gload = [&](int kt) {
#pragma unroll
            for (int i = 0; i < 4; ++i) { const int q = tid + NTHREADS * i, row = q >> 3, c = q & 7; ra[i] = *(const u32x4*)al.ptr(m0 + row, kt * 64 + c * 8); }
#pragma unroll
            for (int i = 0; i < 2; ++i) { const int q = tid + NTHREADS * i, row = q >> 3, c = q & 7; rb[i] = *(const u32x4*)(Bt + (size_t)(n0 + row) * ldb + kt * 64 + c * 8); }
        };
        auto lstore = [&](int buf) {
            unsigned char* la = lds + buf * 32768; unsigned char* lb = lds + 65536 + buf * 16384;
#pragma unroll
            for (int i = 0; i < 4; ++i) { const int q = tid + NTHREADS * i, row = q >> 3, c = q & 7; *(u32x4*)(la + row * 128 + ((c ^ ((row >> 1) & 7)) << 4)) = ra[i]; }
#pragma unroll
            for (int i = 0; i < 2; ++i) { const int q = tid + NTHREADS * i, row = q >> 3, c = q & 7; *(u32x4*)(lb + row * 128 + ((c ^ ((row >> 1) & 7)) << 4)) = rb[i]; }
        };
        gload(0); lstore(0); __syncthreads();
        for (int kt = 0; kt < nk; ++kt) {
            if (kt + 1 < nk) gload(kt + 1);
            const unsigned char* la = lds + (kt & 1) * 32768 + (wm * 64 + l31) * 128;
            const unsigned char* lb = lds + 65536 + (kt & 1) * 16384 + (wn * 64 + l31) * 128;
#pragma unroll
            for (int ks = 0; ks < 4; ++ks) {
                const int co = ((ks * 2 + hi) ^ swz) << 4;
                const bf16x8 a0 = *(const bf16x8*)(la + co), a1 = *(const bf16x8*)(la + 32 * 128 + co);
                const bf16x8 b0 = *(const bf16x8*)(lb + co), b1 = *(const bf16x8*)(lb + 32 * 128 + co);
                acc[0][0] = __builtin_amdgcn_mfma_f32_32x32x16_bf16(a0, b0, acc[0][0], 0, 0, 0);
                acc[0][1] = __builtin_amdgcn_mfma_f32_32x32x16_bf16(a0, b1, acc[0][1], 0, 0, 0);
                acc[1][0] = __builtin_amdgcn_mfma_f32_32x32x16_bf16(a1, b0, acc[1][0], 0, 0, 0);
                acc[1][1] = __builtin_amdgcn_mfma_f32_32x32x16_bf16(a1, b1, acc[1][1], 0, 0, 0);
            }
            if (kt + 1 < nk) lstore((kt + 1) & 1);
            __syncthreads();
        }
        epi(acc, m0 + wm * 64, n0 + wn * 64, lane);
    }
}

__device__ __forceinline__ void store_bf16_tile(const f32x16 (&acc)[2][2], bf16_t* C, int ldc, int N, int row0, int col0, int lane) {
    const int l31 = lane & 31, hi = lane >> 5;
#pragma unroll
    for (int ni = 0; ni < 2; ++ni) {
        const int col = col0 + ni * 32 + l31;
#pragma unroll
        for (int mi = 0; mi < 2; ++mi)
#pragma unroll
            for (int r = 0; r < 16; ++r) {
                const float v = acc[mi][ni][r];
                const float vn = __shfl_xor(v, 1);
                if ((l31 & 1) == 0 && col < N) *(unsigned*)(C + (size_t)(row0 + mi * 32 + crow(r, hi)) * ldc + col) = cvtpk(v, vn);
            }
    }
}
struct EpiBf16 {
    bf16_t* C; int ldc; int N;
    __device__ __forceinline__ void operator()(f32x16 (&acc)[2][2], int row0, int col0, int lane) const { store_bf16_tile(acc, C, ldc, N, row0, col0, lane); }
};
struct EpiMlaQ {
    bf16_t* C; const f32x2* rope64;
    __device__ __forceinline__ void operator()(f32x16 (&acc)[2][2], int row0, int col0, int lane) const {
        const int l31 = lane & 31, hi = lane >> 5;
        if ((col0 % 192) == 128) {
#pragma unroll
            for (int mi = 0; mi < 2; ++mi)
#pragma unroll
                for (int r = 0; r < 16; ++r) {
                    const int row = row0 + mi * 32 + crow(r, hi);
                    const f32x2 cs = rope64[(size_t)row * 32 + l31];
                    const float x1 = acc[mi][0][r], x2 = acc[mi][1][r];
                    acc[mi][0][r] = x1 * cs[0] - x2 * cs[1];
                    acc[mi][1][r] = x2 * cs[0] + x1 * cs[1];
                }
        }
        store_bf16_tile(acc, C, 1536, 1536, row0, col0, lane);
    }
};
struct EpiNsaIn {
    bf16_t* C; const f32x2* rope32;
    __device__ __forceinline__ void operator()(f32x16 (&acc)[2][2], int row0, int col0, int lane) const {
        const int l31 = lane & 31, hi = lane >> 5;
#pragma unroll
        for (int ni = 0; ni < 2; ++ni) {
            const int cb = col0 + ni * 32, hb = cb >> 7;
            const bool is_rope = ((cb & 127) == 0) && (hb < 18 || hb == 20 || hb == 21 || hb == 24 || hb == 25);
            if (is_rope) {
#pragma unroll
                for (int mi = 0; mi < 2; ++mi)
#pragma unroll
                    for (int r = 0; r < 16; ++r) {
                        const int row = row0 + mi * 32 + crow(r, hi);
                        const f32x2 cs = rope32[(size_t)row * 16 + (l31 & 15)];
                        const float own = acc[mi][ni][r];
                        const float oth = __shfl_xor(own, 16);
                        acc[mi][ni][r] = (l31 < 16) ? own * cs[0] - oth * cs[1] : own * cs[0] + oth * cs[1];
                    }
            }
            if (cb >= 3584) {
#pragma unroll
                for (int mi = 0; mi < 2; ++mi)
#pragma unroll
                    for (int r = 0; r < 16; ++r) acc[mi][ni][r] = 1.f / (1.f + __expf(-acc[mi][ni][r]));
            }
        }
        store_bf16_tile(acc, C, NSA_IN, NSA_IN, row0, col0, lane);
    }
};
struct EpiResid {
    const float* xin; float* xout; const float* gate; float gmul;
    __device__ __forceinline__ void operator()(f32x16 (&acc)[2][2], int row0, int col0, int lane) const {
        const int l31 = lane & 31, hi = lane >> 5;
        const float* gp = gate + (row0 >> 13) * 6144;
#pragma unroll
        for (int ni = 0; ni < 2; ++ni) {
            const int col = col0 + ni * 32 + l31;
            const float g = gp[col] * gmul;
#pragma unroll
            for (int mi = 0; mi < 2; ++mi)
#pragma unroll
                for (int r = 0; r < 16; ++r) {
                    const size_t o = (size_t)(row0 + mi * 32 + crow(r, hi)) * 2048 + col;
                    xout[o] = xin[o] + g * acc[mi][ni][r];
                }
        }
    }
};
struct EpiCmpHid {
    bf16_t* C; const float* biasp;
    __device__ __forceinline__ void operator()(f32x16 (&acc)[2][2], int row0, int col0, int lane) const {
        const int l31 = lane & 31;
#pragma unroll
        for (int ni = 0; ni < 2; ++ni) {
            const int col = col0 + ni * 32 + l31;
            float b = 0;
#pragma unroll 8
            for (int c = 0; c < 32; ++c) b += biasp[c * 256 + col];
#pragma unroll
            for (int mi = 0; mi < 2; ++mi)
#pragma unroll
                for (int r = 0; r < 16; ++r) acc[mi][ni][r] = gelu_tanh(acc[mi][ni][r] + b);
        }
        store_bf16_tile(acc, C, 256, 256, row0, col0, lane);
    }
};
struct EpiCmpOut {
    bf16_t* C;
    __device__ __forceinline__ void operator()(f32x16 (&acc)[2][2], int row0, int col0, int lane) const {
        const int l31 = lane & 31, hi = lane >> 5;
#pragma unroll
        for (int ni = 0; ni < 2; ++ni) {
            const int col = col0 + ni * 32 + l31;
#pragma unroll
            for (int mi = 0; mi < 2; ++mi)
#pragma unroll
                for (int r = 0; r < 16; ++r) {
                    const float v = acc[mi][ni][r];
                    const float vn = __shfl_xor(v, 1);
                    int rr = row0 + mi * 32 + crow(r, hi);
                    if ((l31 & 1) == 0 && rr < 2 * BATCH * NCMP) {
                        const int g = rr & 1; rr >>= 1;
                        const int b = rr / NCMP, n = rr - b * NCMP;
                        *(unsigned*)(C + (size_t)((b * NCMP_PAD + n) * 2 + g) * 128 + col) = cvtpk(v, vn);
                    }
                }
        }
    }
};

__device__ __forceinline__ void phase_mla_prep(const Args& A, int bid, int nb) {
    const int tid = opaque_tid(), lane = tid & 63, wave = tid >> 6;
    const bf16_t* BIG = (const bf16_t*)(WSP(A) + WS_BIG);
    bf16_t* CQN = (bf16_t*)(WSP(A) + WS_CQN); bf16_t* CKVN = (bf16_t*)(WSP(A) + WS_CKVN); bf16_t* KVM = (bf16_t*)(WSP(A) + WS_KVM);
    const f32x2* rope64 = (const f32x2*)(WSP(A) + WS_ROPE64);
    const float* qn = A.in[7]; const float* kvn = A.in[9];
    for (int u = bid; u < T / NWAVES; u += nb) {
        const int t = u * NWAVES + wave;
        const bf16_t* row = BIG + (size_t)t * SBMLA_IN;
        {
            const u32x4 w = *(const u32x4*)(row + 3072 + lane * 8);
            float x[8] = {bflo(w[0]), bfhi(w[0]), bflo(w[1]), bfhi(w[1]), bflo(w[2]), bfhi(w[2]), bflo(w[3]), bfhi(w[3])};
            float ss = 0;
#pragma unroll
            for (int j = 0; j < 8; ++j) ss += x[j] * x[j];
            ss = wave_sum(ss);
            const float rinv = rsqrtf(ss * (1.f / 512.f) + EPS);
            const f32x4 g0 = *(const f32x4*)(qn + lane * 8), g1 = *(const f32x4*)(qn + lane * 8 + 4);
            u32x4 o = {cvtpk(x[0] * rinv * g0[0], x[1] * rinv * g0[1]), cvtpk(x[2] * rinv * g0[2], x[3] * rinv * g0[3]),
                       cvtpk(x[4] * rinv * g1[0], x[5] * rinv * g1[1]), cvtpk(x[6] * rinv * g1[2], x[7] * rinv * g1[3])};
            *(u32x4*)(CQN + (size_t)t * 512 + lane * 8) = o;
        }
        {
            const u32x2 w = *(const u32x2*)(row + 3584 + lane * 4);
            float x[4] = {bflo(w[0]), bfhi(w[0]), bflo(w[1]), bfhi(w[1])};
            float ss = x[0] * x[0] + x[1] * x[1] + x[2] * x[2] + x[3] * x[3];
            ss = wave_sum(ss);
            const float rinv = rsqrtf(ss * (1.f / 256.f) + EPS);
            const f32x4 g = *(const f32x4*)(kvn + lane * 4);
            u32x2 o = {cvtpk(x[0] * rinv * g[0], x[1] * rinv * g[1]), cvtpk(x[2] * rinv * g[2], x[3] * rinv * g[3])};
            *(u32x2*)(CKVN + (size_t)t * 256 + lane * 4) = o;
        }
        {
            const float x = bf2f(row[3840 + lane]);
            const float oth = __shfl_xor(x, 32);
            const f32x2 cs = rope64[(size_t)t * 32 + (lane & 31)];
            const float y = (lane < 32) ? x * cs[0] - oth * cs[1] : x * cs[0] + oth * cs[1];
            KVM[(size_t)t * KVM_LD + 2048 + lane] = (bf16_t)(cvtpk(y, y) & 0xFFFFu);
        }
    }
}
constexpr int KSTR128 = 272, KSTR192 = 400, VSTR = 320;
constexpr int ATT_K_BYTES = 64 * KSTR192;
constexpr int ATT_V_BYTES = 64 * VSTR;
constexpr int ATT_KOFF = 0, ATT_VOFF = 2 * ATT_K_BYTES, ATT_MISC = ATT_VOFF + 2 * ATT_V_BYTES;

template <int NKS, int KSTR>
__device__ __forceinline__ void qk_tile(f32x16& p0, f32x16& p1, const unsigned char* kb_lane, const bf16x8* qr) {
#pragma unroll
    for (int r = 0; r < 16; ++r) { p0[r] = 0.f; p1[r] = 0.f; }
#pragma unroll
    for (int ks = 0; ks < NKS; ++ks) {
        const bf16x8 a0 = *(const bf16x8*)(kb_lane + ks * 32);
        const bf16x8 a1 = *(const bf16x8*)(kb_lane + 32 * KSTR + ks * 32);
        p0 = __builtin_amdgcn_mfma_f32_32x32x16_bf16(a0, qr[ks], p0, 0, 0, 0);
        p1 = __builtin_amdgcn_mfma_f32_32x32x16_bf16(a1, qr[ks], p1, 0, 0, 0);
        if ((ks & 3) == 3) __builtin_amdgcn_sched_barrier(0);
    }
}
__device__ __forceinline__ s16x4 tr_read(const unsigned char* p) {
    return __builtin_amdgcn_ds_read_tr16_b64_v4i16((LAS s16x4*)p);
}
__device__ __forceinline__ void pv_tile(f32x16 (&o)[4], const unsigned char* vb_lane, const bf16x8 (&pb)[4]) {
#pragma unroll
    for (int dt = 0; dt < 4; ++dt) {
#pragma unroll
        for (int s = 0; s < 4; ++s) {
            const s16x4 lo = tr_read(vb_lane + (s * 16) * VSTR + dt * 64);
            const s16x4 hh = tr_read(vb_lane + (s * 16 + 8) * VSTR + dt * 64);
            const bf16x8 a = {lo[0], lo[1], lo[2], lo[3], hh[0], hh[1], hh[2], hh[3]};
            o[dt] = __builtin_amdgcn_mfma_f32_32x32x16_bf16(a, pb[s], o[dt], 0, 0, 0);
        }
        __builtin_amdgcn_sched_barrier(0);
    }
}
__device__ __forceinline__ bf16x8 pack8f(const f32x16& p, int b) {
    u32x4 w = {cvtpk(p[b + 0], p[b + 1]), cvtpk(p[b + 2], p[b + 3]), cvtpk(p[b + 4], p[b + 5]), cvtpk(p[b + 6], p[b + 7])};
    return *reinterpret_cast<bf16x8*>(&w);
}
__device__ __forceinline__ int vb_lane_off(int lane) {
    return (4 * (lane >> 5) + ((lane >> 2) & 3)) * VSTR + (16 * ((lane >> 4) & 1) + 4 * (lane & 3)) * 2;
}
__device__ __forceinline__ void softmax_step(f32x16& p0, f32x16& p1, float& m, float& l, f32x16 (&o)[4], float c2, bf16x8 (&pb)[4]) {
    float mx = p0[0];
#pragma unroll
    for (int r = 1; r < 16; ++r) mx = fmaxf(mx, p0[r]);
#pragma unroll
    for (int r = 0; r < 16; ++r) mx = fmaxf(mx, p1[r]);
    mx = fmaxf(mx, __shfl_xor(mx, 32));
    const float mn = fmaxf(m, mx);
    const float alpha = __builtin_amdgcn_exp2f((m - mn) * c2);
    const float mc = mn * c2;
    float rs = 0.f;
#pragma unroll
    for (int r = 0; r < 16; ++r) { p0[r] = __builtin_amdgcn_exp2f(p0[r] * c2 - mc); rs += p0[r]; }
#pragma unroll
    for (int r = 0; r < 16; ++r) { p1[r] = __builtin_amdgcn_exp2f(p1[r] * c2 - mc); rs += p1[r]; }
    rs += __shfl_xor(rs, 32);
    l = l * alpha + rs;
    m = mn;
    if (__any(alpha != 1.f)) {
#pragma unroll
        for (int dt = 0; dt < 4; ++dt)
#pragma unroll
            for (int r = 0; r < 16; ++r) o[dt][r] *= alpha;
    }
    pb[0] = pack8f(p0, 0); pb[1] = pack8f(p0, 8); pb[2] = pack8f(p1, 0); pb[3] = pack8f(p1, 8);
}
__device__ __forceinline__ void store_ot_bf16(const f32x16 (&o)[4], float sc, bf16_t* orow  , int hi) {
#pragma unroll
    for (int dt = 0; dt < 4; ++dt)
#pragma unroll
        for (int g = 0; g < 4; ++g) {
            u32x2 w = {cvtpk(o[dt][4 * g] * sc, o[dt][4 * g + 1] * sc), cvtpk(o[dt][4 * g + 2] * sc, o[dt][4 * g + 3] * sc)};
            *(u32x2*)(orow + dt * 32 + 8 * g + 4 * hi) = w;
        }
}

__device__ __forceinline__ void mla_item(const Args& A, unsigned char* lds, int b, int h, int qt) {
    const int tid = opaque_tid(), lane = tid & 63, wave = tid >> 6, l31 = lane & 31, hi = lane >> 5;
    const bf16_t* QM = (const bf16_t*)(WSP(A) + WS_QM); const bf16_t* KVM = (const bf16_t*)(WSP(A) + WS_KVM);
    bf16_t* O = (bf16_t*)(WSP(A) + WS_O);
    const int q0 = qt * 256, qw = q0 + wave * 32, t = qw + l31;
    const size_t tokb = (size_t)b * SEQ;
    bf16x8 qr[12];
    {
        const bf16_t* qp = QM + (tokb + t) * 1536 + h * 192 + hi * 8;
#pragma unroll
        for (int ks = 0; ks < 12; ++ks) qr[ks] = *(const bf16x8*)(qp + ks * 16);
    }
    const int nkt = (q0 + 256) / 64;
    u32x4 rk[3], rv[2];
    unsigned okb[3], ovb[2], lkb[3], lvb[2];
#pragma unroll
    for (int i = 0; i < 3; ++i) {
        const int q = tid + NTHREADS * i, row = q / 24, c = q - row * 24;
        okb[i] = (unsigned)(row * KVM_LD + ((c < 16) ? h * 256 + c * 8 : 2048 + (c - 16) * 8)) * 2u;
        lkb[i] = (unsigned)(row * KSTR192 + c * 16);
    }
#pragma unroll
    for (int i = 0; i < 2; ++i) {
        const int q = tid + NTHREADS * i, row = q >> 4, c = q & 15;
        ovb[i] = (unsigned)(row * KVM_LD + h * 256 + 128 + c * 8) * 2u;
        lvb[i] = (unsigned)(row * VSTR + c * 16);
    }
    auto gload = [&](int kt) {
        const unsigned char* base = (const unsigned char*)(KVM + (tokb + (size_t)kt * 64) * KVM_LD);
#pragma unroll
        for (int i = 0; i < 3; ++i) rk[i] = *(const u32x4*)(base + okb[i]);
#pragma unroll
        for (int i = 0; i < 2; ++i) rv[i] = *(const u32x4*)(base + ovb[i]);
    };
    auto lstore = [&](int buf) {
        unsigned char* kb = lds + ATT_KOFF + buf * ATT_K_BYTES; unsigned char* vb = lds + ATT_VOFF + buf * ATT_V_BYTES;
#pragma unroll
        for (int i = 0; i < 3; ++i) *(u32x4*)(kb + lkb[i]) = rk[i];
#pragma unroll
        for (int i = 0; i < 2; ++i) *(u32x4*)(vb + lvb[i]) = rv[i];
    };
    f32x16 o[4];
#pragma unroll
    for (int dt = 0; dt < 4; ++dt)
#pragma unroll
        for (int r = 0; r < 16; ++r) o[dt][r] = 0.f;
    float m = -1e30f, l = 0.f;
    const float c2 = 0.07216878364870322f * 1.4426950408889634f;
    const int kl_off = l31 * KSTR192 + hi * 16, vl_off = vb_lane_off(lane);
    gload(0); lstore(0); __syncthreads();
    for (int kt = 0; kt < nkt; ++kt) {
        if (kt + 1 < nkt) gload(kt + 1);
        if (kt * 64 <= qw + 31) {
            f32x16 p0, p1;
            qk_tile<12, KSTR192>(p0, p1, lds + ATT_KOFF + (kt & 1) * ATT_K_BYTES + kl_off, qr);
            if (kt * 64 + 63 > qw) {
                const int dq = t - kt * 64 - 4 * hi;
#pragma unroll
                for (int r = 0; r < 16; ++r) {
                    const int cb = (r & 3) + 8 * (r >> 2);
                    if (cb > dq) p0[r] = -__builtin_inff();
                    if (cb + 32 > dq) p1[r] = -__builtin_inff();
                }
            }
            bf16x8 pb[4];
            softmax_step(p0, p1, m, l, o, c2, pb);
            pv_tile(o, lds + ATT_VOFF + (kt & 1) * ATT_V_BYTES + vl_off, pb);
        }
        if (kt + 1 < nkt) lstore((kt + 1) & 1);
        __syncthreads();
    }
    store_ot_bf16(o, ABL_MLA / l, O + (tokb + t) * 2048 + 1024 + h * 128, hi);
}

__device__ __forceinline__ void sb_item(const Args& A, unsigned char* lds, int b, int h, int qt) {
    const int tid = opaque_tid(), lane = tid & 63, wave = tid >> 6, l31 = lane & 31, hi = lane >> 5;
    const bf16_t* BIG = (const bf16_t*)(WSP(A) + WS_BIG);
    bf16_t* O = (bf16_t*)(WSP(A) + WS_O);
    volatile int* flags = (volatile int*)(lds + ATT_MISC);
    const int q0 = qt * 256, qw = q0 + wave * 32, t = qw + l31;
    const size_t tokb = (size_t)b * SEQ;
    bf16x8 qr[8];
    {
        const bf16_t* qp = BIG + (tokb + t) * SBMLA_IN + h * 128 + hi * 8;
#pragma unroll
        for (int ks = 0; ks < 8; ++ks) qr[ks] = *(const bf16x8*)(qp + ks * 16);
    }
    bf16x8 tri[2];
#pragma unroll
    for (int s2 = 0; s2 < 2; ++s2)
#pragma unroll
        for (int jj = 0; jj < 8; ++jj) tri[s2][jj] = (16 * s2 + 8 * (jj >> 2) + 4 * hi + (jj & 3) > l31) ? (short)0x3F80 : (short)0;
    u32x4 rk[2], rv[2];
    unsigned ogb[2], lkb[2], lvb[2];
#pragma unroll
    for (int i = 0; i < 2; ++i) {
        const int q = tid + NTHREADS * i, row = q >> 4, c = q & 15;
        ogb[i] = (unsigned)(row * SBMLA_IN + c * 8) * 2u; lkb[i] = (unsigned)(row * KSTR128 + c * 16); lvb[i] = (unsigned)(row * VSTR + c * 16);
    }
    auto gload = [&](int kt) {
        const unsigned char* base = (const unsigned char*)(BIG + (tokb + (size_t)kt * 64) * SBMLA_IN + h * 128);
#pragma unroll
        for (int i = 0; i < 2; ++i) { rk[i] = *(const u32x4*)(base + 2048 + ogb[i]); rv[i] = *(const u32x4*)(base + 4096 + ogb[i]); }
    };
    auto lstore = [&](int buf) {
        unsigned char* kb = lds + ATT_KOFF + buf * ATT_K_BYTES; unsigned char* vb = lds + ATT_VOFF + buf * ATT_V_BYTES;
#pragma unroll
        for (int i = 0; i < 2; ++i) { *(u32x4*)(kb + lkb[i]) = rk[i]; *(u32x4*)(vb + lvb[i]) = rv[i]; }
    };
    f32x16 o[4];
#pragma unroll
    for (int dt = 0; dt < 4; ++dt)
#pragma unroll
        for (int r = 0; r < 16; ++r) o[dt][r] = 0.f;
    float R = 0.f;
    bool done = false;
    const float scale = 0.08838834764831845f;
    const int kt_hi = (q0 + 254) / 64, ktw = (qw + 30) / 64;
    const int kl_off = l31 * KSTR128 + hi * 16, vl_off = vb_lane_off(lane);
    gload(kt_hi); lstore(0); __syncthreads();
    int it = 0;
    for (int kt = kt_hi; kt >= 0; --kt, ++it) {
        if (kt > 0) gload(kt - 1);
        if (kt <= ktw && !done) {
            f32x16 p0, p1;
            qk_tile<8, KSTR128>(p0, p1, lds + ATT_KOFF + (it & 1) * ATT_K_BYTES + kl_off, qr);
            const int dq = t - kt * 64 - 4 * hi;
            float tot0 = 0.f, tot1 = 0.f;
            u32x4 w0, w1, w2, w3;
            auto sbf = [&](float pz, bool v, float& tot, float& lbo) -> float {
                const float z = pz * scale;
                const float lp = __logf(1.f + __expf(-fabsf(z)));
                const float lb = fminf(z, 0.f) - lp;
                const float l1 = v ? lb - z : 0.f;
                tot += l1; lbo = v ? lb : -__builtin_inff();
                return l1;
            };
#pragma unroll
            for (int r = 0; r < 16; r += 2) {
                const int cb0 = (r & 3) + 8 * (r >> 2), cb1 = ((r + 1) & 3) + 8 * ((r + 1) >> 2);
                float t0_, t1_, t2_, t3_;
                const float a0 = sbf(p0[r], cb0 < dq, tot0, t0_), a1 = sbf(p0[r + 1], cb1 < dq, tot0, t1_);
                const float b0 = sbf(p1[r], cb0 + 32 < dq, tot1, t2_), b1 = sbf(p1[r + 1], cb1 + 32 < dq, tot1, t3_);
                p0[r] = t0_; p0[r + 1] = t1_; p1[r] = t2_; p1[r + 1] = t3_;
                const unsigned pa = cvtpk(a0, a1), pbb = cvtpk(b0, b1);
                if (r < 8) { w0[r >> 1] = pa; w2[r >> 1] = pbb; } else { w1[(r - 8) >> 1] = pa; w3[(r - 8) >> 1] = pbb; }
            }
            tot0 += __shfl_xor(tot0, 32); tot1 += __shfl_xor(tot1, 32);
            bf16x8 lf[4];
            lf[0] = *reinterpret_cast<bf16x8*>(&w0); lf[1] = *reinterpret_cast<bf16x8*>(&w1); lf[2] = *reinterpret_cast<bf16x8*>(&w2); lf[3] = *reinterpret_cast<bf16x8*>(&w3);
            f32x16 c0, c1;
            const float r1 = R + tot1;
#pragma unroll
            for (int r = 0; r < 16; ++r) { c1[r] = R; c0[r] = r1; }
            c1 = __builtin_amdgcn_mfma_f32_32x32x16_bf16(tri[0], lf[2], c1, 0, 0, 0);
            c1 = __builtin_amdgcn_mfma_f32_32x32x16_bf16(tri[1], lf[3], c1, 0, 0, 0);
            c0 = __builtin_amdgcn_mfma_f32_32x32x16_bf16(tri[0], lf[0], c0, 0, 0, 0);
            c0 = __builtin_amdgcn_mfma_f32_32x32x16_bf16(tri[1], lf[1], c0, 0, 0, 0);
#pragma unroll
            for (int r = 0; r < 16; ++r) { p0[r] = __expf(p0[r] + c0[r]); p1[r] = __expf(p1[r] + c1[r]); }
            R = r1 + tot0;
            bf16x8 pb[4] = {pack8f(p0, 0), pack8f(p0, 8), pack8f(p1, 0), pack8f(p1, 8)};
            pv_tile(o, lds + ATT_VOFF + (it & 1) * ATT_V_BYTES + vl_off, pb);
            done = __all(R < -104.f);
        }
        if (lane == 0) flags[(it & 1) * 8 + wave] = done ? 1 : 0;
        if (kt > 0) lstore((it + 1) & 1);
        __syncthreads();
        int nd = 0;
#pragma unroll
        for (int w = 0; w < 8; ++w) nd += flags[(it & 1) * 8 + w];
        if (nd == 8) break;
    }
    store_ot_bf16(o, ABL_SB, O + (tokb + t) * 2048 + h * 128, hi);
    __syncthreads();
}

__device__ __forceinline__ void phase_attn0(const Args& A, unsigned char* lds, int bid, int nb) {
    for (int u = bid; u < 256; u += nb) {
        const int bh = u >> 4, p = u & 15;
#pragma unroll 1
        for (int rep = 0; rep < 2; ++rep) mla_item(A, lds, bh >> 3, bh & 7, rep ? p : 31 - p);
    }
    for (int v = bid; v < 512; v += nb) {
        const int bh = v >> 5, qt = v & 31;
        sb_item(A, lds, bh >> 3, bh & 7, qt);
    }
}
__device__ __forceinline__ unsigned f2sort(float f) { const unsigned u = __float_as_uint(f); return u ^ ((u & 0x80000000u) ? 0xFFFFFFFFu : 0x80000000u); }
__device__ __forceinline__ float sort2f(unsigned s) { const unsigned u = (s & 0x80000000u) ? (s ^ 0x80000000u) : ~s; return __uint_as_float(u); }
__device__ __forceinline__ unsigned umax3(unsigned a, unsigned b, unsigned c) { return max(max(a, b), c); }

__device__ __forceinline__ void top16_of_128(unsigned (&k)[64], unsigned* out  , int lane) {
#pragma unroll 1
    for (int it = 0; it < 16; ++it) {
        unsigned mx = k[0];
#pragma unroll
        for (int i = 1; i < 63; i += 2) mx = umax3(mx, k[i], k[i + 1]);
        mx = max(mx, k[63]);
        const unsigned pm = (unsigned)__shfl_xor((int)mx, 32);
        const unsigned g = max(mx, pm);
        out[it * 64 + lane] = g;
#pragma unroll
        for (int i = 0; i < 64; ++i) k[i] = (k[i] == g) ? 0u : k[i];
    }
}

constexpr int TOPK_STAGE = 2 * 128 * KSTR128;
constexpr int TOPK_LDS = TOPK_STAGE + 8 * 8192;
__device__ __forceinline__ void phase_topk(const Args& A, unsigned char* lds, int layer, int bid, int nb) {
    const int tid = opaque_tid(), lane = tid & 63, wave = tid >> 6, l31 = lane & 31, hi = lane >> 5;
    const bf16_t* PQ = (const bf16_t*)(WSP(A) + WS_PQ);
    const bf16_t* K12 = (const bf16_t*)(WSP(A) + WS_K12) + (size_t)layer * 2 * 16384;
    int* EXI = (int*)(WSP(A) + WS_EXI); float* EXG = (float*)(WSP(A) + WS_EXG);
    for (int q = tid; q < 2 * 128 * 16; q += NTHREADS) { const int row = q >> 4, c = q & 15; *(u32x4*)(lds + row * KSTR128 + c * 16) = *(const u32x4*)(K12 + row * 128 + c * 8); }
    __syncthreads();
    for (int u = bid; u < T / 32; u += nb) {
        const int t = u * 32 + l31, h = wave;
        unsigned* wl = (unsigned*)(lds + TOPK_STAGE) + wave * 2048;
#pragma unroll
        for (int side = 0; side < 2; ++side) {
            bf16x8 qr[8];
            const bf16_t* qp = PQ + (size_t)t * 2048 + h * 256 + side * 128 + hi * 8;
#pragma unroll
            for (int ks = 0; ks < 8; ++ks) qr[ks] = *(const bf16x8*)(qp + ks * 16);
            const unsigned char* kp = lds + side * 128 * KSTR128 + l31 * KSTR128 + hi * 16;
            unsigned keys[64];
#pragma unroll
            for (int mt = 0; mt < 4; ++mt) {
                f32x16 p;
#pragma unroll
                for (int r = 0; r < 16; ++r) p[r] = 0.f;
#pragma unroll
                for (int ks = 0; ks < 8; ++ks) {
                    const bf16x8 a = *(const bf16x8*)(kp + mt * 32 * KSTR128 + ks * 32);
                    p = __builtin_amdgcn_mfma_f32_32x32x16_bf16(a, qr[ks], p, 0, 0, 0);
                }
#pragma unroll
                for (int r = 0; r < 16; ++r) {
                    const int key = mt * 32 + (r & 3) + 8 * (r >> 2) + 4 * hi;
                    keys[mt * 16 + r] = (f2sort(p[r]) & ~127u) | (unsigned)(127 - key);
                }
                __builtin_amdgcn_sched_barrier(0);
            }
            top16_of_128(keys, wl + side * 1024, lane);
        }
        unsigned lst[2][16];
#pragma unroll
        for (int i = 0; i < 16; ++i) { lst[0][i] = wl[i * 64 + lane]; lst[1][i] = wl[1024 + i * 64 + lane]; }
        float v1[16], v2[16];
#pragma unroll
        for (int i = 0; i < 16; ++i) { v1[i] = sort2f(lst[0][i] & ~127u); v2[i] = sort2f(lst[1][i] & ~127u); }
        unsigned cand[50];
        {
            int c = 0;
#pragma unroll
            for (int i = 0; i < 16; ++i)
#pragma unroll
                for (int j = 0; j < 16; ++j)
                    if ((i + 1) * (j + 1) <= 16) { cand[c] = (f2sort(v1[i] + v2[j]) & ~255u) | (unsigned)(255 - (16 * i + j)); ++c; }
        }
        float* wv = (float*)wl; int* we = (int*)wl + 1024;
#pragma unroll 1
        for (int it = 0; it < 16; ++it) {
            unsigned mx = cand[0];
#pragma unroll
            for (int c = 1; c < 49; c += 2) mx = umax3(mx, cand[c], cand[c + 1]);
            mx = max(mx, cand[49]);
            wv[it * 64 + lane] = sort2f(mx & ~255u);
            int eid = 0;
            {
                int c = 0;
#pragma unroll
                for (int i = 0; i < 16; ++i)
#pragma unroll
                    for (int j = 0; j < 16; ++j)
                        if ((i + 1) * (j + 1) <= 16) {
                            const bool hit = cand[c] == mx;
                            eid = hit ? (int)((127u - (lst[0][i] & 127u)) * 128u + (127u - (lst[1][j] & 127u))) : eid;
                            cand[c] = hit ? 0u : cand[c];
                            ++c;
                        }
            }
            we[it * 64 + lane] = eid;
        }
        float topv[16]; int tope[16];
#pragma unroll
        for (int it = 0; it < 16; ++it) { topv[it] = wv[it * 64 + lane]; tope[it] = we[it * 64 + lane]; }
        const float mx0 = topv[0];
        float sum = 0.f;
#pragma unroll
        for (int it = 0; it < 16; ++it) { topv[it] = __expf(topv[it] - mx0); sum += topv[it]; }
        if (hi == 0) {
            const float inv = 1.f / sum;
            int* ei = EXI + (size_t)t * 128 + h * 16; float* eg = EXG + (size_t)t * 128 + h * 16;
#pragma unroll
            for (int q = 0; q < 4; ++q) {
                *(int4*)(ei + 4 * q) = make_int4(tope[4 * q], tope[4 * q + 1], tope[4 * q + 2], tope[4 * q + 3]);
                *(f32x4*)(eg + 4 * q) = f32x4{topv[4 * q] * inv, topv[4 * q + 1] * inv, topv[4 * q + 2] * inv, topv[4 * q + 3] * inv};
            }
        }
    }
    __syncthreads();
}
__device__ __forceinline__ float dot8(const u32x4 a, const u32x4 b, float acc) {
#pragma unroll
    for (int j = 0; j < 4; ++j) acc = __builtin_amdgcn_fdot2_f32_bf16(__builtin_bit_cast(bf16x2_t, a[j]), __builtin_bit_cast(bf16x2_t, b[j]), acc, false);
    return acc;
}
__device__ __forceinline__ void axpy8(float (&o)[8], const u32x4 v, float w) {
#pragma unroll
    for (int j = 0; j < 4; ++j) { o[2 * j] += w * bflo(v[j]); o[2 * j + 1] += w * bfhi(v[j]); }
}

template <bool FINAL>
__device__ __forceinline__ void phase_gather(const Args& A, int layer, const float* xin, float* xout, int gate_set, const float* next_gain, int next_set, float gmul, int bid, int nb) {
    const int tid = opaque_tid(), lane = tid & 63, wave = tid >> 6;
    bf16_t* H = (bf16_t*)(WSP(A) + WS_H);
    const bf16_t* PU = (const bf16_t*)(WSP(A) + WS_PU) + (size_t)layer * 16384 * 2048;
    const bf16_t* PV = (const bf16_t*)(WSP(A) + WS_PV) + (size_t)layer * 16384 * 2048;
    const int* EXI = (const int*)(WSP(A) + WS_EXI); const float* EXG = (const float*)(WSP(A) + WS_EXG);
    const float* mod = (const float*)(WSP(A) + WS_MOD);
    for (int u = bid; u < T / NWAVES; u += nb) {
        const int t = u * NWAVES + wave;
        u32x4 hp[4];
#pragma unroll
        for (int c = 0; c < 4; ++c) hp[c] = *(const u32x4*)(H + (size_t)t * 2048 + c * 512 + lane * 8);
        const int idxA = EXI[(size_t)t * 128 + lane], idxB = EXI[(size_t)t * 128 + 64 + lane];
        const float gA = EXG[(size_t)t * 128 + lane], gB = EXG[(size_t)t * 128 + 64 + lane];
        float o[4][8];
#pragma unroll
        for (int c = 0; c < 4; ++c)
#pragma unroll
            for (int j = 0; j < 8; ++j) o[c][j] = 0.f;
        u32x4 ua[4], va[4], ub[4], vb[4];
        auto issue = [&](int k, u32x4 (&uu)[4], u32x4 (&vv)[4]) {
            const int e = __builtin_amdgcn_readlane(k < 64 ? idxA : idxB, k & 63);
            const bf16_t* up = PU + (size_t)e * 2048 + lane * 8; const bf16_t* vp = PV + (size_t)e * 2048 + lane * 8;
#pragma unroll
            for (int c = 0; c < 4; ++c) { uu[c] = *(const u32x4*)(up + c * 512); vv[c] = *(const u32x4*)(vp + c * 512); }
        };
        auto consume = [&](int k, const u32x4 (&uu)[4], const u32x4 (&vv)[4]) {
            float d = 0.f;
#pragma unroll
            for (int c = 0; c < 4; ++c) d = dot8(uu[c], hp[c], d);
            d = wave_sum(d);
            const float g = __uint_as_float(__builtin_amdgcn_readlane(__float_as_uint(k < 64 ? gA : gB), k & 63));
            const float w = g * gelu_tanh(d) * gmul;
#pragma unroll
            for (int c = 0; c < 4; ++c) axpy8(o[c], vv[c], w);
        };
#ifdef NAIVE_GATHER
        {
            const float* U32 = A.in[26] + (size_t)layer * 16384 * 2048; const float* V32 = A.in[27] + (size_t)layer * 16384 * 2048;
#pragma unroll 1
            for (int k = 0; k < 128; ++k) {
                const int e = EXI[(size_t)t * 128 + k];
                const float g = EXG[(size_t)t * 128 + k];
                float d = 0.f;
                for (int c = 0; c < 4; ++c)
                    for (int j = 0; j < 8; ++j) {
                        const unsigned w_ = hp[c][j >> 1];
                        const float hv = (j & 1) ? bfhi(w_) : bflo(w_);
                        d += hv * U32[(size_t)e * 2048 + c * 512 + lane * 8 + j];
                    }
                d = wave_sum(d);
                const float w = g * gelu_tanh(d) * gmul;
                for (int c = 0; c < 4; ++c)
                    for (int j = 0; j < 8; ++j) o[c][j] += w * V32[(size_t)e * 2048 + c * 512 + lane * 8 + j];
            }
        }
        if (false)
#endif
        {
        issue(0, ua, va);
#pragma unroll 1
        for (int k = 0; k < 128; k += 2) {
            issue(k + 1, ub, vb);
            consume(k, ua, va);
            if (k + 2 < 128) issue(k + 2, ua, va);
            consume(k + 1, ub, vb);
        }
        }
        const int b = t >> 13;
        const float* gate = mod + (size_t)(gate_set * 2 + b) * 6144 + 4096;
        float xn[4][8];
        float ss = 0.f;
#pragma unroll
        for (int c = 0; c < 4; ++c) {
            const int col = c * 512 + lane * 8;
            const f32x4 x0 = *(const f32x4*)(xin + (size_t)t * 2048 + col), x1 = *(const f32x4*)(xin + (size_t)t * 2048 + col + 4);
            const f32x4 g0 = *(const f32x4*)(gate + col), g1 = *(const f32x4*)(gate + col + 4);
#pragma unroll
            for (int j = 0; j < 4; ++j) { xn[c][j] = x0[j] + g0[j] * o[c][j]; xn[c][4 + j] = x1[j] + g1[j] * o[c][4 + j]; }
#pragma unroll
            for (int j = 0; j < 8; ++j) ss += xn[c][j] * xn[c][j];
        }
        ss = wave_sum(ss);
        const float rinv = rsqrtf(ss * (1.f / 2048.f) + EPS);
        if constexpr (FINAL) {
#pragma unroll
            for (int c = 0; c < 4; ++c) {
                const int col = c * 512 + lane * 8;
                const f32x4 w0 = *(const f32x4*)(next_gain + col), w1 = *(const f32x4*)(next_gain + col + 4);
                f32x4 y0, y1;
#pragma unroll
                for (int j = 0; j < 4; ++j) { y0[j] = xn[c][j] * rinv * w0[j]; y1[j] = xn[c][4 + j] * rinv * w1[j]; }
                *(f32x4*)(xout + (size_t)t * 2048 + col) = y0; *(f32x4*)(xout + (size_t)t * 2048 + col + 4) = y1;
            }
        } else {
            const float* nm = mod + (size_t)(next_set * 2 + b) * 6144;
#pragma unroll
            for (int c = 0; c < 4; ++c) {
                const int col = c * 512 + lane * 8;
                f32x4 y0, y1;
#pragma unroll
                for (int j = 0; j < 4; ++j) { y0[j] = xn[c][j]; y1[j] = xn[c][4 + j]; }
                *(f32x4*)(xout + (size_t)t * 2048 + col) = y0; *(f32x4*)(xout + (size_t)t * 2048 + col + 4) = y1;
                const f32x4 w0 = *(const f32x4*)(next_gain + col), w1 = *(const f32x4*)(next_gain + col + 4);
                const f32x4 s0 = *(const f32x4*)(nm + col), s1 = *(const f32x4*)(nm + col + 4);
                const f32x4 c0 = *(const f32x4*)(nm + 2048 + col), c1 = *(const f32x4*)(nm + 2048 + col + 4);
                float h[8];
#pragma unroll
                for (int j = 0; j < 4; ++j) { h[j] = xn[c][j] * rinv * w0[j] * (1.f + c0[j]) + s0[j]; h[4 + j] = xn[c][4 + j] * rinv * w1[j] * (1.f + c1[j]) + s1[j]; }
                u32x4 w = {cvtpk(h[0], h[1]), cvtpk(h[2], h[3]), cvtpk(h[4], h[5]), cvtpk(h[6], h[7])};
                *(u32x4*)(H + (size_t)t * 2048 + col) = w;
            }
        }
    }
}
constexpr int NSA_IMP = ATT_MISC;
constexpr int NSA_SELM = NSA_IMP + 32 * 128 * 4;
constexpr int NSA_KEYS = NSA_SELM + 512;
constexpr int LDS_BARW = NSA_KEYS + 8 * 128 * 4;
constexpr int LDS_BARW2 = (LDS_BARW > TOPK_LDS ? LDS_BARW : TOPK_LDS);
constexpr int LDS_TOTAL = ((LDS_BARW2 + 16 + 255) / 256) * 256;
static_assert(LDS_TOTAL <= 160 * 1024 && GEMM_LDS <= LDS_BARW2, "LDS budget");

__device__ __forceinline__ int next_bit128(unsigned long long lo, unsigned long long hi, int from) {
    if (from < 64) { const unsigned long long mm = lo >> from; if (mm) return from + __builtin_ctzll(mm); from = 64; }
    if (from < 128) { const unsigned long long mm = hi >> (from - 64); if (mm) return from + __builtin_ctzll(mm); }
    return 128;
}
template <int MODE>
__device__ __forceinline__ void nsa_emit(const f32x16 (&o)[4], float sc, float* acc_row, bf16_t* o_row, int hi) {
#pragma unroll
    for (int dt = 0; dt < 4; ++dt)
#pragma unroll
        for (int g4 = 0; g4 < 4; ++g4) {
            const int d = dt * 32 + 8 * g4 + 4 * hi;
            f32x4 v = {o[dt][4 * g4] * sc, o[dt][4 * g4 + 1] * sc, o[dt][4 * g4 + 2] * sc, o[dt][4 * g4 + 3] * sc};
            if (MODE >= 1) { const f32x4 pv = *(const f32x4*)(acc_row + d); v += pv; }
            if (MODE <= 1) *(f32x4*)(acc_row + d) = v;
            else { u32x2 w = {cvtpk(v[0], v[1]), cvtpk(v[2], v[3])}; *(u32x2*)(o_row + d) = w; }
        }
}

__device__ __forceinline__ void nsa_item(const Args& A, unsigned char* lds, int b, int g, int tt) {
    const int tid = opaque_tid(), lane = tid & 63, wave = tid >> 6, l31 = lane & 31, hi = lane >> 5;
    const bf16_t* NS = (const bf16_t*)(WSP(A) + WS_BIG);
    const bf16_t* KCC = (const bf16_t*)(WSP(A) + WS_KCC); const bf16_t* VCC = (const bf16_t*)(WSP(A) + WS_VCC);
    float* OACC = (float*)(WSP(A) + WS_OACC); bf16_t* O = (bf16_t*)(WSP(A) + WS_O);
    int* IMP = (int*)(lds + NSA_IMP); unsigned* SELM = (unsigned*)(lds + NSA_SELM); int* KEYS = (int*)(lds + NSA_KEYS) + wave * 128;
    const int t0 = tt * 32, t = t0 + l31, hd = g * 8 + wave;
    const size_t tokb = (size_t)b * SEQ;
    const float c2 = 0.08838834764831845f * 1.4426950408889634f;
    bf16x8 qr[8];
    {
        const bf16_t* qp = NS + (tokb + t) * NSA_IN + hd * 128 + hi * 8;
#pragma unroll
        for (int ks = 0; ks < 8; ++ks) qr[ks] = *(const bf16x8*)(qp + ks * 16);
    }
    float gt[3];
    {
        const bf16_t* gp = NS + (tokb + t) * NSA_IN + 3584 + g * 24 + wave * 3;
        gt[0] = bf2f(gp[0]); gt[1] = bf2f(gp[1]); gt[2] = bf2f(gp[2]);
    }
    float* acc_row = OACC + (tokb + t) * 2048 + hd * 128;
    bf16_t* o_row = O + (tokb + t) * 2048 + hd * 128;
    const int kl_off = l31 * KSTR128 + hi * 16, vl_off = vb_lane_off(lane);
    u32x4 rk[2], rv[2];
    unsigned ocm[2], omn[2], lkb[2], lvb[2];
#pragma unroll
    for (int i = 0; i < 2; ++i) {
        const int q = tid + NTHREADS * i, row = q >> 4, c = q & 15;
        ocm[i] = (unsigned)(row * 256 + c * 8) * 2u; omn[i] = (unsigned)(row * NSA_IN + c * 8) * 2u;
        lkb[i] = (unsigned)(row * KSTR128 + c * 16); lvb[i] = (unsigned)(row * VSTR + c * 16);
    }
    auto gloadK = [&](const bf16_t* kbase, bool cmp) {
#pragma unroll
        for (int i = 0; i < 2; ++i) rk[i] = *(const u32x4*)((const unsigned char*)kbase + (cmp ? ocm[i] : omn[i]));
    };
    auto gloadV = [&](const bf16_t* vbase, bool cmp) {
#pragma unroll
        for (int i = 0; i < 2; ++i) rv[i] = *(const u32x4*)((const unsigned char*)vbase + (cmp ? ocm[i] : omn[i]));
    };
    auto lstoreK = [&](int buf) {
        unsigned char* kb = lds + ATT_KOFF + buf * ATT_K_BYTES;
#pragma unroll
        for (int i = 0; i < 2; ++i) *(u32x4*)(kb + lkb[i]) = rk[i];
    };
    auto lstoreV = [&](int buf) {
        unsigned char* vb = lds + ATT_VOFF + buf * ATT_V_BYTES;
#pragma unroll
        for (int i = 0; i < 2; ++i) *(u32x4*)(vb + lvb[i]) = rv[i];
    };
    f32x16 o[4];
    auto zero_o = [&]() {
#pragma unroll
        for (int dt = 0; dt < 4; ++dt)
#pragma unroll
            for (int r = 0; r < 16; ++r) o[dt][r] = 0.f;
    };

    for (int i = tid; i < 32 * 128; i += NTHREADS) IMP[i] = 0;
    const int nct = (tt >> 5) + 1;
    const int nv = (t >= 31) ? ((t - 31) >> 4) : -1;
    const bf16_t* kc0 = KCC + ((size_t)(b * NCMP_PAD) * 2 + g) * 128;
    const bf16_t* vc0 = VCC + ((size_t)(b * NCMP_PAD) * 2 + g) * 128;
    float m = -1e30f, l = 0.f;
    gloadK(kc0, true); lstoreK(0); __syncthreads();
    for (int ct = 0; ct < nct; ++ct) {
        if (ct + 1 < nct) gloadK(kc0 + (size_t)(ct + 1) * 64 * 256, true);
        {
            f32x16 p0, p1;
            qk_tile<8, KSTR128>(p0, p1, lds + ATT_KOFF + (ct & 1) * ATT_K_BYTES + kl_off, qr);
            const int dq = nv - ct * 64 - 4 * hi;
            float mx = -__builtin_inff();
#pragma unroll
            for (int r = 0; r < 16; ++r) {
                const int cb = (r & 3) + 8 * (r >> 2);
                p0[r] = (cb <= dq) ? p0[r] : -__builtin_inff();
                p1[r] = (cb + 32 <= dq) ? p1[r] : -__builtin_inff();
                mx = fmaxf(mx, fmaxf(p0[r], p1[r]));
            }
            mx = fmaxf(mx, __shfl_xor(mx, 32));
            const float mn = fmaxf(m, mx);
            const float alpha = __builtin_amdgcn_exp2f((m - mn) * c2);
            const float mc = mn * c2;
            float rs = 0.f;
#pragma unroll
            for (int r = 0; r < 16; ++r) rs += __builtin_amdgcn_exp2f(p0[r] * c2 - mc) + __builtin_amdgcn_exp2f(p1[r] * c2 - mc);
            rs += __shfl_xor(rs, 32);
            l = l * alpha + rs; m = mn;
        }
        if (ct + 1 < nct) lstoreK((ct + 1) & 1);
        __syncthreads();
    }
    const float inv_l = (l > 0.f) ? 1.f / l : 0.f;
    const float mcF = m * c2;
    zero_o();
    gloadK(kc0, true); gloadV(vc0, true); lstoreK(0); lstoreV(0); __syncthreads();
    for (int ct = 0; ct < nct; ++ct) {
        if (ct + 1 < nct) { gloadK(kc0 + (size_t)(ct + 1) * 64 * 256, true); gloadV(vc0 + (size_t)(ct + 1) * 64 * 256, true); }
        {
            f32x16 p0, p1;
            qk_tile<8, KSTR128>(p0, p1, lds + ATT_KOFF + (ct & 1) * ATT_K_BYTES + kl_off, qr);
            const int dq = nv - ct * 64 - 4 * hi;
#pragma unroll
            for (int r = 0; r < 16; ++r) {
                const int cb = (r & 3) + 8 * (r >> 2);
                p0[r] = (cb <= dq) ? __builtin_amdgcn_exp2f(p0[r] * c2 - mcF) * inv_l : 0.f;
                p1[r] = (cb + 32 <= dq) ? __builtin_amdgcn_exp2f(p1[r] * c2 - mcF) * inv_l : 0.f;
            }
#pragma unroll
            for (int g4 = 0; g4 < 4; ++g4) {
                {
                    const int j = 16 * ct + 2 * g4 + hi;
                    const float mainv = 32.f * (p0[4 * g4] + p0[4 * g4 + 1] + p0[4 * g4 + 2]) + 16.f * p0[4 * g4 + 3];
                    const float spill = 16.f * p0[4 * g4 + 3];
                    atomicAdd(&IMP[l31 * 128 + j], (int)(mainv * 1048576.f + 0.5f));
                    if (j + 1 < 128) atomicAdd(&IMP[l31 * 128 + j + 1], (int)(spill * 1048576.f + 0.5f));
                }
                {
                    const int j = 16 * ct + 8 + 2 * g4 + hi;
                    const float mainv = 32.f * (p1[4 * g4] + p1[4 * g4 + 1] + p1[4 * g4 + 2]) + 16.f * p1[4 * g4 + 3];
                    const float spill = 16.f * p1[4 * g4 + 3];
                    atomicAdd(&IMP[l31 * 128 + j], (int)(mainv * 1048576.f + 0.5f));
                    if (j + 1 < 128) atomicAdd(&IMP[l31 * 128 + j + 1], (int)(spill * 1048576.f + 0.5f));
                }
            }
            bf16x8 pb[4] = {pack8f(p0, 0), pack8f(p0, 8), pack8f(p1, 0), pack8f(p1, 8)};
            pv_tile(o, lds + ATT_VOFF + (ct & 1) * ATT_V_BYTES + vl_off, pb);
        }
        if (ct + 1 < nct) { lstoreK((ct + 1) & 1); lstoreV((ct + 1) & 1); }
        __syncthreads();
    }
    nsa_emit<0>(o, gt[0] * ABL_NC, acc_row, o_row, hi);

#pragma unroll 1
    for (int q = 0; q < 4; ++q) {
        const int ti = wave * 4 + q, tq = t0 + ti, cur = tq >> 6;
        int keyv[2];
#pragma unroll
        for (int half = 0; half < 2; ++half) {
            const int j = lane + 64 * half;
            const bool forced = (j == 0) || (j == cur) || (j == cur - 1);
            keyv[half] = forced ? 0x7FFFFFFF : ((j <= cur) ? IMP[ti * 128 + j] : -1);
            KEYS[j] = keyv[half];
        }
        __builtin_amdgcn_s_waitcnt(0xc07f);
        int rk0 = 0, rk1 = 0;
#pragma unroll 8
        for (int i = 0; i < 128; ++i) {
            const int ki = KEYS[i];
            rk0 += (ki > keyv[0] || (ki == keyv[0] && i < lane)) ? 1 : 0;
            rk1 += (ki > keyv[1] || (ki == keyv[1] && i < lane + 64)) ? 1 : 0;
        }
        const unsigned long long s0 = __ballot(keyv[0] >= 0 && rk0 < 16);
        const unsigned long long s1 = __ballot(keyv[1] >= 0 && rk1 < 16);
        if (lane == 0) { SELM[ti * 4 + 0] = (unsigned)s0; SELM[ti * 4 + 1] = (unsigned)(s0 >> 32); SELM[ti * 4 + 2] = (unsigned)s1; SELM[ti * 4 + 3] = (unsigned)(s1 >> 32); }
    }
    __syncthreads();
    unsigned msk[4], uni[4];
#pragma unroll
    for (int w4 = 0; w4 < 4; ++w4) {
        msk[w4] = SELM[l31 * 4 + w4];
        unsigned x = msk[w4];
#pragma unroll
        for (int off = 16; off >= 1; off >>= 1) x |= (unsigned)__shfl_xor((int)x, off);
        uni[w4] = (unsigned)__builtin_amdgcn_readfirstlane((int)x);
    }
    const unsigned long long ulo = ((unsigned long long)uni[1] << 32) | uni[0], uhi = ((unsigned long long)uni[3] << 32) | uni[2];

    const bf16_t* ks0 = NS + tokb * NSA_IN + 2560 + g * 128;
    const bf16_t* vs0 = NS + tokb * NSA_IN + 2816 + g * 128;
    zero_o(); m = -1e30f; l = 0.f;
    {
        int j = next_bit128(ulo, uhi, 0), it = 0;
        if (j < 128) { gloadK(ks0 + (size_t)j * 64 * NSA_IN, false); gloadV(vs0 + (size_t)j * 64 * NSA_IN, false); lstoreK(0); lstoreV(0); }
        __syncthreads();
        while (j < 128) {
            const int jn = next_bit128(ulo, uhi, j + 1);
            if (jn < 128) { gloadK(ks0 + (size_t)jn * 64 * NSA_IN, false); gloadV(vs0 + (size_t)jn * 64 * NSA_IN, false); }
            {
                f32x16 p0, p1;
                qk_tile<8, KSTR128>(p0, p1, lds + ATT_KOFF + (it & 1) * ATT_K_BYTES + kl_off, qr);
                const bool sel = (msk[j >> 5] >> (j & 31)) & 1u;
                const int dq = sel ? (t - j * 64 - 4 * hi) : -1000;
#pragma unroll
                for (int r = 0; r < 16; ++r) {
                    const int cb = (r & 3) + 8 * (r >> 2);
                    p0[r] = (cb <= dq) ? p0[r] : -__builtin_inff();
                    p1[r] = (cb + 32 <= dq) ? p1[r] : -__builtin_inff();
                }
                bf16x8 pb[4];
                softmax_step(p0, p1, m, l, o, c2, pb);
                pv_tile(o, lds + ATT_VOFF + (it & 1) * ATT_V_BYTES + vl_off, pb);
            }
            if (jn < 128) { lstoreK((it + 1) & 1); lstoreV((it + 1) & 1); }
            __syncthreads();
            j = jn; ++it;
        }
    }
    nsa_emit<1>(o, (l > 0.f) ? ABL_NS * gt[1] / l : 0.f, acc_row, o_row, hi);

    const bf16_t* kw0 = NS + tokb * NSA_IN + 3072 + g * 128;
    const bf16_t* vw0 = NS + tokb * NSA_IN + 3328 + g * 128;
    zero_o(); m = -1e30f; l = 0.f;
    {
        const int kt_lo = (t0 >= 511) ? ((t0 - 511) >> 6) : 0, kt_hi = t0 >> 6;
        gloadK(kw0 + (size_t)kt_lo * 64 * NSA_IN, false); gloadV(vw0 + (size_t)kt_lo * 64 * NSA_IN, false); lstoreK(0); lstoreV(0);
        __syncthreads();
        int it = 0;
        for (int kt = kt_lo; kt <= kt_hi; ++kt, ++it) {
            if (kt < kt_hi) { gloadK(kw0 + (size_t)(kt + 1) * 64 * NSA_IN, false); gloadV(vw0 + (size_t)(kt + 1) * 64 * NSA_IN, false); }
            {
                f32x16 p0, p1;
                qk_tile<8, KSTR128>(p0, p1, lds + ATT_KOFF + (it & 1) * ATT_K_BYTES + kl_off, qr);
                const int dq = t - kt * 64 - 4 * hi;
#pragma unroll
                for (int r = 0; r < 16; ++r) {
                    const int cb = (r & 3) + 8 * (r >> 2);
                    p0[r] = ((unsigned)(dq - cb) < 512u) ? p0[r] : -__builtin_inff();
                    p1[r] = ((unsigned)(dq - cb - 32) < 512u) ? p1[r] : -__builtin_inff();
                }
                bf16x8 pb[4];
                softmax_step(p0, p1, m, l, o, c2, pb);
                pv_tile(o, lds + ATT_VOFF + (it & 1) * ATT_V_BYTES + vl_off, pb);
            }
            if (kt < kt_hi) { lstoreK((it + 1) & 1); lstoreV((it + 1) & 1); }
            __syncthreads();
        }
    }
    nsa_emit<2>(o, (l > 0.f) ? ABL_NW * gt[2] / l : 0.f, acc_row, o_row, hi);
}

__device__ __forceinline__ void phase_nsa(const Args& A, unsigned char* lds, int bid, int nb) {
    for (int u = bid; u < 1024; u += nb) {
        const int tt = 255 - (u >> 2), bg = u & 3;
        nsa_item(A, lds, bg >> 1, bg & 1, tt);
    }
}
constexpr int N_PHASES = 20;
#ifndef ABL_M0
#define ABL_M0 1.f
#endif
#ifndef ABL_M1
#define ABL_M1 1.f
#endif
#ifndef ABL_P0
#define ABL_P0 1.f
#endif
#ifndef ABL_P1
#define ABL_P1 1.f
#endif
__global__ void __launch_bounds__(NTHREADS, 2) fwd_kernel(Args a) {
    extern __shared__ __attribute__((aligned(16))) unsigned char lds[];
    const int bid = blockIdx.x, nb = gridDim.x;
    const bool multi = (a.ph_hi - a.ph_lo) > 1;
    XcdBarrier bar; bar.bar = (unsigned*)(a.ws + WS_CTL); bar.x = 0; bar.st = (volatile LAS unsigned*)(lds + LDS_BARW2);
    if (multi) {
        if (threadIdx.x == 0) *(uint4*)(lds + LDS_BARW2) = make_uint4(0u, 0u, 0u, 0u);
        __syncthreads();
        bar = xcd_barrier_post((unsigned*)(a.ws + WS_CTL), (volatile LAS unsigned*)(lds + LDS_BARW2));
    }
#ifdef ONLY
#define IN(k) ((k) == ONLY && a.ph_lo <= (k) && (k) < a.ph_hi)
#else
#define IN(k) (a.ph_lo <= (k) && (k) < a.ph_hi)
#endif
#define SEAM(k) do { if (IN(k) && IN((k) + 1)) xcd_barrier(bar); } while (0)
    unsigned char* ws = WSP(a);
    const float* MOD = (const float*)(ws + WS_MOD);
    bf16_t* H = (bf16_t*)(ws + WS_H); bf16_t* BIG = (bf16_t*)(ws + WS_BIG); bf16_t* Ob = (bf16_t*)(ws + WS_O);
    float* XA = (float*)(ws + WS_XA); float* XB = (float*)(ws + WS_XB);

    if (IN(0)) phase_prologue(a, lds, bid, nb);
    SEAM(0);
    if (IN(1)) phase_modnorm(a, a.in[0], a.in[3], 0, bid, nb);
    SEAM(1);
    if (IN(2)) gemm_phase(lds, ALoadPlain{H, 2048}, (const bf16_t*)(ws + WS_WIN0), 2048, T, SBMLA_IN_PAD, 2048, EpiBf16{BIG, SBMLA_IN, SBMLA_IN}, bid, nb);
    SEAM(2);
    if (IN(3)) phase_mla_prep(a, bid, nb);
    SEAM(3);
    if (IN(4)) {
        gemm_phase(lds, ALoadPlain{(const bf16_t*)(ws + WS_CQN), 512}, (const bf16_t*)(ws + WS_WUQ), 512, T, 1536, 512, EpiMlaQ{(bf16_t*)(ws + WS_QM), (const f32x2*)(ws + WS_ROPE64)}, bid, nb);
        gemm_phase(lds, ALoadPlain{(const bf16_t*)(ws + WS_CKVN), 256}, (const bf16_t*)(ws + WS_WUKV), 256, T, 2048, 256, EpiBf16{(bf16_t*)(ws + WS_KVM), KVM_LD, 2048}, bid, nb);
    }
    SEAM(4);
    if (IN(5)) phase_attn0(a, lds, bid, nb);
    SEAM(5);
    if (IN(6)) gemm_phase(lds, ALoadPlain{Ob, 2048}, (const bf16_t*)(ws + WS_WOUT0), 2048, T, 2048, 2048, EpiResid{a.in[0], XA, MOD + 0 * 2 * 6144 + 4096, ABL_M0}, bid, nb);
    SEAM(6);
    if (IN(7)) phase_modnorm(a, XA, a.in[20], 1, bid, nb);
    SEAM(7);
    if (IN(8)) gemm_phase(lds, ALoadPlain{H, 2048}, (const bf16_t*)(ws + WS_WPQ), 2048, T, 2048, 2048, EpiBf16{(bf16_t*)(ws + WS_PQ), 2048, 2048}, bid, nb);
    SEAM(8);
    if (IN(9)) phase_topk(a, lds, 0, bid, nb);
    SEAM(9);
    if (IN(10)) phase_gather<false>(a, 0, XA, XB, 1, a.in[3] + 2048, 2, ABL_P0, bid, nb);
    SEAM(10);
    if (IN(11)) gemm_phase(lds, ALoadPlain{H, 2048}, (const bf16_t*)(ws + WS_WNSAIN), 2048, T, NSA_IN_PAD, 2048, EpiNsaIn{BIG, (const f32x2*)(ws + WS_ROPE32)}, bid, nb);
    SEAM(11);
    if (IN(12)) {
        gemm_phase(lds, ALoadCmp{BIG, NSA_IN, 2048}, (const bf16_t*)(ws + WS_W1K), 4096, 2048, 256, 4096, EpiCmpHid{(bf16_t*)(ws + WS_HID), (const float*)(ws + WS_BIASP)}, bid, nb);
        gemm_phase(lds, ALoadCmp{BIG, NSA_IN, 2304}, (const bf16_t*)(ws + WS_W1V), 4096, 2048, 256, 4096, EpiCmpHid{(bf16_t*)(ws + WS_HID) + 2048 * 256, (const float*)(ws + WS_BIASP) + 32 * 256}, bid, nb);
    }
    SEAM(12);
    if (IN(13)) {
        gemm_phase(lds, ALoadPlain{(const bf16_t*)(ws + WS_HID), 256}, (const bf16_t*)(ws + WS_W2K), 256, 2048, 128, 256, EpiCmpOut{(bf16_t*)(ws + WS_KCC)}, bid, nb);
        gemm_phase(lds, ALoadPlain{(const bf16_t*)(ws + WS_HID) + 2048 * 256, 256}, (const bf16_t*)(ws + WS_W2V), 256, 2048, 128, 256, EpiCmpOut{(bf16_t*)(ws + WS_VCC)}, bid, nb);
    }
    SEAM(13);
    if (IN(14)) phase_nsa(a, lds, bid, nb);
    SEAM(14);
    if (IN(15)) gemm_phase(lds, ALoadPlain{Ob, 2048}, (const bf16_t*)(ws + WS_WNSAOUT), 2048, T, 2048, 2048, EpiResid{XB, XA, MOD + 2 * 2 * 6144 + 4096, ABL_M1}, bid, nb);
    SEAM(15);
    if (IN(16)) phase_modnorm(a, XA, a.in[20] + 2048, 3, bid, nb);
    SEAM(16);
    if (IN(17)) gemm_phase(lds, ALoadPlain{H, 2048}, (const bf16_t*)(ws + WS_WPQ) + (size_t)2048 * 2048, 2048, T, 2048, 2048, EpiBf16{(bf16_t*)(ws + WS_PQ), 2048, 2048}, bid, nb);
    SEAM(17);
    if (IN(18)) phase_topk(a, lds, 1, bid, nb);
    SEAM(18);
    if (IN(19)) phase_gather<true>(a, 1, XA, a.out, 3, a.in[28], 0, ABL_P1, bid, nb);
    if (a.ph_lo == 99) {
        const bf16_t* raw = (const bf16_t*)(ws + (size_t)a.ph_hi * 16384);
        for (size_t i = (size_t)bid * NTHREADS + threadIdx.x; i < (size_t)T * 2048; i += (size_t)nb * NTHREADS) a.out[i] = bf2f(raw[i]);
    }
#undef IN
#undef SEAM
}

#ifndef MK_ONE_LAUNCH
#define MK_ONE_LAUNCH 0
#endif
extern "C" void kernel_launch(void* const* d_in, const int* in_sizes, int n_in, void* d_out, int out_size, void* d_ws, size_t ws_size, hipStream_t stream) {
    static int grid = 0;
    if (grid == 0) {
        if (n_in != 29 || out_size != T * D_MODEL || ws_size < WS_END) { fprintf(stderr, "kernel_launch: unexpected shapes (n_in %d out %d ws %zu need %zu)\n", n_in, out_size, ws_size, (size_t)WS_END); grid = -1; return; }
        int dev = 0, cus = 0, per_cu = 0;
        if (hipGetDevice(&dev) != hipSuccess || hipDeviceGetAttribute(&cus, hipDeviceAttributeMultiprocessorCount, dev) != hipSuccess) { grid = -1; return; }
        if (hipFuncSetAttribute((const void*)fwd_kernel, hipFuncAttributeMaxDynamicSharedMemorySize, LDS_TOTAL) != hipSuccess) { fprintf(stderr, "kernel_launch: hipFuncSetAttribute failed\n"); grid = -1; return; }
        if (hipOccupancyMaxActiveBlocksPerMultiprocessor(&per_cu, (const void*)fwd_kernel, NTHREADS, LDS_TOTAL) != hipSuccess || per_cu < 1) { fprintf(stderr, "kernel_launch: occupancy query says %d\n", per_cu); }
        (void)hipGetLastError();
        grid = cus;
    }
    if (grid < 0) return;
    (void)hipMemsetAsync((char*)d_ws + WS_CTL, 0, 16384, stream);
    Args a{};
    for (int i = 0; i < 29; ++i) a.in[i] = (const float*)d_in[i];
    a.out = (float*)d_out; a.ws = (unsigned char*)d_ws;
#if MK_ONE_LAUNCH
    a.ph_lo = 0; a.ph_hi = N_PHASES;
    hipLaunchKernelGGL(fwd_kernel, dim3(grid), dim3(NTHREADS), LDS_TOTAL, stream, a);
#else
#ifdef DBG_UPTO
    for (int p = 0; p <= DBG_UPTO; ++p) {
        a.ph_lo = p; a.ph_hi = p + 1;
        hipLaunchKernelGGL(fwd_kernel, dim3(grid), dim3(NTHREADS), LDS_TOTAL, stream, a);
    }
    a.ph_lo = 99; a.ph_hi = (int)(DBG_OFF / 16384);
    hipLaunchKernelGGL(fwd_kernel, dim3(grid), dim3(NTHREADS), LDS_TOTAL, stream, a);
#else
    for (int p = 0; p < N_PHASES; ++p) {
        a.ph_lo = p; a.ph_hi = p + 1;
        hipLaunchKernelGGL(fwd_kernel, dim3(grid), dim3(NTHREADS), LDS_TOTAL, stream, a);
    }
#endif
#endif
}
```

```cpp
#define MK_ONE_LAUNCH 1
#include <hip/hip_runtime.h>
#include <stdint.h>
#include <stdio.h>

typedef unsigned short bf16_t;
typedef short bf16x8 __attribute__((ext_vector_type(8)));
typedef short s16x4 __attribute__((ext_vector_type(4)));
typedef float f32x16 __attribute__((ext_vector_type(16)));
typedef float f32x4 __attribute__((ext_vector_type(4)));
typedef float f32x2 __attribute__((ext_vector_type(2)));
typedef unsigned u32x4 __attribute__((ext_vector_type(4)));
typedef unsigned u32x2 __attribute__((ext_vector_type(2)));
typedef __bf16 bf16x2_t __attribute__((ext_vector_type(2)));
#define LAS __attribute__((address_space(3)))

constexpr int D_MODEL = 2048, BATCH = 2, SEQ = 8192, T = BATCH * SEQ;
constexpr float EPS = 1e-6f;
constexpr int SBMLA_IN = 3904, SBMLA_IN_PAD = 3968;
constexpr int NSA_IN = 3632, NSA_IN_PAD = 3712;
constexpr int NCMP = 511, NCMP_PAD = 512;
constexpr int NTHREADS = 512, NWAVES = 8;
constexpr int KVM_LD = 2112;

constexpr size_t al256(size_t x) { return (x + 255) & ~(size_t)255; }
constexpr size_t WS_CTL   = 0;
constexpr size_t WS_MOD   = 16384;
constexpr size_t WS_BIASP = WS_MOD + al256((size_t)4 * 2 * 6144 * 4);
constexpr size_t WS_ROPE64 = WS_BIASP + al256((size_t)2 * 32 * 256 * 4);
constexpr size_t WS_ROPE32 = WS_ROPE64 + (size_t)T * 32 * 8;
constexpr size_t WS_WIN0  = WS_ROPE32 + (size_t)T * 16 * 8;
constexpr size_t WS_WUQ   = WS_WIN0 + (size_t)SBMLA_IN_PAD * 2048 * 2;
constexpr size_t WS_WUKV  = WS_WUQ + (size_t)1536 * 512 * 2;
constexpr size_t WS_WOUT0 = WS_WUKV + (size_t)2048 * 256 * 2;
constexpr size_t WS_WNSAIN = WS_WOUT0 + (size_t)2048 * 2048 * 2;
constexpr size_t WS_W1K   = WS_WNSAIN + (size_t)NSA_IN_PAD * 2048 * 2;
constexpr size_t WS_W1V   = WS_W1K + (size_t)256 * 4096 * 2;
constexpr size_t WS_W2K   = WS_W1V + (size_t)256 * 4096 * 2;
constexpr size_t WS_W2V   = WS_W2K + (size_t)128 * 256 * 2;
constexpr size_t WS_WNSAOUT = WS_W2V + (size_t)128 * 256 * 2;
constexpr size_t WS_WPQ   = WS_WNSAOUT + (size_t)2048 * 2048 * 2;
constexpr size_t WS_K12   = WS_WPQ + (size_t)2 * 2048 * 2048 * 2;
constexpr size_t WS_PU    = WS_K12 + (size_t)4 * 128 * 128 * 2;
constexpr size_t WS_PV    = WS_PU + (size_t)2 * 16384 * 2048 * 2;
constexpr size_t WS_H     = WS_PV + (size_t)2 * 16384 * 2048 * 2;
constexpr size_t WS_BIG   = WS_H + (size_t)T * 2048 * 2;
constexpr size_t WS_O     = WS_BIG + (size_t)T * SBMLA_IN * 2;
constexpr size_t WS_XA    = WS_O + (size_t)T * 2048 * 2;
constexpr size_t WS_XB    = WS_XA + (size_t)T * 2048 * 4;
constexpr size_t WS_CQN   = WS_XA;
constexpr size_t WS_CKVN  = WS_CQN + (size_t)T * 512 * 2;
constexpr size_t WS_OACC  = WS_XA;
constexpr size_t WS_QM    = WS_XB;
constexpr size_t WS_KVM   = WS_QM + (size_t)T * 1536 * 2;
constexpr size_t WS_PQ    = WS_XB;
static_assert((size_t)T * 1536 * 2 + (size_t)T * KVM_LD * 2 <= (size_t)T * 2048 * 4, "QM + KVM must fit the XB region");
constexpr size_t WS_EXI   = WS_XB + (size_t)T * 2048 * 4;
constexpr size_t WS_EXG   = WS_EXI + (size_t)T * 128 * 4;
constexpr size_t WS_HID   = WS_EXG + (size_t)T * 128 * 4;
constexpr size_t WS_KCC   = WS_HID + (size_t)2 * 2048 * 256 * 2;
constexpr size_t WS_VCC   = WS_KCC + (size_t)BATCH * NCMP_PAD * 2 * 128 * 2;
constexpr size_t WS_END   = WS_VCC + (size_t)BATCH * NCMP_PAD * 2 * 128 * 2;

struct Args {
    const float* in[29];
    float* out;
    unsigned char* ws;
    int ph_lo, ph_hi;
};

__device__ __forceinline__ unsigned cvtpk(float lo, float hi) {
    bf16x2_t v = {(__bf16)lo, (__bf16)hi};
    return __builtin_bit_cast(unsigned, v);
}
__device__ __forceinline__ float bf2f(unsigned short h) { return __uint_as_float(((unsigned)h) << 16); }
__device__ __forceinline__ float bflo(unsigned w) { return __uint_as_float(w << 16); }
__device__ __forceinline__ float bfhi(unsigned w) { return __uint_as_float(w & 0xFFFF0000u); }
__device__ __forceinline__ int crow(int r, int hi) { return (r & 3) + 8 * (r >> 2) + 4 * hi; }
__device__ __forceinline__ float wave_sum(float v) {
#pragma unroll
    for (int o = 32; o >= 1; o >>= 1) v += __shfl_xor(v, o);
    return v;
}
__device__ __forceinline__ float gelu_tanh(float x) {
    const float u = 0.7978845608028654f * (x + 0.044715f * x * x * x);
    const float e = __expf(2.f * u);
    const float th = 1.f - 2.f / (e + 1.f);
    return 0.5f * x * (1.f + th);
}
__device__ __forceinline__ int opaque_tid() { int t = threadIdx.x; asm volatile("" : "+v"(t)); return t; }
__device__ __forceinline__ unsigned char* WSP(const Args& A) {
    unsigned lo = (unsigned)(uintptr_t)A.ws, hi = (unsigned)((uintptr_t)A.ws >> 32);
    asm volatile("" : "+v"(lo), "+v"(hi));
    lo = (unsigned)__builtin_amdgcn_readfirstlane((int)lo); hi = (unsigned)__builtin_amdgcn_readfirstlane((int)hi);
    return (unsigned char*)(((uintptr_t)hi << 32) | lo);
}
#ifndef ABL_SB
#define ABL_SB 1.f
#endif
#ifndef ABL_MLA
#define ABL_MLA 1.f
#endif
#ifndef ABL_NC
#define ABL_NC 1.f
#endif
#ifndef ABL_NS
#define ABL_NS 1.f
#endif
#ifndef ABL_NW
#define ABL_NW 1.f
#endif
#define XB_TMO      128
#define XB_XCNT(j)  (256  + 64 * (j))
#define XB_XSUB(j)  (1280 + 64 * (j))
#define XB_XGEN(j)  (2304 + 64 * (j))
#define XB_TOP      3328
#define XB_TOPGEN   3392
#define XCD_BAR_WORDS 3456
#define XB_SPIN_CAP (1u << 18)
#define LAS __attribute__((address_space(3)))

__device__ __forceinline__ unsigned xb_ld(unsigned* p)              { return __hip_atomic_load(p, __ATOMIC_RELAXED, __HIP_MEMORY_SCOPE_AGENT); }
__device__ __forceinline__ unsigned xb_add(unsigned* p, unsigned v) { return __hip_atomic_fetch_add(p, v, __ATOMIC_RELAXED, __HIP_MEMORY_SCOPE_AGENT); }
__device__ __forceinline__ unsigned xb_xcc_id() { return (unsigned)__builtin_amdgcn_s_getreg((3 << 11) | 20) & 0xFu; }
#define XB_SPIN(cond, bar) do { unsigned _sp = 0; while (cond) { __builtin_amdgcn_s_sleep(1); \
    if ((++_sp & 255u) == 0u) { if (xb_ld(&(bar)[XB_TMO])) break; if (_sp > XB_SPIN_CAP) { atomicAdd(&(bar)[XB_TMO], 1u); break; } } } } while (0)

struct XcdBarrier {
    unsigned* bar; unsigned x;
    volatile LAS unsigned* st;
};

__device__ __forceinline__ XcdBarrier xcd_barrier_post(unsigned* bar, volatile LAS unsigned* st) {
    XcdBarrier b; b.bar = bar; b.x = xb_xcc_id(); b.st = st;
    if (threadIdx.x == 0) (void)xb_add(&bar[XB_XCNT(b.x)], 1u);
    return b;
}
__device__ __forceinline__ void xcd_barrier_complete(unsigned* bar, unsigned x, unsigned& nloc, unsigned& nx) {
    const unsigned G = gridDim.x * gridDim.y * gridDim.z;
    unsigned sum, cnt, mine, sp = 0u;
    for (;;) {
        sum = 0u; cnt = 0u; mine = 0u;
#pragma unroll
        for (unsigned j = 0; j < 16; ++j) { const unsigned c = xb_ld(&bar[XB_XCNT(j)]); sum += c; cnt += (c > 0u) ? 1u : 0u; mine = (j == x) ? c : mine; }
        if (sum == G) break;
        __builtin_amdgcn_s_sleep(1);
        if ((++sp & 255u) == 0u) { if (xb_ld(&bar[XB_TMO])) break; if (sp > XB_SPIN_CAP) { atomicAdd(&bar[XB_TMO], 1u); break; } }
    }
    nloc = mine > 0u ? mine : 1u; nx = cnt > 0u ? cnt : 1u;
}

__device__ __forceinline__ void xcd_barrier(const XcdBarrier& b) {
    asm volatile("s_waitcnt vmcnt(0)" ::: "memory");
    __syncthreads();
    if (threadIdx.x == 0) {
        unsigned* bar = b.bar;
        __builtin_amdgcn_s_waitcnt(0);
        unsigned nloc = b.st[0], nx = b.st[1];
        if (nloc == 0u) { xcd_barrier_complete(bar, b.x, nloc, nx); b.st[0] = nloc; b.st[1] = nx; }
        const unsigned old = xb_add(&bar[XB_XSUB(b.x)], 1u);
        const unsigned gen = old / nloc;
        if (old + 1u == (gen + 1u) * nloc) {
            __builtin_amdgcn_fence(__ATOMIC_RELEASE, "agent");
            asm volatile("s_waitcnt vmcnt(0)" ::: "memory");
            const unsigned og = xb_add(&bar[XB_TOP], 1u);
            const unsigned tg = og / nx;
            if (og + 1u == (tg + 1u) * nx) xb_add(&bar[XB_TOPGEN], 1u);
            else XB_SPIN(xb_ld(&bar[XB_TOPGEN]) == tg, bar);
            __builtin_amdgcn_fence(__ATOMIC_ACQUIRE, "agent");
            xb_add(&bar[XB_XGEN(b.x)], 1u);
            asm volatile("s_waitcnt vmcnt(0)" ::: "memory");
        } else {
            XB_SPIN(xb_ld(&bar[XB_XGEN(b.x)]) == gen, bar);
            __builtin_amdgcn_fence(__ATOMIC_ACQUIRE, "agent");
            asm volatile("s_waitcnt vmcnt(0)" ::: "memory");
        }
    }
    __syncthreads();
}
constexpr int U0_MOD = 192, U0_TR = 8784, U0_PEER = 2048, U0_ROPE = 192, U0_BIAS = 64, U0_K12 = 8, U0_ZERO = 8;
constexpr int U0_TOTAL = U0_MOD + U0_TR + U0_PEER + U0_ROPE + U0_BIAS + U0_K12 + U0_ZERO;

struct TrDesc { int in_idx; size_t in_off; int K, N, Npad; size_t ws_off; int ntiles; };
__device__ __forceinline__ TrDesc tr_desc(int m) {
    switch (m) {
        case 0:  return TrDesc{6, 0, 2048, 3904, 3968, WS_WIN0, 1984};
        case 1:  return TrDesc{8, 0, 512, 1536, 1536, WS_WUQ, 192};
        case 2:  return TrDesc{10, 0, 256, 2048, 2048, WS_WUKV, 128};
        case 3:  return TrDesc{11, 0, 2048, 2048, 2048, WS_WOUT0, 1024};
        case 4:  return TrDesc{12, 0, 2048, 3632, 3712, WS_WNSAIN, 1856};
        case 5:  return TrDesc{15, 0, 4096, 256, 256, WS_W1K, 256};
        case 6:  return TrDesc{17, 0, 4096, 256, 256, WS_W1V, 256};
        case 7:  return TrDesc{16, 0, 256, 128, 128, WS_W2K, 8};
        case 8:  return TrDesc{18, 0, 256, 128, 128, WS_W2V, 8};
        case 9:  return TrDesc{19, 0, 2048, 2048, 2048, WS_WNSAOUT, 1024};
        case 10: return TrDesc{23, 0, 2048, 2048, 2048, WS_WPQ, 1024};
        default: return TrDesc{23, (size_t)2048 * 2048, 2048, 2048, 2048, WS_WPQ + (size_t)2048 * 2048 * 2, 1024};
    }
}

__device__ __forceinline__ void p0_mod_unit(const Args& A, unsigned char* lds, int u) {
    const int tid = opaque_tid();
    float* sc = (float*)lds;
    float* red = (float*)(lds + 16384);
    const int set = u / 48, cc = u % 48;
    const int layer = set >> 1, kind = set & 1;
    const float* w = (kind ? A.in[21] : A.in[4]) + (size_t)layer * 2048 * 6144;
    const float* bias = (kind ? A.in[22] : A.in[5]) + (size_t)layer * 6144;
    const float* c = A.in[1];
    for (int i = tid; i < 4096; i += NTHREADS) { const float v = c[i]; sc[i] = v / (1.f + __expf(-v)); }
    __syncthreads();
    const int l32 = tid & 31, kg = tid >> 5;
    const int col = cc * 128 + l32 * 4;
    float a0[4] = {0, 0, 0, 0}, a1[4] = {0, 0, 0, 0};
    const float* wp = w + (size_t)(kg * 128) * 6144 + col;
#pragma unroll 8
    for (int i = 0; i < 128; ++i) {
        const f32x4 wv = *(const f32x4*)(wp + (size_t)i * 6144);
        const float s0 = sc[kg * 128 + i], s1 = sc[2048 + kg * 128 + i];
#pragma unroll
        for (int j = 0; j < 4; ++j) { a0[j] += s0 * wv[j]; a1[j] += s1 * wv[j]; }
    }
#pragma unroll
    for (int j = 0; j < 4; ++j) { red[(kg * 2 + 0) * 128 + l32 * 4 + j] = a0[j]; red[(kg * 2 + 1) * 128 + l32 * 4 + j] = a1[j]; }
    __syncthreads();
    if (tid < 256) {
        const int b = tid >> 7, cl = tid & 127;
        float s = 0;
#pragma unroll
        for (int g = 0; g < 16; ++g) s += red[(g * 2 + b) * 128 + cl];
        float* mod = (float*)(WSP(A) + WS_MOD);
        mod[(size_t)(set * 2 + b) * 6144 + cc * 128 + cl] = s + bias[cc * 128 + cl];
    }
    __syncthreads();
}

__device__ __forceinline__ void p0_tr_unit(const Args& A, unsigned char* lds, int u) {
    const int tid = opaque_tid();
    int m = 0, tile = u;
    TrDesc d = tr_desc(0);
    while (tile >= d.ntiles) { tile -= d.ntiles; ++m; d = tr_desc(m); }
    const int nNt = d.Npad / 64;
    const int kt = tile / nNt, nt = tile % nNt;
    const float* src = A.in[d.in_idx] + d.in_off;
    bf16_t* dst = (bf16_t*)(WSP(A) + d.ws_off);
    float* ts = (float*)lds;
    {
        const int r = tid >> 3, cg = tid & 7;
        const int k = kt * 64 + r, n = nt * 64 + cg * 8;
        f32x4 v0 = {0, 0, 0, 0}, v1 = {0, 0, 0, 0};
        if (n < d.N) { const float* p = src + (size_t)k * d.N + n; v0 = *(const f32x4*)p; v1 = *(const f32x4*)(p + 4); }
#pragma unroll
        for (int j = 0; j < 4; ++j) { ts[r * 65 + cg * 8 + j] = v0[j]; ts[r * 65 + cg * 8 + 4 + j] = v1[j]; }
    }
    __syncthreads();
    {
        const int n = tid >> 3, kg = tid & 7;
        float v[8];
#pragma unroll
        for (int j = 0; j < 8; ++j) v[j] = ts[(kg * 8 + j) * 65 + n];
        u32x4 w = {cvtpk(v[0], v[1]), cvtpk(v[2], v[3]), cvtpk(v[4], v[5]), cvtpk(v[6], v[7])};
        *(u32x4*)(dst + (size_t)(nt * 64 + n) * d.K + kt * 64 + kg * 8) = w;
    }
    __syncthreads();
}

__device__ __forceinline__ void p0_peer_unit(const Args& A, int u) {
    const int tid = opaque_tid();
    const bool isv = u >= 1024;
    const int pu = isv ? u - 1024 : u;
    const float* src = (isv ? A.in[27] : A.in[26]) + (size_t)pu * 65536;
    bf16_t* dst = (bf16_t*)(WSP(A) + (isv ? WS_PV : WS_PU)) + (size_t)pu * 65536;
#pragma unroll 4
    for (int it = 0; it < 16; ++it) {
        const int e = (it * NTHREADS + tid) * 8;
        const f32x4 v0 = *(const f32x4*)(src + e), v1 = *(const f32x4*)(src + e + 4);
        u32x4 w = {cvtpk(v0[0], v0[1]), cvtpk(v0[2], v0[3]), cvtpk(v1[0], v1[1]), cvtpk(v1[2], v1[3])};
        *(u32x4*)(dst + e) = w;
    }
}

__device__ __forceinline__ void p0_rope_unit(const Args& A, int u) {
    const int tid = opaque_tid();
    const int* pos = (const int*)A.in[2];
#pragma unroll 1
    for (int it = 0; it < 8; ++it) {
        const int e = u * 4096 + it * NTHREADS + tid;
        if (e < T * 32) {
            const int t = e >> 5, j = e & 31;
            const float inv = powf(500000.0f, -(float)j / 32.0f);
            const float ang = (float)pos[t] * inv;
            float s, c; sincosf(ang, &s, &c);
            ((f32x2*)(WSP(A) + WS_ROPE64))[e] = f32x2{c, s};
        } else {
            const int e2 = e - T * 32;
            const int t = e2 >> 4, j = e2 & 15;
            const float inv = powf(500000.0f, -(float)j / 16.0f);
            const float ang = (float)pos[t] * inv;
            float s, c; sincosf(ang, &s, &c);
            ((f32x2*)(WSP(A) + WS_ROPE32))[e2] = f32x2{c, s};
        }
    }
}

__device__ __forceinline__ void p0_bias_unit(const Args& A, unsigned char* lds, int u) {
    const int tid = opaque_tid();
    const int mat = u >> 5, chunk = u & 31;
    const float* pe = A.in[mat ? 14 : 13];
    const float* w1 = A.in[mat ? 17 : 15];
    const int col = tid & 255, half = tid >> 8;
    float acc = 0;
    const int r0 = chunk * 128 + half * 64;
#pragma unroll 8
    for (int i = 0; i < 64; ++i) acc += pe[r0 + i] * w1[(size_t)(r0 + i) * 256 + col];
    float* red = (float*)lds;
    if (half) red[col] = acc;
    __syncthreads();
    if (!half) ((float*)(WSP(A) + WS_BIASP))[(mat * 32 + chunk) * 256 + col] = acc + red[col];
    __syncthreads();
}

__device__ __forceinline__ void p0_k12_unit(const Args& A, int u) {
    const int tid = opaque_tid();
    bf16_t* dst = (bf16_t*)(WSP(A) + WS_K12);
#pragma unroll
    for (int it = 0; it < 2; ++it) {
        const int e = u * 8192 + (it * NTHREADS + tid) * 8;
        const int layer = e >> 15, which = (e >> 14) & 1, rem = e & 16383;
        const float* src = A.in[which ? 25 : 24] + layer * 16384 + rem;
        const f32x4 v0 = *(const f32x4*)src, v1 = *(const f32x4*)(src + 4);
        u32x4 w = {cvtpk(v0[0], v0[1]), cvtpk(v0[2], v0[3]), cvtpk(v1[0], v1[1]), cvtpk(v1[2], v1[3])};
        *(u32x4*)(dst + e) = w;
    }
}

__device__ __forceinline__ void phase_prologue(const Args& A, unsigned char* lds, int bid, int nb) {
    for (int u = bid; u < U0_TOTAL; u += nb) {
        int v = u;
        if (v < U0_MOD) { p0_mod_unit(A, lds, v); continue; }
        v -= U0_MOD;
        if (v < U0_TR) { p0_tr_unit(A, lds, v); continue; }
        v -= U0_TR;
        if (v < U0_PEER) { p0_peer_unit(A, v); continue; }
        v -= U0_PEER;
        if (v < U0_ROPE) { p0_rope_unit(A, v); continue; }
        v -= U0_ROPE;
        if (v < U0_BIAS) { p0_bias_unit(A, lds, v); continue; }
        v -= U0_BIAS;
        if (v < U0_K12) { p0_k12_unit(A, v); continue; }
        v -= U0_K12;
        {
            u32x4* z = (u32x4*)(WSP(A) + WS_KCC) + (size_t)v * 8192;
            for (int i = opaque_tid(); i < 8192; i += NTHREADS) z[i] = u32x4{0u, 0u, 0u, 0u};
        }
    }
}

__device__ __forceinline__ void modnorm_row(const float* xr, const float* gain, const float* mod  , bf16_t* hr, int lane) {
    f32x4 v[8];
    float ss = 0;
#pragma unroll
    for (int i = 0; i < 8; ++i) { v[i] = *(const f32x4*)(xr + i * 256 + lane * 4); ss += v[i][0] * v[i][0] + v[i][1] * v[i][1] + v[i][2] * v[i][2] + v[i][3] * v[i][3]; }
    ss = wave_sum(ss);
    const float rinv = rsqrtf(ss * (1.0f / 2048.0f) + EPS);
#pragma unroll
    for (int i = 0; i < 8; ++i) {
        const int col = i * 256 + lane * 4;
        const f32x4 g = *(const f32x4*)(gain + col), sh = *(const f32x4*)(mod + col), scl = *(const f32x4*)(mod + 2048 + col);
        float y[4];
#pragma unroll
        for (int j = 0; j < 4; ++j) y[j] = v[i][j] * rinv * g[j] * (1.f + scl[j]) + sh[j];
        u32x2 w = {cvtpk(y[0], y[1]), cvtpk(y[2], y[3])};
        *(u32x2*)(hr + col) = w;
    }
}
__device__ __forceinline__ void phase_modnorm(const Args& A, const float* xin, const float* gain, int set, int bid, int nb) {
    const int tid = opaque_tid(), lane = tid & 63, wave = tid >> 6;
    const float* mod = (const float*)(WSP(A) + WS_MOD) + (size_t)set * 2 * 6144;
    bf16_t* H = (bf16_t*)(WSP(A) + WS_H);
    for (int u = bid; u < T / NWAVES; u += nb) {
        const int row = u * NWAVES + wave;
        modnorm_row(xin + (size_t)row * 2048, gain, mod + (row >> 13) * 6144, H + (size_t)row * 2048, lane);
    }
}

struct ALoadPlain {
    const bf16_t* A; int lda;
    __device__ __forceinline__ const bf16_t* ptr(int row, int k) const { return A + (size_t)row * lda + k; }
};
struct ALoadCmp {
    const bf16_t* base; int ld; int colbase;
    __device__ __forceinline__ const bf16_t* ptr(int row, int k) const {
        int r = row < 2 * BATCH * NCMP ? row : 2 * BATCH * NCMP - 1;
        const int g = r & 1; r >>= 1;
        const int b = r / NCMP, n = r - b * NCMP;
        const int l = k >> 7, d = k & 127;
        return base + (size_t)(b * SEQ + 16 * n + l) * ld + colbase + g * 128 + d;
    }
};

constexpr int GEMM_LDS = 98304;
template <class AL, class Epi>
__device__ __forceinline__ void gemm_phase(unsigned char* lds, const AL al, const bf16_t* __restrict__ Bt, int ldb, int M, int Npad, int K, const Epi epi, int bid, int nb) {
    const int tid = opaque_tid(), lane = tid & 63, wave = tid >> 6, l31 = lane & 31, hi = lane >> 5;
    const int wm = wave >> 1, wn = wave & 1;
    const int nNt = Npad / 128, nU = (M / 256) * nNt, nk = K / 64;
    const int swz = (l31 >> 1) & 7;
    for (int u = bid; u < nU; u += nb) {
        const int mt = u / nNt, nt = u - mt * nNt;
        const int m0 = mt * 256, n0 = nt * 128;
        f32x16 acc[2][2];
#pragma unroll
        for (int i = 0; i < 2; ++i)
#pragma unroll
            for (int j = 0; j < 2; ++j)
#pragma unroll
                for (int r = 0; r < 16; ++r) acc[i][j][r] = 0.f;
        u32x4 ra[4], rb[2];
        auto gload = [&](int kt) {
#pragma unroll
            for (int i = 0; i < 4; ++i) { const int q = tid + NTHREADS * i, row = q >> 3, c = q & 7; ra[i] = *(const u32x4*)al.ptr(m0 + row, kt * 64 + c * 8); }
#pragma unroll
            for (int i = 0; i < 2; ++i) { const int q = tid + NTHREADS * i, row = q >> 3, c = q & 7; rb[i] = *(const u32x4*)(Bt + (size_t)(n0 + row) * ldb + kt * 64 + c * 8); }
        };
        auto lstore = [&](int buf) {
            unsigned char* la = lds + buf * 32768; unsigned char* lb = lds + 65536 + buf * 16384;
#pragma unroll
            for (int i = 0; i < 4; ++i) { const int q = tid + NTHREADS * i, row = q >> 3, c = q & 7; *(u32x4*)(la + row * 128 + ((c ^ ((row >> 1) & 7)) << 4)) = ra[i]; }
#pragma unroll
            for (int i = 0; i < 2; ++i) { const int q = tid + NTHREADS * i, row = q >> 3, c = q & 7; *(u32x4*)(lb + row * 128 + ((c ^ ((row >> 1) & 7)) << 4)) = rb[i]; }
        };
        gload(0); lstore(0); __syncthreads();
        for (int kt = 0; kt < nk; ++kt) {
            if (kt + 1 < nk) gload(kt + 1);
            const unsigned char* la = lds + (kt & 1) * 32768 + (wm * 64 + l31) * 128;
            const unsigned char* lb = lds + 65536 + (kt & 1) * 16384 + (wn * 64 + l31) * 128;
#pragma unroll
            for (int ks = 0; ks < 4; ++ks) {
                const int co = ((ks * 2 + hi) ^ swz) << 4;
                const bf16x8 a0 = *(const bf16x8*)(la + co), a1 = *(const bf16x8*)(la + 32 * 128 + co);
                const bf16x8 b0 = *(const bf16x8*)(lb + co), b1 = *(const bf16x8*)(lb + 32 * 128 + co);
                acc[0][0] = __builtin_amdgcn_mfma_f32_32x32x16_bf16(a0, b0, acc[0][0], 0, 0, 0);
                acc[0][1] = __builtin_amdgcn_mfma_f32_32x32x16_bf16(a0, b1, acc[0][1], 0, 0, 0);
                acc[1][0] = __builtin_amdgcn_mfma_f32_32x32x16_bf16(a1, b0, acc[1][0], 0, 0, 0);
                acc[1][1] = __builtin_amdgcn_mfma_f32_32x32x16_bf16(a1, b1, acc[1][1], 0, 0, 0);
            }
            if (kt + 1 < nk) lstore((kt + 1) & 1);
            __syncthreads();
        }
        epi(acc, m0 + wm * 64, n0 + wn * 64, lane);
    }
}

__device__ __forceinline__ void store_bf16_tile(const f32x16 (&acc)[2][2], bf16_t* C, int ldc, int N, int row0, int col0, int lane) {
    const int l31 = lane & 31, hi = lane >> 5;
#pragma unroll
    for (int ni = 0; ni < 2; ++ni) {
        const int col = col0 + ni * 32 + l31;
#pragma unroll
        for (int mi = 0; mi < 2; ++mi)
#pragma unroll
            for (int r = 0; r < 16; ++r) {
                const float v = acc[mi][ni][r];
                const float vn = __shfl_xor(v, 1);
                if ((l31 & 1) == 0 && col < N) *(unsigned*)(C + (size_t)(row0 + mi * 32 + crow(r, hi)) * ldc + col) = cvtpk(v, vn);
            }
    }
}
struct EpiBf16 {
    bf16_t* C; int ldc; int N;
    __device__ __forceinline__ void operator()(f32x16 (&acc)[2][2], int row0, int col0, int lane) const { store_bf16_tile(acc, C, ldc, N, row0, col0, lane); }
};
struct EpiMlaQ {
    bf16_t* C; const f32x2* rope64;
    __device__ __forceinline__ void operator()(f32x16 (&acc)[2][2], int row0, int col0, int lane) const {
        const int l31 = lane & 31, hi = lane >> 5;
        if ((col0 % 192) == 128) {
#pragma unroll
            for (int mi = 0; mi < 2; ++mi)
#pragma unroll
                for (int r = 0; r < 16; ++r) {
                    const int row = row0 + mi * 32 + crow(r, hi);
                    const f32x2 cs = rope64[(size_t)row * 32 + l31];
                    const float x1 = acc[mi][0][r], x2 = acc[mi][1][r];
                    acc[mi][0][r] = x1 * cs[0] - x2 * cs[1];
                    acc[mi][1][r] = x2 * cs[0] + x1 * cs[1];
                }
        }
        store_bf16_tile(acc, C, 1536, 1536, row0, col0, lane);
    }
};
struct EpiNsaIn {
    bf16_t* C; const f32x2* rope32;
    __device__ __forceinline__ void operator()(f32x16 (&acc)[2][2], int row0, int col0, int lane) const {
        const int l31 = lane & 31, hi = lane >> 5;
#pragma unroll
        for (int ni = 0; ni < 2; ++ni) {
            const int cb = col0 + ni * 32, hb = cb >> 7;
            const bool is_rope = ((cb & 127) == 0) && (hb < 18 || hb == 20 || hb == 21 || hb == 24 || hb == 25);
            if (is_rope) {
#pragma unroll
                for (int mi = 0; mi < 2; ++mi)
#pragma unroll
                    for (int r = 0; r < 16; ++r) {
                        const int row = row0 + mi * 32 + crow(r, hi);
                        const f32x2 cs = rope32[(size_t)row * 16 + (l31 & 15)];
                        const float own = acc[mi][ni][r];
                        const float oth = __shfl_xor(own, 16);
                        acc[mi][ni][r] = (l31 < 16) ? own * cs[0] - oth * cs[1] : own * cs[0] + oth * cs[1];
                    }
            }
            if (cb >= 3584) {
#pragma unroll
                for (int mi = 0; mi < 2; ++mi)
#pragma unroll
                    for (int r = 0; r < 16; ++r) acc[mi][ni][r] = 1.f / (1.f + __expf(-acc[mi][ni][r]));
            }
        }
        store_bf16_tile(acc, C, NSA_IN, NSA_IN, row0, col0, lane);
    }
};
struct EpiResid {
    const float* xin; float* xout; const float* gate; float gmul;
    __device__ __forceinline__ void operator()(f32x16 (&acc)[2][2], int row0, int col0, int lane) const {
        const int l31 = lane & 31, hi = lane >> 5;
        const float* gp = gate + (row0 >> 13) * 6144;
#pragma unroll
        for (int ni = 0; ni < 2; ++ni) {
            const int col = col0 + ni * 32 + l31;
            const float g = gp[col] * gmul;
#pragma unroll
            for (int mi = 0; mi < 2; ++mi)
#pragma unroll
                for (int r = 0; r < 16; ++r) {
                    const size_t o = (size_t)(row0 + mi * 32 + crow(r, hi)) * 2048 + col;
                    xout[o] = xin[o] + g * acc[mi][ni][r];
                }
        }
    }
};
struct EpiCmpHid {
    bf16_t* C; const float* biasp;
    __device__ __forceinline__ void operator()(f32x16 (&acc)[2][2], int row0, int col0, int lane) const {
        const int l31 = lane & 31;
#pragma unroll
        for (int ni = 0; ni < 2; ++ni) {
            const int col = col0 + ni * 32 + l31;
            float b = 0;
#pragma unroll 8
            for (int c = 0; c < 32; ++c) b += biasp[c * 256 + col];
#pragma unroll
            for (int mi = 0; mi < 2; ++mi)
#pragma unroll
                for (int r = 0; r < 16; ++r) acc[mi][ni][r] = gelu_tanh(acc[mi][ni][r] + b);
        }
        store_bf16_tile(acc, C, 256, 256, row0, col0, lane);
    }
};
struct EpiCmpOut {
    bf16_t* C;
    __device__ __forceinline__ void operator()(f32x16 (&acc)[2][2], int row0, int col0, int lane) const {
        const int l31 = lane & 31, hi = lane >> 5;
#pragma unroll
        for (int ni = 0; ni < 2; ++ni) {
            const int col = col0 + ni * 32 + l31;
#pragma unroll
            for (int mi = 0; mi < 2; ++mi)
#pragma unroll
                for (int r = 0; r < 16; ++r) {
                    const float v = acc[mi][ni][r];
                    const float vn = __shfl_xor(v, 1);
                    int rr = row0 + mi * 32 + crow(r, hi);
                    if ((l31 & 1) == 0 && rr < 2 * BATCH * NCMP) {
                        const int g = rr & 1; rr >>= 1;
                        const int b = rr / NCMP, n = rr - b * NCMP;
                        *(unsigned*)(C + (size_t)((b * NCMP_PAD + n) * 2 + g) * 128 + col) = cvtpk(v, vn);
                    }
                }
        }
    }
};

__device__ __forceinline__ void phase_mla_prep(const Args& A, int bid, int nb) {
    const int tid = opaque_tid(), lane = tid & 63, wave = tid >> 6;
    const bf16_t* BIG = (const bf16_t*)(WSP(A) + WS_BIG);
    bf16_t* CQN = (bf16_t*)(WSP(A) + WS_CQN); bf16_t* CKVN = (bf16_t*)(WSP(A) + WS_CKVN); bf16_t* KVM = (bf16_t*)(WSP(A) + WS_KVM);
    const f32x2* rope64 = (const f32x2*)(WSP(A) + WS_ROPE64);
    const float* qn = A.in[7]; const float* kvn = A.in[9];
    for (int u = bid; u < T / NWAVES; u += nb) {
        const int t = u * NWAVES + wave;
        const bf16_t* row = BIG + (size_t)t * SBMLA_IN;
        {
            const u32x4 w = *(const u32x4*)(row + 3072 + lane * 8);
            float x[8] = {bflo(w[0]), bfhi(w[0]), bflo(w[1]), bfhi(w[1]), bflo(w[2]), bfhi(w[2]), bflo(w[3]), bfhi(w[3])};
            float ss = 0;
#pragma unroll
            for (int j = 0; j < 8; ++j) ss += x[j] * x[j];
            ss = wave_sum(ss);
            const float rinv = rsqrtf(ss * (1.f / 512.f) + EPS);
            const f32x4 g0 = *(const f32x4*)(qn + lane * 8), g1 = *(const f32x4*)(qn + lane * 8 + 4);
            u32x4 o = {cvtpk(x[0] * rinv * g0[0], x[1] * rinv * g0[1]), cvtpk(x[2] * rinv * g0[2], x[3] * rinv * g0[3]),
                       cvtpk(x[4] * rinv * g1[0], x[5] * rinv * g1[1]), cvtpk(x[6] * rinv * g1[2], x[7] * rinv * g1[3])};
            *(u32x4*)(CQN + (size_t)t * 512 + lane * 8) = o;
        }
        {
            const u32x2 w = *(const u32x2*)(row + 3584 + lane * 4);
            float x[4] = {bflo(w[0]), bfhi(w[0]), bflo(w[1]), bfhi(w[1])};
            float ss = x[0] * x[0] + x[1] * x[1] + x[2] * x[2] + x[3] * x[3];
            ss = wave_sum(ss);
            const float rinv = rsqrtf(ss * (1.f / 256.f) + EPS);
            const f32x4 g = *(const f32x4*)(kvn + lane * 4);
            u32x2 o = {cvtpk(x[0] * rinv * g[0], x[1] * rinv * g[1]), cvtpk(x[2] * rinv * g[2], x[3] * rinv * g[3])};
            *(u32x2*)(CKVN + (size_t)t * 256 + lane * 4) = o;
        }
        {
            const float x = bf2f(row[3840 + lane]);
            const float oth = __shfl_xor(x, 32);
            const f32x2 cs = rope64[(size_t)t * 32 + (lane & 31)];
            const float y = (lane < 32) ? x * cs[0] - oth * cs[1] : x * cs[0] + oth * cs[1];
            KVM[(size_t)t * KVM_LD + 2048 + lane] = (bf16_t)(cvtpk(y, y) & 0xFFFFu);
        }
    }
}
constexpr int KSTR128 = 272, KSTR192 = 400, VSTR = 320;
constexpr int ATT_K_BYTES = 64 * KSTR192;
constexpr int ATT_V_BYTES = 64 * VSTR;
constexpr int ATT_KOFF = 0, ATT_VOFF = 2 * ATT_K_BYTES, ATT_MISC = ATT_VOFF + 2 * ATT_V_BYTES;

template <int NKS, int KSTR>
__device__ __forceinline__ void qk_tile(f32x16& p0, f32x16& p1, const unsigned char* kb_lane, const bf16x8* qr) {
#pragma unroll
    for (int r = 0; r < 16; ++r) { p0[r] = 0.f; p1[r] = 0.f; }
#pragma unroll
    for (int ks = 0; ks < NKS; ++ks) {
        const bf16x8 a0 = *(const bf16x8*)(kb_lane + ks * 32);
        const bf16x8 a1 = *(const bf16x8*)(kb_lane + 32 * KSTR + ks * 32);
        p0 = __builtin_amdgcn_mfma_f32_32x32x16_bf16(a0, qr[ks], p0, 0, 0, 0);
        p1 = __builtin_amdgcn_mfma_f32_32x32x16_bf16(a1, qr[ks], p1, 0, 0, 0);
        if ((ks & 3) == 3) __builtin_amdgcn_sched_barrier(0);
    }
}
__device__ __forceinline__ s16x4 tr_read(const unsigned char* p) {
    return __builtin_amdgcn_ds_read_tr16_b64_v4i16((LAS s16x4*)p);
}
__device__ __forceinline__ void pv_tile(f32x16 (&o)[4], const unsigned char* vb_lane, const bf16x8 (&pb)[4]) {
#pragma unroll
    for (int dt = 0; dt < 4; ++dt) {
#pragma unroll
        for (int s = 0; s < 4; ++s) {
            const s16x4 lo = tr_read(vb_lane + (s * 16) * VSTR + dt * 64);
            const s16x4 hh = tr_read(vb_lane + (s * 16 + 8) * VSTR + dt * 64);
            const bf16x8 a = {lo[0], lo[1], lo[2], lo[3], hh[0], hh[1], hh[2], hh[3]};
            o[dt] = __builtin_amdgcn_mfma_f32_32x32x16_bf16(a, pb[s], o[dt], 0, 0, 0);
        }
        __builtin_amdgcn_sched_barrier(0);
    }
}
__device__ __forceinline__ bf16x8 pack8f(const f32x16& p, int b) {
    u32x4 w = {cvtpk(p[b + 0], p[b + 1]), cvtpk(p[b + 2], p[b + 3]), cvtpk(p[b + 4], p[b + 5]), cvtpk(p[b + 6], p[b + 7])};
    return *reinterpret_cast<bf16x8*>(&w);
}
__device__ __forceinline__ int vb_lane_off(int lane) {
    return (4 * (lane >> 5) + ((lane >> 2) & 3)) * VSTR + (16 * ((lane >> 4) & 1) + 4 * (lane & 3)) * 2;
}
__device__ __forceinline__ void softmax_step(f32x16& p0, f32x16& p1, float& m, float& l, f32x16 (&o)[4], float c2, bf16x8 (&pb)[4]) {
    float mx = p0[0];
#pragma unroll
    for (int r = 1; r < 16; ++r) mx = fmaxf(mx, p0[r]);
#pragma unroll
    for (int r = 0; r < 16; ++r) mx = fmaxf(mx, p1[r]);
    mx = fmaxf(mx, __shfl_xor(mx, 32));
    const float mn = fmaxf(m, mx);
    const float alpha = __builtin_amdgcn_exp2f((m - mn) * c2);
    const float mc = mn * c2;
    float rs = 0.f;
#pragma unroll
    for (int r = 0; r < 16; ++r) { p0[r] = __builtin_amdgcn_exp2f(p0[r] * c2 - mc); rs += p0[r]; }
#pragma unroll
    for (int r = 0; r < 16; ++r) { p1[r] = __builtin_amdgcn_exp2f(p1[r] * c2 - mc); rs += p1[r]; }
    rs += __shfl_xor(rs, 32);
    l = l * alpha + rs;
    m = mn;
    if (__any(alpha != 1.f)) {
#pragma unroll
        for (int dt = 0; dt < 4; ++dt)
#pragma unroll
            for (int r = 0; r < 16; ++r) o[dt][r] *= alpha;
    }
    pb[0] = pack8f(p0, 0); pb[1] = pack8f(p0, 8); pb[2] = pack8f(p1, 0); pb[3] = pack8f(p1, 8);
}
__device__ __forceinline__ void store_ot_bf16(const f32x16 (&o)[4], float sc, bf16_t* orow  , int hi) {
#pragma unroll
    for (int dt = 0; dt < 4; ++dt)
#pragma unroll
        for (int g = 0; g < 4; ++g) {
            u32x2 w = {cvtpk(o[dt][4 * g] * sc, o[dt][4 * g + 1] * sc), cvtpk(o[dt][4 * g + 2] * sc, o[dt][4 * g + 3] * sc)};
            *(u32x2*)(orow + dt * 32 + 8 * g + 4 * hi) = w;
        }
}

__device__ __forceinline__ void mla_item(const Args& A, unsigned char* lds, int b, int h, int qt) {
    const int tid = opaque_tid(), lane = tid & 63, wave = tid >> 6, l31 = lane & 31, hi = lane >> 5;
    const bf16_t* QM = (const bf16_t*)(WSP(A) + WS_QM); const bf16_t* KVM = (const bf16_t*)(WSP(A) + WS_KVM);
    bf16_t* O = (bf16_t*)(WSP(A) + WS_O);
    const int q0 = qt * 256, qw = q0 + wave * 32, t = qw + l31;
    const size_t tokb = (size_t)b * SEQ;
    bf16x8 qr[12];
    {
        const bf16_t* qp = QM + (tokb + t) * 1536 + h * 192 + hi * 8;
#pragma unroll
        for (int ks = 0; ks < 12; ++ks) qr[ks] = *(const bf16x8*)(qp + ks * 16);
    }
    const int nkt = (q0 + 256) / 64;
    u32x4 rk[3], rv[2];
    unsigned okb[3], ovb[2], lkb[3], lvb[2];
#pragma unroll
    for (int i = 0; i < 3; ++i) {
        const int q = tid + NTHREADS * i, row = q / 24, c = q - row * 24;
        okb[i] = (unsigned)(row * KVM_LD + ((c < 16) ? h * 256 + c * 8 : 2048 + (c - 16) * 8)) * 2u;
        lkb[i] = (unsigned)(row * KSTR192 + c * 16);
    }
#pragma unroll
    for (int i = 0; i < 2; ++i) {
        const int q = tid + NTHREADS * i, row = q >> 4, c = q & 15;
        ovb[i] = (unsigned)(row * KVM_LD + h * 256 + 128 + c * 8) * 2u;
        lvb[i] = (unsigned)(row * VSTR + c * 16);
    }
    auto gload = [&](int kt) {
        const unsigned char* base = (const unsigned char*)(KVM + (tokb + (size_t)kt * 64) * KVM_LD);
#pragma unroll
        for (int i = 0; i < 3; ++i) rk[i] = *(const u32x4*)(base + okb[i]);
#pragma unroll
        for (int i = 0; i < 2; ++i) rv[i] = *(const u32x4*)(base + ovb[i]);
    };
    auto lstore = [&](int buf) {
        unsigned char* kb = lds + ATT_KOFF + buf * ATT_K_BYTES; unsigned char* vb = lds + ATT_VOFF + buf * ATT_V_BYTES;
#pragma unroll
        for (int i = 0; i < 3; ++i) *(u32x4*)(kb + lkb[i]) = rk[i];
#pragma unroll
        for (int i = 0; i < 2; ++i) *(u32x4*)(vb + lvb[i]) = rv[i];
    };
    f32x16 o[4];
#pragma unroll
    for (int dt = 0; dt < 4; ++dt)
#pragma unroll
        for (int r = 0; r < 16; ++r) o[dt][r] = 0.f;
    float m = -1e30f, l = 0.f;
    const float c2 = 0.07216878364870322f * 1.4426950408889634f;
    const int kl_off = l31 * KSTR192 + hi * 16, vl_off = vb_lane_off(lane);
    gload(0); lstore(0); __syncthreads();
    for (int kt = 0; kt < nkt; ++kt) {
        if (kt + 1 < nkt) gload(kt + 1);
        if (kt * 64 <= qw + 31) {
            f32x16 p0, p1;
            qk_tile<12, KSTR192>(p0, p1, lds + ATT_KOFF + (kt & 1) * ATT_K_BYTES + kl_off, qr);
            if (kt * 64 + 63 > qw) {
                const int dq = t - kt * 64 - 4 * hi;
#pragma unroll
                for (int r = 0; r < 16; ++r) {
                    const int cb = (r & 3) + 8 * (r >> 2);
                    if (cb > dq) p0[r] = -__builtin_inff();
                    if (cb + 32 > dq) p1[r] = -__builtin_inff();
                }
            }
            bf16x8 pb[4];
            softmax_step(p0, p1, m, l, o, c2, pb);
            pv_tile(o, lds + ATT_VOFF + (kt & 1) * ATT_V_BYTES + vl_off, pb);
        }
        if (kt + 1 < nkt) lstore((kt + 1) & 1);
        __syncthreads();
    }
    store_ot_bf16(o, ABL_MLA / l, O + (tokb + t) * 2048 + 1024 + h * 128, hi);
}

__device__ __forceinline__ void sb_item(const Args& A, unsigned char* lds, int b, int h, int qt) {
    const int tid = opaque_tid(), lane = tid & 63, wave = tid >> 6, l31 = lane & 31, hi = lane >> 5;
    const bf16_t* BIG = (const bf16_t*)(WSP(A) + WS_BIG);
    bf16_t* O = (bf16_t*)(WSP(A) + WS_O);
    volatile int* flags = (volatile int*)(lds + ATT_MISC);
    const int q0 = qt * 256, qw = q0 + wave * 32, t = qw + l31;
    const size_t tokb = (size_t)b * SEQ;
    bf16x8 qr[8];
    {
        const bf16_t* qp = BIG + (tokb + t) * SBMLA_IN + h * 128 + hi * 8;
#pragma unroll
        for (int ks = 0; ks < 8; ++ks) qr[ks] = *(const bf16x8*)(qp + ks * 16);
    }
    bf16x8 tri[2];
#pragma unroll
    for (int s2 = 0; s2 < 2; ++s2)
#pragma unroll
        for (int jj = 0; jj < 8; ++jj) tri[s2][jj] = (16 * s2 + 8 * (jj >> 2) + 4 * hi + (jj & 3) > l31) ? (short)0x3F80 : (short)0;
    u32x4 rk[2], rv[2];
    unsigned ogb[2], lkb[2], lvb[2];
#pragma unroll
    for (int i = 0; i < 2; ++i) {
        const int q = tid + NTHREADS * i, row = q >> 4, c = q & 15;
        ogb[i] = (unsigned)(row * SBMLA_IN + c * 8) * 2u; lkb[i] = (unsigned)(row * KSTR128 + c * 16); lvb[i] = (unsigned)(row * VSTR + c * 16);
    }
    auto gload = [&](int kt) {
        const unsigned char* base = (const unsigned char*)(BIG + (tokb + (size_t)kt * 64) * SBMLA_IN + h * 128);
#pragma unroll
        for (int i = 0; i < 2; ++i) { rk[i] = *(const u32x4*)(base + 2048 + ogb[i]); rv[i] = *(const u32x4*)(base + 4096 + ogb[i]); }
    };
    auto lstore = [&](int buf) {
        unsigned char* kb = lds + ATT_KOFF + buf * ATT_K_BYTES; unsigned char* vb = lds + ATT_VOFF + buf * ATT_V_BYTES;
#pragma unroll
        for (int i = 0; i < 2; ++i) { *(u32x4*)(kb + lkb[i]) = rk[i]; *(u32x4*)(vb + lvb[i]) = rv[i]; }
    };
    f32x16 o[4];
#pragma unroll
    for (int dt = 0; dt < 4; ++dt)
#pragma unroll
        for (int r = 0; r < 16; ++r) o[dt][r] = 0.f;
    float R = 0.f;
    bool done = false;
    const float scale = 0.08838834764831845f;
    const int kt_hi = (q0 + 254) / 64, ktw = (qw + 30) / 64;
    const int kl_off = l31 * KSTR128 + hi * 16, vl_off = vb_lane_off(lane);
    gload(kt_hi); lstore(0); __syncthreads();
    int it = 0;
    for (int kt = kt_hi; kt >= 0; --kt, ++it) {
        if (kt > 0) gload(kt - 1);
        if (kt <= ktw && !done) {
            f32x16 p0, p1;
            qk_tile<8, KSTR128>(p0, p1, lds + ATT_KOFF + (it & 1) * ATT_K_BYTES + kl_off, qr);
            const int dq = t - kt * 64 - 4 * hi;
            float tot0 = 0.f, tot1 = 0.f;
            u32x4 w0, w1, w2, w3;
            auto sbf = [&](float pz, bool v, float& tot, float& lbo) -> float {
                const float z = pz * scale;
                const float lp = __logf(1.f + __expf(-fabsf(z)));
                const float lb = fminf(z, 0.f) - lp;
                const float l1 = v ? lb - z : 0.f;
                tot += l1; lbo = v ? lb : -__builtin_inff();
                return l1;
            };
#pragma unroll
            for (int r = 0; r < 16; r += 2) {
                const int cb0 = (r & 3) + 8 * (r >> 2), cb1 = ((r + 1) & 3) + 8 * ((r + 1) >> 2);
                float t0_, t1_, t2_, t3_;
                const float a0 = sbf(p0[r], cb0 < dq, tot0, t0_), a1 = sbf(p0[r + 1], cb1 < dq, tot0, t1_);
                const float b0 = sbf(p1[r], cb0 + 32 < dq, tot1, t2_), b1 = sbf(p1[r + 1], cb1 + 32 < dq, tot1, t3_);
                p0[r] = t0_; p0[r + 1] = t1_; p1[r] = t2_; p1[r + 1] = t3_;
                const unsigned pa = cvtpk(a0, a1), pbb = cvtpk(b0, b1);
                if (r < 8) { w0[r >> 1] = pa; w2[r >> 1] = pbb; } else { w1[(r - 8) >> 1] = pa; w3[(r - 8) >> 1] = pbb; }
            }
            tot0 += __shfl_xor(tot0, 32); tot1 += __shfl_xor(tot1, 32);
            bf16x8 lf[4];
            lf[0] = *reinterpret_cast<bf16x8*>(&w0); lf[1] = *reinterpret_cast<bf16x8*>(&w1); lf[2] = *reinterpret_cast<bf16x8*>(&w2); lf[3] = *reinterpret_cast<bf16x8*>(&w3);
            f32x16 c0, c1;
            const float r1 = R + tot1;
#pragma unroll
            for (int r = 0; r < 16; ++r) { c1[r] = R; c0[r] = r1; }
            c1 = __builtin_amdgcn_mfma_f32_32x32x16_bf16(tri[0], lf[2], c1, 0, 0, 0);
            c1 = __builtin_amdgcn_mfma_f32_32x32x16_bf16(tri[1], lf[3], c1, 0, 0, 0);
            c0 = __builtin_amdgcn_mfma_f32_32x32x16_bf16(tri[0], lf[0], c0, 0, 0, 0);
            c0 = __builtin_amdgcn_mfma_f32_32x32x16_bf16(tri[1], lf[1], c0, 0, 0, 0);
#pragma unroll
            for (int r = 0; r < 16; ++r) { p0[r] = __expf(p0[r] + c0[r]); p1[r] = __expf(p1[r] + c1[r]); }
            R = r1 + tot0;
            bf16x8 pb[4] = {pack8f(p0, 0), pack8f(p0, 8), pack8f(p1, 0), pack8f(p1, 8)};
            pv_tile(o, lds + ATT_VOFF + (it & 1) * ATT_V_BYTES + vl_off, pb);
            done = __all(R < -104.f);
        }
        if (lane == 0) flags[(it & 1) * 8 + wave] = done ? 1 : 0;
        if (kt > 0) lstore((it + 1) & 1);
        __syncthreads();
        int nd = 0;
#pragma unroll
        for (int w = 0; w < 8; ++w) nd += flags[(it & 1) * 8 + w];
        if (nd == 8) break;
    }
    store_ot_bf16(o, ABL_SB, O + (tokb + t) * 2048 + h * 128, hi);
    __syncthreads();
}

__device__ __forceinline__ void phase_attn0(const Args& A, unsigned char* lds, int bid, int nb) {
    for (int u = bid; u < 256; u += nb) {
        const int bh = u >> 4, p = u & 15;
#pragma unroll 1
        for (int rep = 0; rep < 2; ++rep) mla_item(A, lds, bh >> 3, bh & 7, rep ? p : 31 - p);
    }
    for (int v = bid; v < 512; v += nb) {
        const int bh = v >> 5, qt = v & 31;
        sb_item(A, lds, bh >> 3, bh & 7, qt);
    }
}
__device__ __forceinline__ unsigned f2sort(float f) { const unsigned u = __float_as_uint(f); return u ^ ((u & 0x80000000u) ? 0xFFFFFFFFu : 0x80000000u); }
__device__ __forceinline__ float sort2f(unsigned s) { const unsigned u = (s & 0x80000000u) ? (s ^ 0x80000000u) : ~s; return __uint_as_float(u); }
__device__ __forceinline__ unsigned umax3(unsigned a, unsigned b, unsigned c) { return max(max(a, b), c); }

__device__ __forceinline__ void top16_of_128(unsigned (&k)[64], unsigned* out  , int lane) {
#pragma unroll 1
    for (int it = 0; it < 16; ++it) {
        unsigned mx = k[0];
#pragma unroll
        for (int i = 1; i < 63; i += 2) mx = umax3(mx, k[i], k[i + 1]);
        mx = max(mx, k[63]);
        const unsigned pm = (unsigned)__shfl_xor((int)mx, 32);
        const unsigned g = max(mx, pm);
        out[it * 64 + lane] = g;
#pragma unroll
        for (int i = 0; i < 64; ++i) k[i] = (k[i] == g) ? 0u : k[i];
    }
}

constexpr int TOPK_STAGE = 2 * 128 * KSTR128;
constexpr int TOPK_LDS = TOPK_STAGE + 8 * 8192;
__device__ __forceinline__ void phase_topk(const Args& A, unsigned char* lds, int layer, int bid, int nb) {
    const int tid = opaque_tid(), lane = tid & 63, wave = tid >> 6, l31 = lane & 31, hi = lane >> 5;
    const bf16_t* PQ = (const bf16_t*)(WSP(A) + WS_PQ);
    const bf16_t* K12 = (const bf16_t*)(WSP(A) + WS_K12) + (size_t)layer * 2 * 16384;
    int* EXI = (int*)(WSP(A) + WS_EXI); float* EXG = (float*)(WSP(A) + WS_EXG);
    for (int q = tid; q < 2 * 128 * 16; q += NTHREADS) { const int row = q >> 4, c = q & 15; *(u32x4*)(lds + row * KSTR128 + c * 16) = *(const u32x4*)(K12 + row * 128 + c * 8); }
    __syncthreads();
    for (int u = bid; u < T / 32; u += nb) {
        const int t = u * 32 + l31, h = wave;
        unsigned* wl = (unsigned*)(lds + TOPK_STAGE) + wave * 2048;
#pragma unroll
        for (int side = 0; side < 2; ++side) {
            bf16x8 qr[8];
            const bf16_t* qp = PQ + (size_t)t * 2048 + h * 256 + side * 128 + hi * 8;
#pragma unroll
            for (int ks = 0; ks < 8; ++ks) qr[ks] = *(const bf16x8*)(qp + ks * 16);
            const unsigned char* kp = lds + side * 128 * KSTR128 + l31 * KSTR128 + hi * 16;
            unsigned keys[64];
#pragma unroll
            for (int mt = 0; mt < 4; ++mt) {
                f32x16 p;
#pragma unroll
                for (int r = 0; r < 16; ++r) p[r] = 0.f;
#pragma unroll
                for (int ks = 0; ks < 8; ++ks) {
                    const bf16x8 a = *(const bf16x8*)(kp + mt * 32 * KSTR128 + ks * 32);
                    p = __builtin_amdgcn_mfma_f32_32x32x16_bf16(a, qr[ks], p, 0, 0, 0);
                }
#pragma unroll
                for (int r = 0; r < 16; ++r) {
                    const int key = mt * 32 + (r & 3) + 8 * (r >> 2) + 4 * hi;
                    keys[mt * 16 + r] = (f2sort(p[r]) & ~127u) | (unsigned)(127 - key);
                }
                __builtin_amdgcn_sched_barrier(0);
            }
            top16_of_128(keys, wl + side * 1024, lane);
        }
        unsigned lst[2][16];
#pragma unroll
        for (int i = 0; i < 16; ++i) { lst[0][i] = wl[i * 64 + lane]; lst[1][i] = wl[1024 + i * 64 + lane]; }
        float v1[16], v2[16];
#pragma unroll
        for (int i = 0; i < 16; ++i) { v1[i] = sort2f(lst[0][i] & ~127u); v2[i] = sort2f(lst[1][i] & ~127u); }
        unsigned cand[50];
        {
            int c = 0;
#pragma unroll
            for (int i = 0; i < 16; ++i)
#pragma unroll
                for (int j = 0; j < 16; ++j)
                    if ((i + 1) * (j + 1) <= 16) { cand[c] = (f2sort(v1[i] + v2[j]) & ~255u) | (unsigned)(255 - (16 * i + j)); ++c; }
        }
        float* wv = (float*)wl; int* we = (int*)wl + 1024;
#pragma unroll 1
        for (int it = 0; it < 16; ++it) {
            unsigned mx = cand[0];
#pragma unroll
            for (int c = 1; c < 49; c += 2) mx = umax3(mx, cand[c], cand[c + 1]);
            mx = max(mx, cand[49]);
            wv[it * 64 + lane] = sort2f(mx & ~255u);
            int eid = 0;
            {
                int c = 0;
#pragma unroll
                for (int i = 0; i < 16; ++i)
#pragma unroll
                    for (int j = 0; j < 16; ++j)
                        if ((i + 1) * (j + 1) <= 16) {
                            const bool hit = cand[c] == mx;
                            eid = hit ? (int)((127u - (lst[0][i] & 127u)) * 128u + (127u - (lst[1][j] & 127u))) : eid;
                            cand[c] = hit ? 0u : cand[c];
                            ++c;
                        }
            }
            we[it * 64 + lane] = eid;
        }
        float topv[16]; int tope[16];
#pragma unroll
        for (int it = 0; it < 16; ++it) { topv[it] = wv[it * 64 + lane]; tope[it] = we[it * 64 + lane]; }
        const float mx0 = topv[0];
        float sum = 0.f;
#pragma unroll
        for (int it = 0; it < 16; ++it) { topv[it] = __expf(topv[it] - mx0); sum += topv[it]; }
        if (hi == 0) {
            const float inv = 1.f / sum;
            int* ei = EXI + (size_t)t * 128 + h * 16; float* eg = EXG + (size_t)t * 128 + h * 16;
#pragma unroll
            for (int q = 0; q < 4; ++q) {
                *(int4*)(ei + 4 * q) = make_int4(tope[4 * q], tope[4 * q + 1], tope[4 * q + 2], tope[4 * q + 3]);
                *(f32x4*)(eg + 4 * q) = f32x4{topv[4 * q] * inv, topv[4 * q + 1] * inv, topv[4 * q + 2] * inv, topv[4 * q + 3] * inv};
            }
        }
    }
    __syncthreads();
}
__device__ __forceinline__ float dot8(const u32x4 a, const float (&h)[8], float acc) {
#pragma unroll
    for (int j = 0; j < 4; ++j) { acc += bflo(a[j]) * h[2 * j]; acc += bfhi(a[j]) * h[2 * j + 1]; }
    return acc;
}
__device__ __forceinline__ void axpy8(float (&o)[8], const u32x4 v, float w) {
#pragma unroll
    for (int j = 0; j < 4; ++j) { o[2 * j] += w * bflo(v[j]); o[2 * j + 1] += w * bfhi(v[j]); }
}

template <bool FINAL>
__device__ __forceinline__ void phase_gather(const Args& A, int layer, const float* xin, float* xout, int gate_set, const float* next_gain, int next_set, float gmul, int bid, int nb) {
    const int tid = opaque_tid(), lane = tid & 63, wave = tid >> 6;
    bf16_t* H = (bf16_t*)(WSP(A) + WS_H);
    const bf16_t* PU = (const bf16_t*)(WSP(A) + WS_PU) + (size_t)layer * 16384 * 2048;
    const bf16_t* PV = (const bf16_t*)(WSP(A) + WS_PV) + (size_t)layer * 16384 * 2048;
    const int* EXI = (const int*)(WSP(A) + WS_EXI); const float* EXG = (const float*)(WSP(A) + WS_EXG);
    const float* mod = (const float*)(WSP(A) + WS_MOD);
    for (int u = bid; u < T / NWAVES; u += nb) {
        const int t = u * NWAVES + wave;
        float hp[4][8];
#pragma unroll
        for (int c = 0; c < 4; ++c) {
            const u32x4 w_ = *(const u32x4*)(H + (size_t)t * 2048 + c * 512 + lane * 8);
#pragma unroll
            for (int j = 0; j < 4; ++j) { hp[c][2 * j] = bflo(w_[j]); hp[c][2 * j + 1] = bfhi(w_[j]); }
        }
        const int idxA = EXI[(size_t)t * 128 + lane], idxB = EXI[(size_t)t * 128 + 64 + lane];
        const float gA = EXG[(size_t)t * 128 + lane], gB = EXG[(size_t)t * 128 + 64 + lane];
        float o[4][8];
#pragma unroll
        for (int c = 0; c < 4; ++c)
#pragma unroll
            for (int j = 0; j < 8; ++j) o[c][j] = 0.f;
        u32x4 ua[4], va[4], ub[4], vb[4];
        auto issue = [&](int k, u32x4 (&uu)[4], u32x4 (&vv)[4]) {
            const int e = __builtin_amdgcn_readlane(k < 64 ? idxA : idxB, k & 63);
            const bf16_t* up = PU + (size_t)e * 2048 + lane * 8; const bf16_t* vp = PV + (size_t)e * 2048 + lane * 8;
#pragma unroll
            for (int c = 0; c < 4; ++c) { uu[c] = *(const u32x4*)(up + c * 512); vv[c] = *(const u32x4*)(vp + c * 512); }
        };
        auto consume = [&](int k, const u32x4 (&uu)[4], const u32x4 (&vv)[4]) {
            float d = 0.f;
#pragma unroll
            for (int c = 0; c < 4; ++c) d = dot8(uu[c], hp[c], d);
            d = wave_sum(d);
            const float g = __uint_as_float(__builtin_amdgcn_readlane(__float_as_uint(k < 64 ? gA : gB), k & 63));
            const float w = g * gelu_tanh(d) * gmul;
#pragma unroll
            for (int c = 0; c < 4; ++c) axpy8(o[c], vv[c], w);
        };
#ifdef NAIVE_GATHER
        {
            const float* U32 = A.in[26] + (size_t)layer * 16384 * 2048; const float* V32 = A.in[27] + (size_t)layer * 16384 * 2048;
#pragma unroll 1
            for (int k = 0; k < 128; ++k) {
                const int e = EXI[(size_t)t * 128 + k];
                const float g = EXG[(size_t)t * 128 + k];
                float d = 0.f;
                for (int c = 0; c < 4; ++c)
                    for (int j = 0; j < 8; ++j) {
                        const float hv = hp[c][j];
                        d += hv * U32[(size_t)e * 2048 + c * 512 + lane * 8 + j];
                    }
                d = wave_sum(d);
                const float w = g * gelu_tanh(d) * gmul;
                for (int c = 0; c < 4; ++c)
                    for (int j = 0; j < 8; ++j) o[c][j] += w * V32[(size_t)e * 2048 + c * 512 + lane * 8 + j];
            }
        }
        if (false)
#endif
        {
#ifdef SIMPLE_LOOP
#pragma unroll 1
        for (int k = 0; k < 128; ++k) { issue(k, ua, va); consume(k, ua, va); }
        if (false)
#endif
        {
        issue(0, ua, va);
#pragma unroll 1
        for (int k = 0; k < 128; k += 2) {
            issue(k + 1, ub, vb);
            consume(k, ua, va);
            if (k + 2 < 128) issue(k + 2, ua, va);
            consume(k + 1, ub, vb);
        }
        }
        }
        const int b = t >> 13;
        const float* gate = mod + (size_t)(gate_set * 2 + b) * 6144 + 4096;
        float xn[4][8];
        float ss = 0.f;
#pragma unroll
        for (int c = 0; c < 4; ++c) {
            const int col = c * 512 + lane * 8;
            const f32x4 x0 = *(const f32x4*)(xin + (size_t)t * 2048 + col), x1 = *(const f32x4*)(xin + (size_t)t * 2048 + col + 4);
            const f32x4 g0 = *(const f32x4*)(gate + col), g1 = *(const f32x4*)(gate + col + 4);
#pragma unroll
            for (int j = 0; j < 4; ++j) { xn[c][j] = x0[j] + g0[j] * o[c][j]; xn[c][4 + j] = x1[j] + g1[j] * o[c][4 + j]; }
#pragma unroll
            for (int j = 0; j < 8; ++j) ss += xn[c][j] * xn[c][j];
        }
        ss = wave_sum(ss);
        const float rinv = rsqrtf(ss * (1.f / 2048.f) + EPS);
        if constexpr (FINAL) {
#pragma unroll
            for (int c = 0; c < 4; ++c) {
                const int col = c * 512 + lane * 8;
                const f32x4 w0 = *(const f32x4*)(next_gain + col), w1 = *(const f32x4*)(next_gain + col + 4);
                f32x4 y0, y1;
#pragma unroll
                for (int j = 0; j < 4; ++j) { y0[j] = xn[c][j] * rinv * w0[j]; y1[j] = xn[c][4 + j] * rinv * w1[j]; }
                *(f32x4*)(xout + (size_t)t * 2048 + col) = y0; *(f32x4*)(xout + (size_t)t * 2048 + col + 4) = y1;
            }
        } else {
            const float* nm = mod + (size_t)(next_set * 2 + b) * 6144;
#pragma unroll
            for (int c = 0; c < 4; ++c) {
                const int col = c * 512 + lane * 8;
                f32x4 y0, y1;
#pragma unroll
                for (int j = 0; j < 4; ++j) { y0[j] = xn[c][j]; y1[j] = xn[c][4 + j]; }
                *(f32x4*)(xout + (size_t)t * 2048 + col) = y0; *(f32x4*)(xout + (size_t)t * 2048 + col + 4) = y1;
                const f32x4 w0 = *(const f32x4*)(next_gain + col), w1 = *(const f32x4*)(next_gain + col + 4);
                const f32x4 s0 = *(const f32x4*)(nm + col), s1 = *(const f32x4*)(nm + col + 4);
                const f32x4 c0 = *(const f32x4*)(nm + 2048 + col), c1 = *(const f32x4*)(nm + 2048 + col + 4);
                float h[8];
#pragma unroll
                for (int j = 0; j < 4; ++j) { h[j] = xn[c][j] * rinv * w0[j] * (1.f + c0[j]) + s0[j]; h[4 + j] = xn[c][4 + j] * rinv * w1[j] * (1.f + c1[j]) + s1[j]; }
                u32x4 w = {cvtpk(h[0], h[1]), cvtpk(h[2], h[3]), cvtpk(h[4], h[5]), cvtpk(h[6], h[7])};
                *(u32x4*)(H + (size_t)t * 2048 + col) = w;
            }
        }
    }
}
constexpr int NSA_IMP = ATT_MISC;
constexpr int NSA_SELM = NSA_IMP + 32 * 128 * 4;
constexpr int NSA_KEYS = NSA_SELM + 512;
constexpr int LDS_BARW = NSA_KEYS + 8 * 128 * 4;
constexpr int LDS_BARW2 = (LDS_BARW > TOPK_LDS ? LDS_BARW : TOPK_LDS);
constexpr int LDS_TOTAL = ((LDS_BARW2 + 16 + 255) / 256) * 256;
static_assert(LDS_TOTAL <= 160 * 1024 && GEMM_LDS <= LDS_BARW2, "LDS budget");

__device__ __forceinline__ int next_bit128(unsigned long long lo, unsigned long long hi, int from) {
    if (from < 64) { const unsigned long long mm = lo >> from; if (mm) return from + __builtin_ctzll(mm); from = 64; }
    if (from < 128) { const unsigned long long mm = hi >> (from - 64); if (mm) return from + __builtin_ctzll(mm); }
    return 128;
}
template <int MODE>
__device__ __forceinline__ void nsa_emit(const f32x16 (&o)[4], float sc, float* acc_row, bf16_t* o_row, int hi) {
#pragma unroll
    for (int dt = 0; dt < 4; ++dt)
#pragma unroll
        for (int g4 = 0; g4 < 4; ++g4) {
            const int d = dt * 32 + 8 * g4 + 4 * hi;
            f32x4 v = {o[dt][4 * g4] * sc, o[dt][4 * g4 + 1] * sc, o[dt][4 * g4 + 2] * sc, o[dt][4 * g4 + 3] * sc};
            if (MODE >= 1) { const f32x4 pv = *(const f32x4*)(acc_row + d); v += pv; }
            if (MODE <= 1) *(f32x4*)(acc_row + d) = v;
            else { u32x2 w = {cvtpk(v[0], v[1]), cvtpk(v[2], v[3])}; *(u32x2*)(o_row + d) = w; }
        }
}

__device__ __forceinline__ void nsa_item(const Args& A, unsigned char* lds, int b, int g, int tt) {
    const int tid = opaque_tid(), lane = tid & 63, wave = tid >> 6, l31 = lane & 31, hi = lane >> 5;
    const bf16_t* NS = (const bf16_t*)(WSP(A) + WS_BIG);
    const bf16_t* KCC = (const bf16_t*)(WSP(A) + WS_KCC); const bf16_t* VCC = (const bf16_t*)(WSP(A) + WS_VCC);
    float* OACC = (float*)(WSP(A) + WS_OACC); bf16_t* O = (bf16_t*)(WSP(A) + WS_O);
    int* IMP = (int*)(lds + NSA_IMP); unsigned* SELM = (unsigned*)(lds + NSA_SELM); int* KEYS = (int*)(lds + NSA_KEYS) + wave * 128;
    const int t0 = tt * 32, t = t0 + l31, hd = g * 8 + wave;
    const size_t tokb = (size_t)b * SEQ;
    const float c2 = 0.08838834764831845f * 1.4426950408889634f;
    bf16x8 qr[8];
    {
        const bf16_t* qp = NS + (tokb + t) * NSA_IN + hd * 128 + hi * 8;
#pragma unroll
        for (int ks = 0; ks < 8; ++ks) qr[ks] = *(const bf16x8*)(qp + ks * 16);
    }
    float gt[3];
    {
        const bf16_t* gp = NS + (tokb + t) * NSA_IN + 3584 + g * 24 + wave * 3;
        gt[0] = bf2f(gp[0]); gt[1] = bf2f(gp[1]); gt[2] = bf2f(gp[2]);
    }
    float* acc_row = OACC + (tokb + t) * 2048 + hd * 128;
    bf16_t* o_row = O + (tokb + t) * 2048 + hd * 128;
    const int kl_off = l31 * KSTR128 + hi * 16, vl_off = vb_lane_off(lane);
    u32x4 rk[2], rv[2];
    unsigned ocm[2], omn[2], lkb[2], lvb[2];
#pragma unroll
    for (int i = 0; i < 2; ++i) {
        const int q = tid + NTHREADS * i, row = q >> 4, c = q & 15;
        ocm[i] = (unsigned)(row * 256 + c * 8) * 2u; omn[i] = (unsigned)(row * NSA_IN + c * 8) * 2u;
        lkb[i] = (unsigned)(row * KSTR128 + c * 16); lvb[i] = (unsigned)(row * VSTR + c * 16);
    }
    auto gloadK = [&](const bf16_t* kbase, bool cmp) {
#pragma unroll
        for (int i = 0; i < 2; ++i) rk[i] = *(const u32x4*)((const unsigned char*)kbase + (cmp ? ocm[i] : omn[i]));
    };
    auto gloadV = [&](const bf16_t* vbase, bool cmp) {
#pragma unroll
        for (int i = 0; i < 2; ++i) rv[i] = *(const u32x4*)((const unsigned char*)vbase + (cmp ? ocm[i] : omn[i]));
    };
    auto lstoreK = [&](int buf) {
        unsigned char* kb = lds + ATT_KOFF + buf * ATT_K_BYTES;
#pragma unroll
        for (int i = 0; i < 2; ++i) *(u32x4*)(kb + lkb[i]) = rk[i];
    };
    auto lstoreV = [&](int buf) {
        unsigned char* vb = lds + ATT_VOFF + buf * ATT_V_BYTES;
#pragma unroll
        for (int i = 0; i < 2; ++i) *(u32x4*)(vb + lvb[i]) = rv[i];
    };
    f32x16 o[4];
    auto zero_o = [&]() {
#pragma unroll
        for (int dt = 0; dt < 4; ++dt)
#pragma unroll
            for (int r = 0; r < 16; ++r) o[dt][r] = 0.f;
    };

    for (int i = tid; i < 32 * 128; i += NTHREADS) IMP[i] = 0;
    const int nct = (tt >> 5) + 1;
    const int nv = (t >= 31) ? ((t - 31) >> 4) : -1;
    const bf16_t* kc0 = KCC + ((size_t)(b * NCMP_PAD) * 2 + g) * 128;
    const bf16_t* vc0 = VCC + ((size_t)(b * NCMP_PAD) * 2 + g) * 128;
    float m = -1e30f, l = 0.f;
    gloadK(kc0, true); lstoreK(0); __syncthreads();
    for (int ct = 0; ct < nct; ++ct) {
        if (ct + 1 < nct) gloadK(kc0 + (size_t)(ct + 1) * 64 * 256, true);
        {
            f32x16 p0, p1;
            qk_tile<8, KSTR128>(p0, p1, lds + ATT_KOFF + (ct & 1) * ATT_K_BYTES + kl_off, qr);
            const int dq = nv - ct * 64 - 4 * hi;
            float mx = -__builtin_inff();
#pragma unroll
            for (int r = 0; r < 16; ++r) {
                const int cb = (r & 3) + 8 * (r >> 2);
                p0[r] = (cb <= dq) ? p0[r] : -__builtin_inff();
                p1[r] = (cb + 32 <= dq) ? p1[r] : -__builtin_inff();
                mx = fmaxf(mx, fmaxf(p0[r], p1[r]));
            }
            mx = fmaxf(mx, __shfl_xor(mx, 32));
            const float mn = fmaxf(m, mx);
            const float alpha = __builtin_amdgcn_exp2f((m - mn) * c2);
            const float mc = mn * c2;
            float rs = 0.f;
#pragma unroll
            for (int r = 0; r < 16; ++r) rs += __builtin_amdgcn_exp2f(p0[r] * c2 - mc) + __builtin_amdgcn_exp2f(p1[r] * c2 - mc);
            rs += __shfl_xor(rs, 32);
            l = l * alpha + rs; m = mn;
        }
        if (ct + 1 < nct) lstoreK((ct + 1) & 1);
        __syncthreads();
    }
    const float inv_l = (l > 0.f) ? 1.f / l : 0.f;
    const float mcF = m * c2;
    zero_o();
    gloadK(kc0, true); gloadV(vc0, true); lstoreK(0); lstoreV(0); __syncthreads();
    for (int ct = 0; ct < nct; ++ct) {
        if (ct + 1 < nct) { gloadK(kc0 + (size_t)(ct + 1) * 64 * 256, true); gloadV(vc0 + (size_t)(ct + 1) * 64 * 256, true); }
        {
            f32x16 p0, p1;
            qk_tile<8, KSTR128>(p0, p1, lds + ATT_KOFF + (ct & 1) * ATT_K_BYTES + kl_off, qr);
            const int dq = nv - ct * 64 - 4 * hi;
#pragma unroll
            for (int r = 0; r < 16; ++r) {
                const int cb = (r & 3) + 8 * (r >> 2);
                p0[r] = (cb <= dq) ? __builtin_amdgcn_exp2f(p0[r] * c2 - mcF) * inv_l : 0.f;
                p1[r] = (cb + 32 <= dq) ? __builtin_amdgcn_exp2f(p1[r] * c2 - mcF) * inv_l : 0.f;
            }
#pragma unroll
            for (int g4 = 0; g4 < 4; ++g4) {
                {
                    const int j = 16 * ct + 2 * g4 + hi;
                    const float mainv = 32.f * (p0[4 * g4] + p0[4 * g4 + 1] + p0[4 * g4 + 2]) + 16.f * p0[4 * g4 + 3];
                    const float spill = 16.f * p0[4 * g4 + 3];
                    atomicAdd(&IMP[l31 * 128 + j], (int)(mainv * 1048576.f + 0.5f));
                    if (j + 1 < 128) atomicAdd(&IMP[l31 * 128 + j + 1], (int)(spill * 1048576.f + 0.5f));
                }
                {
                    const int j = 16 * ct + 8 + 2 * g4 + hi;
                    const float mainv = 32.f * (p1[4 * g4] + p1[4 * g4 + 1] + p1[4 * g4 + 2]) + 16.f * p1[4 * g4 + 3];
                    const float spill = 16.f * p1[4 * g4 + 3];
                    atomicAdd(&IMP[l31 * 128 + j], (int)(mainv * 1048576.f + 0.5f));
                    if (j + 1 < 128) atomicAdd(&IMP[l31 * 128 + j + 1], (int)(spill * 1048576.f + 0.5f));
                }
            }
            bf16x8 pb[4] = {pack8f(p0, 0), pack8f(p0, 8), pack8f(p1, 0), pack8f(p1, 8)};
            pv_tile(o, lds + ATT_VOFF + (ct & 1) * ATT_V_BYTES + vl_off, pb);
        }
        if (ct + 1 < nct) { lstoreK((ct + 1) & 1); lstoreV((ct + 1) & 1); }
        __syncthreads();
    }
    nsa_emit<0>(o, gt[0] * ABL_NC, acc_row, o_row, hi);

#pragma unroll 1
    for (int q = 0; q < 4; ++q) {
        const int ti = wave * 4 + q, tq = t0 + ti, cur = tq >> 6;
        int keyv[2];
#pragma unroll
        for (int half = 0; half < 2; ++half) {
            const int j = lane + 64 * half;
            const bool forced = (j == 0) || (j == cur) || (j == cur - 1);
            keyv[half] = forced ? 0x7FFFFFFF : ((j <= cur) ? IMP[ti * 128 + j] : -1);
            KEYS[j] = keyv[half];
        }
        __builtin_amdgcn_s_waitcnt(0xc07f);
        int rk0 = 0, rk1 = 0;
#pragma unroll 8
        for (int i = 0; i < 128; ++i) {
            const int ki = KEYS[i];
            rk0 += (ki > keyv[0] || (ki == keyv[0] && i < lane)) ? 1 : 0;
            rk1 += (ki > keyv[1] || (ki == keyv[1] && i < lane + 64)) ? 1 : 0;
        }
        const unsigned long long s0 = __ballot(keyv[0] >= 0 && rk0 < 16);
        const unsigned long long s1 = __ballot(keyv[1] >= 0 && rk1 < 16);
        if (lane == 0) { SELM[ti * 4 + 0] = (unsigned)s0; SELM[ti * 4 + 1] = (unsigned)(s0 >> 32); SELM[ti * 4 + 2] = (unsigned)s1; SELM[ti * 4 + 3] = (unsigned)(s1 >> 32); }
    }
    __syncthreads();
    unsigned msk[4], uni[4];
#pragma unroll
    for (int w4 = 0; w4 < 4; ++w4) {
        msk[w4] = SELM[l31 * 4 + w4];
        unsigned x = msk[w4];
#pragma unroll
        for (int off = 16; off >= 1; off >>= 1) x |= (unsigned)__shfl_xor((int)x, off);
        uni[w4] = (unsigned)__builtin_amdgcn_readfirstlane((int)x);
    }
    const unsigned long long ulo = ((unsigned long long)uni[1] << 32) | uni[0], uhi = ((unsigned long long)uni[3] << 32) | uni[2];

    const bf16_t* ks0 = NS + tokb * NSA_IN + 2560 + g * 128;
    const bf16_t* vs0 = NS + tokb * NSA_IN + 2816 + g * 128;
    zero_o(); m = -1e30f; l = 0.f;
    {
        int j = next_bit128(ulo, uhi, 0), it = 0;
        if (j < 128) { gloadK(ks0 + (size_t)j * 64 * NSA_IN, false); gloadV(vs0 + (size_t)j * 64 * NSA_IN, false); lstoreK(0); lstoreV(0); }
        __syncthreads();
        while (j < 128) {
            const int jn = next_bit128(ulo, uhi, j + 1);
            if (jn < 128) { gloadK(ks0 + (size_t)jn * 64 * NSA_IN, false); gloadV(vs0 + (size_t)jn * 64 * NSA_IN, false); }
            {
                f32x16 p0, p1;
                qk_tile<8, KSTR128>(p0, p1, lds + ATT_KOFF + (it & 1) * ATT_K_BYTES + kl_off, qr);
                const bool sel = (msk[j >> 5] >> (j & 31)) & 1u;
                const int dq = sel ? (t - j * 64 - 4 * hi) : -1000;
#pragma unroll
                for (int r = 0; r < 16; ++r) {
                    const int cb = (r & 3) + 8 * (r >> 2);
                    p0[r] = (cb <= dq) ? p0[r] : -__builtin_inff();
                    p1[r] = (cb + 32 <= dq) ? p1[r] : -__builtin_inff();
                }
                bf16x8 pb[4];
                softmax_step(p0, p1, m, l, o, c2, pb);
                pv_tile(o, lds + ATT_VOFF + (it & 1) * ATT_V_BYTES + vl_off, pb);
            }
            if (jn < 128) { lstoreK((it + 1) & 1); lstoreV((it + 1) & 1); }
            __syncthreads();
            j = jn; ++it;
        }
    }
    nsa_emit<1>(o, (l > 0.f) ? ABL_NS * gt[1] / l : 0.f, acc_row, o_row, hi);

    const bf16_t* kw0 = NS + tokb * NSA_IN + 3072 + g * 128;
    const bf16_t* vw0 = NS + tokb * NSA_IN + 3328 + g * 128;
    zero_o(); m = -1e30f; l = 0.f;
    {
        const int kt_lo = (t0 >= 511) ? ((t0 - 511) >> 6) : 0, kt_hi = t0 >> 6;
        gloadK(kw0 + (size_t)kt_lo * 64 * NSA_IN, false); gloadV(vw0 + (size_t)kt_lo * 64 * NSA_IN, false); lstoreK(0); lstoreV(0);
        __syncthreads();
        int it = 0;
        for (int kt = kt_lo; kt <= kt_hi; ++kt, ++it) {
            if (kt < kt_hi) { gloadK(kw0 + (size_t)(kt + 1) * 64 * NSA_IN, false); gloadV(vw0 + (size_t)(kt + 1) * 64 * NSA_IN, false); }
            {
                f32x16 p0, p1;
                qk_tile<8, KSTR128>(p0, p1, lds + ATT_KOFF + (it & 1) * ATT_K_BYTES + kl_off, qr);
                const int dq = t - kt * 64 - 4 * hi;
#pragma unroll
                for (int r = 0; r < 16; ++r) {
                    const int cb = (r & 3) + 8 * (r >> 2);
                    p0[r] = ((unsigned)(dq - cb) < 512u) ? p0[r] : -__builtin_inff();
                    p1[r] = ((unsigned)(dq - cb - 32) < 512u) ? p1[r] : -__builtin_inff();
                }
                bf16x8 pb[4];
                softmax_step(p0, p1, m, l, o, c2, pb);
                pv_tile(o, lds + ATT_VOFF + (it & 1) * ATT_V_BYTES + vl_off, pb);
            }
            if (kt < kt_hi) { lstoreK((it + 1) & 1); lstoreV((it + 1) & 1); }
            __syncthreads();
        }
    }
    nsa_emit<2>(o, (l > 0.f) ? ABL_NW * gt[2] / l : 0.f, acc_row, o_row, hi);
}

__device__ __forceinline__ void phase_nsa(const Args& A, unsigned char* lds, int bid, int nb) {
    for (int u = bid; u < 1024; u += nb) {
        const int tt = 255 - (u >> 2), bg = u & 3;
        nsa_item(A, lds, bg >> 1, bg & 1, tt);
    }
}
constexpr int N_PHASES = 20;
#ifndef ABL_M0
#define ABL_M0 1.f
#endif
#ifndef ABL_M1
#define ABL_M1 1.f
#endif
#ifndef ABL_P0
#define ABL_P0 1.f
#endif
#ifndef ABL_P1
#define ABL_P1 1.f
#endif
__global__ void __launch_bounds__(NTHREADS, 2) fwd_kernel(Args a) {
    extern __shared__ __attribute__((aligned(16))) unsigned char lds[];
    const int bid = blockIdx.x, nb = gridDim.x;
    const bool multi = (a.ph_hi - a.ph_lo) > 1;
    XcdBarrier bar; bar.bar = (unsigned*)(a.ws + WS_CTL); bar.x = 0; bar.st = (volatile LAS unsigned*)(lds + LDS_BARW2);
    if (multi) {
        if (threadIdx.x == 0) *(uint4*)(lds + LDS_BARW2) = make_uint4(0u, 0u, 0u, 0u);
        __syncthreads();
        bar = xcd_barrier_post((unsigned*)(a.ws + WS_CTL), (volatile LAS unsigned*)(lds + LDS_BARW2));
    }
#ifdef ONLY
#define IN(k) ((k) == ONLY && a.ph_lo <= (k) && (k) < a.ph_hi)
#else
#define IN(k) (a.ph_lo <= (k) && (k) < a.ph_hi)
#endif
#define SEAM(k) do { if (IN(k) && IN((k) + 1)) xcd_barrier(bar); } while (0)
    unsigned char* ws = WSP(a);
    const float* MOD = (const float*)(ws + WS_MOD);
    bf16_t* H = (bf16_t*)(ws + WS_H); bf16_t* BIG = (bf16_t*)(ws + WS_BIG); bf16_t* Ob = (bf16_t*)(ws + WS_O);
    float* XA = (float*)(ws + WS_XA); float* XB = (float*)(ws + WS_XB);

    if (IN(0)) phase_prologue(a, lds, bid, nb);
    SEAM(0);
    if (IN(1)) phase_modnorm(a, a.in[0], a.in[3], 0, bid, nb);
    SEAM(1);
    if (IN(2)) gemm_phase(lds, ALoadPlain{H, 2048}, (const bf16_t*)(ws + WS_WIN0), 2048, T, SBMLA_IN_PAD, 2048, EpiBf16{BIG, SBMLA_IN, SBMLA_IN}, bid, nb);
    SEAM(2);
    if (IN(3)) phase_mla_prep(a, bid, nb);
    SEAM(3);
    if (IN(4)) {
        gemm_phase(lds, ALoadPlain{(const bf16_t*)(ws + WS_CQN), 512}, (const bf16_t*)(ws + WS_WUQ), 512, T, 1536, 512, EpiMlaQ{(bf16_t*)(ws + WS_QM), (const f32x2*)(ws + WS_ROPE64)}, bid, nb);
        gemm_phase(lds, ALoadPlain{(const bf16_t*)(ws + WS_CKVN), 256}, (const bf16_t*)(ws + WS_WUKV), 256, T, 2048, 256, EpiBf16{(bf16_t*)(ws + WS_KVM), KVM_LD, 2048}, bid, nb);
    }
    SEAM(4);
    if (IN(5)) phase_attn0(a, lds, bid, nb);
    SEAM(5);
    if (IN(6)) gemm_phase(lds, ALoadPlain{Ob, 2048}, (const bf16_t*)(ws + WS_WOUT0), 2048, T, 2048, 2048, EpiResid{a.in[0], XA, MOD + 0 * 2 * 6144 + 4096, ABL_M0}, bid, nb);
    SEAM(6);
    if (IN(7)) phase_modnorm(a, XA, a.in[20], 1, bid, nb);
    SEAM(7);
    if (IN(8)) gemm_phase(lds, ALoadPlain{H, 2048}, (const bf16_t*)(ws + WS_WPQ), 2048, T, 2048, 2048, EpiBf16{(bf16_t*)(ws + WS_PQ), 2048, 2048}, bid, nb);
    SEAM(8);
    if (IN(9)) phase_topk(a, lds, 0, bid, nb);
    SEAM(9);
    if (IN(10)) phase_gather<false>(a, 0, XA, XB, 1, a.in[3] + 2048, 2, ABL_P0, bid, nb);
    SEAM(10);
    if (IN(11)) gemm_phase(lds, ALoadPlain{H, 2048}, (const bf16_t*)(ws + WS_WNSAIN), 2048, T, NSA_IN_PAD, 2048, EpiNsaIn{BIG, (const f32x2*)(ws + WS_ROPE32)}, bid, nb);
    SEAM(11);
    if (IN(12)) {
        gemm_phase(lds, ALoadCmp{BIG, NSA_IN, 2048}, (const bf16_t*)(ws + WS_W1K), 4096, 2048, 256, 4096, EpiCmpHid{(bf16_t*)(ws + WS_HID), (const float*)(ws + WS_BIASP)}, bid, nb);
        gemm_phase(lds, ALoadCmp{BIG, NSA_IN, 2304}, (const bf16_t*)(ws + WS_W1V), 4096, 2048, 256, 4096, EpiCmpHid{(bf16_t*)(ws + WS_HID) + 2048 * 256, (const float*)(ws + WS_BIASP) + 32 * 256}, bid, nb);
    }
    SEAM(12);
    if (IN(13)) {
        gemm_phase(lds, ALoadPlain{(const bf16_t*)(ws + WS_HID), 256}, (const bf16_t*)(ws + WS_W2K), 256, 2048, 128, 256, EpiCmpOut{(bf16_t*)(ws + WS_KCC)}, bid, nb);
        gemm_phase(lds, ALoadPlain{(const bf16_t*)(ws + WS_HID) + 2048 * 256, 256}, (const bf16_t*)(ws + WS_W2V), 256, 2048, 128, 256, EpiCmpOut{(bf16_t*)(ws + WS_VCC)}, bid, nb);
    }
    SEAM(13);
    if (IN(14)) phase_nsa(a, lds, bid, nb);
    SEAM(14);
    if (IN(15)) gemm_phase(lds, ALoadPlain{Ob, 2048}, (const bf16_t*)(ws + WS_WNSAOUT), 2048, T, 2048, 2048, EpiResid{XB, XA, MOD + 2 * 2 * 6144 + 4096, ABL_M1}, bid, nb);
    SEAM(15);
    if (IN(16)) phase_modnorm(a, XA, a.in[20] + 2048, 3, bid, nb);
    SEAM(16);
    if (IN(17)) gemm_phase(lds, ALoadPlain{H, 2048}, (const bf16_t*)(ws + WS_WPQ) + (size_t)2048 * 2048, 2048, T, 2048, 2048, EpiBf16{(bf16_t*)(ws + WS_PQ), 2048, 2048}, bid, nb);
    SEAM(17);
    if (IN(18)) phase_topk(a, lds, 1, bid, nb);
    SEAM(18);
    if (IN(19)) phase_gather<true>(a, 1, XA, a.out, 3, a.in[28], 0, ABL_P1, bid, nb);
    if (a.ph_lo == 99) {
        const bf16_t* raw = (const bf16_t*)(ws + (size_t)a.ph_hi * 16384);
        for (size_t i = (size_t)bid * NTHREADS + threadIdx.x; i < (size_t)T * 2048; i += (size_t)nb * NTHREADS) a.out[i] = bf2f(raw[i]);
    }
#undef IN
#undef SEAM
}

#ifndef MK_ONE_LAUNCH
#define MK_ONE_LAUNCH 0
#endif
extern "C" void kernel_launch(void* const* d_in, const int* in_sizes, int n_in, void* d_out, int out_size, void* d_ws, size_t ws_size, hipStream_t stream) {
    static int grid = 0;
    if (grid == 0) {
        if (n_in != 29 || out_size != T * D_MODEL || ws_size < WS_END) { fprintf(stderr, "kernel_launch: unexpected shapes (n_in %d out %d ws %zu need %zu)\n", n_in, out_size, ws_size, (size_t)WS_END); grid = -1; return; }
        int dev = 0, cus = 0, per_cu = 0;
        if (hipGetDevice(&dev) != hipSuccess || hipDeviceGetAttribute(&cus, hipDeviceAttributeMultiprocessorCount, dev) != hipSuccess) { grid = -1; return; }
        if (hipFuncSetAttribute((const void*)fwd_kernel, hipFuncAttributeMaxDynamicSharedMemorySize, LDS_TOTAL) != hipSuccess) { fprintf(stderr, "kernel_launch: hipFuncSetAttribute failed\n"); grid = -1; return; }
        if (hipOccupancyMaxActiveBlocksPerMultiprocessor(&per_cu, (const void*)fwd_kernel, NTHREADS, LDS_TOTAL) != hipSuccess || per_cu < 1) { fprintf(stderr, "kernel_launch: occupancy query says %d\n", per_cu); }
        (void)hipGetLastError();
        grid = cus;
    }
    if (grid < 0) return;
    (void)hipMemsetAsync((char*)d_ws + WS_CTL, 0, 16384, stream);
    Args a{};
    for (int i = 0; i < 29; ++i) a.in[i] = (const float*)d_in[i];
    a.out = (float*)d_out; a.ws = (unsigned char*)d_ws;
#if MK_ONE_LAUNCH
    a.ph_lo = 0; a.ph_hi = N_PHASES;
    hipLaunchKernelGGL(fwd_kernel, dim3(grid), dim3(NTHREADS), LDS_TOTAL, stream, a);
#else
#ifdef DBG_UPTO
    for (int p = 0; p <= DBG_UPTO; ++p) {
        a.ph_lo = p; a.ph_hi = p + 1;
        hipLaunchKernelGGL(fwd_kernel, dim3(grid), dim3(NTHREADS), LDS_TOTAL, stream, a);
    }
    a.ph_lo = 99; a.ph_hi = (int)(DBG_OFF / 16384);
    hipLaunchKernelGGL(fwd_kernel, dim3(grid), dim3(NTHREADS), LDS_TOTAL, stream, a);
#else
    for (int p = 0; p < N_PHASES; ++p) {
        a.ph_lo = p; a.ph_hi = p + 1;
        hipLaunchKernelGGL(fwd_kernel, dim3(grid), dim3(NTHREADS), LDS_TOTAL, stream, a);
    }
#endif
#endif
}
```

```cpp
#define MK_ONE_LAUNCH 1
#include <hip/hip_runtime.h>
#include <stdint.h>
#include <stdio.h>

typedef unsigned short bf16_t;
typedef short bf16x8 __attribute__((ext_vector_type(8)));
typedef short s16x4 __attribute__((ext_vector_type(4)));
typedef float f32x16 __attribute__((ext_vector_type(16)));
typedef float f32x4 __attribute__((ext_vector_type(4)));
typedef float f32x2 __attribute__((ext_vector_type(2)));
typedef unsigned u32x4 __attribute__((ext_vector_type(4)));
typedef unsigned u32x2 __attribute__((ext_vector_type(2)));
typedef __bf16 bf16x2_t __attribute__((ext_vector_type(2)));
#define LAS __attribute__((address_space(3)))

constexpr int D_MODEL = 2048, BATCH = 2, SEQ = 8192, T = BATCH * SEQ;
constexpr float EPS = 1e-6f;
constexpr int SBMLA_IN = 3904, SBMLA_IN_PAD = 3968;
constexpr int NSA_IN = 3632, NSA_IN_PAD = 3712;
constexpr int NCMP = 511, NCMP_PAD = 512;
constexpr int NTHREADS = 512, NWAVES = 8;
constexpr int KVM_LD = 2112;

constexpr size_t al256(size_t x) { return (x + 255) & ~(size_t)255; }
constexpr size_t WS_CTL   = 0;
constexpr size_t WS_MOD   = 16384;
constexpr size_t WS_BIASP = WS_MOD + al256((size_t)4 * 2 * 6144 * 4);
constexpr size_t WS_ROPE64 = WS_BIASP + al256((size_t)2 * 32 * 256 * 4);
constexpr size_t WS_ROPE32 = WS_ROPE64 + (size_t)T * 32 * 8;
constexpr size_t WS_WIN0  = WS_ROPE32 + (size_t)T * 16 * 8;
constexpr size_t WS_WUQ   = WS_WIN0 + (size_t)SBMLA_IN_PAD * 2048 * 2;
constexpr size_t WS_WUKV  = WS_WUQ + (size_t)1536 * 512 * 2;
constexpr size_t WS_WOUT0 = WS_WUKV + (size_t)2048 * 256 * 2;
constexpr size_t WS_WNSAIN = WS_WOUT0 + (size_t)2048 * 2048 * 2;
constexpr size_t WS_W1K   = WS_WNSAIN + (size_t)NSA_IN_PAD * 2048 * 2;
constexpr size_t WS_W1V   = WS_W1K + (size_t)256 * 4096 * 2;
constexpr size_t WS_W2K   = WS_W1V + (size_t)256 * 4096 * 2;
constexpr size_t WS_W2V   = WS_W2K + (size_t)128 * 256 * 2;
constexpr size_t WS_WNSAOUT = WS_W2V + (size_t)128 * 256 * 2;
constexpr size_t WS_WPQ   = WS_WNSAOUT + (size_t)2048 * 2048 * 2;
constexpr size_t WS_K12   = WS_WPQ + (size_t)2 * 2048 * 2048 * 2;
constexpr size_t WS_PU    = WS_K12 + (size_t)4 * 128 * 128 * 2;
constexpr size_t WS_PV    = WS_PU + (size_t)2 * 16384 * 2048;
constexpr size_t WS_H     = WS_PV + (size_t)2 * 16384 * 2048;
constexpr size_t WS_BIG   = WS_H + (size_t)T * 2048 * 2;
constexpr size_t WS_O     = WS_BIG + (size_t)T * SBMLA_IN * 2;
constexpr size_t WS_XA    = WS_O + (size_t)T * 2048 * 2;
constexpr size_t WS_XB    = WS_XA + (size_t)T * 2048 * 4;
constexpr size_t WS_CQN   = WS_XA;
constexpr size_t WS_CKVN  = WS_CQN + (size_t)T * 512 * 2;
constexpr size_t WS_OACC  = WS_XA;
constexpr size_t WS_QM    = WS_XB;
constexpr size_t WS_KVM   = WS_QM + (size_t)T * 1536 * 2;
constexpr size_t WS_PQ    = WS_XB;
static_assert((size_t)T * 1536 * 2 + (size_t)T * KVM_LD * 2 <= (size_t)T * 2048 * 4, "QM + KVM must fit the XB region");
constexpr size_t WS_EXI   = WS_XB + (size_t)T * 2048 * 4;
constexpr size_t WS_EXG   = WS_EXI + (size_t)T * 128 * 4;
constexpr size_t WS_HID   = WS_EXG + (size_t)T * 128 * 4;
constexpr size_t WS_KCC   = WS_HID + (size_t)2 * 2048 * 256 * 2;
constexpr size_t WS_VCC   = WS_KCC + (size_t)BATCH * NCMP_PAD * 2 * 128 * 2;
constexpr size_t WS_END   = WS_VCC + (size_t)BATCH * NCMP_PAD * 2 * 128 * 2;

struct Args {
    const float* in[29];
    float* out;
    unsigned char* ws;
    int ph_lo, ph_hi;
};

__device__ __forceinline__ unsigned cvtpk(float lo, float hi) {
    bf16x2_t v = {(__bf16)lo, (__bf16)hi};
    return __builtin_bit_cast(unsigned, v);
}
__device__ __forceinline__ float bf2f(unsigned short h) { return __uint_as_float(((unsigned)h) << 16); }
__device__ __forceinline__ float bflo(unsigned w) { return __uint_as_float(w << 16); }
__device__ __forceinline__ float bfhi(unsigned w) { return __uint_as_float(w & 0xFFFF0000u); }
__device__ __forceinline__ int crow(int r, int hi) { return (r & 3) + 8 * (r >> 2) + 4 * hi; }
__device__ __forceinline__ float wave_sum(float v) {
#pragma unroll
    for (int o = 32; o >= 1; o >>= 1) v += __shfl_xor(v, o);
    return v;
}
__device__ __forceinline__ float gelu_tanh(float x) {
    const float u = 0.7978845608028654f * (x + 0.044715f * x * x * x);
    const float e = __expf(2.f * u);
    const float th = 1.f - 2.f / (e + 1.f);
    return 0.5f * x * (1.f + th);
}
__device__ __forceinline__ int opaque_tid() { int t = threadIdx.x; asm volatile("" : "+v"(t)); return t; }
__device__ __forceinline__ unsigned char* WSP(const Args& A) {
    unsigned lo = (unsigned)(uintptr_t)A.ws, hi = (unsigned)((uintptr_t)A.ws >> 32);
    asm volatile("" : "+v"(lo), "+v"(hi));
    lo = (unsigned)__builtin_amdgcn_readfirstlane((int)lo); hi = (unsigned)__builtin_amdgcn_readfirstlane((int)hi);
    return (unsigned char*)(((uintptr_t)hi << 32) | lo);
}
#ifndef ABL_SB
#define ABL_SB 1.f
#endif
#ifndef ABL_MLA
#define ABL_MLA 1.f
#endif
#ifndef ABL_NC
#define ABL_NC 1.f
#endif
#ifndef ABL_NS
#define ABL_NS 1.f
#endif
#ifndef ABL_NW
#define ABL_NW 1.f
#endif
#define XB_TMO      128
#define XB_XCNT(j)  (256  + 64 * (j))
#define XB_XSUB(j)  (1280 + 64 * (j))
#define XB_XGEN(j)  (2304 + 64 * (j))
#define XB_TOP      3328
#define XB_TOPGEN   3392
#define XCD_BAR_WORDS 3456
#define XB_SPIN_CAP (1u << 18)
#define LAS __attribute__((address_space(3)))

__device__ __forceinline__ unsigned xb_ld(unsigned* p)              { return __hip_atomic_load(p, __ATOMIC_RELAXED, __HIP_MEMORY_SCOPE_AGENT); }
__device__ __forceinline__ unsigned xb_add(unsigned* p, unsigned v) { return __hip_atomic_fetch_add(p, v, __ATOMIC_RELAXED, __HIP_MEMORY_SCOPE_AGENT); }
__device__ __forceinline__ unsigned xb_xcc_id() { return (unsigned)__builtin_amdgcn_s_getreg((3 << 11) | 20) & 0xFu; }
#define XB_SPIN(cond, bar) do { unsigned _sp = 0; while (cond) { __builtin_amdgcn_s_sleep(1); \
    if ((++_sp & 255u) == 0u) { if (xb_ld(&(bar)[XB_TMO])) break; if (_sp > XB_SPIN_CAP) { atomicAdd(&(bar)[XB_TMO], 1u); break; } } } } while (0)

struct XcdBarrier {
    unsigned* bar; unsigned x;
    volatile LAS unsigned* st;
};

__device__ __forceinline__ XcdBarrier xcd_barrier_post(unsigned* bar, volatile LAS unsigned* st) {
    XcdBarrier b; b.bar = bar; b.x = xb_xcc_id(); b.st = st;
    if (threadIdx.x == 0) (void)xb_add(&bar[XB_XCNT(b.x)], 1u);
    return b;
}
__device__ __forceinline__ void xcd_barrier_complete(unsigned* bar, unsigned x, unsigned& nloc, unsigned& nx) {
    const unsigned G = gridDim.x * gridDim.y * gridDim.z;
    unsigned sum, cnt, mine, sp = 0u;
    for (;;) {
        sum = 0u; cnt = 0u; mine = 0u;
#pragma unroll
        for (unsigned j = 0; j < 16; ++j) { const unsigned c = xb_ld(&bar[XB_XCNT(j)]); sum += c; cnt += (c > 0u) ? 1u : 0u; mine = (j == x) ? c : mine; }
        if (sum == G) break;
        __builtin_amdgcn_s_sleep(1);
        if ((++sp & 255u) == 0u) { if (xb_ld(&bar[XB_TMO])) break; if (sp > XB_SPIN_CAP) { atomicAdd(&bar[XB_TMO], 1u); break; } }
    }
    nloc = mine > 0u ? mine : 1u; nx = cnt > 0u ? cnt : 1u;
}

__device__ __forceinline__ void xcd_barrier(const XcdBarrier& b) {
    asm volatile("s_waitcnt vmcnt(0)" ::: "memory");
    __syncthreads();
    if (threadIdx.x == 0) {
        unsigned* bar = b.bar;
        __builtin_amdgcn_s_waitcnt(0);
        unsigned nloc = b.st[0], nx = b.st[1];
        if (nloc == 0u) { xcd_barrier_complete(bar, b.x, nloc, nx); b.st[0] = nloc; b.st[1] = nx; }
        const unsigned old = xb_add(&bar[XB_XSUB(b.x)], 1u);
        const unsigned gen = old / nloc;
        if (old + 1u == (gen + 1u) * nloc) {
            __builtin_amdgcn_fence(__ATOMIC_RELEASE, "agent");
            asm volatile("s_waitcnt vmcnt(0)" ::: "memory");
            const unsigned og = xb_add(&bar[XB_TOP], 1u);
            const unsigned tg = og / nx;
            if (og + 1u == (tg + 1u) * nx) xb_add(&bar[XB_TOPGEN], 1u);
            else XB_SPIN(xb_ld(&bar[XB_TOPGEN]) == tg, bar);
            __builtin_amdgcn_fence(__ATOMIC_ACQUIRE, "agent");
            xb_add(&bar[XB_XGEN(b.x)], 1u);
            asm volatile("s_waitcnt vmcnt(0)" ::: "memory");
        } else {
            XB_SPIN(xb_ld(&bar[XB_XGEN(b.x)]) == gen, bar);
            __builtin_amdgcn_fence(__ATOMIC_ACQUIRE, "agent");
            asm volatile("s_waitcnt vmcnt(0)" ::: "memory");
        }
    }
    __syncthreads();
}
constexpr int U0_MOD = 192, U0_TR = 8784, U0_PEER = 2048, U0_ROPE = 192, U0_BIAS = 64, U0_K12 = 8, U0_ZERO = 8;
constexpr int U0_TOTAL = U0_MOD + U0_TR + U0_PEER + U0_ROPE + U0_BIAS + U0_K12 + U0_ZERO;

struct TrDesc { int in_idx; size_t in_off; int K, N, Npad; size_t ws_off; int ntiles; };
__device__ __forceinline__ TrDesc tr_desc(int m) {
    switch (m) {
        case 0:  return TrDesc{6, 0, 2048, 3904, 3968, WS_WIN0, 1984};
        case 1:  return TrDesc{8, 0, 512, 1536, 1536, WS_WUQ, 192};
        case 2:  return TrDesc{10, 0, 256, 2048, 2048, WS_WUKV, 128};
        case 3:  return TrDesc{11, 0, 2048, 2048, 2048, WS_WOUT0, 1024};
        case 4:  return TrDesc{12, 0, 2048, 3632, 3712, WS_WNSAIN, 1856};
        case 5:  return TrDesc{15, 0, 4096, 256, 256, WS_W1K, 256};
        case 6:  return TrDesc{17, 0, 4096, 256, 256, WS_W1V, 256};
        case 7:  return TrDesc{16, 0, 256, 128, 128, WS_W2K, 8};
        case 8:  return TrDesc{18, 0, 256, 128, 128, WS_W2V, 8};
        case 9:  return TrDesc{19, 0, 2048, 2048, 2048, WS_WNSAOUT, 1024};
        case 10: return TrDesc{23, 0, 2048, 2048, 2048, WS_WPQ, 1024};
        default: return TrDesc{23, (size_t)2048 * 2048, 2048, 2048, 2048, WS_WPQ + (size_t)2048 * 2048 * 2, 1024};
    }
}

__device__ __forceinline__ void p0_mod_unit(const Args& A, unsigned char* lds, int u) {
    const int tid = opaque_tid();
    float* sc = (float*)lds;
    float* red = (float*)(lds + 16384);
    const int set = u / 48, cc = u % 48;
    const int layer = set >> 1, kind = set & 1;
    const float* w = (kind ? A.in[21] : A.in[4]) + (size_t)layer * 2048 * 6144;
    const float* bias = (kind ? A.in[22] : A.in[5]) + (size_t)layer * 6144;
    const float* c = A.in[1];
    for (int i = tid; i < 4096; i += NTHREADS) { const float v = c[i]; sc[i] = v / (1.f + __expf(-v)); }
    __syncthreads();
    const int l32 = tid & 31, kg = tid >> 5;
    const int col = cc * 128 + l32 * 4;
    float a0[4] = {0, 0, 0, 0}, a1[4] = {0, 0, 0, 0};
    const float* wp = w + (size_t)(kg * 128) * 6144 + col;
#pragma unroll 8
    for (int i = 0; i < 128; ++i) {
        const f32x4 wv = *(const f32x4*)(wp + (size_t)i * 6144);
        const float s0 = sc[kg * 128 + i], s1 = sc[2048 + kg * 128 + i];
#pragma unroll
        for (int j = 0; j < 4; ++j) { a0[j] += s0 * wv[j]; a1[j] += s1 * wv[j]; }
    }
#pragma unroll
    for (int j = 0; j < 4; ++j) { red[(kg * 2 + 0) * 128 + l32 * 4 + j] = a0[j]; red[(kg * 2 + 1) * 128 + l32 * 4 + j] = a1[j]; }
    __syncthreads();
    if (tid < 256) {
        const int b = tid >> 7, cl = tid & 127;
        float s = 0;
#pragma unroll
        for (int g = 0; g < 16; ++g) s += red[(g * 2 + b) * 128 + cl];
        float* mod = (float*)(WSP(A) + WS_MOD);
        mod[(size_t)(set * 2 + b) * 6144 + cc * 128 + cl] = s + bias[cc * 128 + cl];
    }
    __syncthreads();
}

__device__ __forceinline__ void p0_tr_unit(const Args& A, unsigned char* lds, int u) {
    const int tid = opaque_tid();
    int m = 0, tile = u;
    TrDesc d = tr_desc(0);
    while (tile >= d.ntiles) { tile -= d.ntiles; ++m; d = tr_desc(m); }
    const int nNt = d.Npad / 64;
    const int kt = tile / nNt, nt = tile % nNt;
    const float* src = A.in[d.in_idx] + d.in_off;
    bf16_t* dst = (bf16_t*)(WSP(A) + d.ws_off);
    float* ts = (float*)lds;
    {
        const int r = tid >> 3, cg = tid & 7;
        const int k = kt * 64 + r, n = nt * 64 + cg * 8;
        f32x4 v0 = {0, 0, 0, 0}, v1 = {0, 0, 0, 0};
        if (n < d.N) { const float* p = src + (size_t)k * d.N + n; v0 = *(const f32x4*)p; v1 = *(const f32x4*)(p + 4); }
#pragma unroll
        for (int j = 0; j < 4; ++j) { ts[r * 65 + cg * 8 + j] = v0[j]; ts[r * 65 + cg * 8 + 4 + j] = v1[j]; }
    }
    __syncthreads();
    {
        const int n = tid >> 3, kg = tid & 7;
        float v[8];
#pragma unroll
        for (int j = 0; j < 8; ++j) v[j] = ts[(kg * 8 + j) * 65 + n];
        u32x4 w = {cvtpk(v[0], v[1]), cvtpk(v[2], v[3]), cvtpk(v[4], v[5]), cvtpk(v[6], v[7])};
        *(u32x4*)(dst + (size_t)(nt * 64 + n) * d.K + kt * 64 + kg * 8) = w;
    }
    __syncthreads();
}

constexpr float PEER_USCALE = 64.f, PEER_VSCALE = 4.f;
__device__ __forceinline__ void p0_peer_unit(const Args& A, int u) {
    const int tid = opaque_tid();
    const bool isv = u >= 1024;
    const int pu = isv ? u - 1024 : u;
    const float sc = isv ? PEER_VSCALE : PEER_USCALE;
    const float* src = (isv ? A.in[27] : A.in[26]) + (size_t)pu * 65536;
    unsigned char* dst = WSP(A) + (isv ? WS_PV : WS_PU) + (size_t)pu * 65536;
#pragma unroll 2
    for (int it = 0; it < 8; ++it) {
        const int e = (it * NTHREADS + tid) * 16;
        u32x4 w;
#pragma unroll
        for (int q = 0; q < 4; ++q) {
            const f32x4 v = *(const f32x4*)(src + e + 4 * q);
            int pk = 0;
            pk = __builtin_amdgcn_cvt_pk_fp8_f32(v[0] * sc, v[1] * sc, pk, false);
            pk = __builtin_amdgcn_cvt_pk_fp8_f32(v[2] * sc, v[3] * sc, pk, true);
            w[q] = (unsigned)pk;
        }
        *(u32x4*)(dst + e) = w;
    }
}

__device__ __forceinline__ void p0_rope_unit(const Args& A, int u) {
    const int tid = opaque_tid();
    const int* pos = (const int*)A.in[2];
#pragma unroll 1
    for (int it = 0; it < 8; ++it) {
        const int e = u * 4096 + it * NTHREADS + tid;
        if (e < T * 32) {
            const int t = e >> 5, j = e & 31;
            const float inv = powf(500000.0f, -(float)j / 32.0f);
            const float ang = (float)pos[t] * inv;
            float s, c; sincosf(ang, &s, &c);
            ((f32x2*)(WSP(A) + WS_ROPE64))[e] = f32x2{c, s};
        } else {
            const int e2 = e - T * 32;
            const int t = e2 >> 4, j = e2 & 15;
            const float inv = powf(500000.0f, -(float)j / 16.0f);
            const float ang = (float)pos[t] * inv;
            float s, c; sincosf(ang, &s, &c);
            ((f32x2*)(WSP(A) + WS_ROPE32))[e2] = f32x2{c, s};
        }
    }
}

__device__ __forceinline__ void p0_bias_unit(const Args& A, unsigned char* lds, int u) {
    const int tid = opaque_tid();
    const int mat = u >> 5, chunk = u & 31;
    const float* pe = A.in[mat ? 14 : 13];
    const float* w1 = A.in[mat ? 17 : 15];
    const int col = tid & 255, half = tid >> 8;
    float acc = 0;
    const int r0 = chunk * 128 + half * 64;
#pragma unroll 8
    for (int i = 0; i < 64; ++i) acc += pe[r0 + i] * w1[(size_t)(r0 + i) * 256 + col];
    float* red = (float*)lds;
    if (half) red[col] = acc;
    __syncthreads();
    if (!half) ((float*)(WSP(A) + WS_BIASP))[(mat * 32 + chunk) * 256 + col] = acc + red[col];
    __syncthreads();
}

__device__ __forceinline__ void p0_k12_unit(const Args& A, int u) {
    const int tid = opaque_tid();
    bf16_t* dst = (bf16_t*)(WSP(A) + WS_K12);
#pragma unroll
    for (int it = 0; it < 2; ++it) {
        const int e = u * 8192 + (it * NTHREADS + tid) * 8;
        const int layer = e >> 15, which = (e >> 14) & 1, rem = e & 16383;
        const float* src = A.in[which ? 25 : 24] + layer * 16384 + rem;
        const f32x4 v0 = *(const f32x4*)src, v1 = *(const f32x4*)(src + 4);
        u32x4 w = {cvtpk(v0[0], v0[1]), cvtpk(v0[2], v0[3]), cvtpk(v1[0], v1[1]), cvtpk(v1[2], v1[3])};
        *(u32x4*)(dst + e) = w;
    }
}

__device__ __forceinline__ void phase_prologue(const Args& A, unsigned char* lds, int bid, int nb) {
    for (int u = bid; u < U0_TOTAL; u += nb) {
        int v = u;
        if (v < U0_MOD) { p0_mod_unit(A, lds, v); continue; }
        v -= U0_MOD;
        if (v < U0_TR) { p0_tr_unit(A, lds, v); continue; }
        v -= U0_TR;
        if (v < U0_PEER) { p0_peer_unit(A, v); continue; }
        v -= U0_PEER;
        if (v < U0_ROPE) { p0_rope_unit(A, v); continue; }
        v -= U0_ROPE;
        if (v < U0_BIAS) { p0_bias_unit(A, lds, v); continue; }
        v -= U0_BIAS;
        if (v < U0_K12) { p0_k12_unit(A, v); continue; }
        v -= U0_K12;
        {
            u32x4* z = (u32x4*)(WSP(A) + WS_KCC) + (size_t)v * 8192;
            for (int i = opaque_tid(); i < 8192; i += NTHREADS) z[i] = u32x4{0u, 0u, 0u, 0u};
        }
    }
}

__device__ __forceinline__ void modnorm_row(const float* xr, const float* gain, const float* mod  , bf16_t* hr, int lane) {
    f32x4 v[8];
    float ss = 0;
#pragma unroll
    for (int i = 0; i < 8; ++i) { v[i] = *(const f32x4*)(xr + i * 256 + lane * 4); ss += v[i][0] * v[i][0] + v[i][1] * v[i][1] + v[i][2] * v[i][2] + v[i][3] * v[i][3]; }
    ss = wave_sum(ss);
    const float rinv = rsqrtf(ss * (1.0f / 2048.0f) + EPS);
#pragma unroll
    for (int i = 0; i < 8; ++i) {
        const int col = i * 256 + lane * 4;
        const f32x4 g = *(const f32x4*)(gain + col), sh = *(const f32x4*)(mod + col), scl = *(const f32x4*)(mod + 2048 + col);
        float y[4];
#pragma unroll
        for (int j = 0; j < 4; ++j) y[j] = v[i][j] * rinv * g[j] * (1.f + scl[j]) + sh[j];
        u32x2 w = {cvtpk(y[0], y[1]), cvtpk(y[2], y[3])};
        *(u32x2*)(hr + col) = w;
    }
}
__device__ __forceinline__ void phase_modnorm(const Args& A, const float* xin, const float* gain, int set, int bid, int nb) {
    const int tid = opaque_tid(), lane = tid & 63, wave = tid >> 6;
    const float* mod = (const float*)(WSP(A) + WS_MOD) + (size_t)set * 2 * 6144;
    bf16_t* H = (bf16_t*)(WSP(A) + WS_H);
    for (int u = bid; u < T / NWAVES; u += nb) {
        const int row = u * NWAVES + wave;
        modnorm_row(xin + (size_t)row * 2048, gain, mod + (row >> 13) * 6144, H + (size_t)row * 2048, lane);
    }
}

struct ALoadPlain {
    const bf16_t* A; int lda;
    __device__ __forceinline__ const bf16_t* ptr(int row, int k) const { return A + (size_t)row * lda + k; }
};
struct ALoadCmp {
    const bf16_t* base; int ld; int colbase;
    __device__ __forceinline__ const bf16_t* ptr(int row, int k) const {
        int r = row < 2 * BATCH * NCMP ? row : 2 * BATCH * NCMP - 1;
        const int g = r & 1; r >>= 1;
        const int b = r / NCMP, n = r - b * NCMP;
        const int l = k >> 7, d = k & 127;
        return base + (size_t)(b * SEQ + 16 * n + l) * ld + colbase + g * 128 + d;
    }
};

constexpr int GEMM_LDS = 98304;
template <class AL, class Epi>
__device__ __forceinline__ void gemm_phase(unsigned char* lds, const AL al, const bf16_t* __restrict__ Bt, int ldb, int M, int Npad, int K, const Epi epi, int bid, int nb) {
    const int tid = opaque_tid(), lane = tid & 63, wave = tid >> 6, l31 = lane & 31, hi = lane >> 5;
    const int wm = wave >> 1, wn = wave & 1;
    const int nNt = Npad / 128, nU = (M / 256) * nNt, nk = K / 64;
    const int swz = (l31 >> 1) & 7;
    for (int u = bid; u < nU; u += nb) {
        const int mt = u / nNt, nt = u - mt * nNt;
        const int m0 = mt * 256, n0 = nt * 128;
        f32x16 acc[2][2];
#pragma unroll
        for (int i = 0; i < 2; ++i)
#pragma unroll
            for (int j = 0; j < 2; ++j)
#pragma unroll
                for (int r = 0; r < 16; ++r) acc[i][j][r] = 0.f;
        u32x4 ra[4], rb[2];
        auto gload = [&](int kt) {
#pragma unroll
            for (int i = 0; i < 4; ++i) { const int q = tid + NTHREADS * i, row = q >> 3, c = q & 7; ra[i] = *(const u32x4*)al.ptr(m0 + row, kt * 64 + c * 8); }
#pragma unroll
            for (int i = 0; i < 2; ++i) { const int q = tid + NTHREADS * i, row = q >> 3, c = q & 7; rb[i] = *(const u32x4*)(Bt + (size_t)(n0 + row) * ldb + kt * 64 + c * 8); }
        };
        auto lstore = [&](int buf) {
            unsigned char* la = lds + buf * 32768; unsigned char* lb = lds + 65536 + buf * 16384;
#pragma unroll
            for (int i = 0; i < 4; ++i) { const int q = tid + NTHREADS * i, row = q >> 3, c = q & 7; *(u32x4*)(la + row * 128 + ((c ^ ((row >> 1) & 7)) << 4)) = ra[i]; }
#pragma unroll
            for (int i = 0; i < 2; ++i) { const int q = tid + NTHREADS * i, row = q >> 3, c = q & 7; *(u32x4*)(lb + row * 128 + ((c ^ ((row >> 1) & 7)) << 4)) = rb[i]; }
        };
        gload(0); lstore(0); __syncthreads();
        for (int kt = 0; kt < nk; ++kt) {
            if (kt + 1 < nk) gload(kt + 1);
            const unsigned char* la = lds + (kt & 1) * 32768 + (wm * 64 + l31) * 128;
            const unsigned char* lb = lds + 65536 + (kt & 1) * 16384 + (wn * 64 + l31) * 128;
#pragma unroll
            for (int ks = 0; ks < 4; ++ks) {
                const int co = ((ks * 2 + hi) ^ swz) << 4;
                const bf16x8 a0 = *(const bf16x8*)(la + co), a1 = *(const bf16x8*)(la + 32 * 128 + co);
                const bf16x8 b0 = *(const bf16x8*)(lb + co), b1 = *(const bf16x8*)(lb + 32 * 128 + co);
                acc[0][0] = __builtin_amdgcn_mfma_f32_32x32x16_bf16(a0, b0, acc[0][0], 0, 0, 0);
                acc[0][1] = __builtin_amdgcn_mfma_f32_32x32x16_bf16(a0, b1, acc[0][1], 0, 0, 0);
                acc[1][0] = __builtin_amdgcn_mfma_f32_32x32x16_bf16(a1, b0, acc[1][0], 0, 0, 0);
                acc[1][1] = __builtin_amdgcn_mfma_f32_32x32x16_bf16(a1, b1, acc[1][1], 0, 0, 0);
            }
            if (kt + 1 < nk) lstore((kt + 1) & 1);
            __syncthreads();
        }
        epi(acc, m0 + wm * 64, n0 + wn * 64, lane);
    }
}

__device__ __forceinline__ void store_bf16_tile(const f32x16 (&acc)[2][2], bf16_t* C, int ldc, int N, int row0, int col0, int lane) {
    const int l31 = lane & 31, hi = lane >> 5;
#pragma unroll
    for (int ni = 0; ni < 2; ++ni) {
        const int col = col0 + ni * 32 + l31;
#pragma unroll
        for (int mi = 0; mi < 2; ++mi)
#pragma unroll
            for (int r = 0; r < 16; ++r) {
                const float v = acc[mi][ni][r];
                const float vn = __shfl_xor(v, 1);
                if ((l31 & 1) == 0 && col < N) *(unsigned*)(C + (size_t)(row0 + mi * 32 + crow(r, hi)) * ldc + col) = cvtpk(v, vn);
            }
    }
}
struct EpiBf16 {
    bf16_t* C; int ldc; int N;
    __device__ __forceinline__ void operator()(f32x16 (&acc)[2][2], int row0, int col0, int lane) const { store_bf16_tile(acc, C, ldc, N, row0, col0, lane); }
};
struct EpiMlaQ {
    bf16_t* C; const f32x2* rope64;
    __device__ __forceinline__ void operator()(f32x16 (&acc)[2][2], int row0, int col0, int lane) const {
        const int l31 = lane & 31, hi = lane >> 5;
        if ((col0 % 192) == 128) {
#pragma unroll
            for (int mi = 0; mi < 2; ++mi)
#pragma unroll
                for (int r = 0; r < 16; ++r) {
                    const int row = row0 + mi * 32 + crow(r, hi);
                    const f32x2 cs = rope64[(size_t)row * 32 + l31];
                    const float x1 = acc[mi][0][r], x2 = acc[mi][1][r];
                    acc[mi][0][r] = x1 * cs[0] - x2 * cs[1];
                    acc[mi][1][r] = x2 * cs[0] + x1 * cs[1];
                }
        }
        store_bf16_tile(acc, C, 1536, 1536, row0, col0, lane);
    }
};
struct EpiNsaIn {
    bf16_t* C; const f32x2* rope32;
    __device__ __forceinline__ void operator()(f32x16 (&acc)[2][2], int row0, int col0, int lane) const {
        const int l31 = lane & 31, hi = lane >> 5;
#pragma unroll
        for (int ni = 0; ni < 2; ++ni) {
            const int cb = col0 + ni * 32, hb = cb >> 7;
            const bool is_rope = ((cb & 127) == 0) && (hb < 18 || hb == 20 || hb == 21 || hb == 24 || hb == 25);
            if (is_rope) {
#pragma unroll
                for (int mi = 0; mi < 2; ++mi)
#pragma unroll
                    for (int r = 0; r < 16; ++r) {
                        const int row = row0 + mi * 32 + crow(r, hi);
                        const f32x2 cs = rope32[(size_t)row * 16 + (l31 & 15)];
                        const float own = acc[mi][ni][r];
                        const float oth = __shfl_xor(own, 16);
                        acc[mi][ni][r] = (l31 < 16) ? own * cs[0] - oth * cs[1] : own * cs[0] + oth * cs[1];
                    }
            }
            if (cb >= 3584) {
#pragma unroll
                for (int mi = 0; mi < 2; ++mi)
#pragma unroll
                    for (int r = 0; r < 16; ++r) acc[mi][ni][r] = 1.f / (1.f + __expf(-acc[mi][ni][r]));
            }
        }
        store_bf16_tile(acc, C, NSA_IN, NSA_IN, row0, col0, lane);
    }
};
struct EpiResid {
    const float* xin; float* xout; const float* gate; float gmul;
    __device__ __forceinline__ void operator()(f32x16 (&acc)[2][2], int row0, int col0, int lane) const {
        const int l31 = lane & 31, hi = lane >> 5;
        const float* gp = gate + (row0 >> 13) * 6144;
#pragma unroll
        for (int ni = 0; ni < 2; ++ni) {
            const int col = col0 + ni * 32 + l31;
            const float g = gp[col] * gmul;
#pragma unroll
            for (int mi = 0; mi < 2; ++mi)
#pragma unroll
                for (int r = 0; r < 16; ++r) {
                    const size_t o = (size_t)(row0 + mi * 32 + crow(r, hi)) * 2048 + col;
                    xout[o] = xin[o] + g * acc[mi][ni][r];
                }
        }
    }
};
struct EpiCmpHid {
    bf16_t* C; const float* biasp;
    __device__ __forceinline__ void operator()(f32x16 (&acc)[2][2], int row0, int col0, int lane) const {
        const int l31 = lane & 31;
#pragma unroll
        for (int ni = 0; ni < 2; ++ni) {
            const int col = col0 + ni * 32 + l31;
            float b = 0;
#pragma unroll 8
            for (int c = 0; c < 32; ++c) b += biasp[c * 256 + col];
#pragma unroll
            for (int mi = 0; mi < 2; ++mi)
#pragma unroll
                for (int r = 0; r < 16; ++r) acc[mi][ni][r] = gelu_tanh(acc[mi][ni][r] + b);
        }
        store_bf16_tile(acc, C, 256, 256, row0, col0, lane);
    }
};
struct EpiCmpOut {
    bf16_t* C;
    __device__ __forceinline__ void operator()(f32x16 (&acc)[2][2], int row0, int col0, int lane) const {
        const int l31 = lane & 31, hi = lane >> 5;
#pragma unroll
        for (int ni = 0; ni < 2; ++ni) {
            const int col = col0 + ni * 32 + l31;
#pragma unroll
            for (int mi = 0; mi < 2; ++mi)
#pragma unroll
                for (int r = 0; r < 16; ++r) {
                    const float v = acc[mi][ni][r];
                    const float vn = __shfl_xor(v, 1);
                    int rr = row0 + mi * 32 + crow(r, hi);
                    if ((l31 & 1) == 0 && rr < 2 * BATCH * NCMP) {
                        const int g = rr & 1; rr >>= 1;
                        const int b = rr / NCMP, n = rr - b * NCMP;
                        *(unsigned*)(C + (size_t)((b * NCMP_PAD + n) * 2 + g) * 128 + col) = cvtpk(v, vn);
                    }
                }
        }
    }
};

__device__ __forceinline__ void phase_mla_prep(const Args& A, int bid, int nb) {
    const int tid = opaque_tid(), lane = tid & 63, wave = tid >> 6;
    const bf16_t* BIG = (const bf16_t*)(WSP(A) + WS_BIG);
    bf16_t* CQN = (bf16_t*)(WSP(A) + WS_CQN); bf16_t* CKVN = (bf16_t*)(WSP(A) + WS_CKVN); bf16_t* KVM = (bf16_t*)(WSP(A) + WS_KVM);
    const f32x2* rope64 = (const f32x2*)(WSP(A) + WS_ROPE64);
    const float* qn = A.in[7]; const float* kvn = A.in[9];
    for (int u = bid; u < T / NWAVES; u += nb) {
        const int t = u * NWAVES + wave;
        const bf16_t* row = BIG + (size_t)t * SBMLA_IN;
        {
            const u32x4 w = *(const u32x4*)(row + 3072 + lane * 8);
            float x[8] = {bflo(w[0]), bfhi(w[0]), bflo(w[1]), bfhi(w[1]), bflo(w[2]), bfhi(w[2]), bflo(w[3]), bfhi(w[3])};
            float ss = 0;
#pragma unroll
            for (int j = 0; j < 8; ++j) ss += x[j] * x[j];
            ss = wave_sum(ss);
            const float rinv = rsqrtf(ss * (1.f / 512.f) + EPS);
            const f32x4 g0 = *(const f32x4*)(qn + lane * 8), g1 = *(const f32x4*)(qn + lane * 8 + 4);
            u32x4 o = {cvtpk(x[0] * rinv * g0[0], x[1] * rinv * g0[1]), cvtpk(x[2] * rinv * g0[2], x[3] * rinv * g0[3]),
                       cvtpk(x[4] * rinv * g1[0], x[5] * rinv * g1[1]), cvtpk(x[6] * rinv * g1[2], x[7] * rinv * g1[3])};
            *(u32x4*)(CQN + (size_t)t * 512 + lane * 8) = o;
        }
        {
            const u32x2 w = *(const u32x2*)(row + 3584 + lane * 4);
            float x[4] = {bflo(w[0]), bfhi(w[0]), bflo(w[1]), bfhi(w[1])};
            float ss = x[0] * x[0] + x[1] * x[1] + x[2] * x[2] + x[3] * x[3];
            ss = wave_sum(ss);
            const float rinv = rsqrtf(ss * (1.f / 256.f) + EPS);
            const f32x4 g = *(const f32x4*)(kvn + lane * 4);
            u32x2 o = {cvtpk(x[0] * rinv * g[0], x[1] * rinv * g[1]), cvtpk(x[2] * rinv * g[2], x[3] * rinv * g[3])};
            *(u32x2*)(CKVN + (size_t)t * 256 + lane * 4) = o;
        }
        {
            const float x = bf2f(row[3840 + lane]);
            const float oth = __shfl_xor(x, 32);
            const f32x2 cs = rope64[(size_t)t * 32 + (lane & 31)];
            const float y = (lane < 32) ? x * cs[0] - oth * cs[1] : x * cs[0] + oth * cs[1];
            KVM[(size_t)t * KVM_LD + 2048 + lane] = (bf16_t)(cvtpk(y, y) & 0xFFFFu);
        }
    }
}
constexpr int KSTR128 = 272, KSTR192 = 400, VSTR = 320;
constexpr int ATT_K_BYTES = 64 * KSTR192;
constexpr int ATT_V_BYTES = 64 * VSTR;
constexpr int ATT_KOFF = 0, ATT_VOFF = 2 * ATT_K_BYTES, ATT_MISC = ATT_VOFF + 2 * ATT_V_BYTES;

template <int NKS, int KSTR>
__device__ __forceinline__ void qk_tile(f32x16& p0, f32x16& p1, const unsigned char* kb_lane, const bf16x8* qr) {
#pragma unroll
    for (int r = 0; r < 16; ++r) { p0[r] = 0.f; p1[r] = 0.f; }
#pragma unroll
    for (int ks = 0; ks < NKS; ++ks) {
        const bf16x8 a0 = *(const bf16x8*)(kb_lane + ks * 32);
        const bf16x8 a1 = *(const bf16x8*)(kb_lane + 32 * KSTR + ks * 32);
        p0 = __builtin_amdgcn_mfma_f32_32x32x16_bf16(a0, qr[ks], p0, 0, 0, 0);
        p1 = __builtin_amdgcn_mfma_f32_32x32x16_bf16(a1, qr[ks], p1, 0, 0, 0);
        if ((ks & 3) == 3) __builtin_amdgcn_sched_barrier(0);
    }
}
__device__ __forceinline__ s16x4 tr_read(const unsigned char* p) {
    return __builtin_amdgcn_ds_read_tr16_b64_v4i16((LAS s16x4*)p);
}
__device__ __forceinline__ void pv_tile(f32x16 (&o)[4], const unsigned char* vb_lane, const bf16x8 (&pb)[4]) {
#pragma unroll
    for (int dt = 0; dt < 4; ++dt) {
#pragma unroll
        for (int s = 0; s < 4; ++s) {
            const s16x4 lo = tr_read(vb_lane + (s * 16) * VSTR + dt * 64);
            const s16x4 hh = tr_read(vb_lane + (s * 16 + 8) * VSTR + dt * 64);
            const bf16x8 a = {lo[0], lo[1], lo[2], lo[3], hh[0], hh[1], hh[2], hh[3]};
            o[dt] = __builtin_amdgcn_mfma_f32_32x32x16_bf16(a, pb[s], o[dt], 0, 0, 0);
        }
        __builtin_amdgcn_sched_barrier(0);
    }
}
__device__ __forceinline__ bf16x8 pack8f(const f32x16& p, int b) {
    u32x4 w = {cvtpk(p[b + 0], p[b + 1]), cvtpk(p[b + 2], p[b + 3]), cvtpk(p[b + 4], p[b + 5]), cvtpk(p[b + 6], p[b + 7])};
    return *reinterpret_cast<bf16x8*>(&w);
}
__device__ __forceinline__ int vb_lane_off(int lane) {
    return (4 * (lane >> 5) + ((lane >> 2) & 3)) * VSTR + (16 * ((lane >> 4) & 1) + 4 * (lane & 3)) * 2;
}
__device__ __forceinline__ void softmax_step(f32x16& p0, f32x16& p1, float& m, float& l, f32x16 (&o)[4], float c2, bf16x8 (&pb)[4]) {
    float mx = p0[0];
#pragma unroll
    for (int r = 1; r < 16; ++r) mx = fmaxf(mx, p0[r]);
#pragma unroll
    for (int r = 0; r < 16; ++r) mx = fmaxf(mx, p1[r]);
    mx = fmaxf(mx, __shfl_xor(mx, 32));
    const float mn = fmaxf(m, mx);
    const float alpha = __builtin_amdgcn_exp2f((m - mn) * c2);
    const float mc = mn * c2;
    float rs = 0.f;
#pragma unroll
    for (int r = 0; r < 16; ++r) { p0[r] = __builtin_amdgcn_exp2f(p0[r] * c2 - mc); rs += p0[r]; }
#pragma unroll
    for (int r = 0; r < 16; ++r) { p1[r] = __builtin_amdgcn_exp2f(p1[r] * c2 - mc); rs += p1[r]; }
    rs += __shfl_xor(rs, 32);
    l = l * alpha + rs;
    m = mn;
    if (__any(alpha != 1.f)) {
#pragma unroll
        for (int dt = 0; dt < 4; ++dt)
#pragma unroll
            for (int r = 0; r < 16; ++r) o[dt][r] *= alpha;
    }
    pb[0] = pack8f(p0, 0); pb[1] = pack8f(p0, 8); pb[2] = pack8f(p1, 0); pb[3] = pack8f(p1, 8);
}
__device__ __forceinline__ void store_ot_bf16(const f32x16 (&o)[4], float sc, bf16_t* orow  , int hi) {
#pragma unroll
    for (int dt = 0; dt < 4; ++dt)
#pragma unroll
        for (int g = 0; g < 4; ++g) {
            u32x2 w = {cvtpk(o[dt][4 * g] * sc, o[dt][4 * g + 1] * sc), cvtpk(o[dt][4 * g + 2] * sc, o[dt][4 * g + 3] * sc)};
            *(u32x2*)(orow + dt * 32 + 8 * g + 4 * hi) = w;
        }
}

__device__ __forceinline__ void mla_item(const Args& A, unsigned char* lds, int b, int h, int qt) {
    const int tid = opaque_tid(), lane = tid & 63, wave = tid >> 6, l31 = lane & 31, hi = lane >> 5;
    const bf16_t* QM = (const bf16_t*)(WSP(A) + WS_QM); const bf16_t* KVM = (const bf16_t*)(WSP(A) + WS_KVM);
    bf16_t* O = (bf16_t*)(WSP(A) + WS_O);
    const int q0 = qt * 256, qw = q0 + wave * 32, t = qw + l31;
    const size_t tokb = (size_t)b * SEQ;
    bf16x8 qr[12];
    {
        const bf16_t* qp = QM + (tokb + t) * 1536 + h * 192 + hi * 8;
#pragma unroll
        for (int ks = 0; ks < 12; ++ks) qr[ks] = *(const bf16x8*)(qp + ks * 16);
    }
    const int nkt = (q0 + 256) / 64;
    u32x4 rk[3], rv[2];
    unsigned okb[3], ovb[2], lkb[3], lvb[2];
#pragma unroll
    for (int i = 0; i < 3; ++i) {
        const int q = tid + NTHREADS * i, row = q / 24, c = q - row * 24;
        okb[i] = (unsigned)(row * KVM_LD + ((c < 16) ? h * 256 + c * 8 : 2048 + (c - 16) * 8)) * 2u;
        lkb[i] = (unsigned)(row * KSTR192 + c * 16);
    }
#pragma unroll
    for (int i = 0; i < 2; ++i) {
        const int q = tid + NTHREADS * i, row = q >> 4, c = q & 15;
        ovb[i] = (unsigned)(row * KVM_LD + h * 256 + 128 + c * 8) * 2u;
        lvb[i] = (unsigned)(row * VSTR + c * 16);
    }
    auto gload = [&](int kt) {
        const unsigned char* base = (const unsigned char*)(KVM + (tokb + (size_t)kt * 64) * KVM_LD);
#pragma unroll
        for (int i = 0; i < 3; ++i) rk[i] = *(const u32x4*)(base + okb[i]);
#pragma unroll
        for (int i = 0; i < 2; ++i) rv[i] = *(const u32x4*)(base + ovb[i]);
    };
    auto lstore = [&](int buf) {
        unsigned char* kb = lds + ATT_KOFF + buf * ATT_K_BYTES; unsigned char* vb = lds + ATT_VOFF + buf * ATT_V_BYTES;
#pragma unroll
        for (int i = 0; i < 3; ++i) *(u32x4*)(kb + lkb[i]) = rk[i];
#pragma unroll
        for (int i = 0; i < 2; ++i) *(u32x4*)(vb + lvb[i]) = rv[i];
    };
    f32x16 o[4];
#pragma unroll
    for (int dt = 0; dt < 4; ++dt)
#pragma unroll
        for (int r = 0; r < 16; ++r) o[dt][r] = 0.f;
    float m = -1e30f, l = 0.f;
    const float c2 = 0.07216878364870322f * 1.4426950408889634f;
    const int kl_off = l31 * KSTR192 + hi * 16, vl_off = vb_lane_off(lane);
    gload(0); lstore(0); __syncthreads();
    for (int kt = 0; kt < nkt; ++kt) {
        if (kt + 1 < nkt) gload(kt + 1);
        if (kt * 64 <= qw + 31) {
            f32x16 p0, p1;
            qk_tile<12, KSTR192>(p0, p1, lds + ATT_KOFF + (kt & 1) * ATT_K_BYTES + kl_off, qr);
            if (kt * 64 + 63 > qw) {
                const int dq = t - kt * 64 - 4 * hi;
#pragma unroll
                for (int r = 0; r < 16; ++r) {
                    const int cb = (r & 3) + 8 * (r >> 2);
                    if (cb > dq) p0[r] = -__builtin_inff();
                    if (cb + 32 > dq) p1[r] = -__builtin_inff();
                }
            }
            bf16x8 pb[4];
            softmax_step(p0, p1, m, l, o, c2, pb);
            pv_tile(o, lds + ATT_VOFF + (kt & 1) * ATT_V_BYTES + vl_off, pb);
        }
        if (kt + 1 < nkt) lstore((kt + 1) & 1);
        __syncthreads();
    }
    store_ot_bf16(o, ABL_MLA / l, O + (tokb + t) * 2048 + 1024 + h * 128, hi);
}

__device__ __forceinline__ void sb_item(const Args& A, unsigned char* lds, int b, int h, int qt) {
    const int tid = opaque_tid(), lane = tid & 63, wave = tid >> 6, l31 = lane & 31, hi = lane >> 5;
    const bf16_t* BIG = (const bf16_t*)(WSP(A) + WS_BIG);
    bf16_t* O = (bf16_t*)(WSP(A) + WS_O);
    volatile int* flags = (volatile int*)(lds + ATT_MISC);
    const int q0 = qt * 256, qw = q0 + wave * 32, t = qw + l31;
    const size_t tokb = (size_t)b * SEQ;
    bf16x8 qr[8];
    {
        const bf16_t* qp = BIG + (tokb + t) * SBMLA_IN + h * 128 + hi * 8;
#pragma unroll
        for (int ks = 0; ks < 8; ++ks) qr[ks] = *(const bf16x8*)(qp + ks * 16);
    }
    bf16x8 tri[2];
#pragma unroll
    for (int s2 = 0; s2 < 2; ++s2)
#pragma unroll
        for (int jj = 0; jj < 8; ++jj) tri[s2][jj] = (16 * s2 + 8 * (jj >> 2) + 4 * hi + (jj & 3) > l31) ? (short)0x3F80 : (short)0;
    u32x4 rk[2], rv[2];
    unsigned ogb[2], lkb[2], lvb[2];
#pragma unroll
    for (int i = 0; i < 2; ++i) {
        const int q = tid + NTHREADS * i, row = q >> 4, c = q & 15;
        ogb[i] = (unsigned)(row * SBMLA_IN + c * 8) * 2u; lkb[i] = (unsigned)(row * KSTR128 + c * 16); lvb[i] = (unsigned)(row * VSTR + c * 16);
    }
    auto gload = [&](int kt) {
        const unsigned char* base = (const unsigned char*)(BIG + (tokb + (size_t)kt * 64) * SBMLA_IN + h * 128);
#pragma unroll
        for (int i = 0; i < 2; ++i) { rk[i] = *(const u32x4*)(base + 2048 + ogb[i]); rv[i] = *(const u32x4*)(base + 4096 + ogb[i]); }
    };
    auto lstore = [&](int buf) {
        unsigned char* kb = lds + ATT_KOFF + buf * ATT_K_BYTES; unsigned char* vb = lds + ATT_VOFF + buf * ATT_V_BYTES;
#pragma unroll
        for (int i = 0; i < 2; ++i) { *(u32x4*)(kb + lkb[i]) = rk[i]; *(u32x4*)(vb + lvb[i]) = rv[i]; }
    };
    f32x16 o[4];
#pragma unroll
    for (int dt = 0; dt < 4; ++dt)
#pragma unroll
        for (int r = 0; r < 16; ++r) o[dt][r] = 0.f;
    float R = 0.f;
    bool done = false;
    const float scale = 0.08838834764831845f;
    const int kt_hi = (q0 + 254) / 64, ktw = (qw + 30) / 64;
    const int kl_off = l31 * KSTR128 + hi * 16, vl_off = vb_lane_off(lane);
    gload(kt_hi); lstore(0); __syncthreads();
    int it = 0;
    for (int kt = kt_hi; kt >= 0; --kt, ++it) {
        if (kt > 0) gload(kt - 1);
        if (kt <= ktw && !done) {
            f32x16 p0, p1;
            qk_tile<8, KSTR128>(p0, p1, lds + ATT_KOFF + (it & 1) * ATT_K_BYTES + kl_off, qr);
            const int dq = t - kt * 64 - 4 * hi;
            float tot0 = 0.f, tot1 = 0.f;
            u32x4 w0, w1, w2, w3;
            auto sbf = [&](float pz, bool v, float& tot, float& lbo) -> float {
                const float z = pz * scale;
                const float lp = __logf(1.f + __expf(-fabsf(z)));
                const float lb = fminf(z, 0.f) - lp;
                const float l1 = v ? lb - z : 0.f;
                tot += l1; lbo = v ? lb : -__builtin_inff();
                return l1;
            };
#pragma unroll
            for (int r = 0; r < 16; r += 2) {
                const int cb0 = (r & 3) + 8 * (r >> 2), cb1 = ((r + 1) & 3) + 8 * ((r + 1) >> 2);
                float t0_, t1_, t2_, t3_;
                const float a0 = sbf(p0[r], cb0 < dq, tot0, t0_), a1 = sbf(p0[r + 1], cb1 < dq, tot0, t1_);
                const float b0 = sbf(p1[r], cb0 + 32 < dq, tot1, t2_), b1 = sbf(p1[r + 1], cb1 + 32 < dq, tot1, t3_);
                p0[r] = t0_; p0[r + 1] = t1_; p1[r] = t2_; p1[r + 1] = t3_;
                const unsigned pa = cvtpk(a0, a1), pbb = cvtpk(b0, b1);
                if (r < 8) { w0[r >> 1] = pa; w2[r >> 1] = pbb; } else { w1[(r - 8) >> 1] = pa; w3[(r - 8) >> 1] = pbb; }
            }
            tot0 += __shfl_xor(tot0, 32); tot1 += __shfl_xor(tot1, 32);
            bf16x8 lf[4];
            lf[0] = *reinterpret_cast<bf16x8*>(&w0); lf[1] = *reinterpret_cast<bf16x8*>(&w1); lf[2] = *reinterpret_cast<bf16x8*>(&w2); lf[3] = *reinterpret_cast<bf16x8*>(&w3);
            f32x16 c0, c1;
            const float r1 = R + tot1;
#pragma unroll
            for (int r = 0; r < 16; ++r) { c1[r] = R; c0[r] = r1; }
            c1 = __builtin_amdgcn_mfma_f32_32x32x16_bf16(tri[0], lf[2], c1, 0, 0, 0);
            c1 = __builtin_amdgcn_mfma_f32_32x32x16_bf16(tri[1], lf[3], c1, 0, 0, 0);
            c0 = __builtin_amdgcn_mfma_f32_32x32x16_bf16(tri[0], lf[0], c0, 0, 0, 0);
            c0 = __builtin_amdgcn_mfma_f32_32x32x16_bf16(tri[1], lf[1], c0, 0, 0, 0);
#pragma unroll
            for (int r = 0; r < 16; ++r) { p0[r] = __expf(p0[r] + c0[r]); p1[r] = __expf(p1[r] + c1[r]); }
            R = r1 + tot0;
            bf16x8 pb[4] = {pack8f(p0, 0), pack8f(p0, 8), pack8f(p1, 0), pack8f(p1, 8)};
            pv_tile(o, lds + ATT_VOFF + (it & 1) * ATT_V_BYTES + vl_off, pb);
            done = __all(R < -104.f);
        }
        if (lane == 0) flags[(it & 1) * 8 + wave] = done ? 1 : 0;
        if (kt > 0) lstore((it + 1) & 1);
        __syncthreads();
        int nd = 0;
#pragma unroll
        for (int w = 0; w < 8; ++w) nd += flags[(it & 1) * 8 + w];
        if (nd == 8) break;
    }
    store_ot_bf16(o, ABL_SB, O + (tokb + t) * 2048 + h * 128, hi);
    __syncthreads();
}

__device__ __forceinline__ void phase_attn0(const Args& A, unsigned char* lds, int bid, int nb) {
    for (int u = bid; u < 256; u += nb) {
        const int bh = u >> 4, p = u & 15;
#pragma unroll 1
        for (int rep = 0; rep < 2; ++rep) mla_item(A, lds, bh >> 3, bh & 7, rep ? p : 31 - p);
    }
    for (int v = bid; v < 512; v += nb) {
        const int bh = v >> 5, qt = v & 31;
        sb_item(A, lds, bh >> 3, bh & 7, qt);
    }
}
__device__ __forceinline__ unsigned f2sort(float f) { const unsigned u = __float_as_uint(f); return u ^ ((u & 0x80000000u) ? 0xFFFFFFFFu : 0x80000000u); }
__device__ __forceinline__ float sort2f(unsigned s) { const unsigned u = (s & 0x80000000u) ? (s ^ 0x80000000u) : ~s; return __uint_as_float(u); }
__device__ __forceinline__ unsigned umax3(unsigned a, unsigned b, unsigned c) { return max(max(a, b), c); }

__device__ __forceinline__ void top16_of_128(unsigned (&k)[64], unsigned* out  , int lane) {
#pragma unroll 1
    for (int it = 0; it < 16; ++it) {
        unsigned mx = k[0];
#pragma unroll
        for (int i = 1; i < 63; i += 2) mx = umax3(mx, k[i], k[i + 1]);
        mx = max(mx, k[63]);
        const unsigned pm = (unsigned)__shfl_xor((int)mx, 32);
        const unsigned g = max(mx, pm);
        out[it * 64 + lane] = g;
#pragma unroll
        for (int i = 0; i < 64; ++i) k[i] = (k[i] == g) ? 0u : k[i];
    }
}

constexpr int TOPK_STAGE = 2 * 128 * KSTR128;
constexpr int TOPK_LDS = TOPK_STAGE + 8 * 8192;
__device__ __forceinline__ void phase_topk(const Args& A, unsigned char* lds, int layer, int bid, int nb) {
    const int tid = opaque_tid(), lane = tid & 63, wave = tid >> 6, l31 = lane & 31, hi = lane >> 5;
    const bf16_t* PQ = (const bf16_t*)(WSP(A) + WS_PQ);
    const bf16_t* K12 = (const bf16_t*)(WSP(A) + WS_K12) + (size_t)layer * 2 * 16384;
    int* EXI = (int*)(WSP(A) + WS_EXI); float* EXG = (float*)(WSP(A) + WS_EXG);
    for (int q = tid; q < 2 * 128 * 16; q += NTHREADS) { const int row = q >> 4, c = q & 15; *(u32x4*)(lds + row * KSTR128 + c * 16) = *(const u32x4*)(K12 + row * 128 + c * 8); }
    __syncthreads();
    for (int u = bid; u < T / 32; u += nb) {
        const int t = u * 32 + l31, h = wave;
        unsigned* wl = (unsigned*)(lds + TOPK_STAGE) + wave * 2048;
#pragma unroll
        for (int side = 0; side < 2; ++side) {
            bf16x8 qr[8];
            const bf16_t* qp = PQ + (size_t)t * 2048 + h * 256 + side * 128 + hi * 8;
#pragma unroll
            for (int ks = 0; ks < 8; ++ks) qr[ks] = *(const bf16x8*)(qp + ks * 16);
            const unsigned char* kp = lds + side * 128 * KSTR128 + l31 * KSTR128 + hi * 16;
            unsigned keys[64];
#pragma unroll
            for (int mt = 0; mt < 4; ++mt) {
                f32x16 p;
#pragma unroll
                for (int r = 0; r < 16; ++r) p[r] = 0.f;
#pragma unroll
                for (int ks = 0; ks < 8; ++ks) {
                    const bf16x8 a = *(const bf16x8*)(kp + mt * 32 * KSTR128 + ks * 32);
                    p = __builtin_amdgcn_mfma_f32_32x32x16_bf16(a, qr[ks], p, 0, 0, 0);
                }
#pragma unroll
                for (int r = 0; r < 16; ++r) {
                    const int key = mt * 32 + (r & 3) + 8 * (r >> 2) + 4 * hi;
                    keys[mt * 16 + r] = (f2sort(p[r]) & ~127u) | (unsigned)(127 - key);
                }
                __builtin_amdgcn_sched_barrier(0);
            }
            top16_of_128(keys, wl + side * 1024, lane);
        }
        unsigned lst[2][16];
#pragma unroll
        for (int i = 0; i < 16; ++i) { lst[0][i] = wl[i * 64 + lane]; lst[1][i] = wl[1024 + i * 64 + lane]; }
        float v1[16], v2[16];
#pragma unroll
        for (int i = 0; i < 16; ++i) { v1[i] = sort2f(lst[0][i] & ~127u); v2[i] = sort2f(lst[1][i] & ~127u); }
        unsigned cand[50];
        {
            int c = 0;
#pragma unroll
            for (int i = 0; i < 16; ++i)
#pragma unroll
                for (int j = 0; j < 16; ++j)
                    if ((i + 1) * (j + 1) <= 16) { cand[c] = (f2sort(v1[i] + v2[j]) & ~255u) | (unsigned)(255 - (16 * i + j)); ++c; }
        }
        float* wv = (float*)wl; int* we = (int*)wl + 1024;
#pragma unroll 1
        for (int it = 0; it < 16; ++it) {
            unsigned mx = cand[0];
#pragma unroll
            for (int c = 1; c < 49; c += 2) mx = umax3(mx, cand[c], cand[c + 1]);
            mx = max(mx, cand[49]);
            wv[it * 64 + lane] = sort2f(mx & ~255u);
            int eid = 0;
            {
                int c = 0;
#pragma unroll
                for (int i = 0; i < 16; ++i)
#pragma unroll
                    for (int j = 0; j < 16; ++j)
                        if ((i + 1) * (j + 1) <= 16) {
                            const bool hit = cand[c] == mx;
                            eid = hit ? (int)((127u - (lst[0][i] & 127u)) * 128u + (127u - (lst[1][j] & 127u))) : eid;
                            cand[c] = hit ? 0u : cand[c];
                            ++c;
                        }
            }
            we[it * 64 + lane] = eid;
        }
        float topv[16]; int tope[16];
#pragma unroll
        for (int it = 0; it < 16; ++it) { topv[it] = wv[it * 64 + lane]; tope[it] = we[it * 64 + lane]; }
        const float mx0 = topv[0];
        float sum = 0.f;
#pragma unroll
        for (int it = 0; it < 16; ++it) { topv[it] = __expf(topv[it] - mx0); sum += topv[it]; }
        if (hi == 0) {
            const float inv = 1.f / sum;
            int* ei = EXI + (size_t)t * 128 + h * 16; float* eg = EXG + (size_t)t * 128 + h * 16;
#pragma unroll
            for (int q = 0; q < 4; ++q) {
                *(int4*)(ei + 4 * q) = make_int4(tope[4 * q], tope[4 * q + 1], tope[4 * q + 2], tope[4 * q + 3]);
                *(f32x4*)(eg + 4 * q) = f32x4{topv[4 * q] * inv, topv[4 * q + 1] * inv, topv[4 * q + 2] * inv, topv[4 * q + 3] * inv};
            }
        }
    }
    __syncthreads();
}
__device__ __forceinline__ void fp8x16_to_f32(const u32x4 w, float (&f)[16]) {
#pragma unroll
    for (int j = 0; j < 4; ++j) {
        const f32x2 lo = __builtin_amdgcn_cvt_pk_f32_fp8((int)w[j], false), hi = __builtin_amdgcn_cvt_pk_f32_fp8((int)w[j], true);
        f[4 * j] = lo[0]; f[4 * j + 1] = lo[1]; f[4 * j + 2] = hi[0]; f[4 * j + 3] = hi[1];
    }
}
struct PeerRow { u32x4 u[2], v[2]; };

template <bool FINAL>
__device__ __forceinline__ void phase_gather(const Args& A, int layer, const float* xin, float* xout, int gate_set, const float* next_gain, int next_set, float gmul, int bid, int nb) {
    const int tid = opaque_tid(), lane = tid & 63, wave = tid >> 6;
    bf16_t* H = (bf16_t*)(WSP(A) + WS_H);
    const unsigned char* PU = WSP(A) + WS_PU + (size_t)layer * 16384 * 2048;
    const unsigned char* PV = WSP(A) + WS_PV + (size_t)layer * 16384 * 2048;
    const int* EXI = (const int*)(WSP(A) + WS_EXI); const float* EXG = (const float*)(WSP(A) + WS_EXG);
    const float* mod = (const float*)(WSP(A) + WS_MOD);
    for (int u = bid; u < T / NWAVES; u += nb) {
        const int t = u * NWAVES + wave;
        float hp[2][16];
#pragma unroll
        for (int c = 0; c < 2; ++c)
#pragma unroll
            for (int q = 0; q < 2; ++q) {
                const u32x4 w_ = *(const u32x4*)(H + (size_t)t * 2048 + c * 1024 + lane * 16 + q * 8);
#pragma unroll
                for (int j = 0; j < 4; ++j) { hp[c][q * 8 + 2 * j] = bflo(w_[j]); hp[c][q * 8 + 2 * j + 1] = bfhi(w_[j]); }
            }
        const int idxA = EXI[(size_t)t * 128 + lane], idxB = EXI[(size_t)t * 128 + 64 + lane];
        const float gA = EXG[(size_t)t * 128 + lane], gB = EXG[(size_t)t * 128 + 64 + lane];
        float o[2][16];
#pragma unroll
        for (int c = 0; c < 2; ++c)
#pragma unroll
            for (int j = 0; j < 16; ++j) o[c][j] = 0.f;
        PeerRow r0, r1, r2, r3;
        auto issue = [&](int k, PeerRow& r) {
            const int e = __builtin_amdgcn_readlane(k < 64 ? idxA : idxB, k & 63);
            const unsigned char* up = PU + (size_t)e * 2048 + lane * 16; const unsigned char* vp = PV + (size_t)e * 2048 + lane * 16;
#pragma unroll
            for (int c = 0; c < 2; ++c) { r.u[c] = *(const u32x4*)(up + c * 1024); r.v[c] = *(const u32x4*)(vp + c * 1024); }
        };
        auto consume = [&](int k, const PeerRow& r) {
            float d = 0.f;
#pragma unroll
            for (int c = 0; c < 2; ++c) {
                float f[16]; fp8x16_to_f32(r.u[c], f);
#pragma unroll
                for (int j = 0; j < 16; ++j) d += f[j] * hp[c][j];
            }
            d = wave_sum(d) * (1.f / PEER_USCALE);
            const float g = __uint_as_float(__builtin_amdgcn_readlane(__float_as_uint(k < 64 ? gA : gB), k & 63));
            const float w = g * gelu_tanh(d) * (gmul / PEER_VSCALE);
#pragma unroll
            for (int c = 0; c < 2; ++c) {
                float f[16]; fp8x16_to_f32(r.v[c], f);
#pragma unroll
                for (int j = 0; j < 16; ++j) o[c][j] += w * f[j];
            }
        };
        issue(0, r0); issue(1, r1); issue(2, r2); issue(3, r3);
#pragma unroll 1
        for (int k = 0; k < 128; k += 4) {
            consume(k, r0);     if (k + 4 < 128) issue(k + 4, r0);
            consume(k + 1, r1); if (k + 4 < 128) issue(k + 5, r1);
            consume(k + 2, r2); if (k + 4 < 128) issue(k + 6, r2);
            consume(k + 3, r3); if (k + 4 < 128) issue(k + 7, r3);
        }
        const int b = t >> 13;
        const float* gate = mod + (size_t)(gate_set * 2 + b) * 6144 + 4096;
        float ss = 0.f;
#pragma unroll
        for (int c = 0; c < 2; ++c)
#pragma unroll
            for (int q = 0; q < 4; ++q) {
                const int col = c * 1024 + lane * 16 + q * 4;
                const f32x4 x0 = *(const f32x4*)(xin + (size_t)t * 2048 + col), g0 = *(const f32x4*)(gate + col);
#pragma unroll
                for (int j = 0; j < 4; ++j) { const float xv = x0[j] + g0[j] * o[c][q * 4 + j]; o[c][q * 4 + j] = xv; ss += xv * xv; }
            }
        ss = wave_sum(ss);
        const float rinv = rsqrtf(ss * (1.f / 2048.f) + EPS);
        if constexpr (FINAL) {
#pragma unroll
            for (int c = 0; c < 2; ++c)
#pragma unroll
                for (int q = 0; q < 4; ++q) {
                    const int col = c * 1024 + lane * 16 + q * 4;
                    const f32x4 w0 = *(const f32x4*)(next_gain + col);
                    f32x4 y;
#pragma unroll
                    for (int j = 0; j < 4; ++j) y[j] = o[c][q * 4 + j] * rinv * w0[j];
                    *(f32x4*)(xout + (size_t)t * 2048 + col) = y;
                }
        } else {
            const float* nm = mod + (size_t)(next_set * 2 + b) * 6144;
#pragma unroll
            for (int c = 0; c < 2; ++c) {
                float hh[16];
#pragma unroll
                for (int q = 0; q < 4; ++q) {
                    const int col = c * 1024 + lane * 16 + q * 4;
                    f32x4 y;
#pragma unroll
                    for (int j = 0; j < 4; ++j) y[j] = o[c][q * 4 + j];
                    *(f32x4*)(xout + (size_t)t * 2048 + col) = y;
                    const f32x4 w0 = *(const f32x4*)(next_gain + col), s0 = *(const f32x4*)(nm + col), c0 = *(const f32x4*)(nm + 2048 + col);
#pragma unroll
                    for (int j = 0; j < 4; ++j) hh[q * 4 + j] = y[j] * rinv * w0[j] * (1.f + c0[j]) + s0[j];
                }
#pragma unroll
                for (int q = 0; q < 2; ++q) {
                    u32x4 w = {cvtpk(hh[q * 8], hh[q * 8 + 1]), cvtpk(hh[q * 8 + 2], hh[q * 8 + 3]), cvtpk(hh[q * 8 + 4], hh[q * 8 + 5]), cvtpk(hh[q * 8 + 6], hh[q * 8 + 7])};
                    *(u32x4*)(H + (size_t)t * 2048 + c * 1024 + lane * 16 + q * 8) = w;
                }
            }
        }
    }
}
constexpr int NSA_IMP = ATT_MISC;
constexpr int NSA_SELM = NSA_IMP + 32 * 128 * 4;
constexpr int NSA_KEYS = NSA_SELM + 512;
constexpr int LDS_BARW = NSA_KEYS + 8 * 128 * 4;
constexpr int LDS_BARW2 = (LDS_BARW > TOPK_LDS ? LDS_BARW : TOPK_LDS);
constexpr int LDS_TOTAL = ((LDS_BARW2 + 16 + 255) / 256) * 256;
static_assert(LDS_TOTAL <= 160 * 1024 && GEMM_LDS <= LDS_BARW2, "LDS budget");

__device__ __forceinline__ int next_bit128(unsigned long long lo, unsigned long long hi, int from) {
    if (from < 64) { const unsigned long long mm = lo >> from; if (mm) return from + __builtin_ctzll(mm); from = 64; }
    if (from < 128) { const unsigned long long mm = hi >> (from - 64); if (mm) return from + __builtin_ctzll(mm); }
    return 128;
}
template <int MODE>
__device__ __forceinline__ void nsa_emit(const f32x16 (&o)[4], float sc, float* acc_row, bf16_t* o_row, int hi) {
#pragma unroll
    for (int dt = 0; dt < 4; ++dt)
#pragma unroll
        for (int g4 = 0; g4 < 4; ++g4) {
            const int d = dt * 32 + 8 * g4 + 4 * hi;
            f32x4 v = {o[dt][4 * g4] * sc, o[dt][4 * g4 + 1] * sc, o[dt][4 * g4 + 2] * sc, o[dt][4 * g4 + 3] * sc};
            if (MODE >= 1) { const f32x4 pv = *(const f32x4*)(acc_row + d); v += pv; }
            if (MODE <= 1) *(f32x4*)(acc_row + d) = v;
            else { u32x2 w = {cvtpk(v[0], v[1]), cvtpk(v[2], v[3])}; *(u32x2*)(o_row + d) = w; }
        }
}

__device__ __forceinline__ void nsa_item(const Args& A, unsigned char* lds, int b, int g, int tt) {
    const int tid = opaque_tid(), lane = tid & 63, wave = tid >> 6, l31 = lane & 31, hi = lane >> 5;
    const bf16_t* NS = (const bf16_t*)(WSP(A) + WS_BIG);
    const bf16_t* KCC = (const bf16_t*)(WSP(A) + WS_KCC); const bf16_t* VCC = (const bf16_t*)(WSP(A) + WS_VCC);
    float* OACC = (float*)(WSP(A) + WS_OACC); bf16_t* O = (bf16_t*)(WSP(A) + WS_O);
    int* IMP = (int*)(lds + NSA_IMP); unsigned* SELM = (unsigned*)(lds + NSA_SELM); int* KEYS = (int*)(lds + NSA_KEYS) + wave * 128;
    const int t0 = tt * 32, t = t0 + l31, hd = g * 8 + wave;
    const size_t tokb = (size_t)b * SEQ;
    const float c2 = 0.08838834764831845f * 1.4426950408889634f;
    bf16x8 qr[8];
    {
        const bf16_t* qp = NS + (tokb + t) * NSA_IN + hd * 128 + hi * 8;
#pragma unroll
        for (int ks = 0; ks < 8; ++ks) qr[ks] = *(const bf16x8*)(qp + ks * 16);
    }
    float gt[3];
    {
        const bf16_t* gp = NS + (tokb + t) * NSA_IN + 3584 + g * 24 + wave * 3;
        gt[0] = bf2f(gp[0]); gt[1] = bf2f(gp[1]); gt[2] = bf2f(gp[2]);
    }
    float* acc_row = OACC + (tokb + t) * 2048 + hd * 128;
    bf16_t* o_row = O + (tokb + t) * 2048 + hd * 128;
    const int kl_off = l31 * KSTR128 + hi * 16, vl_off = vb_lane_off(lane);
    u32x4 rk[2], rv[2];
    unsigned ocm[2], omn[2], lkb[2], lvb[2];
#pragma unroll
    for (int i = 0; i < 2; ++i) {
        const int q = tid + NTHREADS * i, row = q >> 4, c = q & 15;
        ocm[i] = (unsigned)(row * 256 + c * 8) * 2u; omn[i] = (unsigned)(row * NSA_IN + c * 8) * 2u;
        lkb[i] = (unsigned)(row * KSTR128 + c * 16); lvb[i] = (unsigned)(row * VSTR + c * 16);
    }
    auto gloadK = [&](const bf16_t* kbase, bool cmp) {
#pragma unroll
        for (int i = 0; i < 2; ++i) rk[i] = *(const u32x4*)((const unsigned char*)kbase + (cmp ? ocm[i] : omn[i]));
    };
    auto gloadV = [&](const bf16_t* vbase, bool cmp) {
#pragma unroll
        for (int i = 0; i < 2; ++i) rv[i] = *(const u32x4*)((const unsigned char*)vbase + (cmp ? ocm[i] : omn[i]));
    };
    auto lstoreK = [&](int buf) {
        unsigned char* kb = lds + ATT_KOFF + buf * ATT_K_BYTES;
#pragma unroll
        for (int i = 0; i < 2; ++i) *(u32x4*)(kb + lkb[i]) = rk[i];
    };
    auto lstoreV = [&](int buf) {
        unsigned char* vb = lds + ATT_VOFF + buf * ATT_V_BYTES;
#pragma unroll
        for (int i = 0; i < 2; ++i) *(u32x4*)(vb + lvb[i]) = rv[i];
    };
    f32x16 o[4];
    auto zero_o = [&]() {
#pragma unroll
        for (int dt = 0; dt < 4; ++dt)
#pragma unroll
            for (int r = 0; r < 16; ++r) o[dt][r] = 0.f;
    };

    for (int i = tid; i < 32 * 128; i += NTHREADS) IMP[i] = 0;
    const int nct = (tt >> 5) + 1;
    const int nv = (t >= 31) ? ((t - 31) >> 4) : -1;
    const bf16_t* kc0 = KCC + ((size_t)(b * NCMP_PAD) * 2 + g) * 128;
    const bf16_t* vc0 = VCC + ((size_t)(b * NCMP_PAD) * 2 + g) * 128;
    float m = -1e30f, l = 0.f;
    gloadK(kc0, true); lstoreK(0); __syncthreads();
    for (int ct = 0; ct < nct; ++ct) {
        if (ct + 1 < nct) gloadK(kc0 + (size_t)(ct + 1) * 64 * 256, true);
        {
            f32x16 p0, p1;
            qk_tile<8, KSTR128>(p0, p1, lds + ATT_KOFF + (ct & 1) * ATT_K_BYTES + kl_off, qr);
            const int dq = nv - ct * 64 - 4 * hi;
            float mx = -__builtin_inff();
#pragma unroll
            for (int r = 0; r < 16; ++r) {
                const int cb = (r & 3) + 8 * (r >> 2);
                p0[r] = (cb <= dq) ? p0[r] : -__builtin_inff();
                p1[r] = (cb + 32 <= dq) ? p1[r] : -__builtin_inff();
                mx = fmaxf(mx, fmaxf(p0[r], p1[r]));
            }
            mx = fmaxf(mx, __shfl_xor(mx, 32));
            const float mn = fmaxf(m, mx);
            const float alpha = __builtin_amdgcn_exp2f((m - mn) * c2);
            const float mc = mn * c2;
            float rs = 0.f;
#pragma unroll
            for (int r = 0; r < 16; ++r) rs += __builtin_amdgcn_exp2f(p0[r] * c2 - mc) + __builtin_amdgcn_exp2f(p1[r] * c2 - mc);
            rs += __shfl_xor(rs, 32);
            l = l * alpha + rs; m = mn;
        }
        if (ct + 1 < nct) lstoreK((ct + 1) & 1);
        __syncthreads();
    }
    const float inv_l = (l > 0.f) ? 1.f / l : 0.f;
    const float mcF = m * c2;
    zero_o();
    gloadK(kc0, true); gloadV(vc0, true); lstoreK(0); lstoreV(0); __syncthreads();
    for (int ct = 0; ct < nct; ++ct) {
        if (ct + 1 < nct) { gloadK(kc0 + (size_t)(ct + 1) * 64 * 256, true); gloadV(vc0 + (size_t)(ct + 1) * 64 * 256, true); }
        {
            f32x16 p0, p1;
            qk_tile<8, KSTR128>(p0, p1, lds + ATT_KOFF + (ct & 1) * ATT_K_BYTES + kl_off, qr);
            const int dq = nv - ct * 64 - 4 * hi;
#pragma unroll
            for (int r = 0; r < 16; ++r) {
                const int cb = (r & 3) + 8 * (r >> 2);
                p0[r] = (cb <= dq) ? __builtin_amdgcn_exp2f(p0[r] * c2 - mcF) * inv_l : 0.f;
                p1[r] = (cb + 32 <= dq) ? __builtin_amdgcn_exp2f(p1[r] * c2 - mcF) * inv_l : 0.f;
            }
#pragma unroll
            for (int g4 = 0; g4 < 4; ++g4) {
                {
                    const int j = 16 * ct + 2 * g4 + hi;
                    const float mainv = 32.f * (p0[4 * g4] + p0[4 * g4 + 1] + p0[4 * g4 + 2]) + 16.f * p0[4 * g4 + 3];
                    const float spill = 16.f * p0[4 * g4 + 3];
                    atomicAdd(&IMP[l31 * 128 + j], (int)(mainv * 1048576.f + 0.5f));
                    if (j + 1 < 128) atomicAdd(&IMP[l31 * 128 + j + 1], (int)(spill * 1048576.f + 0.5f));
                }
                {
                    const int j = 16 * ct + 8 + 2 * g4 + hi;
                    const float mainv = 32.f * (p1[4 * g4] + p1[4 * g4 + 1] + p1[4 * g4 + 2]) + 16.f * p1[4 * g4 + 3];
                    const float spill = 16.f * p1[4 * g4 + 3];
                    atomicAdd(&IMP[l31 * 128 + j], (int)(mainv * 1048576.f + 0.5f));
                    if (j + 1 < 128) atomicAdd(&IMP[l31 * 128 + j + 1], (int)(spill * 1048576.f + 0.5f));
                }
            }
            bf16x8 pb[4] = {pack8f(p0, 0), pack8f(p0, 8), pack8f(p1, 0), pack8f(p1, 8)};
            pv_tile(o, lds + ATT_VOFF + (ct & 1) * ATT_V_BYTES + vl_off, pb);
        }
        if (ct + 1 < nct) { lstoreK((ct + 1) & 1); lstoreV((ct + 1) & 1); }
        __syncthreads();
    }
    nsa_emit<0>(o, gt[0] * ABL_NC, acc_row, o_row, hi);

#pragma unroll 1
    for (int q = 0; q < 4; ++q) {
        const int ti = wave * 4 + q, tq = t0 + ti, cur = tq >> 6;
        int keyv[2];
#pragma unroll
        for (int half = 0; half < 2; ++half) {
            const int j = lane + 64 * half;
            const bool forced = (j == 0) || (j == cur) || (j == cur - 1);
            keyv[half] = forced ? 0x7FFFFFFF : ((j <= cur) ? IMP[ti * 128 + j] : -1);
            KEYS[j] = keyv[half];
        }
        __builtin_amdgcn_s_waitcnt(0xc07f);
        int rk0 = 0, rk1 = 0;
#pragma unroll 8
        for (int i = 0; i < 128; ++i) {
            const int ki = KEYS[i];
            rk0 += (ki > keyv[0] || (ki == keyv[0] && i < lane)) ? 1 : 0;
            rk1 += (ki > keyv[1] || (ki == keyv[1] && i < lane + 64)) ? 1 : 0;
        }
        const unsigned long long s0 = __ballot(keyv[0] >= 0 && rk0 < 16);
        const unsigned long long s1 = __ballot(keyv[1] >= 0 && rk1 < 16);
        if (lane == 0) { SELM[ti * 4 + 0] = (unsigned)s0; SELM[ti * 4 + 1] = (unsigned)(s0 >> 32); SELM[ti * 4 + 2] = (unsigned)s1; SELM[ti * 4 + 3] = (unsigned)(s1 >> 32); }
    }
    __syncthreads();
    unsigned msk[4], uni[4];
#pragma unroll
    for (int w4 = 0; w4 < 4; ++w4) {
        msk[w4] = SELM[l31 * 4 + w4];
        unsigned x = msk[w4];
#pragma unroll
        for (int off = 16; off >= 1; off >>= 1) x |= (unsigned)__shfl_xor((int)x, off);
        uni[w4] = (unsigned)__builtin_amdgcn_readfirstlane((int)x);
    }
    const unsigned long long ulo = ((unsigned long long)uni[1] << 32) | uni[0], uhi = ((unsigned long long)uni[3] << 32) | uni[2];

    const bf16_t* ks0 = NS + tokb * NSA_IN + 2560 + g * 128;
    const bf16_t* vs0 = NS + tokb * NSA_IN + 2816 + g * 128;
    zero_o(); m = -1e30f; l = 0.f;
    {
        int j = next_bit128(ulo, uhi, 0), it = 0;
        if (j < 128) { gloadK(ks0 + (size_t)j * 64 * NSA_IN, false); gloadV(vs0 + (size_t)j * 64 * NSA_IN, false); lstoreK(0); lstoreV(0); }
        __syncthreads();
        while (j < 128) {
            const int jn = next_bit128(ulo, uhi, j + 1);
            if (jn < 128) { gloadK(ks0 + (size_t)jn * 64 * NSA_IN, false); gloadV(vs0 + (size_t)jn * 64 * NSA_IN, false); }
            {
                f32x16 p0, p1;
                qk_tile<8, KSTR128>(p0, p1, lds + ATT_KOFF + (it & 1) * ATT_K_BYTES + kl_off, qr);
                const bool sel = (msk[j >> 5] >> (j & 31)) & 1u;
                const int dq = sel ? (t - j * 64 - 4 * hi) : -1000;
#pragma unroll
                for (int r = 0; r < 16; ++r) {
                    const int cb = (r & 3) + 8 * (r >> 2);
                    p0[r] = (cb <= dq) ? p0[r] : -__builtin_inff();
                    p1[r] = (cb + 32 <= dq) ? p1[r] : -__builtin_inff();
                }
                bf16x8 pb[4];
                softmax_step(p0, p1, m, l, o, c2, pb);
                pv_tile(o, lds + ATT_VOFF + (it & 1) * ATT_V_BYTES + vl_off, pb);
            }
            if (jn < 128) { lstoreK((it + 1) & 1); lstoreV((it + 1) & 1); }
            __syncthreads();
            j = jn; ++it;
        }
    }
    nsa_emit<1>(o, (l > 0.f) ? ABL_NS * gt[1] / l : 0.f, acc_row, o_row, hi);

    const bf16_t* kw0 = NS + tokb * NSA_IN + 3072 + g * 128;
    const bf16_t* vw0 = NS + tokb * NSA_IN + 3328 + g * 128;
    zero_o(); m = -1e30f; l = 0.f;
    {
        const int kt_lo = (t0 >= 511) ? ((t0 - 511) >> 6) : 0, kt_hi = t0 >> 6;
        gloadK(kw0 + (size_t)kt_lo * 64 * NSA_IN, false); gloadV(vw0 + (size_t)kt_lo * 64 * NSA_IN, false); lstoreK(0); lstoreV(0);
        __syncthreads();
        int it = 0;
        for (int kt = kt_lo; kt <= kt_hi; ++kt, ++it) {
            if (kt < kt_hi) { gloadK(kw0 + (size_t)(kt + 1) * 64 * NSA_IN, false); gloadV(vw0 + (size_t)(kt + 1) * 64 * NSA_IN, false); }
            {
                f32x16 p0, p1;
                qk_tile<8, KSTR128>(p0, p1, lds + ATT_KOFF + (it & 1) * ATT_K_BYTES + kl_off, qr);
                const int dq = t - kt * 64 - 4 * hi;
#pragma unroll
                for (int r = 0; r < 16; ++r) {
                    const int cb = (r & 3) + 8 * (r >> 2);
                    p0[r] = ((unsigned)(dq - cb) < 512u) ? p0[r] : -__builtin_inff();
                    p1[r] = ((unsigned)(dq - cb - 32) < 512u) ? p1[r] : -__builtin_inff();
                }
                bf16x8 pb[4];
                softmax_step(p0, p1, m, l, o, c2, pb);
                pv_tile(o, lds + ATT_VOFF + (it & 1) * ATT_V_BYTES + vl_off, pb);
            }
            if (kt < kt_hi) { lstoreK((it + 1) & 1); lstoreV((it + 1) & 1); }
            __syncthreads();
        }
    }
    nsa_emit<2>(o, (l > 0.f) ? ABL_NW * gt[2] / l : 0.f, acc_row, o_row, hi);
}

__device__ __forceinline__ void phase_nsa(const Args& A, unsigned char* lds, int bid, int nb) {
    for (int u = bid; u < 1024; u += nb) {
        const int tt = 255 - (u >> 2), bg = u & 3;
        nsa_item(A, lds, bg >> 1, bg & 1, tt);
    }
}
constexpr int N_PHASES = 20;
#ifndef ABL_M0
#define ABL_M0 1.f
#endif
#ifndef ABL_M1
#define ABL_M1 1.f
#endif
#ifndef ABL_P0
#define ABL_P0 1.f
#endif
#ifndef ABL_P1
#define ABL_P1 1.f
#endif
__global__ void __launch_bounds__(NTHREADS, 2) fwd_kernel(Args a) {
    extern __shared__ __attribute__((aligned(16))) unsigned char lds[];
    const int bid = blockIdx.x, nb = gridDim.x;
    const bool multi = (a.ph_hi - a.ph_lo) > 1;
    XcdBarrier bar; bar.bar = (unsigned*)(a.ws + WS_CTL); bar.x = 0; bar.st = (volatile LAS unsigned*)(lds + LDS_BARW2);
    if (multi) {
        if (threadIdx.x == 0) *(uint4*)(lds + LDS_BARW2) = make_uint4(0u, 0u, 0u, 0u);
        __syncthreads();
        bar = xcd_barrier_post((unsigned*)(a.ws + WS_CTL), (volatile LAS unsigned*)(lds + LDS_BARW2));
    }
#ifdef ONLY
#define IN(k) ((k) == ONLY && a.ph_lo <= (k) && (k) < a.ph_hi)
#else
#define IN(k) (a.ph_lo <= (k) && (k) < a.ph_hi)
#endif
#define SEAM(k) do { if (IN(k) && IN((k) + 1)) xcd_barrier(bar); } while (0)
    unsigned char* ws = WSP(a);
    const float* MOD = (const float*)(ws + WS_MOD);
    bf16_t* H = (bf16_t*)(ws + WS_H); bf16_t* BIG = (bf16_t*)(ws + WS_BIG); bf16_t* Ob = (bf16_t*)(ws + WS_O);
    float* XA = (float*)(ws + WS_XA); float* XB = (float*)(ws + WS_XB);

    if (IN(0)) phase_prologue(a, lds, bid, nb);
    SEAM(0);
    if (IN(1)) phase_modnorm(a, a.in[0], a.in[3], 0, bid, nb);
    SEAM(1);
    if (IN(2)) gemm_phase(lds, ALoadPlain{H, 2048}, (const bf16_t*)(ws + WS_WIN0), 2048, T, SBMLA_IN_PAD, 2048, EpiBf16{BIG, SBMLA_IN, SBMLA_IN}, bid, nb);
    SEAM(2);
    if (IN(3)) phase_mla_prep(a, bid, nb);
    SEAM(3);
    if (IN(4)) {
        gemm_phase(lds, ALoadPlain{(const bf16_t*)(ws + WS_CQN), 512}, (const bf16_t*)(ws + WS_WUQ), 512, T, 1536, 512, EpiMlaQ{(bf16_t*)(ws + WS_QM), (const f32x2*)(ws + WS_ROPE64)}, bid, nb);
        gemm_phase(lds, ALoadPlain{(const bf16_t*)(ws + WS_CKVN), 256}, (const bf16_t*)(ws + WS_WUKV), 256, T, 2048, 256, EpiBf16{(bf16_t*)(ws + WS_KVM), KVM_LD, 2048}, bid, nb);
    }
    SEAM(4);
    if (IN(5)) phase_attn0(a, lds, bid, nb);
    SEAM(5);
    if (IN(6)) gemm_phase(lds, ALoadPlain{Ob, 2048}, (const bf16_t*)(ws + WS_WOUT0), 2048, T, 2048, 2048, EpiResid{a.in[0], XA, MOD + 0 * 2 * 6144 + 4096, ABL_M0}, bid, nb);
    SEAM(6);
    if (IN(7)) phase_modnorm(a, XA, a.in[20], 1, bid, nb);
    SEAM(7);
    if (IN(8)) gemm_phase(lds, ALoadPlain{H, 2048}, (const bf16_t*)(ws + WS_WPQ), 2048, T, 2048, 2048, EpiBf16{(bf16_t*)(ws + WS_PQ), 2048, 2048}, bid, nb);
    SEAM(8);
    if (IN(9)) phase_topk(a, lds, 0, bid, nb);
    SEAM(9);
    if (IN(10)) phase_gather<false>(a, 0, XA, XB, 1, a.in[3] + 2048, 2, ABL_P0, bid, nb);
    SEAM(10);
    if (IN(11)) gemm_phase(lds, ALoadPlain{H, 2048}, (const bf16_t*)(ws + WS_WNSAIN), 2048, T, NSA_IN_PAD, 2048, EpiNsaIn{BIG, (const f32x2*)(ws + WS_ROPE32)}, bid, nb);
    SEAM(11);
    if (IN(12)) {
        gemm_phase(lds, ALoadCmp{BIG, NSA_IN, 2048}, (const bf16_t*)(ws + WS_W1K), 4096, 2048, 256, 4096, EpiCmpHid{(bf16_t*)(ws + WS_HID), (const float*)(ws + WS_BIASP)}, bid, nb);
        gemm_phase(lds, ALoadCmp{BIG, NSA_IN, 2304}, (const bf16_t*)(ws + WS_W1V), 4096, 2048, 256, 4096, EpiCmpHid{(bf16_t*)(ws + WS_HID) + 2048 * 256, (const float*)(ws + WS_BIASP) + 32 * 256}, bid, nb);
    }
    SEAM(12);
    if (IN(13)) {
        gemm_phase(lds, ALoadPlain{(const bf16_t*)(ws + WS_HID), 256}, (const bf16_t*)(ws + WS_W2K), 256, 2048, 128, 256, EpiCmpOut{(bf16_t*)(ws + WS_KCC)}, bid, nb);
        gemm_phase(lds, ALoadPlain{(const bf16_t*)(ws + WS_HID) + 2048 * 256, 256}, (const bf16_t*)(ws + WS_W2V), 256, 2048, 128, 256, EpiCmpOut{(bf16_t*)(ws + WS_VCC)}, bid, nb);
    }
    SEAM(13);
    if (IN(14)) phase_nsa(a, lds, bid, nb);
    SEAM(14);
    if (IN(15)) gemm_phase(lds, ALoadPlain{Ob, 2048}, (const bf16_t*)(ws + WS_WNSAOUT), 2048, T, 2048, 2048, EpiResid{XB, XA, MOD + 2 * 2 * 6144 + 4096, ABL_M1}, bid, nb);
    SEAM(15);
    if (IN(16)) phase_modnorm(a, XA, a.in[20] + 2048, 3, bid, nb);
    SEAM(16);
    if (IN(17)) gemm_phase(lds, ALoadPlain{H, 2048}, (const bf16_t*)(ws + WS_WPQ) + (size_t)2048 * 2048, 2048, T, 2048, 2048, EpiBf16{(bf16_t*)(ws + WS_PQ), 2048, 2048}, bid, nb);
    SEAM(17);
    if (IN(18)) phase_topk(a, lds, 1, bid, nb);
    SEAM(18);
    if (IN(19)) phase_gather<true>(a, 1, XA, a.out, 3, a.in[28], 0, ABL_P1, bid, nb);
    if (a.ph_lo == 99) {
        const bf16_t* raw = (const bf16_t*)(ws + (size_t)a.ph_hi * 16384);
        for (size_t i = (size_t)bid * NTHREADS + threadIdx.x; i < (size_t)T * 2048; i += (size_t)nb * NTHREADS) a.out[i] = bf2f(raw[i]);
    }
#undef IN
#undef SEAM
}

#ifndef MK_ONE_LAUNCH
#define MK_ONE_LAUNCH 0
#endif
extern "C" void kernel_launch(void* const* d_in, const int* in_sizes, int n_in, void* d_out, int out_size, void* d_ws, size_t ws_size, hipStream_t stream) {
    static int grid = 0;
    if (grid == 0) {
        if (n_in != 29 || out_size != T * D_MODEL || ws_size < WS_END) { fprintf(stderr, "kernel_launch: unexpected shapes (n_in %d out %d ws %zu need %zu)\n", n_in, out_size, ws_size, (size_t)WS_END); grid = -1; return; }
        int dev = 0, cus = 0, per_cu = 0;
        if (hipGetDevice(&dev) != hipSuccess || hipDeviceGetAttribute(&cus, hipDeviceAttributeMultiprocessorCount, dev) != hipSuccess) { grid = -1; return; }
        if (hipFuncSetAttribute((const void*)fwd_kernel, hipFuncAttributeMaxDynamicSharedMemorySize, LDS_TOTAL) != hipSuccess) { fprintf(stderr, "kernel_launch: hipFuncSetAttribute failed\n"); grid = -1; return; }
        if (hipOccupancyMaxActiveBlocksPerMultiprocessor(&per_cu, (const void*)fwd_kernel, NTHREADS, LDS_TOTAL) != hipSuccess || per_cu < 1) { fprintf(stderr, "kernel_launch: occupancy query says %d\n", per_cu); }
        (void)hipGetLastError();
        grid = cus;
    }
    if (grid < 0) return;
    (void)hipMemsetAsync((char*)d_ws + WS_CTL, 0, 16384, stream);
    Args a{};
    for (int i = 0; i < 29; ++i) a.in[i] = (const float*)d_in[i];
    a.out = (float*)d_out; a.ws = (unsigned char*)d_ws;
#if MK_ONE_LAUNCH
    a.ph_lo = 0; a.ph_hi = N_PHASES;
    hipLaunchKernelGGL(fwd_kernel, dim3(grid), dim3(NTHREADS), LDS_TOTAL, stream, a);
#else
#ifdef DBG_UPTO
    for (int p = 0; p <= DBG_UPTO; ++p) {
        a.ph_lo = p; a.ph_hi = p + 1;
        hipLaunchKernelGGL(fwd_kernel, dim3(grid), dim3(NTHREADS), LDS_TOTAL, stream, a);
    }
    a.ph_lo = 99; a.ph_hi = (int)(DBG_OFF / 16384);
    hipLaunchKernelGGL(fwd_kernel, dim3(grid), dim3(NTHREADS), LDS_TOTAL, stream, a);
#else
    for (int p = 0; p < N_PHASES; ++p) {
        a.ph_lo = p; a.ph_hi = p + 1;
        hipLaunchKernelGGL(fwd_kernel, dim3(grid), dim3(NTHREADS), LDS_TOTAL, stream, a);
#ifdef REPEAT_LIST
        { const int rl[] = REPEAT_LIST; for (int q : rl) if (q == p) hipLaunchKernelGGL(fwd_kernel, dim3(grid), dim3(NTHREADS), LDS_TOTAL, stream, a); }
#endif
    }
#endif
#endif
}
```

```cpp
#define MK_ONE_LAUNCH 1
#include <hip/hip_runtime.h>
#include <stdint.h>
#include <stdio.h>

typedef unsigned short bf16_t;
typedef short bf16x8 __attribute__((ext_vector_type(8)));
typedef short s16x4 __attribute__((ext_vector_type(4)));
typedef float f32x16 __attribute__((ext_vector_type(16)));
typedef float f32x4 __attribute__((ext_vector_type(4)));
typedef float f32x2 __attribute__((ext_vector_type(2)));
typedef unsigned u32x4 __attribute__((ext_vector_type(4)));
typedef unsigned u32x2 __attribute__((ext_vector_type(2)));
typedef __bf16 bf16x2_t __attribute__((ext_vector_type(2)));
#define LAS __attribute__((address_space(3)))

constexpr int D_MODEL = 2048, BATCH = 2, SEQ = 8192, T = BATCH * SEQ;
constexpr float EPS = 1e-6f;
constexpr int SBMLA_IN = 3904, SBMLA_IN_PAD = 4096;
constexpr int NSA_IN = 3632, NSA_IN_PAD = 3840;
constexpr int NCMP = 511, NCMP_PAD = 512;
constexpr int NTHREADS = 512, NWAVES = 8;
constexpr int KVM_LD = 2112;

constexpr size_t al256(size_t x) { return (x + 255) & ~(size_t)255; }
constexpr size_t WS_CTL   = 0;
constexpr size_t WS_MOD   = 16384;
constexpr size_t WS_BIASP = WS_MOD + al256((size_t)4 * 2 * 6144 * 4);
constexpr size_t WS_ROPE64 = WS_BIASP + al256((size_t)2 * 32 * 256 * 4);
constexpr size_t WS_ROPE32 = WS_ROPE64 + (size_t)T * 32 * 8;
constexpr size_t WS_WIN0  = WS_ROPE32 + (size_t)T * 16 * 8;
constexpr size_t WS_WUQ   = WS_WIN0 + (size_t)SBMLA_IN_PAD * 2048 * 2;
constexpr size_t WS_WUKV  = WS_WUQ + (size_t)1536 * 512 * 2;
constexpr size_t WS_WOUT0 = WS_WUKV + (size_t)2048 * 256 * 2;
constexpr size_t WS_WNSAIN = WS_WOUT0 + (size_t)2048 * 2048 * 2;
constexpr size_t WS_W1K   = WS_WNSAIN + (size_t)NSA_IN_PAD * 2048 * 2;
constexpr size_t WS_W1V   = WS_W1K + (size_t)256 * 4096 * 2;
constexpr size_t WS_W2K   = WS_W1V + (size_t)256 * 4096 * 2;
constexpr size_t WS_W2V   = WS_W2K + (size_t)128 * 256 * 2;
constexpr size_t WS_WNSAOUT = WS_W2V + (size_t)128 * 256 * 2;
constexpr size_t WS_WPQ   = WS_WNSAOUT + (size_t)2048 * 2048 * 2;
constexpr size_t WS_K12   = WS_WPQ + (size_t)2 * 2048 * 2048 * 2;
constexpr size_t WS_PU    = WS_K12 + (size_t)4 * 128 * 128 * 2;
constexpr size_t WS_PV    = WS_PU + (size_t)2 * 16384 * 2048;
constexpr size_t WS_H     = WS_PV + (size_t)2 * 16384 * 2048;
constexpr size_t WS_BIG   = WS_H + (size_t)T * 2048 * 2;
constexpr size_t WS_O     = WS_BIG + (size_t)T * SBMLA_IN * 2;
constexpr size_t WS_XA    = WS_O + (size_t)T * 2048 * 2;
constexpr size_t WS_XB    = WS_XA + (size_t)T * 2048 * 4;
constexpr size_t WS_CQN   = WS_XA;
constexpr size_t WS_CKVN  = WS_CQN + (size_t)T * 512 * 2;
constexpr size_t WS_OACC  = WS_XA;
constexpr size_t WS_QM    = WS_XB;
constexpr size_t WS_KVM   = WS_QM + (size_t)T * 1536 * 2;
constexpr size_t WS_PQ    = WS_XB;
static_assert((size_t)T * 1536 * 2 + (size_t)T * KVM_LD * 2 <= (size_t)T * 2048 * 4, "QM + KVM must fit the XB region");
constexpr size_t WS_EXI   = WS_XB + (size_t)T * 2048 * 4;
constexpr size_t WS_EXG   = WS_EXI + (size_t)T * 128 * 4;
constexpr size_t WS_HID   = WS_EXG + (size_t)T * 128 * 4;
constexpr size_t WS_KCC   = WS_HID + (size_t)2 * 2048 * 256 * 2;
constexpr size_t WS_VCC   = WS_KCC + (size_t)BATCH * NCMP_PAD * 2 * 128 * 2;
constexpr size_t WS_END   = WS_VCC + (size_t)BATCH * NCMP_PAD * 2 * 128 * 2;

struct Args {
    const float* in[29];
    float* out;
    unsigned char* ws;
    int ph_lo, ph_hi;
};

__device__ __forceinline__ unsigned cvtpk(float lo, float hi) {
    bf16x2_t v = {(__bf16)lo, (__bf16)hi};
    return __builtin_bit_cast(unsigned, v);
}
__device__ __forceinline__ float bf2f(unsigned short h) { return __uint_as_float(((unsigned)h) << 16); }
__device__ __forceinline__ float bflo(unsigned w) { return __uint_as_float(w << 16); }
__device__ __forceinline__ float bfhi(unsigned w) { return __uint_as_float(w & 0xFFFF0000u); }
__device__ __forceinline__ int crow(int r, int hi) { return (r & 3) + 8 * (r >> 2) + 4 * hi; }
__device__ __forceinline__ float wave_sum(float v) {
#pragma unroll
    for (int o = 32; o >= 1; o >>= 1) v += __shfl_xor(v, o);
    return v;
}
__device__ __forceinline__ float gelu_tanh(float x) {
    const float u = 0.7978845608028654f * (x + 0.044715f * x * x * x);
    const float e = __expf(2.f * u);
    const float th = 1.f - 2.f / (e + 1.f);
    return 0.5f * x * (1.f + th);
}
__device__ __forceinline__ int opaque_tid() { int t = threadIdx.x; asm volatile("" : "+v"(t)); return t; }
__device__ __forceinline__ unsigned char* WSP(const Args& A) {
    unsigned lo = (unsigned)(uintptr_t)A.ws, hi = (unsigned)((uintptr_t)A.ws >> 32);
    asm volatile("" : "+v"(lo), "+v"(hi));
    lo = (unsigned)__builtin_amdgcn_readfirstlane((int)lo); hi = (unsigned)__builtin_amdgcn_readfirstlane((int)hi);
    return (unsigned char*)(((uintptr_t)hi << 32) | lo);
}
#ifndef ABL_SB
#define ABL_SB 1.f
#endif
#ifndef ABL_MLA
#define ABL_MLA 1.f
#endif
#ifndef ABL_NC
#define ABL_NC 1.f
#endif
#ifndef ABL_NS
#define ABL_NS 1.f
#endif
#ifndef ABL_NW
#define ABL_NW 1.f
#endif
#define XB_TMO      128
#define XB_XCNT(j)  (256  + 64 * (j))
#define XB_XSUB(j)  (1280 + 64 * (j))
#define XB_XGEN(j)  (2304 + 64 * (j))
#define XB_TOP      3328
#define XB_TOPGEN   3392
#define XCD_BAR_WORDS 3456
#define XB_SPIN_CAP (1u << 18)
#define LAS __attribute__((address_space(3)))

__device__ __forceinline__ unsigned xb_ld(unsigned* p)              { return __hip_atomic_load(p, __ATOMIC_RELAXED, __HIP_MEMORY_SCOPE_AGENT); }
__device__ __forceinline__ unsigned xb_add(unsigned* p, unsigned v) { return __hip_atomic_fetch_add(p, v, __ATOMIC_RELAXED, __HIP_MEMORY_SCOPE_AGENT); }
__device__ __forceinline__ unsigned xb_xcc_id() { return (unsigned)__builtin_amdgcn_s_getreg((3 << 11) | 20) & 0xFu; }
#define XB_SPIN(cond, bar) do { unsigned _sp = 0; while (cond) { __builtin_amdgcn_s_sleep(1); \
    if ((++_sp & 255u) == 0u) { if (xb_ld(&(bar)[XB_TMO])) break; if (_sp > XB_SPIN_CAP) { atomicAdd(&(bar)[XB_TMO], 1u); break; } } } } while (0)

struct XcdBarrier {
    unsigned* bar; unsigned x;
    volatile LAS unsigned* st;
};

__device__ __forceinline__ XcdBarrier xcd_barrier_post(unsigned* bar, volatile LAS unsigned* st) {
    XcdBarrier b; b.bar = bar; b.x = xb_xcc_id(); b.st = st;
    if (threadIdx.x == 0) (void)xb_add(&bar[XB_XCNT(b.x)], 1u);
    return b;
}
__device__ __forceinline__ void xcd_barrier_complete(unsigned* bar, unsigned x, unsigned& nloc, unsigned& nx) {
    const unsigned G = gridDim.x * gridDim.y * gridDim.z;
    unsigned sum, cnt, mine, sp = 0u;
    for (;;) {
        sum = 0u; cnt = 0u; mine = 0u;
#pragma unroll
        for (unsigned j = 0; j < 16; ++j) { const unsigned c = xb_ld(&bar[XB_XCNT(j)]); sum += c; cnt += (c > 0u) ? 1u : 0u; mine = (j == x) ? c : mine; }
        if (sum == G) break;
        __builtin_amdgcn_s_sleep(1);
        if ((++sp & 255u) == 0u) { if (xb_ld(&bar[XB_TMO])) break; if (sp > XB_SPIN_CAP) { atomicAdd(&bar[XB_TMO], 1u); break; } }
    }
    nloc = mine > 0u ? mine : 1u; nx = cnt > 0u ? cnt : 1u;
}

__device__ __forceinline__ void xcd_barrier(const XcdBarrier& b) {
    asm volatile("s_waitcnt vmcnt(0)" ::: "memory");
    __syncthreads();
    if (threadIdx.x == 0) {
        unsigned* bar = b.bar;
        __builtin_amdgcn_s_waitcnt(0);
        unsigned nloc = b.st[0], nx = b.st[1];
        if (nloc == 0u) { xcd_barrier_complete(bar, b.x, nloc, nx); b.st[0] = nloc; b.st[1] = nx; }
        const unsigned old = xb_add(&bar[XB_XSUB(b.x)], 1u);
        const unsigned gen = old / nloc;
        if (old + 1u == (gen + 1u) * nloc) {
            __builtin_amdgcn_fence(__ATOMIC_RELEASE, "agent");
            asm volatile("s_waitcnt vmcnt(0)" ::: "memory");
            const unsigned og = xb_add(&bar[XB_TOP], 1u);
            const unsigned tg = og / nx;
            if (og + 1u == (tg + 1u) * nx) xb_add(&bar[XB_TOPGEN], 1u);
            else XB_SPIN(xb_ld(&bar[XB_TOPGEN]) == tg, bar);
            __builtin_amdgcn_fence(__ATOMIC_ACQUIRE, "agent");
            xb_add(&bar[XB_XGEN(b.x)], 1u);
            asm volatile("s_waitcnt vmcnt(0)" ::: "memory");
        } else {
            XB_SPIN(xb_ld(&bar[XB_XGEN(b.x)]) == gen, bar);
            __builtin_amdgcn_fence(__ATOMIC_ACQUIRE, "agent");
            asm volatile("s_waitcnt vmcnt(0)" ::: "memory");
        }
    }
    __syncthreads();
}
constexpr int U0_MOD = 192, U0_TR = 8912, U0_PEER = 2048, U0_ROPE = 192, U0_BIAS = 64, U0_K12 = 8, U0_ZERO = 8;
constexpr int U0_TOTAL = U0_MOD + U0_TR + U0_PEER + U0_ROPE + U0_BIAS + U0_K12 + U0_ZERO;

struct TrDesc { int in_idx; size_t in_off; int K, N, Npad; size_t ws_off; int ntiles; };
__device__ __forceinline__ TrDesc tr_desc(int m) {
    switch (m) {
        case 0:  return TrDesc{6, 0, 2048, 3904, 4096, WS_WIN0, 2048};
        case 1:  return TrDesc{8, 0, 512, 1536, 1536, WS_WUQ, 192};
        case 2:  return TrDesc{10, 0, 256, 2048, 2048, WS_WUKV, 128};
        case 3:  return TrDesc{11, 0, 2048, 2048, 2048, WS_WOUT0, 1024};
        case 4:  return TrDesc{12, 0, 2048, 3632, 3840, WS_WNSAIN, 1920};
        case 5:  return TrDesc{15, 0, 4096, 256, 256, WS_W1K, 256};
        case 6:  return TrDesc{17, 0, 4096, 256, 256, WS_W1V, 256};
        case 7:  return TrDesc{16, 0, 256, 128, 128, WS_W2K, 8};
        case 8:  return TrDesc{18, 0, 256, 128, 128, WS_W2V, 8};
        case 9:  return TrDesc{19, 0, 2048, 2048, 2048, WS_WNSAOUT, 1024};
        case 10: return TrDesc{23, 0, 2048, 2048, 2048, WS_WPQ, 1024};
        default: return TrDesc{23, (size_t)2048 * 2048, 2048, 2048, 2048, WS_WPQ + (size_t)2048 * 2048 * 2, 1024};
    }
}

__device__ __forceinline__ void p0_mod_unit(const Args& A, unsigned char* lds, int u) {
    const int tid = opaque_tid();
    float* sc = (float*)lds;
    float* red = (float*)(lds + 16384);
    const int set = u / 48, cc = u % 48;
    const int layer = set >> 1, kind = set & 1;
    const float* w = (kind ? A.in[21] : A.in[4]) + (size_t)layer * 2048 * 6144;
    const float* bias = (kind ? A.in[22] : A.in[5]) + (size_t)layer * 6144;
    const float* c = A.in[1];
    for (int i = tid; i < 4096; i += NTHREADS) { const float v = c[i]; sc[i] = v / (1.f + __expf(-v)); }
    __syncthreads();
    const int l32 = tid & 31, kg = tid >> 5;
    const int col = cc * 128 + l32 * 4;
    float a0[4] = {0, 0, 0, 0}, a1[4] = {0, 0, 0, 0};
    const float* wp = w + (size_t)(kg * 128) * 6144 + col;
#pragma unroll 8
    for (int i = 0; i < 128; ++i) {
        const f32x4 wv = *(const f32x4*)(wp + (size_t)i * 6144);
        const float s0 = sc[kg * 128 + i], s1 = sc[2048 + kg * 128 + i];
#pragma unroll
        for (int j = 0; j < 4; ++j) { a0[j] += s0 * wv[j]; a1[j] += s1 * wv[j]; }
    }
#pragma unroll
    for (int j = 0; j < 4; ++j) { red[(kg * 2 + 0) * 128 + l32 * 4 + j] = a0[j]; red[(kg * 2 + 1) * 128 + l32 * 4 + j] = a1[j]; }
    __syncthreads();
    if (tid < 256) {
        const int b = tid >> 7, cl = tid & 127;
        float s = 0;
#pragma unroll
        for (int g = 0; g < 16; ++g) s += red[(g * 2 + b) * 128 + cl];
        float* mod = (float*)(WSP(A) + WS_MOD);
        mod[(size_t)(set * 2 + b) * 6144 + cc * 128 + cl] = s + bias[cc * 128 + cl];
    }
    __syncthreads();
}

__device__ __forceinline__ void p0_tr_unit(const Args& A, unsigned char* lds, int u) {
    const int tid = opaque_tid();
    int m = 0, tile = u;
    TrDesc d = tr_desc(0);
    while (tile >= d.ntiles) { tile -= d.ntiles; ++m; d = tr_desc(m); }
    const int nNt = d.Npad / 64;
    const int kt = tile / nNt, nt = tile % nNt;
    const float* src = A.in[d.in_idx] + d.in_off;
    bf16_t* dst = (bf16_t*)(WSP(A) + d.ws_off);
    float* ts = (float*)lds;
    {
        const int r = tid >> 3, cg = tid & 7;
        const int k = kt * 64 + r, n = nt * 64 + cg * 8;
        f32x4 v0 = {0, 0, 0, 0}, v1 = {0, 0, 0, 0};
        if (n < d.N) { const float* p = src + (size_t)k * d.N + n; v0 = *(const f32x4*)p; v1 = *(const f32x4*)(p + 4); }
#pragma unroll
        for (int j = 0; j < 4; ++j) { ts[r * 65 + cg * 8 + j] = v0[j]; ts[r * 65 + cg * 8 + 4 + j] = v1[j]; }
    }
    __syncthreads();
    {
        const int n = tid >> 3, kg = tid & 7;
        float v[8];
#pragma unroll
        for (int j = 0; j < 8; ++j) v[j] = ts[(kg * 8 + j) * 65 + n];
        u32x4 w = {cvtpk(v[0], v[1]), cvtpk(v[2], v[3]), cvtpk(v[4], v[5]), cvtpk(v[6], v[7])};
        *(u32x4*)(dst + (size_t)(nt * 64 + n) * d.K + kt * 64 + kg * 8) = w;
    }
    __syncthreads();
}

constexpr float PEER_USCALE = 64.f, PEER_VSCALE = 4.f;
__device__ __forceinline__ void p0_peer_unit(const Args& A, int u) {
    const int tid = opaque_tid();
    const bool isv = u >= 1024;
    const int pu = isv ? u - 1024 : u;
    const float sc = isv ? PEER_VSCALE : PEER_USCALE;
    const float* src = (isv ? A.in[27] : A.in[26]) + (size_t)pu * 65536;
    unsigned char* dst = WSP(A) + (isv ? WS_PV : WS_PU) + (size_t)pu * 65536;
#pragma unroll 2
    for (int it = 0; it < 8; ++it) {
        const int e = (it * NTHREADS + tid) * 16;
        u32x4 w;
#pragma unroll
        for (int q = 0; q < 4; ++q) {
            const f32x4 v = *(const f32x4*)(src + e + 4 * q);
            int pk = 0;
            pk = __builtin_amdgcn_cvt_pk_fp8_f32(v[0] * sc, v[1] * sc, pk, false);
            pk = __builtin_amdgcn_cvt_pk_fp8_f32(v[2] * sc, v[3] * sc, pk, true);
            w[q] = (unsigned)pk;
        }
        *(u32x4*)(dst + e) = w;
    }
}

__device__ __forceinline__ void p0_rope_unit(const Args& A, int u) {
    const int tid = opaque_tid();
    const int* pos = (const int*)A.in[2];
#pragma unroll 1
    for (int it = 0; it < 8; ++it) {
        const int e = u * 4096 + it * NTHREADS + tid;
        if (e < T * 32) {
            const int t = e >> 5, j = e & 31;
            const float inv = powf(500000.0f, -(float)j / 32.0f);
            const float ang = (float)pos[t] * inv;
            float s, c; sincosf(ang, &s, &c);
            ((f32x2*)(WSP(A) + WS_ROPE64))[e] = f32x2{c, s};
        } else {
            const int e2 = e - T * 32;
            const int t = e2 >> 4, j = e2 & 15;
            const float inv = powf(500000.0f, -(float)j / 16.0f);
            const float ang = (float)pos[t] * inv;
            float s, c; sincosf(ang, &s, &c);
            ((f32x2*)(WSP(A) + WS_ROPE32))[e2] = f32x2{c, s};
        }
    }
}

__device__ __forceinline__ void p0_bias_unit(const Args& A, unsigned char* lds, int u) {
    const int tid = opaque_tid();
    const int mat = u >> 5, chunk = u & 31;
    const float* pe = A.in[mat ? 14 : 13];
    const float* w1 = A.in[mat ? 17 : 15];
    const int col = tid & 255, half = tid >> 8;
    float acc = 0;
    const int r0 = chunk * 128 + half * 64;
#pragma unroll 8
    for (int i = 0; i < 64; ++i) acc += pe[r0 + i] * w1[(size_t)(r0 + i) * 256 + col];
    float* red = (float*)lds;
    if (half) red[col] = acc;
    __syncthreads();
    if (!half) ((float*)(WSP(A) + WS_BIASP))[(mat * 32 + chunk) * 256 + col] = acc + red[col];
    __syncthreads();
}

__device__ __forceinline__ void p0_k12_unit(const Args& A, int u) {
    const int tid = opaque_tid();
    bf16_t* dst = (bf16_t*)(WSP(A) + WS_K12);
#pragma unroll
    for (int it = 0; it < 2; ++it) {
        const int e = u * 8192 + (it * NTHREADS + tid) * 8;
        const int layer = e >> 15, which = (e >> 14) & 1, rem = e & 16383;
        const float* src = A.in[which ? 25 : 24] + layer * 16384 + rem;
        const f32x4 v0 = *(const f32x4*)src, v1 = *(const f32x4*)(src + 4);
        u32x4 w = {cvtpk(v0[0], v0[1]), cvtpk(v0[2], v0[3]), cvtpk(v1[0], v1[1]), cvtpk(v1[2], v1[3])};
        *(u32x4*)(dst + e) = w;
    }
}

__device__ __forceinline__ void phase_prologue(const Args& A, unsigned char* lds, int bid, int nb) {
    for (int u = bid; u < U0_TOTAL; u += nb) {
        int v = u;
        if (v < U0_MOD) { p0_mod_unit(A, lds, v); continue; }
        v -= U0_MOD;
        if (v < U0_TR) { p0_tr_unit(A, lds, v); continue; }
        v -= U0_TR;
        if (v < U0_PEER) { p0_peer_unit(A, v); continue; }
        v -= U0_PEER;
        if (v < U0_ROPE) { p0_rope_unit(A, v); continue; }
        v -= U0_ROPE;
        if (v < U0_BIAS) { p0_bias_unit(A, lds, v); continue; }
        v -= U0_BIAS;
        if (v < U0_K12) { p0_k12_unit(A, v); continue; }
        v -= U0_K12;
        {
            u32x4* z = (u32x4*)(WSP(A) + WS_KCC) + (size_t)v * 8192;
            for (int i = opaque_tid(); i < 8192; i += NTHREADS) z[i] = u32x4{0u, 0u, 0u, 0u};
        }
    }
}

__device__ __forceinline__ void modnorm_row(const float* xr, const float* gain, const float* mod  , bf16_t* hr, int lane) {
    f32x4 v[8];
    float ss = 0;
#pragma unroll
    for (int i = 0; i < 8; ++i) { v[i] = *(const f32x4*)(xr + i * 256 + lane * 4); ss += v[i][0] * v[i][0] + v[i][1] * v[i][1] + v[i][2] * v[i][2] + v[i][3] * v[i][3]; }
    ss = wave_sum(ss);
    const float rinv = rsqrtf(ss * (1.0f / 2048.0f) + EPS);
#pragma unroll
    for (int i = 0; i < 8; ++i) {
        const int col = i * 256 + lane * 4;
        const f32x4 g = *(const f32x4*)(gain + col), sh = *(const f32x4*)(mod + col), scl = *(const f32x4*)(mod + 2048 + col);
        float y[4];
#pragma unroll
        for (int j = 0; j < 4; ++j) y[j] = v[i][j] * rinv * g[j] * (1.f + scl[j]) + sh[j];
        u32x2 w = {cvtpk(y[0], y[1]), cvtpk(y[2], y[3])};
        *(u32x2*)(hr + col) = w;
    }
}
__device__ __forceinline__ void phase_modnorm(const Args& A, const float* xin, const float* gain, int set, int bid, int nb) {
    const int tid = opaque_tid(), lane = tid & 63, wave = tid >> 6;
    const float* mod = (const float*)(WSP(A) + WS_MOD) + (size_t)set * 2 * 6144;
    bf16_t* H = (bf16_t*)(WSP(A) + WS_H);
    for (int u = bid; u < T / NWAVES; u += nb) {
        const int row = u * NWAVES + wave;
        modnorm_row(xin + (size_t)row * 2048, gain, mod + (row >> 13) * 6144, H + (size_t)row * 2048, lane);
    }
}

struct ALoadPlain {
    const bf16_t* A; int lda;
    __device__ __forceinline__ const bf16_t* ptr(int row, int k) const { return A + (size_t)row * lda + k; }
};
struct ALoadCmp {
    const bf16_t* base; int ld; int colbase;
    __device__ __forceinline__ const bf16_t* ptr(int row, int k) const {
        int r = row < 2 * BATCH * NCMP ? row : 2 * BATCH * NCMP - 1;
        const int g = r & 1; r >>= 1;
        const int b = r / NCMP, n = r - b * NCMP;
        const int l = k >> 7, d = k & 127;
        return base + (size_t)(b * SEQ + 16 * n + l) * ld + colbase + g * 128 + d;
    }
};

constexpr int GEMM_LDS = 98304;
template <class AL, class Epi>
__device__ __forceinline__ void gemm_phase(unsigned char* lds, const AL al, const bf16_t* __restrict__ Bt, int ldb, int M, int Npad, int K, const Epi epi, int bid, int nb) {
    const int tid = opaque_tid(), lane = tid & 63, wave = tid >> 6, l31 = lane & 31, hi = lane >> 5;
    const int wm = wave >> 1, wn = wave & 1;
    const int nNt = Npad / 128, nU = (M / 256) * nNt, nk = K / 64;
    const int swz = (l31 >> 1) & 7;
    for (int u = bid; u < nU; u += nb) {
        const int mt = u / nNt, nt = u - mt * nNt;
        const int m0 = mt * 256, n0 = nt * 128;
        f32x16 acc[2][2];
#pragma unroll
        for (int i = 0; i < 2; ++i)
#pragma unroll
            for (int j = 0; j < 2; ++j)
#pragma unroll
                for (int r = 0; r < 16; ++r) acc[i][j][r] = 0.f;
        u32x4 ra[4], rb[2];
        auto gload = [&](int kt) {
#pragma unroll
            for (int i = 0; i < 4; ++i) { const int q = tid + NTHREADS * i, row = q >> 3, c = q & 7; ra[i] = *(const u32x4*)al.ptr(m0 + row, kt * 64 + c * 8); }
#pragma unroll
            for (int i = 0; i < 2; ++i) { const int q = tid + NTHREADS * i, row = q >> 3, c = q & 7; rb[i] = *(const u32x4*)(Bt + (size_t)(n0 + row) * ldb + kt * 64 + c * 8); }
        };
        auto lstore = [&](int buf) {
            unsigned char* la = lds + buf * 32768; unsigned char* lb = lds + 65536 + buf * 16384;
#pragma unroll
            for (int i = 0; i < 4; ++i) { const int q = tid + NTHREADS * i, row = q >> 3, c = q & 7; *(u32x4*)(la + row * 128 + ((c ^ ((row >> 1) & 7)) << 4)) = ra[i]; }
#pragma unroll
            for (int i = 0; i < 2; ++i) { const int q = tid + NTHREADS * i, row = q >> 3, c = q & 7; *(u32x4*)(lb + row * 128 + ((c ^ ((row >> 1) & 7)) << 4)) = rb[i]; }
        };
        gload(0); lstore(0); __syncthreads();
        for (int kt = 0; kt < nk; ++kt) {
            if (kt + 1 < nk) gload(kt + 1);
            const unsigned char* la = lds + (kt & 1) * 32768 + (wm * 64 + l31) * 128;
            const unsigned char* lb = lds + 65536 + (kt & 1) * 16384 + (wn * 64 + l31) * 128;
#pragma unroll
            for (int ks = 0; ks < 4; ++ks) {
                const int co = ((ks * 2 + hi) ^ swz) << 4;
                const bf16x8 a0 = *(const bf16x8*)(la + co), a1 = *(const bf16x8*)(la + 32 * 128 + co);
                const bf16x8 b0 = *(const bf16x8*)(lb + co), b1 = *(const bf16x8*)(lb + 32 * 128 + co);
                acc[0][0] = __builtin_amdgcn_mfma_f32_32x32x16_bf16(a0, b0, acc[0][0], 0, 0, 0);
                acc[0][1] = __builtin_amdgcn_mfma_f32_32x32x16_bf16(a0, b1, acc[0][1], 0, 0, 0);
                acc[1][0] = __builtin_amdgcn_mfma_f32_32x32x16_bf16(a1, b0, acc[1][0], 0, 0, 0);
                acc[1][1] = __builtin_amdgcn_mfma_f32_32x32x16_bf16(a1, b1, acc[1][1], 0, 0, 0);
            }
            if (kt + 1 < nk) lstore((kt + 1) & 1);
            __syncthreads();
        }
        epi.template operator()<2>(acc, m0 + wm * 64, n0 + wn * 64, lane);
    }
}

constexpr int GEMM256_LDS = 131072;
template <class Epi>
__device__ __forceinline__ void gemm256_phase(unsigned char* lds, const bf16_t* __restrict__ Ag, int lda, const bf16_t* __restrict__ Bt, int ldb, int M, int Npad, int K, const Epi epi, int bid, int nb) {
    const int tid = opaque_tid(), lane = tid & 63, wave = __builtin_amdgcn_readfirstlane(tid >> 6), l31 = lane & 31, hi = lane >> 5;
    const int wm = wave >> 2, wn = wave & 3;
    const int nNt = Npad / 256, nU = (M / 256) * nNt, nk = K / 64;
    const int swz = (l31 >> 1) & 7;
    unsigned aoff[4], boff[4];
#pragma unroll
    for (int i = 0; i < 4; ++i) {
        const int row = (wave * 4 + i) * 8 + (lane >> 3), c = (lane & 7) ^ ((row >> 1) & 7);
        aoff[i] = (unsigned)(row * lda + c * 8) * 2u; boff[i] = (unsigned)(row * ldb + c * 8) * 2u;
    }
    const int vcu = (nb % 8 == 0) ? (bid % 8) * (nb / 8) + bid / 8 : bid;
    for (int u = vcu; u < nU; u += nb) {
        const int mt = u / nNt, nt = u - mt * nNt;
        const int m0 = mt * 256, n0 = nt * 256;
        const unsigned char* abase = (const unsigned char*)(Ag + (size_t)m0 * lda);
        const unsigned char* bbase = (const unsigned char*)(Bt + (size_t)n0 * ldb);
        f32x16 acc[4][2];
#pragma unroll
        for (int i = 0; i < 4; ++i)
#pragma unroll
            for (int j = 0; j < 2; ++j)
#pragma unroll
                for (int r = 0; r < 16; ++r) acc[i][j][r] = 0.f;
        auto issue = [&](int kt, int stage) {
            unsigned char* la = lds + stage * 65536 + wave * 4096; unsigned char* lb = la + 32768;
#pragma unroll
            for (int i = 0; i < 4; ++i) {
                __builtin_amdgcn_global_load_lds((const unsigned*)(abase + aoff[i] + kt * 128), (unsigned*)(la + i * 1024), 16, 0, 0);
                __builtin_amdgcn_global_load_lds((const unsigned*)(bbase + boff[i] + kt * 128), (unsigned*)(lb + i * 1024), 16, 0, 0);
            }
        };
        issue(0, 0);
        asm volatile("s_waitcnt vmcnt(0)" ::: "memory");
        __syncthreads();
        for (int kt = 0; kt < nk; ++kt) {
            if (kt + 1 < nk) issue(kt + 1, (kt + 1) & 1);
            const unsigned char* la = lds + (kt & 1) * 65536 + (wm * 128 + l31) * 128;
            const unsigned char* lb = lds + (kt & 1) * 65536 + 32768 + (wn * 64 + l31) * 128;
#pragma unroll
            for (int ks = 0; ks < 4; ++ks) {
                const int co = ((ks * 2 + hi) ^ swz) << 4;
                const bf16x8 b0 = *(const bf16x8*)(lb + co), b1 = *(const bf16x8*)(lb + 32 * 128 + co);
#pragma unroll
                for (int mi = 0; mi < 4; ++mi) {
                    const bf16x8 a = *(const bf16x8*)(la + mi * 32 * 128 + co);
                    acc[mi][0] = __builtin_amdgcn_mfma_f32_32x32x16_bf16(a, b0, acc[mi][0], 0, 0, 0);
                    acc[mi][1] = __builtin_amdgcn_mfma_f32_32x32x16_bf16(a, b1, acc[mi][1], 0, 0, 0);
                }
            }
            asm volatile("s_waitcnt vmcnt(0)" ::: "memory");
            __syncthreads();
        }
        epi.template operator()<4>(acc, m0 + wm * 128, n0 + wn * 64, lane);
    }
}

template <int MI>
__device__ __forceinline__ void store_bf16_tile(const f32x16 (&acc)[MI][2], bf16_t* C, int ldc, int N, int row0, int col0, int lane) {
    const int l31 = lane & 31, hi = lane >> 5;
#pragma unroll
    for (int ni = 0; ni < 2; ++ni) {
        const int col = col0 + ni * 32 + l31;
#pragma unroll
        for (int mi = 0; mi < MI; ++mi)
#pragma unroll
            for (int r = 0; r < 16; ++r) {
                const float v = acc[mi][ni][r];
                const float vn = __shfl_xor(v, 1);
                if ((l31 & 1) == 0 && col < N) *(unsigned*)(C + (size_t)(row0 + mi * 32 + crow(r, hi)) * ldc + col) = cvtpk(v, vn);
            }
    }
}
struct EpiBf16 {
    bf16_t* C; int ldc; int N;
    template <int MI> __device__ __forceinline__ void operator()(f32x16 (&acc)[MI][2], int row0, int col0, int lane) const { store_bf16_tile<MI>(acc, C, ldc, N, row0, col0, lane); }
};
struct EpiMlaQ {
    bf16_t* C; const f32x2* rope64;
    template <int MI> __device__ __forceinline__ void operator()(f32x16 (&acc)[MI][2], int row0, int col0, int lane) const {
        const int l31 = lane & 31, hi = lane >> 5;
        if ((col0 % 192) == 128) {
#pragma unroll
            for (int mi = 0; mi < MI; ++mi)
#pragma unroll
                for (int r = 0; r < 16; ++r) {
                    const int row = row0 + mi * 32 + crow(r, hi);
                    const f32x2 cs = rope64[(size_t)row * 32 + l31];
                    const float x1 = acc[mi][0][r], x2 = acc[mi][1][r];
                    acc[mi][0][r] = x1 * cs[0] - x2 * cs[1];
                    acc[mi][1][r] = x2 * cs[0] + x1 * cs[1];
                    if ((r & 3) == 3) __builtin_amdgcn_sched_barrier(0);
                }
        }
        store_bf16_tile<MI>(acc, C, 1536, 1536, row0, col0, lane);
    }
};
struct EpiNsaIn {
    bf16_t* C; const f32x2* rope32;
    template <int MI> __device__ __forceinline__ void operator()(f32x16 (&acc)[MI][2], int row0, int col0, int lane) const {
        const int l31 = lane & 31, hi = lane >> 5;
#pragma unroll
        for (int ni = 0; ni < 2; ++ni) {
            const int cb = col0 + ni * 32, hb = cb >> 7;
            const bool is_rope = ((cb & 127) == 0) && (hb < 18 || hb == 20 || hb == 21 || hb == 24 || hb == 25);
            if (is_rope) {
#pragma unroll
                for (int mi = 0; mi < MI; ++mi)
#pragma unroll
                    for (int r = 0; r < 16; ++r) {
                        const int row = row0 + mi * 32 + crow(r, hi);
                        const f32x2 cs = rope32[(size_t)row * 16 + (l31 & 15)];
                        const float own = acc[mi][ni][r];
                        const float oth = __shfl_xor(own, 16);
                        acc[mi][ni][r] = (l31 < 16) ? own * cs[0] - oth * cs[1] : own * cs[0] + oth * cs[1];
                    }
            }
            if (cb >= 3584) {
#pragma unroll
                for (int mi = 0; mi < MI; ++mi)
#pragma unroll
                    for (int r = 0; r < 16; ++r) acc[mi][ni][r] = 1.f / (1.f + __expf(-acc[mi][ni][r]));
            }
        }
        store_bf16_tile<MI>(acc, C, NSA_IN, NSA_IN, row0, col0, lane);
    }
};
struct EpiResid {
    const float* xin; float* xout; const float* gate; float gmul;
    template <int MI> __device__ __forceinline__ void operator()(f32x16 (&acc)[MI][2], int row0, int col0, int lane) const {
        const int l31 = lane & 31, hi = lane >> 5;
        const float* gp = gate + (row0 >> 13) * 6144 + col0 + l31;
        const float g0 = gp[0] * gmul, g1 = gp[32] * gmul;
        const size_t base = (size_t)(row0 + 4 * hi) * 2048 + col0 + l31;
#pragma unroll
        for (int mi = 0; mi < MI; ++mi) {
#pragma unroll
            for (int q = 0; q < 4; ++q) {
                float xv[8];
#pragma unroll
                for (int j = 0; j < 4; ++j) { const size_t o = base + (size_t)(mi * 32 + 8 * q + j) * 2048; xv[j] = xin[o]; xv[4 + j] = xin[o + 32]; }
#pragma unroll
                for (int j = 0; j < 4; ++j) { const size_t o = base + (size_t)(mi * 32 + 8 * q + j) * 2048; xout[o] = xv[j] + g0 * acc[mi][0][4 * q + j]; xout[o + 32] = xv[4 + j] + g1 * acc[mi][1][4 * q + j]; }
                __builtin_amdgcn_sched_barrier(0);
            }
        }
    }
};
struct EpiCmpHid {
    bf16_t* C; const float* biasp;
    template <int MI> __device__ __forceinline__ void operator()(f32x16 (&acc)[MI][2], int row0, int col0, int lane) const {
        const int l31 = lane & 31;
#pragma unroll
        for (int ni = 0; ni < 2; ++ni) {
            const int col = col0 + ni * 32 + l31;
            float b = 0;
#pragma unroll 8
            for (int c = 0; c < 32; ++c) b += biasp[c * 256 + col];
#pragma unroll
            for (int mi = 0; mi < MI; ++mi)
#pragma unroll
                for (int r = 0; r < 16; ++r) acc[mi][ni][r] = gelu_tanh(acc[mi][ni][r] + b);
        }
        store_bf16_tile<MI>(acc, C, 256, 256, row0, col0, lane);
    }
};
struct EpiCmpOut {
    bf16_t* C;
    template <int MI> __device__ __forceinline__ void operator()(f32x16 (&acc)[MI][2], int row0, int col0, int lane) const {
        const int l31 = lane & 31, hi = lane >> 5;
#pragma unroll
        for (int ni = 0; ni < 2; ++ni) {
            const int col = col0 + ni * 32 + l31;
#pragma unroll
            for (int mi = 0; mi < MI; ++mi)
#pragma unroll
                for (int r = 0; r < 16; ++r) {
                    const float v = acc[mi][ni][r];
                    const float vn = __shfl_xor(v, 1);
                    int rr = row0 + mi * 32 + crow(r, hi);
                    if ((l31 & 1) == 0 && rr < 2 * BATCH * NCMP) {
                        const int g = rr & 1; rr >>= 1;
                        const int b = rr / NCMP, n = rr - b * NCMP;
                        *(unsigned*)(C + (size_t)((b * NCMP_PAD + n) * 2 + g) * 128 + col) = cvtpk(v, vn);
                    }
                }
        }
    }
};

__device__ __forceinline__ void phase_mla_prep(const Args& A, int bid, int nb) {
    const int tid = opaque_tid(), lane = tid & 63, wave = tid >> 6;
    const bf16_t* BIG = (const bf16_t*)(WSP(A) + WS_BIG);
    bf16_t* CQN = (bf16_t*)(WSP(A) + WS_CQN); bf16_t* CKVN = (bf16_t*)(WSP(A) + WS_CKVN); bf16_t* KVM = (bf16_t*)(WSP(A) + WS_KVM);
    const f32x2* rope64 = (const f32x2*)(WSP(A) + WS_ROPE64);
    const float* qn = A.in[7]; const float* kvn = A.in[9];
    for (int u = bid; u < T / NWAVES; u += nb) {
        const int t = u * NWAVES + wave;
        const bf16_t* row = BIG + (size_t)t * SBMLA_IN;
        {
            const u32x4 w = *(const u32x4*)(row + 3072 + lane * 8);
            float x[8] = {bflo(w[0]), bfhi(w[0]), bflo(w[1]), bfhi(w[1]), bflo(w[2]), bfhi(w[2]), bflo(w[3]), bfhi(w[3])};
            float ss = 0;
#pragma unroll
            for (int j = 0; j < 8; ++j) ss += x[j] * x[j];
            ss = wave_sum(ss);
            const float rinv = rsqrtf(ss * (1.f / 512.f) + EPS);
            const f32x4 g0 = *(const f32x4*)(qn + lane * 8), g1 = *(const f32x4*)(qn + lane * 8 + 4);
            u32x4 o = {cvtpk(x[0] * rinv * g0[0], x[1] * rinv * g0[1]), cvtpk(x[2] * rinv * g0[2], x[3] * rinv * g0[3]),
                       cvtpk(x[4] * rinv * g1[0], x[5] * rinv * g1[1]), cvtpk(x[6] * rinv * g1[2], x[7] * rinv * g1[3])};
            *(u32x4*)(CQN + (size_t)t * 512 + lane * 8) = o;
        }
        {
            const u32x2 w = *(const u32x2*)(row + 3584 + lane * 4);
            float x[4] = {bflo(w[0]), bfhi(w[0]), bflo(w[1]), bfhi(w[1])};
            float ss = x[0] * x[0] + x[1] * x[1] + x[2] * x[2] + x[3] * x[3];
            ss = wave_sum(ss);
            const float rinv = rsqrtf(ss * (1.f / 256.f) + EPS);
            const f32x4 g = *(const f32x4*)(kvn + lane * 4);
            u32x2 o = {cvtpk(x[0] * rinv * g[0], x[1] * rinv * g[1]), cvtpk(x[2] * rinv * g[2], x[3] * rinv * g[3])};
            *(u32x2*)(CKVN + (size_t)t * 256 + lane * 4) = o;
        }
        {
            const float x = bf2f(row[3840 + lane]);
            const float oth = __shfl_xor(x, 32);
            const f32x2 cs = rope64[(size_t)t * 32 + (lane & 31)];
            const float y = (lane < 32) ? x * cs[0] - oth * cs[1] : x * cs[0] + oth * cs[1];
            KVM[(size_t)t * KVM_LD + 2048 + lane] = (bf16_t)(cvtpk(y, y) & 0xFFFFu);
        }
    }
}
constexpr int KSTR128 = 272, KSTR192 = 400, VSTR = 320;
constexpr int ATT_K_BYTES = 64 * KSTR192;
constexpr int ATT_V_BYTES = 64 * VSTR;
constexpr int ATT_KOFF = 0, ATT_VOFF = 2 * ATT_K_BYTES, ATT_MISC = ATT_VOFF + 2 * ATT_V_BYTES;

template <int NKS, int KSTR>
__device__ __forceinline__ void qk_tile(f32x16& p0, f32x16& p1, const unsigned char* kb_lane, const bf16x8* qr) {
#pragma unroll
    for (int r = 0; r < 16; ++r) { p0[r] = 0.f; p1[r] = 0.f; }
#pragma unroll
    for (int ks = 0; ks < NKS; ++ks) {
        const bf16x8 a0 = *(const bf16x8*)(kb_lane + ks * 32);
        const bf16x8 a1 = *(const bf16x8*)(kb_lane + 32 * KSTR + ks * 32);
        p0 = __builtin_amdgcn_mfma_f32_32x32x16_bf16(a0, qr[ks], p0, 0, 0, 0);
        p1 = __builtin_amdgcn_mfma_f32_32x32x16_bf16(a1, qr[ks], p1, 0, 0, 0);
        if ((ks & 3) == 3) __builtin_amdgcn_sched_barrier(0);
    }
}
__device__ __forceinline__ s16x4 tr_read(const unsigned char* p) {
    return __builtin_amdgcn_ds_read_tr16_b64_v4i16((LAS s16x4*)p);
}
__device__ __forceinline__ void pv_tile(f32x16 (&o)[4], const unsigned char* vb_lane, const bf16x8 (&pb)[4]) {
#pragma unroll
    for (int dt = 0; dt < 4; ++dt) {
#pragma unroll
        for (int s = 0; s < 4; ++s) {
            const s16x4 lo = tr_read(vb_lane + (s * 16) * VSTR + dt * 64);
            const s16x4 hh = tr_read(vb_lane + (s * 16 + 8) * VSTR + dt * 64);
            const bf16x8 a = {lo[0], lo[1], lo[2], lo[3], hh[0], hh[1], hh[2], hh[3]};
            o[dt] = __builtin_amdgcn_mfma_f32_32x32x16_bf16(a, pb[s], o[dt], 0, 0, 0);
        }
        __builtin_amdgcn_sched_barrier(0);
    }
}
__device__ __forceinline__ bf16x8 pack8f(const f32x16& p, int b) {
    u32x4 w = {cvtpk(p[b + 0], p[b + 1]), cvtpk(p[b + 2], p[b + 3]), cvtpk(p[b + 4], p[b + 5]), cvtpk(p[b + 6], p[b + 7])};
    return *reinterpret_cast<bf16x8*>(&w);
}
__device__ __forceinline__ int vb_lane_off(int lane) {
    return (4 * (lane >> 5) + ((lane >> 2) & 3)) * VSTR + (16 * ((lane >> 4) & 1) + 4 * (lane & 3)) * 2;
}
__device__ __forceinline__ void softmax_step(f32x16& p0, f32x16& p1, float& m, float& l, f32x16 (&o)[4], float c2, bf16x8 (&pb)[4]) {
    float mx = p0[0];
#pragma unroll
    for (int r = 1; r < 16; ++r) mx = fmaxf(mx, p0[r]);
#pragma unroll
    for (int r = 0; r < 16; ++r) mx = fmaxf(mx, p1[r]);
    mx = fmaxf(mx, __shfl_xor(mx, 32));
    const float mn = fmaxf(m, mx);
    const float alpha = __builtin_amdgcn_exp2f((m - mn) * c2);
    const float mc = mn * c2;
    float rs = 0.f;
#pragma unroll
    for (int r = 0; r < 16; ++r) { p0[r] = __builtin_amdgcn_exp2f(p0[r] * c2 - mc); rs += p0[r]; }
#pragma unroll
    for (int r = 0; r < 16; ++r) { p1[r] = __builtin_amdgcn_exp2f(p1[r] * c2 - mc); rs += p1[r]; }
    rs += __shfl_xor(rs, 32);
    l = l * alpha + rs;
    m = mn;
    if (__any(alpha != 1.f)) {
#pragma unroll
        for (int dt = 0; dt < 4; ++dt)
#pragma unroll
            for (int r = 0; r < 16; ++r) o[dt][r] *= alpha;
    }
    pb[0] = pack8f(p0, 0); pb[1] = pack8f(p0, 8); pb[2] = pack8f(p1, 0); pb[3] = pack8f(p1, 8);
}
__device__ __forceinline__ void store_ot_bf16(const f32x16 (&o)[4], float sc, bf16_t* orow  , int hi) {
#pragma unroll
    for (int dt = 0; dt < 4; ++dt)
#pragma unroll
        for (int g = 0; g < 4; ++g) {
            u32x2 w = {cvtpk(o[dt][4 * g] * sc, o[dt][4 * g + 1] * sc), cvtpk(o[dt][4 * g + 2] * sc, o[dt][4 * g + 3] * sc)};
            *(u32x2*)(orow + dt * 32 + 8 * g + 4 * hi) = w;
        }
}

__device__ __forceinline__ void mla_item(const Args& A, unsigned char* lds, int b, int h, int qt) {
    const int tid = opaque_tid(), lane = tid & 63, wave = tid >> 6, l31 = lane & 31, hi = lane >> 5;
    const bf16_t* QM = (const bf16_t*)(WSP(A) + WS_QM); const bf16_t* KVM = (const bf16_t*)(WSP(A) + WS_KVM);
    bf16_t* O = (bf16_t*)(WSP(A) + WS_O);
    const int q0 = qt * 256, qw = q0 + wave * 32, t = qw + l31;
    const size_t tokb = (size_t)b * SEQ;
    bf16x8 qr[12];
    {
        const bf16_t* qp = QM + (tokb + t) * 1536 + h * 192 + hi * 8;
#pragma unroll
        for (int ks = 0; ks < 12; ++ks) qr[ks] = *(const bf16x8*)(qp + ks * 16);
    }
    const int nkt = (q0 + 256) / 64;
    u32x4 rk[3], rv[2];
    unsigned okb[3], ovb[2], lkb[3], lvb[2];
#pragma unroll
    for (int i = 0; i < 3; ++i) {
        const int q = tid + NTHREADS * i, row = q / 24, c = q - row * 24;
        okb[i] = (unsigned)(row * KVM_LD + ((c < 16) ? h * 256 + c * 8 : 2048 + (c - 16) * 8)) * 2u;
        lkb[i] = (unsigned)(row * KSTR192 + c * 16);
    }
#pragma unroll
    for (int i = 0; i < 2; ++i) {
        const int q = tid + NTHREADS * i, row = q >> 4, c = q & 15;
        ovb[i] = (unsigned)(row * KVM_LD + h * 256 + 128 + c * 8) * 2u;
        lvb[i] = (unsigned)(row * VSTR + c * 16);
    }
    auto gload = [&](int kt) {
        const unsigned char* base = (const unsigned char*)(KVM + (tokb + (size_t)kt * 64) * KVM_LD);
#pragma unroll
        for (int i = 0; i < 3; ++i) rk[i] = *(const u32x4*)(base + okb[i]);
#pragma unroll
        for (int i = 0; i < 2; ++i) rv[i] = *(const u32x4*)(base + ovb[i]);
    };
    auto lstore = [&](int buf) {
        unsigned char* kb = lds + ATT_KOFF + buf * ATT_K_BYTES; unsigned char* vb = lds + ATT_VOFF + buf * ATT_V_BYTES;
#pragma unroll
        for (int i = 0; i < 3; ++i) *(u32x4*)(kb + lkb[i]) = rk[i];
#pragma unroll
        for (int i = 0; i < 2; ++i) *(u32x4*)(vb + lvb[i]) = rv[i];
    };
    f32x16 o[4];
#pragma unroll
    for (int dt = 0; dt < 4; ++dt)
#pragma unroll
        for (int r = 0; r < 16; ++r) o[dt][r] = 0.f;
    float m = -1e30f, l = 0.f;
    const float c2 = 0.07216878364870322f * 1.4426950408889634f;
    const int kl_off = l31 * KSTR192 + hi * 16, vl_off = vb_lane_off(lane);
    gload(0); lstore(0); __syncthreads();
    for (int kt = 0; kt < nkt; ++kt) {
        if (kt + 1 < nkt) gload(kt + 1);
        if (kt * 64 <= qw + 31) {
            f32x16 p0, p1;
            qk_tile<12, KSTR192>(p0, p1, lds + ATT_KOFF + (kt & 1) * ATT_K_BYTES + kl_off, qr);
            if (kt * 64 + 63 > qw) {
                const int dq = t - kt * 64 - 4 * hi;
#pragma unroll
                for (int r = 0; r < 16; ++r) {
                    const int cb = (r & 3) + 8 * (r >> 2);
                    if (cb > dq) p0[r] = -__builtin_inff();
                    if (cb + 32 > dq) p1[r] = -__builtin_inff();
                }
            }
            bf16x8 pb[4];
            softmax_step(p0, p1, m, l, o, c2, pb);
            pv_tile(o, lds + ATT_VOFF + (kt & 1) * ATT_V_BYTES + vl_off, pb);
        }
        if (kt + 1 < nkt) lstore((kt + 1) & 1);
        __syncthreads();
    }
    store_ot_bf16(o, ABL_MLA / l, O + (tokb + t) * 2048 + 1024 + h * 128, hi);
}

__device__ __forceinline__ void sb_item(const Args& A, unsigned char* lds, int b, int h, int qt) {
    const int tid = opaque_tid(), lane = tid & 63, wave = tid >> 6, l31 = lane & 31, hi = lane >> 5;
    const bf16_t* BIG = (const bf16_t*)(WSP(A) + WS_BIG);
    bf16_t* O = (bf16_t*)(WSP(A) + WS_O);
    volatile int* flags = (volatile int*)(lds + ATT_MISC);
    const int q0 = qt * 256, qw = q0 + wave * 32, t = qw + l31;
    const size_t tokb = (size_t)b * SEQ;
    bf16x8 qr[8];
    {
        const bf16_t* qp = BIG + (tokb + t) * SBMLA_IN + h * 128 + hi * 8;
#pragma unroll
        for (int ks = 0; ks < 8; ++ks) qr[ks] = *(const bf16x8*)(qp + ks * 16);
    }
    bf16x8 tri[2];
#pragma unroll
    for (int s2 = 0; s2 < 2; ++s2)
#pragma unroll
        for (int jj = 0; jj < 8; ++jj) tri[s2][jj] = (16 * s2 + 8 * (jj >> 2) + 4 * hi + (jj & 3) > l31) ? (short)0x3F80 : (short)0;
    u32x4 rk[2], rv[2];
    unsigned ogb[2], lkb[2], lvb[2];
#pragma unroll
    for (int i = 0; i < 2; ++i) {
        const int q = tid + NTHREADS * i, row = q >> 4, c = q & 15;
        ogb[i] = (unsigned)(row * SBMLA_IN + c * 8) * 2u; lkb[i] = (unsigned)(row * KSTR128 + c * 16); lvb[i] = (unsigned)(row * VSTR + c * 16);
    }
    auto gload = [&](int kt) {
        const unsigned char* base = (const unsigned char*)(BIG + (tokb + (size_t)kt * 64) * SBMLA_IN + h * 128);
#pragma unroll
        for (int i = 0; i < 2; ++i) { rk[i] = *(const u32x4*)(base + 2048 + ogb[i]); rv[i] = *(const u32x4*)(base + 4096 + ogb[i]); }
    };
    auto lstore = [&](int buf) {
        unsigned char* kb = lds + ATT_KOFF + buf * ATT_K_BYTES; unsigned char* vb = lds + ATT_VOFF + buf * ATT_V_BYTES;
#pragma unroll
        for (int i = 0; i < 2; ++i) { *(u32x4*)(kb + lkb[i]) = rk[i]; *(u32x4*)(vb + lvb[i]) = rv[i]; }
    };
    f32x16 o[4];
#pragma unroll
    for (int dt = 0; dt < 4; ++dt)
#pragma unroll
        for (int r = 0; r < 16; ++r) o[dt][r] = 0.f;
    float R = 0.f;
    bool done = false;
    const float scale = 0.08838834764831845f;
    const int kt_hi = (q0 + 254) / 64, ktw = (qw + 30) / 64;
    const int kl_off = l31 * KSTR128 + hi * 16, vl_off = vb_lane_off(lane);
    gload(kt_hi); lstore(0); __syncthreads();
    int it = 0;
    for (int kt = kt_hi; kt >= 0; --kt, ++it) {
        if (kt > 0) gload(kt - 1);
        if (kt <= ktw && !done) {
            f32x16 p0, p1;
            qk_tile<8, KSTR128>(p0, p1, lds + ATT_KOFF + (it & 1) * ATT_K_BYTES + kl_off, qr);
            const int dq = t - kt * 64 - 4 * hi;
            float tot0 = 0.f, tot1 = 0.f;
            u32x4 w0, w1, w2, w3;
            auto sbf = [&](float pz, bool v, float& tot, float& lbo) -> float {
                const float z = pz * scale;
                const float lp = __logf(1.f + __expf(-fabsf(z)));
                const float lb = fminf(z, 0.f) - lp;
                const float l1 = v ? lb - z : 0.f;
                tot += l1; lbo = v ? lb : -__builtin_inff();
                return l1;
            };
#pragma unroll
            for (int r = 0; r < 16; r += 2) {
                const int cb0 = (r & 3) + 8 * (r >> 2), cb1 = ((r + 1) & 3) + 8 * ((r + 1) >> 2);
                float t0_, t1_, t2_, t3_;
                const float a0 = sbf(p0[r], cb0 < dq, tot0, t0_), a1 = sbf(p0[r + 1], cb1 < dq, tot0, t1_);
                const float b0 = sbf(p1[r], cb0 + 32 < dq, tot1, t2_), b1 = sbf(p1[r + 1], cb1 + 32 < dq, tot1, t3_);
                p0[r] = t0_; p0[r + 1] = t1_; p1[r] = t2_; p1[r + 1] = t3_;
                const unsigned pa = cvtpk(a0, a1), pbb = cvtpk(b0, b1);
                if (r < 8) { w0[r >> 1] = pa; w2[r >> 1] = pbb; } else { w1[(r - 8) >> 1] = pa; w3[(r - 8) >> 1] = pbb; }
            }
            tot0 += __shfl_xor(tot0, 32); tot1 += __shfl_xor(tot1, 32);
            bf16x8 lf[4];
            lf[0] = *reinterpret_cast<bf16x8*>(&w0); lf[1] = *reinterpret_cast<bf16x8*>(&w1); lf[2] = *reinterpret_cast<bf16x8*>(&w2); lf[3] = *reinterpret_cast<bf16x8*>(&w3);
            f32x16 c0, c1;
            const float r1 = R + tot1;
#pragma unroll
            for (int r = 0; r < 16; ++r) { c1[r] = R; c0[r] = r1; }
            c1 = __builtin_amdgcn_mfma_f32_32x32x16_bf16(tri[0], lf[2], c1, 0, 0, 0);
            c1 = __builtin_amdgcn_mfma_f32_32x32x16_bf16(tri[1], lf[3], c1, 0, 0, 0);
            c0 = __builtin_amdgcn_mfma_f32_32x32x16_bf16(tri[0], lf[0], c0, 0, 0, 0);
            c0 = __builtin_amdgcn_mfma_f32_32x32x16_bf16(tri[1], lf[1], c0, 0, 0, 0);
#pragma unroll
            for (int r = 0; r < 16; ++r) { p0[r] = __expf(p0[r] + c0[r]); p1[r] = __expf(p1[r] + c1[r]); }
            R = r1 + tot0;
            bf16x8 pb[4] = {pack8f(p0, 0), pack8f(p0, 8), pack8f(p1, 0), pack8f(p1, 8)};
            pv_tile(o, lds + ATT_VOFF + (it & 1) * ATT_V_BYTES + vl_off, pb);
            done = __all(R < -104.f);
        }
        if (lane == 0) flags[(it & 1) * 8 + wave] = done ? 1 : 0;
        if (kt > 0) lstore((it + 1) & 1);
        __syncthreads();
        int nd = 0;
#pragma unroll
        for (int w = 0; w < 8; ++w) nd += flags[(it & 1) * 8 + w];
        if (nd == 8) break;
    }
    store_ot_bf16(o, ABL_SB, O + (tokb + t) * 2048 + h * 128, hi);
    __syncthreads();
}

__device__ __forceinline__ void phase_attn0(const Args& A, unsigned char* lds, int bid, int nb) {
    for (int u = bid; u < 256; u += nb) {
        const int bh = u >> 4, p = u & 15;
#pragma unroll 1
        for (int rep = 0; rep < 2; ++rep) mla_item(A, lds, bh >> 3, bh & 7, rep ? p : 31 - p);
    }
    for (int v = bid; v < 512; v += nb) {
        const int bh = v >> 5, qt = v & 31;
        sb_item(A, lds, bh >> 3, bh & 7, qt);
    }
}
__device__ __forceinline__ unsigned f2sort(float f) { const unsigned u = __float_as_uint(f); return u ^ ((u & 0x80000000u) ? 0xFFFFFFFFu : 0x80000000u); }
__device__ __forceinline__ float sort2f(unsigned s) { const unsigned u = (s & 0x80000000u) ? (s ^ 0x80000000u) : ~s; return __uint_as_float(u); }
__device__ __forceinline__ unsigned umax3(unsigned a, unsigned b, unsigned c) { return max(max(a, b), c); }

__device__ __forceinline__ void top16_of_128(unsigned (&k)[64], unsigned* out  , int lane) {
#pragma unroll 1
    for (int it = 0; it < 16; ++it) {
        unsigned mx = k[0];
#pragma unroll
        for (int i = 1; i < 63; i += 2) mx = umax3(mx, k[i], k[i + 1]);
        mx = max(mx, k[63]);
        const unsigned pm = (unsigned)__shfl_xor((int)mx, 32);
        const unsigned g = max(mx, pm);
        out[it * 64 + lane] = g;
#pragma unroll
        for (int i = 0; i < 64; ++i) k[i] = (k[i] == g) ? 0u : k[i];
    }
}

constexpr int TOPK_STAGE = 2 * 128 * KSTR128;
constexpr int TOPK_LDS = TOPK_STAGE + 8 * 8192;
__device__ __forceinline__ void phase_topk(const Args& A, unsigned char* lds, int layer, int bid, int nb) {
    const int tid = opaque_tid(), lane = tid & 63, wave = tid >> 6, l31 = lane & 31, hi = lane >> 5;
    const bf16_t* PQ = (const bf16_t*)(WSP(A) + WS_PQ);
    const bf16_t* K12 = (const bf16_t*)(WSP(A) + WS_K12) + (size_t)layer * 2 * 16384;
    int* EXI = (int*)(WSP(A) + WS_EXI); float* EXG = (float*)(WSP(A) + WS_EXG);
    for (int q = tid; q < 2 * 128 * 16; q += NTHREADS) { const int row = q >> 4, c = q & 15; *(u32x4*)(lds + row * KSTR128 + c * 16) = *(const u32x4*)(K12 + row * 128 + c * 8); }
    __syncthreads();
    for (int u = bid; u < T / 32; u += nb) {
        const int t = u * 32 + l31, h = wave;
        unsigned* wl = (unsigned*)(lds + TOPK_STAGE) + wave * 2048;
#pragma unroll
        for (int side = 0; side < 2; ++side) {
            bf16x8 qr[8];
            const bf16_t* qp = PQ + (size_t)t * 2048 + h * 256 + side * 128 + hi * 8;
#pragma unroll
            for (int ks = 0; ks < 8; ++ks) qr[ks] = *(const bf16x8*)(qp + ks * 16);
            const unsigned char* kp = lds + side * 128 * KSTR128 + l31 * KSTR128 + hi * 16;
            unsigned keys[64];
#pragma unroll
            for (int mt = 0; mt < 4; ++mt) {
                f32x16 p;
#pragma unroll
                for (int r = 0; r < 16; ++r) p[r] = 0.f;
#pragma unroll
                for (int ks = 0; ks < 8; ++ks) {
                    const bf16x8 a = *(const bf16x8*)(kp + mt * 32 * KSTR128 + ks * 32);
                    p = __builtin_amdgcn_mfma_f32_32x32x16_bf16(a, qr[ks], p, 0, 0, 0);
                }
#pragma unroll
                for (int r = 0; r < 16; ++r) {
                    const int key = mt * 32 + (r & 3) + 8 * (r >> 2) + 4 * hi;
                    keys[mt * 16 + r] = (f2sort(p[r]) & ~127u) | (unsigned)(127 - key);
                }
                __builtin_amdgcn_sched_barrier(0);
            }
            top16_of_128(keys, wl + side * 1024, lane);
        }
        unsigned lst[2][16];
#pragma unroll
        for (int i = 0; i < 16; ++i) { lst[0][i] = wl[i * 64 + lane]; lst[1][i] = wl[1024 + i * 64 + lane]; }
        float v1[16], v2[16];
#pragma unroll
        for (int i = 0; i < 16; ++i) { v1[i] = sort2f(lst[0][i] & ~127u); v2[i] = sort2f(lst[1][i] & ~127u); }
        unsigned cand[50];
        {
            int c = 0;
#pragma unroll
            for (int i = 0; i < 16; ++i)
#pragma unroll
                for (int j = 0; j < 16; ++j)
                    if ((i + 1) * (j + 1) <= 16) { cand[c] = (f2sort(v1[i] + v2[j]) & ~255u) | (unsigned)(255 - (16 * i + j)); ++c; }
        }
        float* wv = (float*)wl; int* we = (int*)wl + 1024;
#pragma unroll 1
        for (int it = 0; it < 16; ++it) {
            unsigned mx = cand[0];
#pragma unroll
            for (int c = 1; c < 49; c += 2) mx = umax3(mx, cand[c], cand[c + 1]);
            mx = max(mx, cand[49]);
            wv[it * 64 + lane] = sort2f(mx & ~255u);
            int eid = 0;
            {
                int c = 0;
#pragma unroll
                for (int i = 0; i < 16; ++i)
#pragma unroll
                    for (int j = 0; j < 16; ++j)
                        if ((i + 1) * (j + 1) <= 16) {
                            const bool hit = cand[c] == mx;
                            eid = hit ? (int)((127u - (lst[0][i] & 127u)) * 128u + (127u - (lst[1][j] & 127u))) : eid;
                            cand[c] = hit ? 0u : cand[c];
                            ++c;
                        }
            }
            we[it * 64 + lane] = eid;
        }
        float topv[16]; int tope[16];
#pragma unroll
        for (int it = 0; it < 16; ++it) { topv[it] = wv[it * 64 + lane]; tope[it] = we[it * 64 + lane]; }
        const float mx0 = topv[0];
        float sum = 0.f;
#pragma unroll
        for (int it = 0; it < 16; ++it) { topv[it] = __expf(topv[it] - mx0); sum += topv[it]; }
        if (hi == 0) {
            const float inv = 1.f / sum;
            int* ei = EXI + (size_t)t * 128 + h * 16; float* eg = EXG + (size_t)t * 128 + h * 16;
#pragma unroll
            for (int q = 0; q < 4; ++q) {
                *(int4*)(ei + 4 * q) = make_int4(tope[4 * q], tope[4 * q + 1], tope[4 * q + 2], tope[4 * q + 3]);
                *(f32x4*)(eg + 4 * q) = f32x4{topv[4 * q] * inv, topv[4 * q + 1] * inv, topv[4 * q + 2] * inv, topv[4 * q + 3] * inv};
            }
        }
    }
    __syncthreads();
}
__device__ __forceinline__ void fp8x16_to_f32(const u32x4 w, float (&f)[16]) {
#pragma unroll
    for (int j = 0; j < 4; ++j) {
        const f32x2 lo = __builtin_amdgcn_cvt_pk_f32_fp8((int)w[j], false), hi = __builtin_amdgcn_cvt_pk_f32_fp8((int)w[j], true);
        f[4 * j] = lo[0]; f[4 * j + 1] = lo[1]; f[4 * j + 2] = hi[0]; f[4 * j + 3] = hi[1];
    }
}
struct PeerRow { u32x4 u[2], v[2]; };

template <bool FINAL>
__device__ __forceinline__ void phase_gather(const Args& A, int layer, const float* xin, float* xout, int gate_set, const float* next_gain, int next_set, float gmul, int bid, int nb) {
    const int tid = opaque_tid(), lane = tid & 63, wave = tid >> 6;
    bf16_t* H = (bf16_t*)(WSP(A) + WS_H);
    const unsigned char* PU = WSP(A) + WS_PU + (size_t)layer * 16384 * 2048;
    const unsigned char* PV = WSP(A) + WS_PV + (size_t)layer * 16384 * 2048;
    const int* EXI = (const int*)(WSP(A) + WS_EXI); const float* EXG = (const float*)(WSP(A) + WS_EXG);
    const float* mod = (const float*)(WSP(A) + WS_MOD);
    for (int u = bid; u < T / NWAVES; u += nb) {
        const int t = u * NWAVES + wave;
        float hp[2][16];
#pragma unroll
        for (int c = 0; c < 2; ++c)
#pragma unroll
            for (int q = 0; q < 2; ++q) {
                const u32x4 w_ = *(const u32x4*)(H + (size_t)t * 2048 + c * 1024 + lane * 16 + q * 8);
#pragma unroll
                for (int j = 0; j < 4; ++j) { hp[c][q * 8 + 2 * j] = bflo(w_[j]); hp[c][q * 8 + 2 * j + 1] = bfhi(w_[j]); }
            }
        const int idxA = EXI[(size_t)t * 128 + lane], idxB = EXI[(size_t)t * 128 + 64 + lane];
        const float gA = EXG[(size_t)t * 128 + lane], gB = EXG[(size_t)t * 128 + 64 + lane];
        float o[2][16];
#pragma unroll
        for (int c = 0; c < 2; ++c)
#pragma unroll
            for (int j = 0; j < 16; ++j) o[c][j] = 0.f;
        PeerRow r0, r1, r2, r3;
        auto issue = [&](int k, PeerRow& r) {
            const int e = __builtin_amdgcn_readlane(k < 64 ? idxA : idxB, k & 63);
            const unsigned char* up = PU + (size_t)e * 2048 + lane * 16; const unsigned char* vp = PV + (size_t)e * 2048 + lane * 16;
#pragma unroll
            for (int c = 0; c < 2; ++c) { r.u[c] = *(const u32x4*)(up + c * 1024); r.v[c] = *(const u32x4*)(vp + c * 1024); }
        };
        auto consume = [&](int k, const PeerRow& r) {
            float d = 0.f;
#pragma unroll
            for (int c = 0; c < 2; ++c) {
                float f[16]; fp8x16_to_f32(r.u[c], f);
#pragma unroll
                for (int j = 0; j < 16; ++j) d += f[j] * hp[c][j];
            }
            d = wave_sum(d) * (1.f / PEER_USCALE);
            const float g = __uint_as_float(__builtin_amdgcn_readlane(__float_as_uint(k < 64 ? gA : gB), k & 63));
            const float w = g * gelu_tanh(d) * (gmul / PEER_VSCALE);
#pragma unroll
            for (int c = 0; c < 2; ++c) {
                float f[16]; fp8x16_to_f32(r.v[c], f);
#pragma unroll
                for (int j = 0; j < 16; ++j) o[c][j] += w * f[j];
            }
        };
        issue(0, r0); issue(1, r1); issue(2, r2); issue(3, r3);
#pragma unroll 1
        for (int k = 0; k < 128; k += 4) {
            consume(k, r0);     if (k + 4 < 128) issue(k + 4, r0);
            consume(k + 1, r1); if (k + 4 < 128) issue(k + 5, r1);
            consume(k + 2, r2); if (k + 4 < 128) issue(k + 6, r2);
            consume(k + 3, r3); if (k + 4 < 128) issue(k + 7, r3);
        }
        const int b = t >> 13;
        const float* gate = mod + (size_t)(gate_set * 2 + b) * 6144 + 4096;
        float ss = 0.f;
#pragma unroll
        for (int c = 0; c < 2; ++c)
#pragma unroll
            for (int q = 0; q < 4; ++q) {
                const int col = c * 1024 + lane * 16 + q * 4;
                const f32x4 x0 = *(const f32x4*)(xin + (size_t)t * 2048 + col), g0 = *(const f32x4*)(gate + col);
#pragma unroll
                for (int j = 0; j < 4; ++j) { const float xv = x0[j] + g0[j] * o[c][q * 4 + j]; o[c][q * 4 + j] = xv; ss += xv * xv; }
            }
        ss = wave_sum(ss);
        const float rinv = rsqrtf(ss * (1.f / 2048.f) + EPS);
        if constexpr (FINAL) {
#pragma unroll
            for (int c = 0; c < 2; ++c)
#pragma unroll
                for (int q = 0; q < 4; ++q) {
                    const int col = c * 1024 + lane * 16 + q * 4;
                    const f32x4 w0 = *(const f32x4*)(next_gain + col);
                    f32x4 y;
#pragma unroll
                    for (int j = 0; j < 4; ++j) y[j] = o[c][q * 4 + j] * rinv * w0[j];
                    *(f32x4*)(xout + (size_t)t * 2048 + col) = y;
                }
        } else {
            const float* nm = mod + (size_t)(next_set * 2 + b) * 6144;
#pragma unroll
            for (int c = 0; c < 2; ++c) {
                float hh[16];
#pragma unroll
                for (int q = 0; q < 4; ++q) {
                    const int col = c * 1024 + lane * 16 + q * 4;
                    f32x4 y;
#pragma unroll
                    for (int j = 0; j < 4; ++j) y[j] = o[c][q * 4 + j];
                    *(f32x4*)(xout + (size_t)t * 2048 + col) = y;
                    const f32x4 w0 = *(const f32x4*)(next_gain + col), s0 = *(const f32x4*)(nm + col), c0 = *(const f32x4*)(nm + 2048 + col);
#pragma unroll
                    for (int j = 0; j < 4; ++j) hh[q * 4 + j] = y[j] * rinv * w0[j] * (1.f + c0[j]) + s0[j];
                }
#pragma unroll
                for (int q = 0; q < 2; ++q) {
                    u32x4 w = {cvtpk(hh[q * 8], hh[q * 8 + 1]), cvtpk(hh[q * 8 + 2], hh[q * 8 + 3]), cvtpk(hh[q * 8 + 4], hh[q * 8 + 5]), cvtpk(hh[q * 8 + 6], hh[q * 8 + 7])};
                    *(u32x4*)(H + (size_t)t * 2048 + c * 1024 + lane * 16 + q * 8) = w;
                }
            }
        }
    }
}
constexpr int NSA_IMP = ATT_MISC;
constexpr int NSA_SELM = NSA_IMP + 32 * 128 * 4;
constexpr int NSA_KEYS = NSA_SELM + 512;
constexpr int LDS_BARW = NSA_KEYS + 8 * 128 * 4;
constexpr int LDS_BARW2 = (LDS_BARW > TOPK_LDS ? LDS_BARW : TOPK_LDS);
constexpr int LDS_TOTAL = ((LDS_BARW2 + 16 + 255) / 256) * 256;
static_assert(LDS_TOTAL <= 160 * 1024 && GEMM_LDS <= LDS_BARW2 && GEMM256_LDS <= LDS_BARW2, "LDS budget");

__device__ __forceinline__ int next_bit128(unsigned long long lo, unsigned long long hi, int from) {
    if (from < 64) { const unsigned long long mm = lo >> from; if (mm) return from + __builtin_ctzll(mm); from = 64; }
    if (from < 128) { const unsigned long long mm = hi >> (from - 64); if (mm) return from + __builtin_ctzll(mm); }
    return 128;
}
template <int MODE>
__device__ __forceinline__ void nsa_emit(const f32x16 (&o)[4], float sc, float* acc_row, bf16_t* o_row, int hi) {
#pragma unroll
    for (int dt = 0; dt < 4; ++dt)
#pragma unroll
        for (int g4 = 0; g4 < 4; ++g4) {
            const int d = dt * 32 + 8 * g4 + 4 * hi;
            f32x4 v = {o[dt][4 * g4] * sc, o[dt][4 * g4 + 1] * sc, o[dt][4 * g4 + 2] * sc, o[dt][4 * g4 + 3] * sc};
            if (MODE >= 1) { const f32x4 pv = *(const f32x4*)(acc_row + d); v += pv; }
            if (MODE <= 1) *(f32x4*)(acc_row + d) = v;
            else { u32x2 w = {cvtpk(v[0], v[1]), cvtpk(v[2], v[3])}; *(u32x2*)(o_row + d) = w; }
        }
}

__device__ __forceinline__ void nsa_item(const Args& A, unsigned char* lds, int b, int g, int tt) {
    const int tid = opaque_tid(), lane = tid & 63, wave = tid >> 6, l31 = lane & 31, hi = lane >> 5;
    const bf16_t* NS = (const bf16_t*)(WSP(A) + WS_BIG);
    const bf16_t* KCC = (const bf16_t*)(WSP(A) + WS_KCC); const bf16_t* VCC = (const bf16_t*)(WSP(A) + WS_VCC);
    float* OACC = (float*)(WSP(A) + WS_OACC); bf16_t* O = (bf16_t*)(WSP(A) + WS_O);
    int* IMP = (int*)(lds + NSA_IMP); unsigned* SELM = (unsigned*)(lds + NSA_SELM); int* KEYS = (int*)(lds + NSA_KEYS) + wave * 128;
    const int t0 = tt * 32, t = t0 + l31, hd = g * 8 + wave;
    const size_t tokb = (size_t)b * SEQ;
    const float c2 = 0.08838834764831845f * 1.4426950408889634f;
    bf16x8 qr[8];
    {
        const bf16_t* qp = NS + (tokb + t) * NSA_IN + hd * 128 + hi * 8;
#pragma unroll
        for (int ks = 0; ks < 8; ++ks) qr[ks] = *(const bf16x8*)(qp + ks * 16);
    }
    float gt[3];
    {
        const bf16_t* gp = NS + (tokb + t) * NSA_IN + 3584 + g * 24 + wave * 3;
        gt[0] = bf2f(gp[0]); gt[1] = bf2f(gp[1]); gt[2] = bf2f(gp[2]);
    }
    float* acc_row = OACC + (tokb + t) * 2048 + hd * 128;
    bf16_t* o_row = O + (tokb + t) * 2048 + hd * 128;
    const int kl_off = l31 * KSTR128 + hi * 16, vl_off = vb_lane_off(lane);
    u32x4 rk[2], rv[2];
    unsigned ocm[2], omn[2], lkb[2], lvb[2];
#pragma unroll
    for (int i = 0; i < 2; ++i) {
        const int q = tid + NTHREADS * i, row = q >> 4, c = q & 15;
        ocm[i] = (unsigned)(row * 256 + c * 8) * 2u; omn[i] = (unsigned)(row * NSA_IN + c * 8) * 2u;
        lkb[i] = (unsigned)(row * KSTR128 + c * 16); lvb[i] = (unsigned)(row * VSTR + c * 16);
    }
    auto gloadK = [&](const bf16_t* kbase, bool cmp) {
#pragma unroll
        for (int i = 0; i < 2; ++i) rk[i] = *(const u32x4*)((const unsigned char*)kbase + (cmp ? ocm[i] : omn[i]));
    };
    auto gloadV = [&](const bf16_t* vbase, bool cmp) {
#pragma unroll
        for (int i = 0; i < 2; ++i) rv[i] = *(const u32x4*)((const unsigned char*)vbase + (cmp ? ocm[i] : omn[i]));
    };
    auto lstoreK = [&](int buf) {
        unsigned char* kb = lds + ATT_KOFF + buf * ATT_K_BYTES;
#pragma unroll
        for (int i = 0; i < 2; ++i) *(u32x4*)(kb + lkb[i]) = rk[i];
    };
    auto lstoreV = [&](int buf) {
        unsigned char* vb = lds + ATT_VOFF + buf * ATT_V_BYTES;
#pragma unroll
        for (int i = 0; i < 2; ++i) *(u32x4*)(vb + lvb[i]) = rv[i];
    };
    f32x16 o[4];
    auto zero_o = [&]() {
#pragma unroll
        for (int dt = 0; dt < 4; ++dt)
#pragma unroll
            for (int r = 0; r < 16; ++r) o[dt][r] = 0.f;
    };

    for (int i = tid; i < 32 * 128; i += NTHREADS) IMP[i] = 0;
    const int nct = (tt >> 5) + 1;
    const int nv = (t >= 31) ? ((t - 31) >> 4) : -1;
    const bf16_t* kc0 = KCC + ((size_t)(b * NCMP_PAD) * 2 + g) * 128;
    const bf16_t* vc0 = VCC + ((size_t)(b * NCMP_PAD) * 2 + g) * 128;
    float m = -1e30f, l = 0.f;
    gloadK(kc0, true); lstoreK(0); __syncthreads();
    for (int ct = 0; ct < nct; ++ct) {
        if (ct + 1 < nct) gloadK(kc0 + (size_t)(ct + 1) * 64 * 256, true);
        {
            f32x16 p0, p1;
            qk_tile<8, KSTR128>(p0, p1, lds + ATT_KOFF + (ct & 1) * ATT_K_BYTES + kl_off, qr);
            const int dq = nv - ct * 64 - 4 * hi;
            float mx = -__builtin_inff();
#pragma unroll
            for (int r = 0; r < 16; ++r) {
                const int cb = (r & 3) + 8 * (r >> 2);
                p0[r] = (cb <= dq) ? p0[r] : -__builtin_inff();
                p1[r] = (cb + 32 <= dq) ? p1[r] : -__builtin_inff();
                mx = fmaxf(mx, fmaxf(p0[r], p1[r]));
            }
            mx = fmaxf(mx, __shfl_xor(mx, 32));
            const float mn = fmaxf(m, mx);
            const float alpha = __builtin_amdgcn_exp2f((m - mn) * c2);
            const float mc = mn * c2;
            float rs = 0.f;
#pragma unroll
            for (int r = 0; r < 16; ++r) rs += __builtin_amdgcn_exp2f(p0[r] * c2 - mc) + __builtin_amdgcn_exp2f(p1[r] * c2 - mc);
            rs += __shfl_xor(rs, 32);
            l = l * alpha + rs; m = mn;
        }
        if (ct + 1 < nct) lstoreK((ct + 1) & 1);
        __syncthreads();
    }
    const float inv_l = (l > 0.f) ? 1.f / l : 0.f;
    const float mcF = m * c2;
    zero_o();
    gloadK(kc0, true); gloadV(vc0, true); lstoreK(0); lstoreV(0); __syncthreads();
    for (int ct = 0; ct < nct; ++ct) {
        if (ct + 1 < nct) { gloadK(kc0 + (size_t)(ct + 1) * 64 * 256, true); gloadV(vc0 + (size_t)(ct + 1) * 64 * 256, true); }
        {
            f32x16 p0, p1;
            qk_tile<8, KSTR128>(p0, p1, lds + ATT_KOFF + (ct & 1) * ATT_K_BYTES + kl_off, qr);
            const int dq = nv - ct * 64 - 4 * hi;
#pragma unroll
            for (int r = 0; r < 16; ++r) {
                const int cb = (r & 3) + 8 * (r >> 2);
                p0[r] = (cb <= dq) ? __builtin_amdgcn_exp2f(p0[r] * c2 - mcF) * inv_l : 0.f;
                p1[r] = (cb + 32 <= dq) ? __builtin_amdgcn_exp2f(p1[r] * c2 - mcF) * inv_l : 0.f;
            }
#pragma unroll
            for (int g4 = 0; g4 < 4; ++g4) {
                {
                    const int j = 16 * ct + 2 * g4 + hi;
                    const float mainv = 32.f * (p0[4 * g4] + p0[4 * g4 + 1] + p0[4 * g4 + 2]) + 16.f * p0[4 * g4 + 3];
                    const float spill = 16.f * p0[4 * g4 + 3];
                    atomicAdd(&IMP[l31 * 128 + j], (int)(mainv * 1048576.f + 0.5f));
                    if (j + 1 < 128) atomicAdd(&IMP[l31 * 128 + j + 1], (int)(spill * 1048576.f + 0.5f));
                }
                {
                    const int j = 16 * ct + 8 + 2 * g4 + hi;
                    const float mainv = 32.f * (p1[4 * g4] + p1[4 * g4 + 1] + p1[4 * g4 + 2]) + 16.f * p1[4 * g4 + 3];
                    const float spill = 16.f * p1[4 * g4 + 3];
                    atomicAdd(&IMP[l31 * 128 + j], (int)(mainv * 1048576.f + 0.5f));
                    if (j + 1 < 128) atomicAdd(&IMP[l31 * 128 + j + 1], (int)(spill * 1048576.f + 0.5f));
                }
            }
            bf16x8 pb[4] = {pack8f(p0, 0), pack8f(p0, 8), pack8f(p1, 0), pack8f(p1, 8)};
            pv_tile(o, lds + ATT_VOFF + (ct & 1) * ATT_V_BYTES + vl_off, pb);
        }
        if (ct + 1 < nct) { lstoreK((ct + 1) & 1); lstoreV((ct + 1) & 1); }
        __syncthreads();
    }
    nsa_emit<0>(o, gt[0] * ABL_NC, acc_row, o_row, hi);

#pragma unroll 1
    for (int q = 0; q < 4; ++q) {
        const int ti = wave * 4 + q, tq = t0 + ti, cur = tq >> 6;
        int keyv[2];
#pragma unroll
        for (int half = 0; half < 2; ++half) {
            const int j = lane + 64 * half;
            const bool forced = (j == 0) || (j == cur) || (j == cur - 1);
            keyv[half] = forced ? 0x7FFFFFFF : ((j <= cur) ? IMP[ti * 128 + j] : -1);
            KEYS[j] = keyv[half];
        }
        __builtin_amdgcn_s_waitcnt(0xc07f);
        int rk0 = 0, rk1 = 0;
#pragma unroll 8
        for (int i = 0; i < 128; ++i) {
            const int ki = KEYS[i];
            rk0 += (ki > keyv[0] || (ki == keyv[0] && i < lane)) ? 1 : 0;
            rk1 += (ki > keyv[1] || (ki == keyv[1] && i < lane + 64)) ? 1 : 0;
        }
        const unsigned long long s0 = __ballot(keyv[0] >= 0 && rk0 < 16);
        const unsigned long long s1 = __ballot(keyv[1] >= 0 && rk1 < 16);
        if (lane == 0) { SELM[ti * 4 + 0] = (unsigned)s0; SELM[ti * 4 + 1] = (unsigned)(s0 >> 32); SELM[ti * 4 + 2] = (unsigned)s1; SELM[ti * 4 + 3] = (unsigned)(s1 >> 32); }
    }
    __syncthreads();
    unsigned msk[4], uni[4];
#pragma unroll
    for (int w4 = 0; w4 < 4; ++w4) {
        msk[w4] = SELM[l31 * 4 + w4];
        unsigned x = msk[w4];
#pragma unroll
        for (int off = 16; off >= 1; off >>= 1) x |= (unsigned)__shfl_xor((int)x, off);
        uni[w4] = (unsigned)__builtin_amdgcn_readfirstlane((int)x);
    }
    const unsigned long long ulo = ((unsigned long long)uni[1] << 32) | uni[0], uhi = ((unsigned long long)uni[3] << 32) | uni[2];

    const bf16_t* ks0 = NS + tokb * NSA_IN + 2560 + g * 128;
    const bf16_t* vs0 = NS + tokb * NSA_IN + 2816 + g * 128;
    zero_o(); m = -1e30f; l = 0.f;
    {
        int j = next_bit128(ulo, uhi, 0), it = 0;
        if (j < 128) { gloadK(ks0 + (size_t)j * 64 * NSA_IN, false); gloadV(vs0 + (size_t)j * 64 * NSA_IN, false); lstoreK(0); lstoreV(0); }
        __syncthreads();
        while (j < 128) {
            const int jn = next_bit128(ulo, uhi, j + 1);
            if (jn < 128) { gloadK(ks0 + (size_t)jn * 64 * NSA_IN, false); gloadV(vs0 + (size_t)jn * 64 * NSA_IN, false); }
            {
                f32x16 p0, p1;
                qk_tile<8, KSTR128>(p0, p1, lds + ATT_KOFF + (it & 1) * ATT_K_BYTES + kl_off, qr);
                const bool sel = (msk[j >> 5] >> (j & 31)) & 1u;
                const int dq = sel ? (t - j * 64 - 4 * hi) : -1000;
#pragma unroll
                for (int r = 0; r < 16; ++r) {
                    const int cb = (r & 3) + 8 * (r >> 2);
                    p0[r] = (cb <= dq) ? p0[r] : -__builtin_inff();
                    p1[r] = (cb + 32 <= dq) ? p1[r] : -__builtin_inff();
                }
                bf16x8 pb[4];
                softmax_step(p0, p1, m, l, o, c2, pb);
                pv_tile(o, lds + ATT_VOFF + (it & 1) * ATT_V_BYTES + vl_off, pb);
            }
            if (jn < 128) { lstoreK((it + 1) & 1); lstoreV((it + 1) & 1); }
            __syncthreads();
            j = jn; ++it;
        }
    }
    nsa_emit<1>(o, (l > 0.f) ? ABL_NS * gt[1] / l : 0.f, acc_row, o_row, hi);

    const bf16_t* kw0 = NS + tokb * NSA_IN + 3072 + g * 128;
    const bf16_t* vw0 = NS + tokb * NSA_IN + 3328 + g * 128;
    zero_o(); m = -1e30f; l = 0.f;
    {
        const int kt_lo = (t0 >= 511) ? ((t0 - 511) >> 6) : 0, kt_hi = t0 >> 6;
        gloadK(kw0 + (size_t)kt_lo * 64 * NSA_IN, false); gloadV(vw0 + (size_t)kt_lo * 64 * NSA_IN, false); lstoreK(0); lstoreV(0);
        __syncthreads();
        int it = 0;
        for (int kt = kt_lo; kt <= kt_hi; ++kt, ++it) {
            if (kt < kt_hi) { gloadK(kw0 + (size_t)(kt + 1) * 64 * NSA_IN, false); gloadV(vw0 + (size_t)(kt + 1) * 64 * NSA_IN, false); }
            {
                f32x16 p0, p1;
                qk_tile<8, KSTR128>(p0, p1, lds + ATT_KOFF + (it & 1) * ATT_K_BYTES + kl_off, qr);
                const int dq = t - kt * 64 - 4 * hi;
#pragma unroll
                for (int r = 0; r < 16; ++r) {
                    const int cb = (r & 3) + 8 * (r >> 2);
                    p0[r] = ((unsigned)(dq - cb) < 512u) ? p0[r] : -__builtin_inff();
                    p1[r] = ((unsigned)(dq - cb - 32) < 512u) ? p1[r] : -__builtin_inff();
                }
                bf16x8 pb[4];
                softmax_step(p0, p1, m, l, o, c2, pb);
                pv_tile(o, lds + ATT_VOFF + (it & 1) * ATT_V_BYTES + vl_off, pb);
            }
            if (kt < kt_hi) { lstoreK((it + 1) & 1); lstoreV((it + 1) & 1); }
            __syncthreads();
        }
    }
    nsa_emit<2>(o, (l > 0.f) ? ABL_NW * gt[2] / l : 0.f, acc_row, o_row, hi);
}

__device__ __forceinline__ void phase_nsa(const Args& A, unsigned char* lds, int bid, int nb) {
    for (int u = bid; u < 1024; u += nb) {
        const int tt = 255 - (u >> 2), bg = u & 3;
        nsa_item(A, lds, bg >> 1, bg & 1, tt);
    }
}
constexpr int N_PHASES = 20;
#ifndef ABL_M0
#define ABL_M0 1.f
#endif
#ifndef ABL_M1
#define ABL_M1 1.f
#endif
#ifndef ABL_P0
#define ABL_P0 1.f
#endif
#ifndef ABL_P1
#define ABL_P1 1.f
#endif
__global__ void __launch_bounds__(NTHREADS, 2) fwd_kernel(Args a) {
    extern __shared__ __attribute__((aligned(16))) unsigned char lds[];
    const int bid = blockIdx.x, nb = gridDim.x;
    const bool multi = (a.ph_hi - a.ph_lo) > 1;
    XcdBarrier bar; bar.bar = (unsigned*)(a.ws + WS_CTL); bar.x = 0; bar.st = (volatile LAS unsigned*)(lds + LDS_BARW2);
    if (multi) {
        if (threadIdx.x == 0) *(uint4*)(lds + LDS_BARW2) = make_uint4(0u, 0u, 0u, 0u);
        __syncthreads();
        bar = xcd_barrier_post((unsigned*)(a.ws + WS_CTL), (volatile LAS unsigned*)(lds + LDS_BARW2));
    }
#ifdef ONLY
#define IN(k) ((k) == ONLY && a.ph_lo <= (k) && (k) < a.ph_hi)
#else
#define IN(k) (a.ph_lo <= (k) && (k) < a.ph_hi)
#endif
#define SEAM(k) do { if (IN(k) && IN((k) + 1)) xcd_barrier(bar); } while (0)
    unsigned char* ws = WSP(a);
    const float* MOD = (const float*)(ws + WS_MOD);
    bf16_t* H = (bf16_t*)(ws + WS_H); bf16_t* BIG = (bf16_t*)(ws + WS_BIG); bf16_t* Ob = (bf16_t*)(ws + WS_O);
    float* XA = (float*)(ws + WS_XA); float* XB = (float*)(ws + WS_XB);

    if (IN(0)) phase_prologue(a, lds, bid, nb);
    SEAM(0);
    if (IN(1)) phase_modnorm(a, a.in[0], a.in[3], 0, bid, nb);
    SEAM(1);
    if (IN(2)) gemm256_phase(lds, H, 2048, (const bf16_t*)(ws + WS_WIN0), 2048, T, SBMLA_IN_PAD, 2048, EpiBf16{BIG, SBMLA_IN, SBMLA_IN}, bid, nb);
    SEAM(2);
    if (IN(3)) phase_mla_prep(a, bid, nb);
    SEAM(3);
    if (IN(4)) {
        gemm256_phase(lds, (const bf16_t*)(ws + WS_CQN), 512, (const bf16_t*)(ws + WS_WUQ), 512, T, 1536, 512, EpiMlaQ{(bf16_t*)(ws + WS_QM), (const f32x2*)(ws + WS_ROPE64)}, bid, nb);
        gemm256_phase(lds, (const bf16_t*)(ws + WS_CKVN), 256, (const bf16_t*)(ws + WS_WUKV), 256, T, 2048, 256, EpiBf16{(bf16_t*)(ws + WS_KVM), KVM_LD, 2048}, bid, nb);
    }
    SEAM(4);
    if (IN(5)) phase_attn0(a, lds, bid, nb);
    SEAM(5);
    if (IN(6)) gemm256_phase(lds, Ob, 2048, (const bf16_t*)(ws + WS_WOUT0), 2048, T, 2048, 2048, EpiResid{a.in[0], XA, MOD + 0 * 2 * 6144 + 4096, ABL_M0}, bid, nb);
    SEAM(6);
    if (IN(7)) phase_modnorm(a, XA, a.in[20], 1, bid, nb);
    SEAM(7);
    if (IN(8)) gemm256_phase(lds, H, 2048, (const bf16_t*)(ws + WS_WPQ), 2048, T, 2048, 2048, EpiBf16{(bf16_t*)(ws + WS_PQ), 2048, 2048}, bid, nb);
    SEAM(8);
    if (IN(9)) phase_topk(a, lds, 0, bid, nb);
    SEAM(9);
    if (IN(10)) phase_gather<false>(a, 0, XA, XB, 1, a.in[3] + 2048, 2, ABL_P0, bid, nb);
    SEAM(10);
    if (IN(11)) gemm256_phase(lds, H, 2048, (const bf16_t*)(ws + WS_WNSAIN), 2048, T, NSA_IN_PAD, 2048, EpiNsaIn{BIG, (const f32x2*)(ws + WS_ROPE32)}, bid, nb);
    SEAM(11);
    if (IN(12)) {
        gemm_phase(lds, ALoadCmp{BIG, NSA_IN, 2048}, (const bf16_t*)(ws + WS_W1K), 4096, 2048, 256, 4096, EpiCmpHid{(bf16_t*)(ws + WS_HID), (const float*)(ws + WS_BIASP)}, bid, nb);
        gemm_phase(lds, ALoadCmp{BIG, NSA_IN, 2304}, (const bf16_t*)(ws + WS_W1V), 4096, 2048, 256, 4096, EpiCmpHid{(bf16_t*)(ws + WS_HID) + 2048 * 256, (const float*)(ws + WS_BIASP) + 32 * 256}, bid, nb);
    }
    SEAM(12);
    if (IN(13)) {
        gemm_phase(lds, ALoadPlain{(const bf16_t*)(ws + WS_HID), 256}, (const bf16_t*)(ws + WS_W2K), 256, 2048, 128, 256, EpiCmpOut{(bf16_t*)(ws + WS_KCC)}, bid, nb);
        gemm_phase(lds, ALoadPlain{(const bf16_t*)(ws + WS_HID) + 2048 * 256, 256}, (const bf16_t*)(ws + WS_W2V), 256, 2048, 128, 256, EpiCmpOut{(bf16_t*)(ws + WS_VCC)}, bid, nb);
    }
    SEAM(13);
    if (IN(14)) phase_nsa(a, lds, bid, nb);
    SEAM(14);
    if (IN(15)) gemm256_phase(lds, Ob, 2048, (const bf16_t*)(ws + WS_WNSAOUT), 2048, T, 2048, 2048, EpiResid{XB, XA, MOD + 2 * 2 * 6144 + 4096, ABL_M1}, bid, nb);
    SEAM(15);
    if (IN(16)) phase_modnorm(a, XA, a.in[20] + 2048, 3, bid, nb);
    SEAM(16);
    if (IN(17)) gemm256_phase(lds, H, 2048, (const bf16_t*)(ws + WS_WPQ) + (size_t)2048 * 2048, 2048, T, 2048, 2048, EpiBf16{(bf16_t*)(ws + WS_PQ), 2048, 2048}, bid, nb);
    SEAM(17);
    if (IN(18)) phase_topk(a, lds, 1, bid, nb);
    SEAM(18);
    if (IN(19)) phase_gather<true>(a, 1, XA, a.out, 3, a.in[28], 0, ABL_P1, bid, nb);
    if (a.ph_lo == 99) {
        const bf16_t* raw = (const bf16_t*)(ws + (size_t)a.ph_hi * 16384);
        for (size_t i = (size_t)bid * NTHREADS + threadIdx.x; i < (size_t)T * 2048; i += (size_t)nb * NTHREADS) a.out[i] = bf2f(raw[i]);
    }
#undef IN
#undef SEAM
}

#ifndef MK_ONE_LAUNCH
#define MK_ONE_LAUNCH 0
#endif
extern "C" void kernel_launch(void* const* d_in, const int* in_sizes, int n_in, void* d_out, int out_size, void* d_ws, size_t ws_size, hipStream_t stream) {
    static int grid = 0;
    if (grid == 0) {
        if (n_in != 29 || out_size != T * D_MODEL || ws_size < WS_END) { fprintf(stderr, "kernel_launch: unexpected shapes (n_in %d out %d ws %zu need %zu)\n", n_in, out_size, ws_size, (size_t)WS_END); grid = -1; return; }
        int dev = 0, cus = 0, per_cu = 0;
        if (hipGetDevice(&dev) != hipSuccess || hipDeviceGetAttribute(&cus, hipDeviceAttributeMultiprocessorCount, dev) != hipSuccess) { grid = -1; return; }
        if (hipFuncSetAttribute((const void*)fwd_kernel, hipFuncAttributeMaxDynamicSharedMemorySize, LDS_TOTAL) != hipSuccess) { fprintf(stderr, "kernel_launch: hipFuncSetAttribute failed\n"); grid = -1; return; }
        if (hipOccupancyMaxActiveBlocksPerMultiprocessor(&per_cu, (const void*)fwd_kernel, NTHREADS, LDS_TOTAL) != hipSuccess || per_cu < 1) { fprintf(stderr, "kernel_launch: occupancy query says %d\n", per_cu); }
        (void)hipGetLastError();
        grid = cus;
    }
    if (grid < 0) return;
    (void)hipMemsetAsync((char*)d_ws + WS_CTL, 0, 16384, stream);
    Args a{};
    for (int i = 0; i < 29; ++i) a.in[i] = (const float*)d_in[i];
    a.out = (float*)d_out; a.ws = (unsigned char*)d_ws;
#if MK_ONE_LAUNCH
    a.ph_lo = 0; a.ph_hi = N_PHASES;
    hipLaunchKernelGGL(fwd_kernel, dim3(grid), dim3(NTHREADS), LDS_TOTAL, stream, a);
#else
#ifdef DBG_UPTO
    for (int p = 0; p <= DBG_UPTO; ++p) {
        a.ph_lo = p; a.ph_hi = p + 1;
        hipLaunchKernelGGL(fwd_kernel, dim3(grid), dim3(NTHREADS), LDS_TOTAL, stream, a);
    }
    a.ph_lo = 99; a.ph_hi = (int)(DBG_OFF / 16384);
    hipLaunchKernelGGL(fwd_kernel, dim3(grid), dim3(NTHREADS), LDS_TOTAL, stream, a);
#else
    for (int p = 0; p < N_PHASES; ++p) {
        a.ph_lo = p; a.ph_hi = p + 1;
        hipLaunchKernelGGL(fwd_kernel, dim3(grid), dim3(NTHREADS), LDS_TOTAL, stream, a);
#ifdef REPEAT_LIST
        { const int rl[] = REPEAT_LIST; for (int q : rl) if (q == p) hipLaunchKernelGGL(fwd_kernel, dim3(grid), dim3(NTHREADS), LDS_TOTAL, stream, a); }
#endif
    }
#endif
#endif
}
```

```cpp
#define MK_ONE_LAUNCH 1
#include <hip/hip_runtime.h>
#include <stdint.h>
#include <stdio.h>

typedef unsigned short bf16_t;
typedef short bf16x8 __attribute__((ext_vector_type(8)));
typedef short s16x4 __attribute__((ext_vector_type(4)));
typedef float f32x16 __attribute__((ext_vector_type(16)));
typedef float f32x4 __attribute__((ext_vector_type(4)));
typedef float f32x2 __attribute__((ext_vector_type(2)));
typedef unsigned u32x4 __attribute__((ext_vector_type(4)));
typedef unsigned u32x2 __attribute__((ext_vector_type(2)));
typedef __bf16 bf16x2_t __attribute__((ext_vector_type(2)));
#define LAS __attribute__((address_space(3)))

constexpr int D_MODEL = 2048, BATCH = 2, SEQ = 8192, T = BATCH * SEQ;
constexpr float EPS = 1e-6f;
constexpr int SBMLA_IN = 3904, SBMLA_IN_PAD = 4096;
constexpr int NSA_IN = 3632, NSA_IN_PAD = 3840;
constexpr int NCMP = 511, NCMP_PAD = 512;
constexpr int NTHREADS = 512, NWAVES = 8;
constexpr int KVM_LD = 2112;

constexpr size_t al256(size_t x) { return (x + 255) & ~(size_t)255; }
constexpr size_t WS_CTL   = 0;
constexpr size_t WS_MOD   = 16384;
constexpr size_t WS_BIASP = WS_MOD + al256((size_t)4 * 2 * 6144 * 4);
constexpr size_t WS_ROPE64 = WS_BIASP + al256((size_t)2 * 32 * 256 * 4);
constexpr size_t WS_ROPE32 = WS_ROPE64 + (size_t)T * 32 * 8;
constexpr size_t WS_WIN0  = WS_ROPE32 + (size_t)T * 16 * 8;
constexpr size_t WS_WUQ   = WS_WIN0 + (size_t)SBMLA_IN_PAD * 2048 * 2;
constexpr size_t WS_WUKV  = WS_WUQ + (size_t)1536 * 512 * 2;
constexpr size_t WS_WOUT0 = WS_WUKV + (size_t)2048 * 256 * 2;
constexpr size_t WS_WNSAIN = WS_WOUT0 + (size_t)2048 * 2048 * 2;
constexpr size_t WS_W1K   = WS_WNSAIN + (size_t)NSA_IN_PAD * 2048 * 2;
constexpr size_t WS_W1V   = WS_W1K + (size_t)256 * 4096 * 2;
constexpr size_t WS_W2K   = WS_W1V + (size_t)256 * 4096 * 2;
constexpr size_t WS_W2V   = WS_W2K + (size_t)128 * 256 * 2;
constexpr size_t WS_WNSAOUT = WS_W2V + (size_t)128 * 256 * 2;
constexpr size_t WS_WPQ   = WS_WNSAOUT + (size_t)2048 * 2048 * 2;
constexpr size_t WS_K12   = WS_WPQ + (size_t)2 * 2048 * 2048 * 2;
constexpr size_t WS_PU    = WS_K12 + (size_t)4 * 128 * 128 * 2;
constexpr size_t WS_PV    = WS_PU + (size_t)2 * 16384 * 2048;
constexpr size_t WS_H     = WS_PV + (size_t)2 * 16384 * 2048;
constexpr size_t WS_BIG   = WS_H + (size_t)T * 2048 * 2;
constexpr size_t WS_O     = WS_BIG + (size_t)T * SBMLA_IN * 2;
constexpr size_t WS_XA    = WS_O + (size_t)T * 2048 * 2;
constexpr size_t WS_XB    = WS_XA + (size_t)T * 2048 * 4;
constexpr size_t WS_CQN   = WS_XA;
constexpr size_t WS_CKVN  = WS_CQN + (size_t)T * 512 * 2;
constexpr size_t WS_OACC  = WS_XA;
constexpr size_t WS_QM    = WS_XB;
constexpr size_t WS_KVM   = WS_QM + (size_t)T * 1536 * 2;
constexpr size_t WS_PQ    = WS_XB;
static_assert((size_t)T * 1536 * 2 + (size_t)T * KVM_LD * 2 <= (size_t)T * 2048 * 4, "QM + KVM must fit the XB region");
constexpr size_t WS_EXI   = WS_XB + (size_t)T * 2048 * 4;
constexpr size_t WS_EXG   = WS_EXI + (size_t)T * 128 * 4;
constexpr size_t WS_HID   = WS_EXG + (size_t)T * 128 * 4;
constexpr size_t WS_KCC   = WS_HID + (size_t)2 * 2048 * 256 * 2;
constexpr size_t WS_VCC   = WS_KCC + (size_t)BATCH * NCMP_PAD * 2 * 128 * 2;
constexpr size_t WS_END   = WS_VCC + (size_t)BATCH * NCMP_PAD * 2 * 128 * 2;

struct Args {
    const float* in[29];
    float* out;
    unsigned char* ws;
    int ph_lo, ph_hi;
};

__device__ __forceinline__ unsigned cvtpk(float lo, float hi) {
    bf16x2_t v = {(__bf16)lo, (__bf16)hi};
    return __builtin_bit_cast(unsigned, v);
}
__device__ __forceinline__ float bf2f(unsigned short h) { return __uint_as_float(((unsigned)h) << 16); }
__device__ __forceinline__ float bflo(unsigned w) { return __uint_as_float(w << 16); }
__device__ __forceinline__ float bfhi(unsigned w) { return __uint_as_float(w & 0xFFFF0000u); }
__device__ __forceinline__ int crow(int r, int hi) { return (r & 3) + 8 * (r >> 2) + 4 * hi; }
__device__ __forceinline__ float wave_sum(float v) {
#pragma unroll
    for (int o = 32; o >= 1; o >>= 1) v += __shfl_xor(v, o);
    return v;
}
__device__ __forceinline__ float gelu_tanh(float x) {
    const float u = 0.7978845608028654f * (x + 0.044715f * x * x * x);
    const float e = __expf(2.f * u);
    const float th = 1.f - 2.f / (e + 1.f);
    return 0.5f * x * (1.f + th);
}
__device__ __forceinline__ int opaque_tid() { int t = threadIdx.x; asm volatile("" : "+v"(t)); return t; }
__device__ __forceinline__ unsigned char* WSP(const Args& A) {
    size_t z = 0; asm volatile("" : "+s"(z));
    return A.ws + z;
}
#ifndef ABL_SB
#define ABL_SB 1.f
#endif
#ifndef ABL_MLA
#define ABL_MLA 1.f
#endif
#ifndef ABL_NC
#define ABL_NC 1.f
#endif
#ifndef ABL_NS
#define ABL_NS 1.f
#endif
#ifndef ABL_NW
#define ABL_NW 1.f
#endif
#define XB_TMO      128
#define XB_XCNT(j)  (256  + 64 * (j))
#define XB_XSUB(j)  (1280 + 64 * (j))
#define XB_XGEN(j)  (2304 + 64 * (j))
#define XB_TOP      3328
#define XB_TOPGEN   3392
#define XCD_BAR_WORDS 3456
#define XB_SPIN_CAP (1u << 18)
#define LAS __attribute__((address_space(3)))

__device__ __forceinline__ unsigned xb_ld(unsigned* p)              { return __hip_atomic_load(p, __ATOMIC_RELAXED, __HIP_MEMORY_SCOPE_AGENT); }
__device__ __forceinline__ unsigned xb_add(unsigned* p, unsigned v) { return __hip_atomic_fetch_add(p, v, __ATOMIC_RELAXED, __HIP_MEMORY_SCOPE_AGENT); }
__device__ __forceinline__ unsigned xb_xcc_id() { return (unsigned)__builtin_amdgcn_s_getreg((3 << 11) | 20) & 0xFu; }
#define XB_SPIN(cond, bar) do { unsigned _sp = 0; while (cond) { __builtin_amdgcn_s_sleep(1); \
    if ((++_sp & 255u) == 0u) { if (xb_ld(&(bar)[XB_TMO])) break; if (_sp > XB_SPIN_CAP) { atomicAdd(&(bar)[XB_TMO], 1u); break; } } } } while (0)

struct XcdBarrier {
    unsigned* bar; unsigned x;
    volatile LAS unsigned* st;
};

__device__ __forceinline__ XcdBarrier xcd_barrier_post(unsigned* bar, volatile LAS unsigned* st) {
    XcdBarrier b; b.bar = bar; b.x = xb_xcc_id(); b.st = st;
    if (threadIdx.x == 0) (void)xb_add(&bar[XB_XCNT(b.x)], 1u);
    return b;
}
__device__ __forceinline__ void xcd_barrier_complete(unsigned* bar, unsigned x, unsigned& nloc, unsigned& nx) {
    const unsigned G = gridDim.x * gridDim.y * gridDim.z;
    unsigned sum, cnt, mine, sp = 0u;
    for (;;) {
        sum = 0u; cnt = 0u; mine = 0u;
#pragma unroll
        for (unsigned j = 0; j < 16; ++j) { const unsigned c = xb_ld(&bar[XB_XCNT(j)]); sum += c; cnt += (c > 0u) ? 1u : 0u; mine = (j == x) ? c : mine; }
        if (sum == G) break;
        __builtin_amdgcn_s_sleep(1);
        if ((++sp & 255u) == 0u) { if (xb_ld(&bar[XB_TMO])) break; if (sp > XB_SPIN_CAP) { atomicAdd(&bar[XB_TMO], 1u); break; } }
    }
    nloc = mine > 0u ? mine : 1u; nx = cnt > 0u ? cnt : 1u;
}

__device__ __forceinline__ void xcd_barrier(const XcdBarrier& b) {
    asm volatile("s_waitcnt vmcnt(0)" ::: "memory");
    __syncthreads();
    if (threadIdx.x == 0) {
        unsigned* bar = b.bar;
        __builtin_amdgcn_s_waitcnt(0);
        unsigned nloc = b.st[0], nx = b.st[1];
        if (nloc == 0u) { xcd_barrier_complete(bar, b.x, nloc, nx); b.st[0] = nloc; b.st[1] = nx; }
        const unsigned old = xb_add(&bar[XB_XSUB(b.x)], 1u);
        const unsigned gen = old / nloc;
        if (old + 1u == (gen + 1u) * nloc) {
            __builtin_amdgcn_fence(__ATOMIC_RELEASE, "agent");
            asm volatile("s_waitcnt vmcnt(0)" ::: "memory");
            const unsigned og = xb_add(&bar[XB_TOP], 1u);
            const unsigned tg = og / nx;
            if (og + 1u == (tg + 1u) * nx) xb_add(&bar[XB_TOPGEN], 1u);
            else XB_SPIN(xb_ld(&bar[XB_TOPGEN]) == tg, bar);
            __builtin_amdgcn_fence(__ATOMIC_ACQUIRE, "agent");
            xb_add(&bar[XB_XGEN(b.x)], 1u);
            asm volatile("s_waitcnt vmcnt(0)" ::: "memory");
        } else {
            XB_SPIN(xb_ld(&bar[XB_XGEN(b.x)]) == gen, bar);
            __builtin_amdgcn_fence(__ATOMIC_ACQUIRE, "agent");
            asm volatile("s_waitcnt vmcnt(0)" ::: "memory");
        }
    }
    __syncthreads();
}
constexpr int U0_MOD = 192, U0_TR = 8912, U0_PEER = 2048, U0_ROPE = 192, U0_BIAS = 64, U0_K12 = 8, U0_ZERO = 8;
constexpr int U0_TOTAL = U0_MOD + U0_TR + U0_PEER + U0_ROPE + U0_BIAS + U0_K12 + U0_ZERO;

struct TrDesc { int in_idx; size_t in_off; int K, N, Npad; size_t ws_off; int ntiles; };
__device__ __forceinline__ TrDesc tr_desc(int m) {
    switch (m) {
        case 0:  return TrDesc{6, 0, 2048, 3904, 4096, WS_WIN0, 2048};
        case 1:  return TrDesc{8, 0, 512, 1536, 1536, WS_WUQ, 192};
        case 2:  return TrDesc{10, 0, 256, 2048, 2048, WS_WUKV, 128};
        case 3:  return TrDesc{11, 0, 2048, 2048, 2048, WS_WOUT0, 1024};
        case 4:  return TrDesc{12, 0, 2048, 3632, 3840, WS_WNSAIN, 1920};
        case 5:  return TrDesc{15, 0, 4096, 256, 256, WS_W1K, 256};
        case 6:  return TrDesc{17, 0, 4096, 256, 256, WS_W1V, 256};
        case 7:  return TrDesc{16, 0, 256, 128, 128, WS_W2K, 8};
        case 8:  return TrDesc{18, 0, 256, 128, 128, WS_W2V, 8};
        case 9:  return TrDesc{19, 0, 2048, 2048, 2048, WS_WNSAOUT, 1024};
        case 10: return TrDesc{23, 0, 2048, 2048, 2048, WS_WPQ, 1024};
        default: return TrDesc{23, (size_t)2048 * 2048, 2048, 2048, 2048, WS_WPQ + (size_t)2048 * 2048 * 2, 1024};
    }
}

__device__ __forceinline__ void p0_mod_unit(const Args& A, unsigned char* lds, int u) {
    const int tid = opaque_tid();
    float* sc = (float*)lds;
    float* red = (float*)(lds + 16384);
    const int set = u / 48, cc = u % 48;
    const int layer = set >> 1, kind = set & 1;
    const float* w = (kind ? A.in[21] : A.in[4]) + (size_t)layer * 2048 * 6144;
    const float* bias = (kind ? A.in[22] : A.in[5]) + (size_t)layer * 6144;
    const float* c = A.in[1];
    for (int i = tid; i < 4096; i += NTHREADS) { const float v = c[i]; sc[i] = v / (1.f + __expf(-v)); }
    __syncthreads();
    const int l32 = tid & 31, kg = tid >> 5;
    const int col = cc * 128 + l32 * 4;
    float a0[4] = {0, 0, 0, 0}, a1[4] = {0, 0, 0, 0};
    const float* wp = w + (size_t)(kg * 128) * 6144 + col;
#pragma unroll 8
    for (int i = 0; i < 128; ++i) {
        const f32x4 wv = *(const f32x4*)(wp + (size_t)i * 6144);
        const float s0 = sc[kg * 128 + i], s1 = sc[2048 + kg * 128 + i];
#pragma unroll
        for (int j = 0; j < 4; ++j) { a0[j] += s0 * wv[j]; a1[j] += s1 * wv[j]; }
    }
#pragma unroll
    for (int j = 0; j < 4; ++j) { red[(kg * 2 + 0) * 128 + l32 * 4 + j] = a0[j]; red[(kg * 2 + 1) * 128 + l32 * 4 + j] = a1[j]; }
    __syncthreads();
    if (tid < 256) {
        const int b = tid >> 7, cl = tid & 127;
        float s = 0;
#pragma unroll
        for (int g = 0; g < 16; ++g) s += red[(g * 2 + b) * 128 + cl];
        float* mod = (float*)(WSP(A) + WS_MOD);
        mod[(size_t)(set * 2 + b) * 6144 + cc * 128 + cl] = s + bias[cc * 128 + cl];
    }
    __syncthreads();
}

__device__ __forceinline__ void p0_tr_unit(const Args& A, unsigned char* lds, int u) {
    const int tid = opaque_tid();
    int m = 0, tile = u;
    TrDesc d = tr_desc(0);
    while (tile >= d.ntiles) { tile -= d.ntiles; ++m; d = tr_desc(m); }
    const int nNt = d.Npad / 64;
    const int kt = tile / nNt, nt = tile % nNt;
    const float* src = A.in[d.in_idx] + d.in_off;
    bf16_t* dst = (bf16_t*)(WSP(A) + d.ws_off);
    float* ts = (float*)lds;
    {
        const int r = tid >> 3, cg = tid & 7;
        const int k = kt * 64 + r, n = nt * 64 + cg * 8;
        f32x4 v0 = {0, 0, 0, 0}, v1 = {0, 0, 0, 0};
        if (n < d.N) { const float* p = src + (size_t)k * d.N + n; v0 = *(const f32x4*)p; v1 = *(const f32x4*)(p + 4); }
#pragma unroll
        for (int j = 0; j < 4; ++j) { ts[r * 65 + cg * 8 + j] = v0[j]; ts[r * 65 + cg * 8 + 4 + j] = v1[j]; }
    }
    __syncthreads();
    {
        const int n = tid >> 3, kg = tid & 7;
        float v[8];
#pragma unroll
        for (int j = 0; j < 8; ++j) v[j] = ts[(kg * 8 + j) * 65 + n];
        u32x4 w = {cvtpk(v[0], v[1]), cvtpk(v[2], v[3]), cvtpk(v[4], v[5]), cvtpk(v[6], v[7])};
        *(u32x4*)(dst + (size_t)(nt * 64 + n) * d.K + kt * 64 + kg * 8) = w;
    }
    __syncthreads();
}

constexpr float PEER_USCALE = 64.f, PEER_VSCALE = 4.f;
__device__ __forceinline__ void p0_peer_unit(const Args& A, int u) {
    const int tid = opaque_tid();
    const bool isv = u >= 1024;
    const int pu = isv ? u - 1024 : u;
    const float sc = isv ? PEER_VSCALE : PEER_USCALE;
    const float* src = (isv ? A.in[27] : A.in[26]) + (size_t)pu * 65536;
    unsigned char* dst = WSP(A) + (isv ? WS_PV : WS_PU) + (size_t)pu * 65536;
#pragma unroll 2
    for (int it = 0; it < 8; ++it) {
        const int e = (it * NTHREADS + tid) * 16;
        u32x4 w;
#pragma unroll
        for (int q = 0; q < 4; ++q) {
            const f32x4 v = *(const f32x4*)(src + e + 4 * q);
            int pk = 0;
            pk = __builtin_amdgcn_cvt_pk_fp8_f32(v[0] * sc, v[1] * sc, pk, false);
            pk = __builtin_amdgcn_cvt_pk_fp8_f32(v[2] * sc, v[3] * sc, pk, true);
            w[q] = (unsigned)pk;
        }
        *(u32x4*)(dst + e) = w;
    }
}

__device__ __forceinline__ void p0_rope_unit(const Args& A, int u) {
    const int tid = opaque_tid();
    const int* pos = (const int*)A.in[2];
#pragma unroll 1
    for (int it = 0; it < 8; ++it) {
        const int e = u * 4096 + it * NTHREADS + tid;
        if (e < T * 32) {
            const int t = e >> 5, j = e & 31;
            const float inv = powf(500000.0f, -(float)j / 32.0f);
            const float ang = (float)pos[t] * inv;
            float s, c; sincosf(ang, &s, &c);
            ((f32x2*)(WSP(A) + WS_ROPE64))[e] = f32x2{c, s};
        } else {
            const int e2 = e - T * 32;
            const int t = e2 >> 4, j = e2 & 15;
            const float inv = powf(500000.0f, -(float)j / 16.0f);
            const float ang = (float)pos[t] * inv;
            float s, c; sincosf(ang, &s, &c);
            ((f32x2*)(WSP(A) + WS_ROPE32))[e2] = f32x2{c, s};
        }
    }
}

__device__ __forceinline__ void p0_bias_unit(const Args& A, unsigned char* lds, int u) {
    const int tid = opaque_tid();
    const int mat = u >> 5, chunk = u & 31;
    const float* pe = A.in[mat ? 14 : 13];
    const float* w1 = A.in[mat ? 17 : 15];
    const int col = tid & 255, half = tid >> 8;
    float acc = 0;
    const int r0 = chunk * 128 + half * 64;
#pragma unroll 8
    for (int i = 0; i < 64; ++i) acc += pe[r0 + i] * w1[(size_t)(r0 + i) * 256 + col];
    float* red = (float*)lds;
    if (half) red[col] = acc;
    __syncthreads();
    if (!half) ((float*)(WSP(A) + WS_BIASP))[(mat * 32 + chunk) * 256 + col] = acc + red[col];
    __syncthreads();
}

__device__ __forceinline__ void p0_k12_unit(const Args& A, int u) {
    const int tid = opaque_tid();
    bf16_t* dst = (bf16_t*)(WSP(A) + WS_K12);
#pragma unroll
    for (int it = 0; it < 2; ++it) {
        const int e = u * 8192 + (it * NTHREADS + tid) * 8;
        const int layer = e >> 15, which = (e >> 14) & 1, rem = e & 16383;
        const float* src = A.in[which ? 25 : 24] + layer * 16384 + rem;
        const f32x4 v0 = *(const f32x4*)src, v1 = *(const f32x4*)(src + 4);
        u32x4 w = {cvtpk(v0[0], v0[1]), cvtpk(v0[2], v0[3]), cvtpk(v1[0], v1[1]), cvtpk(v1[2], v1[3])};
        *(u32x4*)(dst + e) = w;
    }
}

__device__ __forceinline__ void phase_prologue(const Args& A, unsigned char* lds, int bid, int nb) {
    for (int u = bid; u < U0_TOTAL; u += nb) {
        int v = u;
        if (v < U0_MOD) { p0_mod_unit(A, lds, v); continue; }
        v -= U0_MOD;
        if (v < U0_TR) { p0_tr_unit(A, lds, v); continue; }
        v -= U0_TR;
        if (v < U0_PEER) { p0_peer_unit(A, v); continue; }
        v -= U0_PEER;
        if (v < U0_ROPE) { p0_rope_unit(A, v); continue; }
        v -= U0_ROPE;
        if (v < U0_BIAS) { p0_bias_unit(A, lds, v); continue; }
        v -= U0_BIAS;
        if (v < U0_K12) { p0_k12_unit(A, v); continue; }
        v -= U0_K12;
        {
            u32x4* z = (u32x4*)(WSP(A) + WS_KCC) + (size_t)v * 8192;
            for (int i = opaque_tid(); i < 8192; i += NTHREADS) z[i] = u32x4{0u, 0u, 0u, 0u};
        }
    }
}

__device__ __forceinline__ void modnorm_row(const float* xr, const float* gain, const float* mod  , bf16_t* hr, int lane) {
    f32x4 v[8];
    float ss = 0;
#pragma unroll
    for (int i = 0; i < 8; ++i) { v[i] = *(const f32x4*)(xr + i * 256 + lane * 4); ss += v[i][0] * v[i][0] + v[i][1] * v[i][1] + v[i][2] * v[i][2] + v[i][3] * v[i][3]; }
    ss = wave_sum(ss);
    const float rinv = rsqrtf(ss * (1.0f / 2048.0f) + EPS);
#pragma unroll
    for (int i = 0; i < 8; ++i) {
        const int col = i * 256 + lane * 4;
        const f32x4 g = *(const f32x4*)(gain + col), sh = *(const f32x4*)(mod + col), scl = *(const f32x4*)(mod + 2048 + col);
        float y[4];
#pragma unroll
        for (int j = 0; j < 4; ++j) y[j] = v[i][j] * rinv * g[j] * (1.f + scl[j]) + sh[j];
        u32x2 w = {cvtpk(y[0], y[1]), cvtpk(y[2], y[3])};
        *(u32x2*)(hr + col) = w;
    }
}
__device__ __forceinline__ void phase_modnorm(const Args& A, const float* xin, const float* gain, int set, int bid, int nb) {
    const int tid = opaque_tid(), lane = tid & 63, wave = tid >> 6;
    const float* mod = (const float*)(WSP(A) + WS_MOD) + (size_t)set * 2 * 6144;
    bf16_t* H = (bf16_t*)(WSP(A) + WS_H);
    for (int u = bid; u < T / NWAVES; u += nb) {
        const int row = u * NWAVES + wave;
        modnorm_row(xin + (size_t)row * 2048, gain, mod + (row >> 13) * 6144, H + (size_t)row * 2048, lane);
    }
}

struct ALoadPlain {
    const bf16_t* A; int lda;
    __device__ __forceinline__ const bf16_t* ptr(int row, int k) const { return A + (size_t)row * lda + k; }
};
struct ALoadCmp {
    const bf16_t* base; int ld; int colbase;
    __device__ __forceinline__ const bf16_t* ptr(int row, int k) const {
        int r = row < 2 * BATCH * NCMP ? row : 2 * BATCH * NCMP - 1;
        const int g = r & 1; r >>= 1;
        const int b = r / NCMP, n = r - b * NCMP;
        const int l = k >> 7, d = k & 127;
        return base + (size_t)(b * SEQ + 16 * n + l) * ld + colbase + g * 128 + d;
    }
};

constexpr int GEMM_LDS = 98304;
template <class AL, class Epi>
__device__ __forceinline__ void gemm_phase(unsigned char* lds, const AL al, const bf16_t* __restrict__ Bt, int ldb, int M, int Npad, int K, const Epi epi, int bid, int nb) {
    const int tid = opaque_tid(), lane = tid & 63, wave = tid >> 6, l31 = lane & 31, hi = lane >> 5;
    const int wm = wave >> 1, wn = wave & 1;
    const int nNt = Npad / 128, nU = (M / 256) * nNt, nk = K / 64;
    const int swz = (l31 >> 1) & 7;
    for (int u = bid; u < nU; u += nb) {
        const int mt = u / nNt, nt = u - mt * nNt;
        const int m0 = mt * 256, n0 = nt * 128;
        f32x16 acc[2][2];
#pragma unroll
        for (int i = 0; i < 2; ++i)
#pragma unroll
            for (int j = 0; j < 2; ++j)
#pragma unroll
                for (int r = 0; r < 16; ++r) acc[i][j][r] = 0.f;
        u32x4 ra[4], rb[2];
        auto gload = [&](int kt) {
#pragma unroll
            for (int i = 0; i < 4; ++i) { const int q = tid + NTHREADS * i, row = q >> 3, c = q & 7; ra[i] = *(const u32x4*)al.ptr(m0 + row, kt * 64 + c * 8); }
#pragma unroll
            for (int i = 0; i < 2; ++i) { const int q = tid + NTHREADS * i, row = q >> 3, c = q & 7; rb[i] = *(const u32x4*)(Bt + (size_t)(n0 + row) * ldb + kt * 64 + c * 8); }
        };
        auto lstore = [&](int buf) {
            unsigned char* la = lds + buf * 32768; unsigned char* lb = lds + 65536 + buf * 16384;
#pragma unroll
            for (int i = 0; i < 4; ++i) { const int q = tid + NTHREADS * i, row = q >> 3, c = q & 7; *(u32x4*)(la + row * 128 + ((c ^ ((row >> 1) & 7)) << 4)) = ra[i]; }
#pragma unroll
            for (int i = 0; i < 2; ++i) { const int q = tid + NTHREADS * i, row = q >> 3, c = q & 7; *(u32x4*)(lb + row * 128 + ((c ^ ((row >> 1) & 7)) << 4)) = rb[i]; }
        };
        gload(0); lstore(0); __syncthreads();
        for (int kt = 0; kt < nk; ++kt) {
            if (kt + 1 < nk) gload(kt + 1);
            const unsigned char* la = lds + (kt & 1) * 32768 + (wm * 64 + l31) * 128;
            const unsigned char* lb = lds + 65536 + (kt & 1) * 16384 + (wn * 64 + l31) * 128;
#pragma unroll
            for (int ks = 0; ks < 4; ++ks) {
                const int co = ((ks * 2 + hi) ^ swz) << 4;
                const bf16x8 a0 = *(const bf16x8*)(la + co), a1 = *(const bf16x8*)(la + 32 * 128 + co);
                const bf16x8 b0 = *(const bf16x8*)(lb + co), b1 = *(const bf16x8*)(lb + 32 * 128 + co);
                acc[0][0] = __builtin_amdgcn_mfma_f32_32x32x16_bf16(a0, b0, acc[0][0], 0, 0, 0);
                acc[0][1] = __builtin_amdgcn_mfma_f32_32x32x16_bf16(a0, b1, acc[0][1], 0, 0, 0);
                acc[1][0] = __builtin_amdgcn_mfma_f32_32x32x16_bf16(a1, b0, acc[1][0], 0, 0, 0);
                acc[1][1] = __builtin_amdgcn_mfma_f32_32x32x16_bf16(a1, b1, acc[1][1], 0, 0, 0);
            }
            if (kt + 1 < nk) lstore((kt + 1) & 1);
            __syncthreads();
        }
        epi.template operator()<2>(acc, m0 + wm * 64, n0 + wn * 64, lane);
    }
}

constexpr int GEMM256_LDS = 131072;
template <class Epi>
__device__ __forceinline__ void gemm256_phase(unsigned char* lds, const bf16_t* __restrict__ Ag, int lda, const bf16_t* __restrict__ Bt, int ldb, int M, int Npad, int K, const Epi epi, int bid, int nb) {
    const int tid = opaque_tid(), lane = tid & 63, wave = __builtin_amdgcn_readfirstlane(tid >> 6), l31 = lane & 31, hi = lane >> 5;
    const int wm = wave >> 2, wn = wave & 3;
    const int nNt = Npad / 256, nU = (M / 256) * nNt, nk = K / 64;
    const int swz = (l31 >> 1) & 7;
    unsigned aoff[4], boff[4];
#pragma unroll
    for (int i = 0; i < 4; ++i) {
        const int row = (wave * 4 + i) * 8 + (lane >> 3), c = (lane & 7) ^ ((row >> 1) & 7);
        aoff[i] = (unsigned)(row * lda + c * 8) * 2u; boff[i] = (unsigned)(row * ldb + c * 8) * 2u;
    }
    const int vcu = (nb % 8 == 0) ? (bid % 8) * (nb / 8) + bid / 8 : bid;
    for (int u = vcu; u < nU; u += nb) {
        const int mt = u / nNt, nt = u - mt * nNt;
        const int m0 = mt * 256, n0 = nt * 256;
        const unsigned char* abase = (const unsigned char*)(Ag + (size_t)m0 * lda);
        const unsigned char* bbase = (const unsigned char*)(Bt + (size_t)n0 * ldb);
        f32x16 acc[4][2];
#pragma unroll
        for (int i = 0; i < 4; ++i)
#pragma unroll
            for (int j = 0; j < 2; ++j)
#pragma unroll
                for (int r = 0; r < 16; ++r) acc[i][j][r] = 0.f;
        auto issue = [&](int kt, int stage) {
            unsigned char* la = lds + stage * 65536 + wave * 4096; unsigned char* lb = la + 32768;
#pragma unroll
            for (int i = 0; i < 4; ++i) {
                __builtin_amdgcn_global_load_lds((const unsigned*)(abase + aoff[i] + kt * 128), (unsigned*)(la + i * 1024), 16, 0, 0);
                __builtin_amdgcn_global_load_lds((const unsigned*)(bbase + boff[i] + kt * 128), (unsigned*)(lb + i * 1024), 16, 0, 0);
            }
        };
        issue(0, 0);
        asm volatile("s_waitcnt vmcnt(0)" ::: "memory");
        __syncthreads();
        for (int kt = 0; kt < nk; ++kt) {
            if (kt + 1 < nk) issue(kt + 1, (kt + 1) & 1);
            const unsigned char* la = lds + (kt & 1) * 65536 + (wm * 128 + l31) * 128;
            const unsigned char* lb = lds + (kt & 1) * 65536 + 32768 + (wn * 64 + l31) * 128;
#pragma unroll
            for (int ks = 0; ks < 4; ++ks) {
                const int co = ((ks * 2 + hi) ^ swz) << 4;
                const bf16x8 b0 = *(const bf16x8*)(lb + co), b1 = *(const bf16x8*)(lb + 32 * 128 + co);
#pragma unroll
                for (int mi = 0; mi < 4; ++mi) {
                    const bf16x8 a = *(const bf16x8*)(la + mi * 32 * 128 + co);
                    acc[mi][0] = __builtin_amdgcn_mfma_f32_32x32x16_bf16(a, b0, acc[mi][0], 0, 0, 0);
                    acc[mi][1] = __builtin_amdgcn_mfma_f32_32x32x16_bf16(a, b1, acc[mi][1], 0, 0, 0);
                }
            }
            asm volatile("s_waitcnt vmcnt(0)" ::: "memory");
            __syncthreads();
        }
        epi.template operator()<4>(acc, m0 + wm * 128, n0 + wn * 64, lane);
    }
}

template <int MI>
__device__ __forceinline__ void store_bf16_tile(const f32x16 (&acc)[MI][2], bf16_t* C, int ldc, int N, int row0, int col0, int lane) {
    const int l31 = lane & 31, hi = lane >> 5;
#pragma unroll
    for (int ni = 0; ni < 2; ++ni) {
        const int col = col0 + ni * 32 + l31;
#pragma unroll
        for (int mi = 0; mi < MI; ++mi)
#pragma unroll
            for (int r = 0; r < 16; ++r) {
                const float v = acc[mi][ni][r];
                const float vn = __shfl_xor(v, 1);
                if ((l31 & 1) == 0 && col < N) *(unsigned*)(C + (size_t)(row0 + mi * 32 + crow(r, hi)) * ldc + col) = cvtpk(v, vn);
            }
    }
}
struct EpiBf16 {
    bf16_t* C; int ldc; int N;
    template <int MI> __device__ __forceinline__ void operator()(f32x16 (&acc)[MI][2], int row0, int col0, int lane) const { store_bf16_tile<MI>(acc, C, ldc, N, row0, col0, lane); }
};
struct EpiMlaQ {
    bf16_t* C; const f32x2* rope64;
    template <int MI> __device__ __forceinline__ void operator()(f32x16 (&acc)[MI][2], int row0, int col0, int lane) const {
        const int l31 = lane & 31, hi = lane >> 5;
        if ((col0 % 192) == 128) {
#pragma unroll
            for (int mi = 0; mi < MI; ++mi)
#pragma unroll
                for (int r = 0; r < 16; ++r) {
                    const int row = row0 + mi * 32 + crow(r, hi);
                    const f32x2 cs = rope64[(size_t)row * 32 + l31];
                    const float x1 = acc[mi][0][r], x2 = acc[mi][1][r];
                    acc[mi][0][r] = x1 * cs[0] - x2 * cs[1];
                    acc[mi][1][r] = x2 * cs[0] + x1 * cs[1];
                    if ((r & 3) == 3) __builtin_amdgcn_sched_barrier(0);
                }
        }
        store_bf16_tile<MI>(acc, C, 1536, 1536, row0, col0, lane);
    }
};
struct EpiNsaIn {
    bf16_t* C; const f32x2* rope32;
    template <int MI> __device__ __forceinline__ void operator()(f32x16 (&acc)[MI][2], int row0, int col0, int lane) const {
        const int l31 = lane & 31, hi = lane >> 5;
#pragma unroll
        for (int ni = 0; ni < 2; ++ni) {
            const int cb = col0 + ni * 32, hb = cb >> 7;
            const bool is_rope = ((cb & 127) == 0) && (hb < 18 || hb == 20 || hb == 21 || hb == 24 || hb == 25);
            if (is_rope) {
#pragma unroll
                for (int mi = 0; mi < MI; ++mi)
#pragma unroll
                    for (int r = 0; r < 16; ++r) {
                        const int row = row0 + mi * 32 + crow(r, hi);
                        const f32x2 cs = rope32[(size_t)row * 16 + (l31 & 15)];
                        const float own = acc[mi][ni][r];
                        const float oth = __shfl_xor(own, 16);
                        acc[mi][ni][r] = (l31 < 16) ? own * cs[0] - oth * cs[1] : own * cs[0] + oth * cs[1];
                    }
            }
            if (cb >= 3584) {
#pragma unroll
                for (int mi = 0; mi < MI; ++mi)
#pragma unroll
                    for (int r = 0; r < 16; ++r) acc[mi][ni][r] = 1.f / (1.f + __expf(-acc[mi][ni][r]));
            }
        }
        store_bf16_tile<MI>(acc, C, NSA_IN, NSA_IN, row0, col0, lane);
    }
};
struct EpiResid {
    const float* xin; float* xout; const float* gate; float gmul;
    template <int MI> __device__ __forceinline__ void operator()(f32x16 (&acc)[MI][2], int row0, int col0, int lane) const {
        const int l31 = lane & 31, hi = lane >> 5;
        const float* gp = gate + (row0 >> 13) * 6144 + col0 + l31;
        const float g0 = gp[0] * gmul, g1 = gp[32] * gmul;
        const size_t base = (size_t)(row0 + 4 * hi) * 2048 + col0 + l31;
#pragma unroll
        for (int mi = 0; mi < MI; ++mi) {
#pragma unroll
            for (int q = 0; q < 4; ++q) {
                float xv[8];
#pragma unroll
                for (int j = 0; j < 4; ++j) { const size_t o = base + (size_t)(mi * 32 + 8 * q + j) * 2048; xv[j] = xin[o]; xv[4 + j] = xin[o + 32]; }
#pragma unroll
                for (int j = 0; j < 4; ++j) { const size_t o = base + (size_t)(mi * 32 + 8 * q + j) * 2048; xout[o] = xv[j] + g0 * acc[mi][0][4 * q + j]; xout[o + 32] = xv[4 + j] + g1 * acc[mi][1][4 * q + j]; }
                __builtin_amdgcn_sched_barrier(0);
            }
        }
    }
};
struct EpiCmpHid {
    bf16_t* C; const float* biasp;
    template <int MI> __device__ __forceinline__ void operator()(f32x16 (&acc)[MI][2], int row0, int col0, int lane) const {
        const int l31 = lane & 31;
#pragma unroll
        for (int ni = 0; ni < 2; ++ni) {
            const int col = col0 + ni * 32 + l31;
            float b = 0;
#pragma unroll 8
            for (int c = 0; c < 32; ++c) b += biasp[c * 256 + col];
#pragma unroll
            for (int mi = 0; mi < MI; ++mi)
#pragma unroll
                for (int r = 0; r < 16; ++r) acc[mi][ni][r] = gelu_tanh(acc[mi][ni][r] + b);
        }
        store_bf16_tile<MI>(acc, C, 256, 256, row0, col0, lane);
    }
};
struct EpiCmpOut {
    bf16_t* C;
    template <int MI> __device__ __forceinline__ void operator()(f32x16 (&acc)[MI][2], int row0, int col0, int lane) const {
        const int l31 = lane & 31, hi = lane >> 5;
#pragma unroll
        for (int ni = 0; ni < 2; ++ni) {
            const int col = col0 + ni * 32 + l31;
#pragma unroll
            for (int mi = 0; mi < MI; ++mi)
#pragma unroll
                for (int r = 0; r < 16; ++r) {
                    const float v = acc[mi][ni][r];
                    const float vn = __shfl_xor(v, 1);
                    int rr = row0 + mi * 32 + crow(r, hi);
                    if ((l31 & 1) == 0 && rr < 2 * BATCH * NCMP) {
                        const int g = rr & 1; rr >>= 1;
                        const int b = rr / NCMP, n = rr - b * NCMP;
                        *(unsigned*)(C + (size_t)((b * NCMP_PAD + n) * 2 + g) * 128 + col) = cvtpk(v, vn);
                    }
                }
        }
    }
};

__device__ __forceinline__ void phase_mla_prep(const Args& A, int bid, int nb) {
    const int tid = opaque_tid(), lane = tid & 63, wave = tid >> 6;
    const bf16_t* BIG = (const bf16_t*)(WSP(A) + WS_BIG);
    bf16_t* CQN = (bf16_t*)(WSP(A) + WS_CQN); bf16_t* CKVN = (bf16_t*)(WSP(A) + WS_CKVN); bf16_t* KVM = (bf16_t*)(WSP(A) + WS_KVM);
    const f32x2* rope64 = (const f32x2*)(WSP(A) + WS_ROPE64);
    const float* qn = A.in[7]; const float* kvn = A.in[9];
    for (int u = bid; u < T / NWAVES; u += nb) {
        const int t = u * NWAVES + wave;
        const bf16_t* row = BIG + (size_t)t * SBMLA_IN;
        {
            const u32x4 w = *(const u32x4*)(row + 3072 + lane * 8);
            float x[8] = {bflo(w[0]), bfhi(w[0]), bflo(w[1]), bfhi(w[1]), bflo(w[2]), bfhi(w[2]), bflo(w[3]), bfhi(w[3])};
            float ss = 0;
#pragma unroll
            for (int j = 0; j < 8; ++j) ss += x[j] * x[j];
            ss = wave_sum(ss);
            const float rinv = rsqrtf(ss * (1.f / 512.f) + EPS);
            const f32x4 g0 = *(const f32x4*)(qn + lane * 8), g1 = *(const f32x4*)(qn + lane * 8 + 4);
            u32x4 o = {cvtpk(x[0] * rinv * g0[0], x[1] * rinv * g0[1]), cvtpk(x[2] * rinv * g0[2], x[3] * rinv * g0[3]),
                       cvtpk(x[4] * rinv * g1[0], x[5] * rinv * g1[1]), cvtpk(x[6] * rinv * g1[2], x[7] * rinv * g1[3])};
            *(u32x4*)(CQN + (size_t)t * 512 + lane * 8) = o;
        }
        {
            const u32x2 w = *(const u32x2*)(row + 3584 + lane * 4);
            float x[4] = {bflo(w[0]), bfhi(w[0]), bflo(w[1]), bfhi(w[1])};
            float ss = x[0] * x[0] + x[1] * x[1] + x[2] * x[2] + x[3] * x[3];
            ss = wave_sum(ss);
            const float rinv = rsqrtf(ss * (1.f / 256.f) + EPS);
            const f32x4 g = *(const f32x4*)(kvn + lane * 4);
            u32x2 o = {cvtpk(x[0] * rinv * g[0], x[1] * rinv * g[1]), cvtpk(x[2] * rinv * g[2], x[3] * rinv * g[3])};
            *(u32x2*)(CKVN + (size_t)t * 256 + lane * 4) = o;
        }
        {
            const float x = bf2f(row[3840 + lane]);
            const float oth = __shfl_xor(x, 32);
            const f32x2 cs = rope64[(size_t)t * 32 + (lane & 31)];
            const float y = (lane < 32) ? x * cs[0] - oth * cs[1] : x * cs[0] + oth * cs[1];
            KVM[(size_t)t * KVM_LD + 2048 + lane] = (bf16_t)(cvtpk(y, y) & 0xFFFFu);
        }
    }
}
constexpr int KSTR128 = 272, KSTR192 = 400, VSTR = 320;
constexpr int ATT_K_BYTES = 64 * KSTR192;
constexpr int ATT_V_BYTES = 64 * VSTR;
constexpr int ATT_KOFF = 0, ATT_VOFF = 2 * ATT_K_BYTES, ATT_MISC = ATT_VOFF + 2 * ATT_V_BYTES;

template <int NKS, int KSTR>
__device__ __forceinline__ void qk_tile(f32x16& p0, f32x16& p1, const unsigned char* kb_lane, const bf16x8* qr) {
#pragma unroll
    for (int r = 0; r < 16; ++r) { p0[r] = 0.f; p1[r] = 0.f; }
#pragma unroll
    for (int ks = 0; ks < NKS; ++ks) {
        const bf16x8 a0 = *(const bf16x8*)(kb_lane + ks * 32);
        const bf16x8 a1 = *(const bf16x8*)(kb_lane + 32 * KSTR + ks * 32);
        p0 = __builtin_amdgcn_mfma_f32_32x32x16_bf16(a0, qr[ks], p0, 0, 0, 0);
        p1 = __builtin_amdgcn_mfma_f32_32x32x16_bf16(a1, qr[ks], p1, 0, 0, 0);
        if ((ks & 3) == 3) __builtin_amdgcn_sched_barrier(0);
    }
}
__device__ __forceinline__ s16x4 tr_read(const unsigned char* p) {
    return __builtin_amdgcn_ds_read_tr16_b64_v4i16((LAS s16x4*)p);
}
__device__ __forceinline__ void pv_tile(f32x16 (&o)[4], const unsigned char* vb_lane, const bf16x8 (&pb)[4]) {
#pragma unroll
    for (int dt = 0; dt < 4; ++dt) {
#pragma unroll
        for (int s = 0; s < 4; ++s) {
            const s16x4 lo = tr_read(vb_lane + (s * 16) * VSTR + dt * 64);
            const s16x4 hh = tr_read(vb_lane + (s * 16 + 8) * VSTR + dt * 64);
            const bf16x8 a = {lo[0], lo[1], lo[2], lo[3], hh[0], hh[1], hh[2], hh[3]};
            o[dt] = __builtin_amdgcn_mfma_f32_32x32x16_bf16(a, pb[s], o[dt], 0, 0, 0);
        }
        __builtin_amdgcn_sched_barrier(0);
    }
}
__device__ __forceinline__ bf16x8 pack8f(const f32x16& p, int b) {
    u32x4 w = {cvtpk(p[b + 0], p[b + 1]), cvtpk(p[b + 2], p[b + 3]), cvtpk(p[b + 4], p[b + 5]), cvtpk(p[b + 6], p[b + 7])};
    return *reinterpret_cast<bf16x8*>(&w);
}
__device__ __forceinline__ int vb_lane_off(int lane) {
    return (4 * (lane >> 5) + ((lane >> 2) & 3)) * VSTR + (16 * ((lane >> 4) & 1) + 4 * (lane & 3)) * 2;
}
__device__ __forceinline__ void softmax_step(f32x16& p0, f32x16& p1, float& m, float& l, f32x16 (&o)[4], float c2, bf16x8 (&pb)[4]) {
    float mx = p0[0];
#pragma unroll
    for (int r = 1; r < 16; ++r) mx = fmaxf(mx, p0[r]);
#pragma unroll
    for (int r = 0; r < 16; ++r) mx = fmaxf(mx, p1[r]);
    mx = fmaxf(mx, __shfl_xor(mx, 32));
    const float mn = fmaxf(m, mx);
    const float alpha = __builtin_amdgcn_exp2f((m - mn) * c2);
    const float mc = mn * c2;
    float rs = 0.f;
#pragma unroll
    for (int r = 0; r < 16; ++r) { p0[r] = __builtin_amdgcn_exp2f(p0[r] * c2 - mc); rs += p0[r]; }
#pragma unroll
    for (int r = 0; r < 16; ++r) { p1[r] = __builtin_amdgcn_exp2f(p1[r] * c2 - mc); rs += p1[r]; }
    rs += __shfl_xor(rs, 32);
    l = l * alpha + rs;
    m = mn;
    if (__any(alpha != 1.f)) {
#pragma unroll
        for (int dt = 0; dt < 4; ++dt)
#pragma unroll
            for (int r = 0; r < 16; ++r) o[dt][r] *= alpha;
    }
    pb[0] = pack8f(p0, 0); pb[1] = pack8f(p0, 8); pb[2] = pack8f(p1, 0); pb[3] = pack8f(p1, 8);
}
__device__ __forceinline__ void store_ot_bf16(const f32x16 (&o)[4], float sc, bf16_t* orow  , int hi) {
#pragma unroll
    for (int dt = 0; dt < 4; ++dt)
#pragma unroll
        for (int g = 0; g < 4; ++g) {
            u32x2 w = {cvtpk(o[dt][4 * g] * sc, o[dt][4 * g + 1] * sc), cvtpk(o[dt][4 * g + 2] * sc, o[dt][4 * g + 3] * sc)};
            *(u32x2*)(orow + dt * 32 + 8 * g + 4 * hi) = w;
        }
}

__device__ __forceinline__ void mla_item(const Args& A, unsigned char* lds, int b, int h, int qt) {
    const int tid = opaque_tid(), lane = tid & 63, wave = tid >> 6, l31 = lane & 31, hi = lane >> 5;
    const bf16_t* QM = (const bf16_t*)(WSP(A) + WS_QM); const bf16_t* KVM = (const bf16_t*)(WSP(A) + WS_KVM);
    bf16_t* O = (bf16_t*)(WSP(A) + WS_O);
    const int q0 = qt * 256, qw = q0 + wave * 32, t = qw + l31;
    const size_t tokb = (size_t)b * SEQ;
    bf16x8 qr[12];
    {
        const bf16_t* qp = QM + (tokb + t) * 1536 + h * 192 + hi * 8;
#pragma unroll
        for (int ks = 0; ks < 12; ++ks) qr[ks] = *(const bf16x8*)(qp + ks * 16);
    }
    const int nkt = (q0 + 256) / 64;
    u32x4 rk[3], rv[2];
    unsigned okb[3], ovb[2], lkb[3], lvb[2];
#pragma unroll
    for (int i = 0; i < 3; ++i) {
        const int q = tid + NTHREADS * i, row = q / 24, c = q - row * 24;
        okb[i] = (unsigned)(row * KVM_LD + ((c < 16) ? h * 256 + c * 8 : 2048 + (c - 16) * 8)) * 2u;
        lkb[i] = (unsigned)(row * KSTR192 + c * 16);
    }
#pragma unroll
    for (int i = 0; i < 2; ++i) {
        const int q = tid + NTHREADS * i, row = q >> 4, c = q & 15;
        ovb[i] = (unsigned)(row * KVM_LD + h * 256 + 128 + c * 8) * 2u;
        lvb[i] = (unsigned)(row * VSTR + c * 16);
    }
    auto gload = [&](int kt) {
        const unsigned char* base = (const unsigned char*)(KVM + (tokb + (size_t)kt * 64) * KVM_LD);
#pragma unroll
        for (int i = 0; i < 3; ++i) rk[i] = *(const u32x4*)(base + okb[i]);
#pragma unroll
        for (int i = 0; i < 2; ++i) rv[i] = *(const u32x4*)(base + ovb[i]);
    };
    auto lstore = [&](int buf) {
        unsigned char* kb = lds + ATT_KOFF + buf * ATT_K_BYTES; unsigned char* vb = lds + ATT_VOFF + buf * ATT_V_BYTES;
#pragma unroll
        for (int i = 0; i < 3; ++i) *(u32x4*)(kb + lkb[i]) = rk[i];
#pragma unroll
        for (int i = 0; i < 2; ++i) *(u32x4*)(vb + lvb[i]) = rv[i];
    };
    f32x16 o[4];
#pragma unroll
    for (int dt = 0; dt < 4; ++dt)
#pragma unroll
        for (int r = 0; r < 16; ++r) o[dt][r] = 0.f;
    float m = -1e30f, l = 0.f;
    const float c2 = 0.07216878364870322f * 1.4426950408889634f;
    const int kl_off = l31 * KSTR192 + hi * 16, vl_off = vb_lane_off(lane);
    gload(0); lstore(0); __syncthreads();
    for (int kt = 0; kt < nkt; ++kt) {
        if (kt + 1 < nkt) gload(kt + 1);
        if (kt * 64 <= qw + 31) {
            f32x16 p0, p1;
            qk_tile<12, KSTR192>(p0, p1, lds + ATT_KOFF + (kt & 1) * ATT_K_BYTES + kl_off, qr);
            if (kt * 64 + 63 > qw) {
                const int dq = t - kt * 64 - 4 * hi;
#pragma unroll
                for (int r = 0; r < 16; ++r) {
                    const int cb = (r & 3) + 8 * (r >> 2);
                    if (cb > dq) p0[r] = -__builtin_inff();
                    if (cb + 32 > dq) p1[r] = -__builtin_inff();
                }
            }
            bf16x8 pb[4];
            softmax_step(p0, p1, m, l, o, c2, pb);
            pv_tile(o, lds + ATT_VOFF + (kt & 1) * ATT_V_BYTES + vl_off, pb);
        }
        if (kt + 1 < nkt) lstore((kt + 1) & 1);
        __syncthreads();
    }
    store_ot_bf16(o, ABL_MLA / l, O + (tokb + t) * 2048 + 1024 + h * 128, hi);
}

__device__ __forceinline__ void sb_item(const Args& A, unsigned char* lds, int b, int h, int qt) {
    const int tid = opaque_tid(), lane = tid & 63, wave = tid >> 6, l31 = lane & 31, hi = lane >> 5;
    const bf16_t* BIG = (const bf16_t*)(WSP(A) + WS_BIG);
    bf16_t* O = (bf16_t*)(WSP(A) + WS_O);
    volatile int* flags = (volatile int*)(lds + ATT_MISC);
    const int q0 = qt * 256, qw = q0 + wave * 32, t = qw + l31;
    const size_t tokb = (size_t)b * SEQ;
    bf16x8 qr[8];
    {
        const bf16_t* qp = BIG + (tokb + t) * SBMLA_IN + h * 128 + hi * 8;
#pragma unroll
        for (int ks = 0; ks < 8; ++ks) qr[ks] = *(const bf16x8*)(qp + ks * 16);
    }
    bf16x8 tri[2];
#pragma unroll
    for (int s2 = 0; s2 < 2; ++s2)
#pragma unroll
        for (int jj = 0; jj < 8; ++jj) tri[s2][jj] = (16 * s2 + 8 * (jj >> 2) + 4 * hi + (jj & 3) > l31) ? (short)0x3F80 : (short)0;
    u32x4 rk[2], rv[2];
    unsigned ogb[2], lkb[2], lvb[2];
#pragma unroll
    for (int i = 0; i < 2; ++i) {
        const int q = tid + NTHREADS * i, row = q >> 4, c = q & 15;
        ogb[i] = (unsigned)(row * SBMLA_IN + c * 8) * 2u; lkb[i] = (unsigned)(row * KSTR128 + c * 16); lvb[i] = (unsigned)(row * VSTR + c * 16);
    }
    auto gload = [&](int kt) {
        const unsigned char* base = (const unsigned char*)(BIG + (tokb + (size_t)kt * 64) * SBMLA_IN + h * 128);
#pragma unroll
        for (int i = 0; i < 2; ++i) { rk[i] = *(const u32x4*)(base + 2048 + ogb[i]); rv[i] = *(const u32x4*)(base + 4096 + ogb[i]); }
    };
    auto lstore = [&](int buf) {
        unsigned char* kb = lds + ATT_KOFF + buf * ATT_K_BYTES; unsigned char* vb = lds + ATT_VOFF + buf * ATT_V_BYTES;
#pragma unroll
        for (int i = 0; i < 2; ++i) { *(u32x4*)(kb + lkb[i]) = rk[i]; *(u32x4*)(vb + lvb[i]) = rv[i]; }
    };
    f32x16 o[4];
#pragma unroll
    for (int dt = 0; dt < 4; ++dt)
#pragma unroll
        for (int r = 0; r < 16; ++r) o[dt][r] = 0.f;
    float R = 0.f;
    bool done = false;
    const float scale = 0.08838834764831845f;
    const int kt_hi = (q0 + 254) / 64, ktw = (qw + 30) / 64;
    const int kl_off = l31 * KSTR128 + hi * 16, vl_off = vb_lane_off(lane);
    gload(kt_hi); lstore(0); __syncthreads();
    int it = 0;
    for (int kt = kt_hi; kt >= 0; --kt, ++it) {
        if (kt > 0) gload(kt - 1);
        if (kt <= ktw && !done) {
            f32x16 p0, p1;
            qk_tile<8, KSTR128>(p0, p1, lds + ATT_KOFF + (it & 1) * ATT_K_BYTES + kl_off, qr);
            const int dq = t - kt * 64 - 4 * hi;
            float tot0 = 0.f, tot1 = 0.f;
            u32x4 w0, w1, w2, w3;
            auto sbf = [&](float pz, bool v, float& tot, float& lbo) -> float {
                const float z = pz * scale;
                const float lp = __logf(1.f + __expf(-fabsf(z)));
                const float lb = fminf(z, 0.f) - lp;
                const float l1 = v ? lb - z : 0.f;
                tot += l1; lbo = v ? lb : -__builtin_inff();
                return l1;
            };
#pragma unroll
            for (int r = 0; r < 16; r += 2) {
                const int cb0 = (r & 3) + 8 * (r >> 2), cb1 = ((r + 1) & 3) + 8 * ((r + 1) >> 2);
                float t0_, t1_, t2_, t3_;
                const float a0 = sbf(p0[r], cb0 < dq, tot0, t0_), a1 = sbf(p0[r + 1], cb1 < dq, tot0, t1_);
                const float b0 = sbf(p1[r], cb0 + 32 < dq, tot1, t2_), b1 = sbf(p1[r + 1], cb1 + 32 < dq, tot1, t3_);
                p0[r] = t0_; p0[r + 1] = t1_; p1[r] = t2_; p1[r + 1] = t3_;
                const unsigned pa = cvtpk(a0, a1), pbb = cvtpk(b0, b1);
                if (r < 8) { w0[r >> 1] = pa; w2[r >> 1] = pbb; } else { w1[(r - 8) >> 1] = pa; w3[(r - 8) >> 1] = pbb; }
            }
            tot0 += __shfl_xor(tot0, 32); tot1 += __shfl_xor(tot1, 32);
            bf16x8 lf[4];
            lf[0] = *reinterpret_cast<bf16x8*>(&w0); lf[1] = *reinterpret_cast<bf16x8*>(&w1); lf[2] = *reinterpret_cast<bf16x8*>(&w2); lf[3] = *reinterpret_cast<bf16x8*>(&w3);
            f32x16 c0, c1;
            const float r1 = R + tot1;
#pragma unroll
            for (int r = 0; r < 16; ++r) { c1[r] = R; c0[r] = r1; }
            c1 = __builtin_amdgcn_mfma_f32_32x32x16_bf16(tri[0], lf[2], c1, 0, 0, 0);
            c1 = __builtin_amdgcn_mfma_f32_32x32x16_bf16(tri[1], lf[3], c1, 0, 0, 0);
            c0 = __builtin_amdgcn_mfma_f32_32x32x16_bf16(tri[0], lf[0], c0, 0, 0, 0);
            c0 = __builtin_amdgcn_mfma_f32_32x32x16_bf16(tri[1], lf[1], c0, 0, 0, 0);
#pragma unroll
            for (int r = 0; r < 16; ++r) { p0[r] = __expf(p0[r] + c0[r]); p1[r] = __expf(p1[r] + c1[r]); }
            R = r1 + tot0;
            bf16x8 pb[4] = {pack8f(p0, 0), pack8f(p0, 8), pack8f(p1, 0), pack8f(p1, 8)};
            pv_tile(o, lds + ATT_VOFF + (it & 1) * ATT_V_BYTES + vl_off, pb);
            done = __all(R < -104.f);
        }
        if (lane == 0) flags[(it & 1) * 8 + wave] = done ? 1 : 0;
        if (kt > 0) lstore((it + 1) & 1);
        __syncthreads();
        int nd = 0;
#pragma unroll
        for (int w = 0; w < 8; ++w) nd += flags[(it & 1) * 8 + w];
        if (nd == 8) break;
    }
    store_ot_bf16(o, ABL_SB, O + (tokb + t) * 2048 + h * 128, hi);
    __syncthreads();
}

__device__ __forceinline__ void phase_attn0(const Args& A, unsigned char* lds, int bid, int nb) {
    for (int u = bid; u < 256; u += nb) {
        const int bh = u >> 4, p = u & 15;
#pragma unroll 1
        for (int rep = 0; rep < 2; ++rep) mla_item(A, lds, bh >> 3, bh & 7, rep ? p : 31 - p);
    }
    for (int v = bid; v < 512; v += nb) {
        const int bh = v >> 5, qt = v & 31;
        sb_item(A, lds, bh >> 3, bh & 7, qt);
    }
}
__device__ __forceinline__ unsigned f2sort(float f) { const unsigned u = __float_as_uint(f); return u ^ ((u & 0x80000000u) ? 0xFFFFFFFFu : 0x80000000u); }
__device__ __forceinline__ float sort2f(unsigned s) { const unsigned u = (s & 0x80000000u) ? (s ^ 0x80000000u) : ~s; return __uint_as_float(u); }
__device__ __forceinline__ unsigned umax3(unsigned a, unsigned b, unsigned c) { return max(max(a, b), c); }

__device__ __forceinline__ void top16_of_128(unsigned (&k)[64], unsigned* out  , int lane) {
#pragma unroll 1
    for (int it = 0; it < 16; ++it) {
        unsigned mx = k[0];
#pragma unroll
        for (int i = 1; i < 63; i += 2) mx = umax3(mx, k[i], k[i + 1]);
        mx = max(mx, k[63]);
        const unsigned pm = (unsigned)__shfl_xor((int)mx, 32);
        const unsigned g = max(mx, pm);
        out[it * 64 + lane] = g;
#pragma unroll
        for (int i = 0; i < 64; ++i) k[i] = (k[i] == g) ? 0u : k[i];
    }
}

constexpr int TOPK_STAGE = 2 * 128 * KSTR128;
constexpr int TOPK_LDS = TOPK_STAGE + 8 * 8192;
__device__ __forceinline__ void phase_topk(const Args& A, unsigned char* lds, int layer, int bid, int nb) {
    const int tid = opaque_tid(), lane = tid & 63, wave = tid >> 6, l31 = lane & 31, hi = lane >> 5;
    const bf16_t* PQ = (const bf16_t*)(WSP(A) + WS_PQ);
    const bf16_t* K12 = (const bf16_t*)(WSP(A) + WS_K12) + (size_t)layer * 2 * 16384;
    int* EXI = (int*)(WSP(A) + WS_EXI); float* EXG = (float*)(WSP(A) + WS_EXG);
    for (int q = tid; q < 2 * 128 * 16; q += NTHREADS) { const int row = q >> 4, c = q & 15; *(u32x4*)(lds + row * KSTR128 + c * 16) = *(const u32x4*)(K12 + row * 128 + c * 8); }
    __syncthreads();
    for (int u = bid; u < T / 32; u += nb) {
        const int t = u * 32 + l31, h = wave;
        unsigned* wl = (unsigned*)(lds + TOPK_STAGE) + wave * 2048;
#pragma unroll
        for (int side = 0; side < 2; ++side) {
            bf16x8 qr[8];
            const bf16_t* qp = PQ + (size_t)t * 2048 + h * 256 + side * 128 + hi * 8;
#pragma unroll
            for (int ks = 0; ks < 8; ++ks) qr[ks] = *(const bf16x8*)(qp + ks * 16);
            const unsigned char* kp = lds + side * 128 * KSTR128 + l31 * KSTR128 + hi * 16;
            unsigned keys[64];
#pragma unroll
            for (int mt = 0; mt < 4; ++mt) {
                f32x16 p;
#pragma unroll
                for (int r = 0; r < 16; ++r) p[r] = 0.f;
#pragma unroll
                for (int ks = 0; ks < 8; ++ks) {
                    const bf16x8 a = *(const bf16x8*)(kp + mt * 32 * KSTR128 + ks * 32);
                    p = __builtin_amdgcn_mfma_f32_32x32x16_bf16(a, qr[ks], p, 0, 0, 0);
                }
#pragma unroll
                for (int r = 0; r < 16; ++r) {
                    const int key = mt * 32 + (r & 3) + 8 * (r >> 2) + 4 * hi;
                    keys[mt * 16 + r] = (f2sort(p[r]) & ~127u) | (unsigned)(127 - key);
                }
                __builtin_amdgcn_sched_barrier(0);
            }
            top16_of_128(keys, wl + side * 1024, lane);
        }
        unsigned lst[2][16];
#pragma unroll
        for (int i = 0; i < 16; ++i) { lst[0][i] = wl[i * 64 + lane]; lst[1][i] = wl[1024 + i * 64 + lane]; }
        float v1[16], v2[16];
#pragma unroll
        for (int i = 0; i < 16; ++i) { v1[i] = sort2f(lst[0][i] & ~127u); v2[i] = sort2f(lst[1][i] & ~127u); }
        unsigned cand[50];
        {
            int c = 0;
#pragma unroll
            for (int i = 0; i < 16; ++i)
#pragma unroll
                for (int j = 0; j < 16; ++j)
                    if ((i + 1) * (j + 1) <= 16) { cand[c] = (f2sort(v1[i] + v2[j]) & ~255u) | (unsigned)(255 - (16 * i + j)); ++c; }
        }
        float* wv = (float*)wl; int* we = (int*)wl + 1024;
#pragma unroll 1
        for (int it = 0; it < 16; ++it) {
            unsigned mx = cand[0];
#pragma unroll
            for (int c = 1; c < 49; c += 2) mx = umax3(mx, cand[c], cand[c + 1]);
            mx = max(mx, cand[49]);
            wv[it * 64 + lane] = sort2f(mx & ~255u);
            int eid = 0;
            {
                int c = 0;
#pragma unroll
                for (int i = 0; i < 16; ++i)
#pragma unroll
                    for (int j = 0; j < 16; ++j)
                        if ((i + 1) * (j + 1) <= 16) {
                            const bool hit = cand[c] == mx;
                            eid = hit ? (int)((127u - (lst[0][i] & 127u)) * 128u + (127u - (lst[1][j] & 127u))) : eid;
                            cand[c] = hit ? 0u : cand[c];
                            ++c;
                        }
            }
            we[it * 64 + lane] = eid;
        }
        float topv[16]; int tope[16];
#pragma unroll
        for (int it = 0; it < 16; ++it) { topv[it] = wv[it * 64 + lane]; tope[it] = we[it * 64 + lane]; }
        const float mx0 = topv[0];
        float sum = 0.f;
#pragma unroll
        for (int it = 0; it < 16; ++it) { topv[it] = __expf(topv[it] - mx0); sum += topv[it]; }
        if (hi == 0) {
            const float inv = 1.f / sum;
            int* ei = EXI + (size_t)t * 128 + h * 16; float* eg = EXG + (size_t)t * 128 + h * 16;
#pragma unroll
            for (int q = 0; q < 4; ++q) {
                *(int4*)(ei + 4 * q) = make_int4(tope[4 * q], tope[4 * q + 1], tope[4 * q + 2], tope[4 * q + 3]);
                *(f32x4*)(eg + 4 * q) = f32x4{topv[4 * q] * inv, topv[4 * q + 1] * inv, topv[4 * q + 2] * inv, topv[4 * q + 3] * inv};
            }
        }
    }
    __syncthreads();
}
__device__ __forceinline__ void fp8x16_to_f32(const u32x4 w, float (&f)[16]) {
#pragma unroll
    for (int j = 0; j < 4; ++j) {
        const f32x2 lo = __builtin_amdgcn_cvt_pk_f32_fp8((int)w[j], false), hi = __builtin_amdgcn_cvt_pk_f32_fp8((int)w[j], true);
        f[4 * j] = lo[0]; f[4 * j + 1] = lo[1]; f[4 * j + 2] = hi[0]; f[4 * j + 3] = hi[1];
    }
}
struct PeerRow { u32x4 u[2], v[2]; };

template <bool FINAL>
__device__ __forceinline__ void phase_gather(const Args& A, int layer, const float* xin, float* xout, int gate_set, const float* next_gain, int next_set, float gmul, int bid, int nb) {
    const int tid = opaque_tid(), lane = tid & 63, wave = tid >> 6;
    bf16_t* H = (bf16_t*)(WSP(A) + WS_H);
    const unsigned char* PU = WSP(A) + WS_PU + (size_t)layer * 16384 * 2048;
    const unsigned char* PV = WSP(A) + WS_PV + (size_t)layer * 16384 * 2048;
    const int* EXI = (const int*)(WSP(A) + WS_EXI); const float* EXG = (const float*)(WSP(A) + WS_EXG);
    const float* mod = (const float*)(WSP(A) + WS_MOD);
    for (int u = bid; u < T / NWAVES; u += nb) {
        const int t = u * NWAVES + wave;
        float hp[2][16];
#pragma unroll
        for (int c = 0; c < 2; ++c)
#pragma unroll
            for (int q = 0; q < 2; ++q) {
                const u32x4 w_ = *(const u32x4*)(H + (size_t)t * 2048 + c * 1024 + lane * 16 + q * 8);
#pragma unroll
                for (int j = 0; j < 4; ++j) { hp[c][q * 8 + 2 * j] = bflo(w_[j]); hp[c][q * 8 + 2 * j + 1] = bfhi(w_[j]); }
            }
        const int idxA = EXI[(size_t)t * 128 + lane], idxB = EXI[(size_t)t * 128 + 64 + lane];
        const float gA = EXG[(size_t)t * 128 + lane], gB = EXG[(size_t)t * 128 + 64 + lane];
        float o[2][16];
#pragma unroll
        for (int c = 0; c < 2; ++c)
#pragma unroll
            for (int j = 0; j < 16; ++j) o[c][j] = 0.f;
        PeerRow r0, r1, r2, r3;
        auto issue = [&](int k, PeerRow& r) {
            const int e = __builtin_amdgcn_readlane(k < 64 ? idxA : idxB, k & 63);
            const unsigned char* up = PU + (size_t)e * 2048 + lane * 16; const unsigned char* vp = PV + (size_t)e * 2048 + lane * 16;
#pragma unroll
            for (int c = 0; c < 2; ++c) { r.u[c] = *(const u32x4*)(up + c * 1024); r.v[c] = *(const u32x4*)(vp + c * 1024); }
        };
        auto consume = [&](int k, const PeerRow& r) {
            float d = 0.f;
#pragma unroll
            for (int c = 0; c < 2; ++c) {
                float f[16]; fp8x16_to_f32(r.u[c], f);
#pragma unroll
                for (int j = 0; j < 16; ++j) d += f[j] * hp[c][j];
            }
            d = wave_sum(d) * (1.f / PEER_USCALE);
            const float g = __uint_as_float(__builtin_amdgcn_readlane(__float_as_uint(k < 64 ? gA : gB), k & 63));
            const float w = g * gelu_tanh(d) * (gmul / PEER_VSCALE);
#pragma unroll
            for (int c = 0; c < 2; ++c) {
                float f[16]; fp8x16_to_f32(r.v[c], f);
#pragma unroll
                for (int j = 0; j < 16; ++j) o[c][j] += w * f[j];
            }
        };
        issue(0, r0); issue(1, r1); issue(2, r2); issue(3, r3);
#pragma unroll 1
        for (int k = 0; k < 128; k += 4) {
            consume(k, r0);     if (k + 4 < 128) issue(k + 4, r0);
            consume(k + 1, r1); if (k + 4 < 128) issue(k + 5, r1);
            consume(k + 2, r2); if (k + 4 < 128) issue(k + 6, r2);
            consume(k + 3, r3); if (k + 4 < 128) issue(k + 7, r3);
        }
        const int b = t >> 13;
        const float* gate = mod + (size_t)(gate_set * 2 + b) * 6144 + 4096;
        float ss = 0.f;
#pragma unroll
        for (int c = 0; c < 2; ++c)
#pragma unroll
            for (int q = 0; q < 4; ++q) {
                const int col = c * 1024 + lane * 16 + q * 4;
                const f32x4 x0 = *(const f32x4*)(xin + (size_t)t * 2048 + col), g0 = *(const f32x4*)(gate + col);
#pragma unroll
                for (int j = 0; j < 4; ++j) { const float xv = x0[j] + g0[j] * o[c][q * 4 + j]; o[c][q * 4 + j] = xv; ss += xv * xv; }
            }
        ss = wave_sum(ss);
        const float rinv = rsqrtf(ss * (1.f / 2048.f) + EPS);
        if constexpr (FINAL) {
#pragma unroll
            for (int c = 0; c < 2; ++c)
#pragma unroll
                for (int q = 0; q < 4; ++q) {
                    const int col = c * 1024 + lane * 16 + q * 4;
                    const f32x4 w0 = *(const f32x4*)(next_gain + col);
                    f32x4 y;
#pragma unroll
                    for (int j = 0; j < 4; ++j) y[j] = o[c][q * 4 + j] * rinv * w0[j];
                    *(f32x4*)(xout + (size_t)t * 2048 + col) = y;
                }
        } else {
            const float* nm = mod + (size_t)(next_set * 2 + b) * 6144;
#pragma unroll
            for (int c = 0; c < 2; ++c) {
                float hh[16];
#pragma unroll
                for (int q = 0; q < 4; ++q) {
                    const int col = c * 1024 + lane * 16 + q * 4;
                    f32x4 y;
#pragma unroll
                    for (int j = 0; j < 4; ++j) y[j] = o[c][q * 4 + j];
                    *(f32x4*)(xout + (size_t)t * 2048 + col) = y;
                    const f32x4 w0 = *(const f32x4*)(next_gain + col), s0 = *(const f32x4*)(nm + col), c0 = *(const f32x4*)(nm + 2048 + col);
#pragma unroll
                    for (int j = 0; j < 4; ++j) hh[q * 4 + j] = y[j] * rinv * w0[j] * (1.f + c0[j]) + s0[j];
                }
#pragma unroll
                for (int q = 0; q < 2; ++q) {
                    u32x4 w = {cvtpk(hh[q * 8], hh[q * 8 + 1]), cvtpk(hh[q * 8 + 2], hh[q * 8 + 3]), cvtpk(hh[q * 8 + 4], hh[q * 8 + 5]), cvtpk(hh[q * 8 + 6], hh[q * 8 + 7])};
                    *(u32x4*)(H + (size_t)t * 2048 + c * 1024 + lane * 16 + q * 8) = w;
                }
            }
        }
    }
}
constexpr int NSA_IMP = ATT_MISC;
constexpr int NSA_SELM = NSA_IMP + 32 * 128 * 4;
constexpr int NSA_KEYS = NSA_SELM + 512;
constexpr int LDS_BARW = NSA_KEYS + 8 * 128 * 4;
constexpr int LDS_BARW2 = (LDS_BARW > TOPK_LDS ? LDS_BARW : TOPK_LDS);
constexpr int LDS_TOTAL = ((LDS_BARW2 + 16 + 255) / 256) * 256;
static_assert(LDS_TOTAL <= 160 * 1024 && GEMM_LDS <= LDS_BARW2 && GEMM256_LDS <= LDS_BARW2, "LDS budget");

__device__ __forceinline__ int next_bit128(unsigned long long lo, unsigned long long hi, int from) {
    if (from < 64) { const unsigned long long mm = lo >> from; if (mm) return from + __builtin_ctzll(mm); from = 64; }
    if (from < 128) { const unsigned long long mm = hi >> (from - 64); if (mm) return from + __builtin_ctzll(mm); }
    return 128;
}
template <int MODE>
__device__ __forceinline__ void nsa_emit(const f32x16 (&o)[4], float sc, float* acc_row, bf16_t* o_row, int hi) {
#pragma unroll
    for (int dt = 0; dt < 4; ++dt)
#pragma unroll
        for (int g4 = 0; g4 < 4; ++g4) {
            const int d = dt * 32 + 8 * g4 + 4 * hi;
            f32x4 v = {o[dt][4 * g4] * sc, o[dt][4 * g4 + 1] * sc, o[dt][4 * g4 + 2] * sc, o[dt][4 * g4 + 3] * sc};
            if (MODE >= 1) { const f32x4 pv = *(const f32x4*)(acc_row + d); v += pv; }
            if (MODE <= 1) *(f32x4*)(acc_row + d) = v;
            else { u32x2 w = {cvtpk(v[0], v[1]), cvtpk(v[2], v[3])}; *(u32x2*)(o_row + d) = w; }
        }
}

__device__ __forceinline__ void nsa_item(const Args& A, unsigned char* lds, int b, int g, int tt) {
    const int tid = opaque_tid(), lane = tid & 63, wave = tid >> 6, l31 = lane & 31, hi = lane >> 5;
    const bf16_t* NS = (const bf16_t*)(WSP(A) + WS_BIG);
    const bf16_t* KCC = (const bf16_t*)(WSP(A) + WS_KCC); const bf16_t* VCC = (const bf16_t*)(WSP(A) + WS_VCC);
    float* OACC = (float*)(WSP(A) + WS_OACC); bf16_t* O = (bf16_t*)(WSP(A) + WS_O);
    int* IMP = (int*)(lds + NSA_IMP); unsigned* SELM = (unsigned*)(lds + NSA_SELM); int* KEYS = (int*)(lds + NSA_KEYS) + wave * 128;
    const int t0 = tt * 32, t = t0 + l31, hd = g * 8 + wave;
    const size_t tokb = (size_t)b * SEQ;
    const float c2 = 0.08838834764831845f * 1.4426950408889634f;
    bf16x8 qr[8];
    {
        const bf16_t* qp = NS + (tokb + t) * NSA_IN + hd * 128 + hi * 8;
#pragma unroll
        for (int ks = 0; ks < 8; ++ks) qr[ks] = *(const bf16x8*)(qp + ks * 16);
    }
    float gt[3];
    {
        const bf16_t* gp = NS + (tokb + t) * NSA_IN + 3584 + g * 24 + wave * 3;
        gt[0] = bf2f(gp[0]); gt[1] = bf2f(gp[1]); gt[2] = bf2f(gp[2]);
    }
    float* acc_row = OACC + (tokb + t) * 2048 + hd * 128;
    bf16_t* o_row = O + (tokb + t) * 2048 + hd * 128;
    const int kl_off = l31 * KSTR128 + hi * 16, vl_off = vb_lane_off(lane);
    u32x4 rk[2], rv[2];
    unsigned ocm[2], omn[2], lkb[2], lvb[2];
#pragma unroll
    for (int i = 0; i < 2; ++i) {
        const int q = tid + NTHREADS * i, row = q >> 4, c = q & 15;
        ocm[i] = (unsigned)(row * 256 + c * 8) * 2u; omn[i] = (unsigned)(row * NSA_IN + c * 8) * 2u;
        lkb[i] = (unsigned)(row * KSTR128 + c * 16); lvb[i] = (unsigned)(row * VSTR + c * 16);
    }
    auto gloadK = [&](const bf16_t* kbase, bool cmp) {
#pragma unroll
        for (int i = 0; i < 2; ++i) rk[i] = *(const u32x4*)((const unsigned char*)kbase + (cmp ? ocm[i] : omn[i]));
    };
    auto gloadV = [&](const bf16_t* vbase, bool cmp) {
#pragma unroll
        for (int i = 0; i < 2; ++i) rv[i] = *(const u32x4*)((const unsigned char*)vbase + (cmp ? ocm[i] : omn[i]));
    };
    auto lstoreK = [&](int buf) {
        unsigned char* kb = lds + ATT_KOFF + buf * ATT_K_BYTES;
#pragma unroll
        for (int i = 0; i < 2; ++i) *(u32x4*)(kb + lkb[i]) = rk[i];
    };
    auto lstoreV = [&](int buf) {
        unsigned char* vb = lds + ATT_VOFF + buf * ATT_V_BYTES;
#pragma unroll
        for (int i = 0; i < 2; ++i) *(u32x4*)(vb + lvb[i]) = rv[i];
    };
    f32x16 o[4];
    auto zero_o = [&]() {
#pragma unroll
        for (int dt = 0; dt < 4; ++dt)
#pragma unroll
            for (int r = 0; r < 16; ++r) o[dt][r] = 0.f;
    };

    for (int i = tid; i < 32 * 128; i += NTHREADS) IMP[i] = 0;
    const int nct = (tt >> 5) + 1;
    const int nv = (t >= 31) ? ((t - 31) >> 4) : -1;
    const bf16_t* kc0 = KCC + ((size_t)(b * NCMP_PAD) * 2 + g) * 128;
    const bf16_t* vc0 = VCC + ((size_t)(b * NCMP_PAD) * 2 + g) * 128;
    float m = -1e30f, l = 0.f;
    gloadK(kc0, true); lstoreK(0); __syncthreads();
    for (int ct = 0; ct < nct; ++ct) {
        if (ct + 1 < nct) gloadK(kc0 + (size_t)(ct + 1) * 64 * 256, true);
        {
            f32x16 p0, p1;
            qk_tile<8, KSTR128>(p0, p1, lds + ATT_KOFF + (ct & 1) * ATT_K_BYTES + kl_off, qr);
            const int dq = nv - ct * 64 - 4 * hi;
            float mx = -__builtin_inff();
#pragma unroll
            for (int r = 0; r < 16; ++r) {
                const int cb = (r & 3) + 8 * (r >> 2);
                p0[r] = (cb <= dq) ? p0[r] : -__builtin_inff();
                p1[r] = (cb + 32 <= dq) ? p1[r] : -__builtin_inff();
                mx = fmaxf(mx, fmaxf(p0[r], p1[r]));
            }
            mx = fmaxf(mx, __shfl_xor(mx, 32));
            const float mn = fmaxf(m, mx);
            const float alpha = __builtin_amdgcn_exp2f((m - mn) * c2);
            const float mc = mn * c2;
            float rs = 0.f;
#pragma unroll
            for (int r = 0; r < 16; ++r) rs += __builtin_amdgcn_exp2f(p0[r] * c2 - mc) + __builtin_amdgcn_exp2f(p1[r] * c2 - mc);
            rs += __shfl_xor(rs, 32);
            l = l * alpha + rs; m = mn;
        }
        if (ct + 1 < nct) lstoreK((ct + 1) & 1);
        __syncthreads();
    }
    const float inv_l = (l > 0.f) ? 1.f / l : 0.f;
    const float mcF = m * c2;
    zero_o();
    gloadK(kc0, true); gloadV(vc0, true); lstoreK(0); lstoreV(0); __syncthreads();
    for (int ct = 0; ct < nct; ++ct) {
        if (ct + 1 < nct) { gloadK(kc0 + (size_t)(ct + 1) * 64 * 256, true); gloadV(vc0 + (size_t)(ct + 1) * 64 * 256, true); }
        {
            f32x16 p0, p1;
            qk_tile<8, KSTR128>(p0, p1, lds + ATT_KOFF + (ct & 1) * ATT_K_BYTES + kl_off, qr);
            const int dq = nv - ct * 64 - 4 * hi;
#pragma unroll
            for (int r = 0; r < 16; ++r) {
                const int cb = (r & 3) + 8 * (r >> 2);
                p0[r] = (cb <= dq) ? __builtin_amdgcn_exp2f(p0[r] * c2 - mcF) * inv_l : 0.f;
                p1[r] = (cb + 32 <= dq) ? __builtin_amdgcn_exp2f(p1[r] * c2 - mcF) * inv_l : 0.f;
            }
#pragma unroll
            for (int g4 = 0; g4 < 4; ++g4) {
                {
                    const int j = 16 * ct + 2 * g4 + hi;
                    const float mainv = 32.f * (p0[4 * g4] + p0[4 * g4 + 1] + p0[4 * g4 + 2]) + 16.f * p0[4 * g4 + 3];
                    const float spill = 16.f * p0[4 * g4 + 3];
                    atomicAdd(&IMP[l31 * 128 + j], (int)(mainv * 1048576.f + 0.5f));
                    if (j + 1 < 128) atomicAdd(&IMP[l31 * 128 + j + 1], (int)(spill * 1048576.f + 0.5f));
                }
                {
                    const int j = 16 * ct + 8 + 2 * g4 + hi;
                    const float mainv = 32.f * (p1[4 * g4] + p1[4 * g4 + 1] + p1[4 * g4 + 2]) + 16.f * p1[4 * g4 + 3];
                    const float spill = 16.f * p1[4 * g4 + 3];
                    atomicAdd(&IMP[l31 * 128 + j], (int)(mainv * 1048576.f + 0.5f));
                    if (j + 1 < 128) atomicAdd(&IMP[l31 * 128 + j + 1], (int)(spill * 1048576.f + 0.5f));
                }
            }
            bf16x8 pb[4] = {pack8f(p0, 0), pack8f(p0, 8), pack8f(p1, 0), pack8f(p1, 8)};
            pv_tile(o, lds + ATT_VOFF + (ct & 1) * ATT_V_BYTES + vl_off, pb);
        }
        if (ct + 1 < nct) { lstoreK((ct + 1) & 1); lstoreV((ct + 1) & 1); }
        __syncthreads();
    }
    nsa_emit<0>(o, gt[0] * ABL_NC, acc_row, o_row, hi);

#pragma unroll 1
    for (int q = 0; q < 4; ++q) {
        const int ti = wave * 4 + q, tq = t0 + ti, cur = tq >> 6;
        int keyv[2];
#pragma unroll
        for (int half = 0; half < 2; ++half) {
            const int j = lane + 64 * half;
            const bool forced = (j == 0) || (j == cur) || (j == cur - 1);
            keyv[half] = forced ? 0x7FFFFFFF : ((j <= cur) ? IMP[ti * 128 + j] : -1);
            KEYS[j] = keyv[half];
        }
        __builtin_amdgcn_s_waitcnt(0xc07f);
        int rk0 = 0, rk1 = 0;
#pragma unroll 8
        for (int i = 0; i < 128; ++i) {
            const int ki = KEYS[i];
            rk0 += (ki > keyv[0] || (ki == keyv[0] && i < lane)) ? 1 : 0;
            rk1 += (ki > keyv[1] || (ki == keyv[1] && i < lane + 64)) ? 1 : 0;
        }
        const unsigned long long s0 = __ballot(keyv[0] >= 0 && rk0 < 16);
        const unsigned long long s1 = __ballot(keyv[1] >= 0 && rk1 < 16);
        if (lane == 0) { SELM[ti * 4 + 0] = (unsigned)s0; SELM[ti * 4 + 1] = (unsigned)(s0 >> 32); SELM[ti * 4 + 2] = (unsigned)s1; SELM[ti * 4 + 3] = (unsigned)(s1 >> 32); }
    }
    __syncthreads();
    unsigned msk[4], uni[4];
#pragma unroll
    for (int w4 = 0; w4 < 4; ++w4) {
        msk[w4] = SELM[l31 * 4 + w4];
        unsigned x = msk[w4];
#pragma unroll
        for (int off = 16; off >= 1; off >>= 1) x |= (unsigned)__shfl_xor((int)x, off);
        uni[w4] = (unsigned)__builtin_amdgcn_readfirstlane((int)x);
    }
    const unsigned long long ulo = ((unsigned long long)uni[1] << 32) | uni[0], uhi = ((unsigned long long)uni[3] << 32) | uni[2];

    const bf16_t* ks0 = NS + tokb * NSA_IN + 2560 + g * 128;
    const bf16_t* vs0 = NS + tokb * NSA_IN + 2816 + g * 128;
    zero_o(); m = -1e30f; l = 0.f;
    {
        int j = next_bit128(ulo, uhi, 0), it = 0;
        if (j < 128) { gloadK(ks0 + (size_t)j * 64 * NSA_IN, false); gloadV(vs0 + (size_t)j * 64 * NSA_IN, false); lstoreK(0); lstoreV(0); }
        __syncthreads();
        while (j < 128) {
            const int jn = next_bit128(ulo, uhi, j + 1);
            if (jn < 128) { gloadK(ks0 + (size_t)jn * 64 * NSA_IN, false); gloadV(vs0 + (size_t)jn * 64 * NSA_IN, false); }
            {
                f32x16 p0, p1;
                qk_tile<8, KSTR128>(p0, p1, lds + ATT_KOFF + (it & 1) * ATT_K_BYTES + kl_off, qr);
                const bool sel = (msk[j >> 5] >> (j & 31)) & 1u;
                const int dq = sel ? (t - j * 64 - 4 * hi) : -1000;
#pragma unroll
                for (int r = 0; r < 16; ++r) {
                    const int cb = (r & 3) + 8 * (r >> 2);
                    p0[r] = (cb <= dq) ? p0[r] : -__builtin_inff();
                    p1[r] = (cb + 32 <= dq) ? p1[r] : -__builtin_inff();
                }
                bf16x8 pb[4];
                softmax_step(p0, p1, m, l, o, c2, pb);
                pv_tile(o, lds + ATT_VOFF + (it & 1) * ATT_V_BYTES + vl_off, pb);
            }
            if (jn < 128) { lstoreK((it + 1) & 1); lstoreV((it + 1) & 1); }
            __syncthreads();
            j = jn; ++it;
        }
    }
    nsa_emit<1>(o, (l > 0.f) ? ABL_NS * gt[1] / l : 0.f, acc_row, o_row, hi);

    const bf16_t* kw0 = NS + tokb * NSA_IN + 3072 + g * 128;
    const bf16_t* vw0 = NS + tokb * NSA_IN + 3328 + g * 128;
    zero_o(); m = -1e30f; l = 0.f;
    {
        const int kt_lo = (t0 >= 511) ? ((t0 - 511) >> 6) : 0, kt_hi = t0 >> 6;
        gloadK(kw0 + (size_t)kt_lo * 64 * NSA_IN, false); gloadV(vw0 + (size_t)kt_lo * 64 * NSA_IN, false); lstoreK(0); lstoreV(0);
        __syncthreads();
        int it = 0;
        for (int kt = kt_lo; kt <= kt_hi; ++kt, ++it) {
            if (kt < kt_hi) { gloadK(kw0 + (size_t)(kt + 1) * 64 * NSA_IN, false); gloadV(vw0 + (size_t)(kt + 1) * 64 * NSA_IN, false); }
            {
                f32x16 p0, p1;
                qk_tile<8, KSTR128>(p0, p1, lds + ATT_KOFF + (it & 1) * ATT_K_BYTES + kl_off, qr);
                const int dq = t - kt * 64 - 4 * hi;
#pragma unroll
                for (int r = 0; r < 16; ++r) {
                    const int cb = (r & 3) + 8 * (r >> 2);
                    p0[r] = ((unsigned)(dq - cb) < 512u) ? p0[r] : -__builtin_inff();
                    p1[r] = ((unsigned)(dq - cb - 32) < 512u) ? p1[r] : -__builtin_inff();
                }
                bf16x8 pb[4];
                softmax_step(p0, p1, m, l, o, c2, pb);
                pv_tile(o, lds + ATT_VOFF + (it & 1) * ATT_V_BYTES + vl_off, pb);
            }
            if (kt < kt_hi) { lstoreK((it + 1) & 1); lstoreV((it + 1) & 1); }
            __syncthreads();
        }
    }
    nsa_emit<2>(o, (l > 0.f) ? ABL_NW * gt[2] / l : 0.f, acc_row, o_row, hi);
}

__device__ __forceinline__ void phase_nsa(const Args& A, unsigned char* lds, int bid, int nb) {
    for (int u = bid; u < 1024; u += nb) {
        const int bg = u & 3, s = (u >> 2) & 63, r = u >> 8;
        const int tt = (r == 0) ? 255 - s : (r == 1) ? 128 + s : (r == 2) ? 127 - s : s;
        nsa_item(A, lds, bg >> 1, bg & 1, tt);
    }
}
constexpr int N_PHASES = 20;
#ifndef ABL_M0
#define ABL_M0 1.f
#endif
#ifndef ABL_M1
#define ABL_M1 1.f
#endif
#ifndef ABL_P0
#define ABL_P0 1.f
#endif
#ifndef ABL_P1
#define ABL_P1 1.f
#endif
__global__ void __launch_bounds__(NTHREADS, 2) fwd_kernel(Args a) {
    extern __shared__ __attribute__((aligned(16))) unsigned char lds[];
    const int bid = blockIdx.x, nb = gridDim.x;
    const bool multi = (a.ph_hi - a.ph_lo) > 1;
    XcdBarrier bar; bar.bar = (unsigned*)(a.ws + WS_CTL); bar.x = 0; bar.st = (volatile LAS unsigned*)(lds + LDS_BARW2);
    if (multi) {
        if (threadIdx.x == 0) *(uint4*)(lds + LDS_BARW2) = make_uint4(0u, 0u, 0u, 0u);
        __syncthreads();
        bar = xcd_barrier_post((unsigned*)(a.ws + WS_CTL), (volatile LAS unsigned*)(lds + LDS_BARW2));
    }
#ifdef ONLY
#define IN(k) ((k) == ONLY && a.ph_lo <= (k) && (k) < a.ph_hi)
#else
#define IN(k) (a.ph_lo <= (k) && (k) < a.ph_hi)
#endif
#define SEAM(k) do { if (IN(k) && IN((k) + 1)) xcd_barrier(bar); } while (0)
    unsigned char* ws = WSP(a);
    const float* MOD = (const float*)(ws + WS_MOD);
    bf16_t* H = (bf16_t*)(ws + WS_H); bf16_t* BIG = (bf16_t*)(ws + WS_BIG); bf16_t* Ob = (bf16_t*)(ws + WS_O);
    float* XA = (float*)(ws + WS_XA); float* XB = (float*)(ws + WS_XB);

    if (IN(0)) phase_prologue(a, lds, bid, nb);
    SEAM(0);
    if (IN(1)) phase_modnorm(a, a.in[0], a.in[3], 0, bid, nb);
    SEAM(1);
    if (IN(2)) gemm256_phase(lds, H, 2048, (const bf16_t*)(ws + WS_WIN0), 2048, T, SBMLA_IN_PAD, 2048, EpiBf16{BIG, SBMLA_IN, SBMLA_IN}, bid, nb);
    SEAM(2);
    if (IN(3)) phase_mla_prep(a, bid, nb);
    SEAM(3);
    if (IN(4)) {
        gemm256_phase(lds, (const bf16_t*)(ws + WS_CQN), 512, (const bf16_t*)(ws + WS_WUQ), 512, T, 1536, 512, EpiMlaQ{(bf16_t*)(ws + WS_QM), (const f32x2*)(ws + WS_ROPE64)}, bid, nb);
        gemm256_phase(lds, (const bf16_t*)(ws + WS_CKVN), 256, (const bf16_t*)(ws + WS_WUKV), 256, T, 2048, 256, EpiBf16{(bf16_t*)(ws + WS_KVM), KVM_LD, 2048}, bid, nb);
    }
    SEAM(4);
    if (IN(5)) phase_attn0(a, lds, bid, nb);
    SEAM(5);
    if (IN(6)) gemm256_phase(lds, Ob, 2048, (const bf16_t*)(ws + WS_WOUT0), 2048, T, 2048, 2048, EpiResid{a.in[0], XA, MOD + 0 * 2 * 6144 + 4096, ABL_M0}, bid, nb);
    SEAM(6);
    if (IN(7)) phase_modnorm(a, XA, a.in[20], 1, bid, nb);
    SEAM(7);
    if (IN(8)) gemm256_phase(lds, H, 2048, (const bf16_t*)(ws + WS_WPQ), 2048, T, 2048, 2048, EpiBf16{(bf16_t*)(ws + WS_PQ), 2048, 2048}, bid, nb);
    SEAM(8);
    if (IN(9)) phase_topk(a, lds, 0, bid, nb);
    SEAM(9);
    if (IN(10)) phase_gather<false>(a, 0, XA, XB, 1, a.in[3] + 2048, 2, ABL_P0, bid, nb);
    SEAM(10);
    if (IN(11)) gemm256_phase(lds, H, 2048, (const bf16_t*)(ws + WS_WNSAIN), 2048, T, NSA_IN_PAD, 2048, EpiNsaIn{BIG, (const f32x2*)(ws + WS_ROPE32)}, bid, nb);
    SEAM(11);
    if (IN(12)) {
        gemm_phase(lds, ALoadCmp{BIG, NSA_IN, 2048}, (const bf16_t*)(ws + WS_W1K), 4096, 2048, 256, 4096, EpiCmpHid{(bf16_t*)(ws + WS_HID), (const float*)(ws + WS_BIASP)}, bid, nb);
        gemm_phase(lds, ALoadCmp{BIG, NSA_IN, 2304}, (const bf16_t*)(ws + WS_W1V), 4096, 2048, 256, 4096, EpiCmpHid{(bf16_t*)(ws + WS_HID) + 2048 * 256, (const float*)(ws + WS_BIASP) + 32 * 256}, bid, nb);
    }
    SEAM(12);
    if (IN(13)) {
        gemm_phase(lds, ALoadPlain{(const bf16_t*)(ws + WS_HID), 256}, (const bf16_t*)(ws + WS_W2K), 256, 2048, 128, 256, EpiCmpOut{(bf16_t*)(ws + WS_KCC)}, bid, nb);
        gemm_phase(lds, ALoadPlain{(const bf16_t*)(ws + WS_HID) + 2048 * 256, 256}, (const bf16_t*)(ws + WS_W2V), 256, 2048, 128, 256, EpiCmpOut{(bf16_t*)(ws + WS_VCC)}, bid, nb);
    }
    SEAM(13);
    if (IN(14)) phase_nsa(a, lds, bid, nb);
    SEAM(14);
    if (IN(15)) gemm256_phase(lds, Ob, 2048, (const bf16_t*)(ws + WS_WNSAOUT), 2048, T, 2048, 2048, EpiResid{XB, XA, MOD + 2 * 2 * 6144 + 4096, ABL_M1}, bid, nb);
    SEAM(15);
    if (IN(16)) phase_modnorm(a, XA, a.in[20] + 2048, 3, bid, nb);
    SEAM(16);
    if (IN(17)) gemm256_phase(lds, H, 2048, (const bf16_t*)(ws + WS_WPQ) + (size_t)2048 * 2048, 2048, T, 2048, 2048, EpiBf16{(bf16_t*)(ws + WS_PQ), 2048, 2048}, bid, nb);
    SEAM(17);
    if (IN(18)) phase_topk(a, lds, 1, bid, nb);
    SEAM(18);
    if (IN(19)) phase_gather<true>(a, 1, XA, a.out, 3, a.in[28], 0, ABL_P1, bid, nb);
    if (a.ph_lo == 99) {
        const bf16_t* raw = (const bf16_t*)(ws + (size_t)a.ph_hi * 16384);
        for (size_t i = (size_t)bid * NTHREADS + threadIdx.x; i < (size_t)T * 2048; i += (size_t)nb * NTHREADS) a.out[i] = bf2f(raw[i]);
    }
#undef IN
#undef SEAM
}

#ifndef MK_ONE_LAUNCH
#define MK_ONE_LAUNCH 0
#endif
extern "C" void kernel_launch(void* const* d_in, const int* in_sizes, int n_in, void* d_out, int out_size, void* d_ws, size_t ws_size, hipStream_t stream) {
    static int grid = 0;
    if (grid == 0) {
        if (n_in != 29 || out_size != T * D_MODEL || ws_size < WS_END) { fprintf(stderr, "kernel_launch: unexpected shapes (n_in %d out %d ws %zu need %zu)\n", n_in, out_size, ws_size, (size_t)WS_END); grid = -1; return; }
        int dev = 0, cus = 0, per_cu = 0;
        if (hipGetDevice(&dev) != hipSuccess || hipDeviceGetAttribute(&cus, hipDeviceAttributeMultiprocessorCount, dev) != hipSuccess) { grid = -1; return; }
        if (hipFuncSetAttribute((const void*)fwd_kernel, hipFuncAttributeMaxDynamicSharedMemorySize, LDS_TOTAL) != hipSuccess) { fprintf(stderr, "kernel_launch: hipFuncSetAttribute failed\n"); grid = -1; return; }
        if (hipOccupancyMaxActiveBlocksPerMultiprocessor(&per_cu, (const void*)fwd_kernel, NTHREADS, LDS_TOTAL) != hipSuccess || per_cu < 1) { fprintf(stderr, "kernel_launch: occupancy query says %d\n", per_cu); }
        (void)hipGetLastError();
        grid = cus;
    }
    if (grid < 0) return;
    (void)hipMemsetAsync((char*)d_ws + WS_CTL, 0, 16384, stream);
    Args a{};
    for (int i = 0; i < 29; ++i) a.in[i] = (const float*)d_in[i];
    a.out = (float*)d_out; a.ws = (unsigned char*)d_ws;
#if MK_ONE_LAUNCH
    a.ph_lo = 0; a.ph_hi = N_PHASES;
    hipLaunchKernelGGL(fwd_kernel, dim3(grid), dim3(NTHREADS), LDS_TOTAL, stream, a);
#else
#ifdef DBG_UPTO
    for (int p = 0; p <= DBG_UPTO; ++p) {
        a.ph_lo = p; a.ph_hi = p + 1;
        hipLaunchKernelGGL(fwd_kernel, dim3(grid), dim3(NTHREADS), LDS_TOTAL, stream, a);
    }
    a.ph_lo = 99; a.ph_hi = (int)(DBG_OFF / 16384);
    hipLaunchKernelGGL(fwd_kernel, dim3(grid), dim3(NTHREADS), LDS_TOTAL, stream, a);
#else
    for (int p = 0; p < N_PHASES; ++p) {
        a.ph_lo = p; a.ph_hi = p + 1;
        hipLaunchKernelGGL(fwd_kernel, dim3(grid), dim3(NTHREADS), LDS_TOTAL, stream, a);
#ifdef REPEAT_LIST
        { const int rl[] = REPEAT_LIST; for (int q : rl) if (q == p) hipLaunchKernelGGL(fwd_kernel, dim3(grid), dim3(NTHREADS), LDS_TOTAL, stream, a); }
#endif
    }
#endif
#endif
}
```

```cpp
#include <hip/hip_runtime.h>
#include <stdint.h>
#include <stdio.h>

typedef unsigned short bf16_t;
typedef short bf16x8 __attribute__((ext_vector_type(8)));
typedef short s16x4 __attribute__((ext_vector_type(4)));
typedef float f32x16 __attribute__((ext_vector_type(16)));
typedef float f32x4 __attribute__((ext_vector_type(4)));
typedef float f32x2 __attribute__((ext_vector_type(2)));
typedef unsigned u32x4 __attribute__((ext_vector_type(4)));
typedef unsigned u32x2 __attribute__((ext_vector_type(2)));
typedef __bf16 bf16x2_t __attribute__((ext_vector_type(2)));
#define LAS __attribute__((address_space(3)))

constexpr int D_MODEL = 2048, BATCH = 2, SEQ = 8192, T = BATCH * SEQ;
constexpr float EPS = 1e-6f;
constexpr int SBMLA_IN = 3904, SBMLA_IN_PAD = 4096;
constexpr int NSA_IN = 3632, NSA_IN_PAD = 3840;
constexpr int NCMP = 511, NCMP_PAD = 512;
constexpr int NTHREADS = 512, NWAVES = 8;
constexpr int KVM_LD = 2112;

constexpr size_t al256(size_t x) { return (x + 255) & ~(size_t)255; }
constexpr size_t WS_CTL   = 0;
constexpr size_t WS_MOD   = 16384;
constexpr size_t WS_BIASP = WS_MOD + al256((size_t)4 * 2 * 6144 * 4);
constexpr size_t WS_ROPE64 = WS_BIASP + al256((size_t)2 * 32 * 256 * 4);
constexpr size_t WS_ROPE32 = WS_ROPE64 + (size_t)T * 32 * 8;
constexpr size_t WS_WIN0  = WS_ROPE32 + (size_t)T * 16 * 8;
constexpr size_t WS_WUQ   = WS_WIN0 + (size_t)SBMLA_IN_PAD * 2048 * 2;
constexpr size_t WS_WUKV  = WS_WUQ + (size_t)1536 * 512 * 2;
constexpr size_t WS_WOUT0 = WS_WUKV + (size_t)2048 * 256 * 2;
constexpr size_t WS_WNSAIN = WS_WOUT0 + (size_t)2048 * 2048 * 2;
constexpr size_t WS_W1K   = WS_WNSAIN + (size_t)NSA_IN_PAD * 2048 * 2;
constexpr size_t WS_W1V   = WS_W1K + (size_t)256 * 4096 * 2;
constexpr size_t WS_W2K   = WS_W1V + (size_t)256 * 4096 * 2;
constexpr size_t WS_W2V   = WS_W2K + (size_t)128 * 256 * 2;
constexpr size_t WS_WNSAOUT = WS_W2V + (size_t)128 * 256 * 2;
constexpr size_t WS_WPQ   = WS_WNSAOUT + (size_t)2048 * 2048 * 2;
constexpr size_t WS_K12   = WS_WPQ + (size_t)2 * 2048 * 2048 * 2;
constexpr size_t WS_PU    = WS_K12 + (size_t)4 * 128 * 128 * 2;
constexpr size_t WS_PV    = WS_PU + (size_t)2 * 16384 * 1536;
constexpr size_t WS_H     = WS_PV + (size_t)2 * 16384 * 1024;
constexpr size_t WS_BIG   = WS_H + (size_t)T * 2048 * 2;
constexpr size_t WS_O     = WS_BIG + (size_t)T * SBMLA_IN * 2;
constexpr size_t WS_XA    = WS_O + (size_t)T * 2048 * 2;
constexpr size_t WS_XB    = WS_XA + (size_t)T * 2048 * 4;
constexpr size_t WS_CQN   = WS_XA;
constexpr size_t WS_CKVN  = WS_CQN + (size_t)T * 512 * 2;
constexpr size_t WS_CMPPART = WS_XA;
constexpr size_t WS_OACC  = WS_XA;
constexpr size_t WS_QM    = WS_XB;
constexpr size_t WS_KVM   = WS_QM + (size_t)T * 1536 * 2;
constexpr size_t WS_PQ    = WS_XB;
static_assert((size_t)T * 1536 * 2 + (size_t)T * KVM_LD * 2 <= (size_t)T * 2048 * 4, "QM + KVM must fit the XB region");
constexpr size_t WS_EXI   = WS_XB + (size_t)T * 2048 * 4;
constexpr size_t WS_EXG   = WS_EXI + (size_t)T * 128 * 4;
constexpr size_t WS_HID   = WS_EXG + (size_t)T * 128 * 4;
constexpr size_t WS_KCC   = WS_HID + (size_t)2 * 2048 * 256 * 2;
constexpr size_t WS_VCC   = WS_KCC + (size_t)BATCH * NCMP_PAD * 2 * 128 * 2;
constexpr size_t WS_END   = WS_VCC + (size_t)BATCH * NCMP_PAD * 2 * 128 * 2;

struct Args {
    const float* in[29];
    float* out;
    unsigned char* ws;
    int ph_lo, ph_hi;
};

__device__ __forceinline__ unsigned cvtpk(float lo, float hi) {
    bf16x2_t v = {(__bf16)lo, (__bf16)hi};
    return __builtin_bit_cast(unsigned, v);
}
__device__ __forceinline__ float bf2f(unsigned short h) { return __uint_as_float(((unsigned)h) << 16); }
__device__ __forceinline__ float bflo(unsigned w) { return __uint_as_float(w << 16); }
__device__ __forceinline__ float bfhi(unsigned w) { return __uint_as_float(w & 0xFFFF0000u); }
__device__ __forceinline__ int crow(int r, int hi) { return (r & 3) + 8 * (r >> 2) + 4 * hi; }
__device__ __forceinline__ float wave_sum(float v) {
#pragma unroll
    for (int o = 32; o >= 1; o >>= 1) v += __shfl_xor(v, o);
    return v;
}
__device__ __forceinline__ float wave_sum_dpp(float v) {
#define WS_DPP(ctrl, rmask) v += __int_as_float(__builtin_amdgcn_update_dpp(0, __float_as_int(v), ctrl, rmask, 0xF, false))
    WS_DPP(0xB1, 0xF);
    WS_DPP(0x4E, 0xF);
    WS_DPP(0x141, 0xF);
    WS_DPP(0x140, 0xF);
    WS_DPP(0x142, 0xA);
    WS_DPP(0x143, 0xC);
#undef WS_DPP
    return __int_as_float(__builtin_amdgcn_readlane(__float_as_int(v), 63));
}
__device__ __forceinline__ float gelu_tanh(float x) {
    const float u = 0.7978845608028654f * (x + 0.044715f * x * x * x);
    const float e = __expf(2.f * u);
    const float th = 1.f - 2.f / (e + 1.f);
    return 0.5f * x * (1.f + th);
}
__device__ __forceinline__ int opaque_tid() { int t = threadIdx.x; asm volatile("" : "+v"(t)); return t; }
__device__ __forceinline__ unsigned char* WSP(const Args& A) {
    size_t z = 0; asm volatile("" : "+s"(z));
    return A.ws + z;
}
#ifndef ABL_SB
#define ABL_SB 1.f
#endif
#ifndef ABL_MLA
#define ABL_MLA 1.f
#endif
#ifndef ABL_NC
#define ABL_NC 1.f
#endif
#ifndef ABL_NS
#define ABL_NS 1.f
#endif
#ifndef ABL_NW
#define ABL_NW 1.f
#endif
#define XB_TMO      128
#define XB_XCNT(j)  (256  + 64 * (j))
#define XB_XSUB(j)  (1280 + 64 * (j))
#define XB_XGEN(j)  (2304 + 64 * (j))
#define XB_TOP      3328
#define XB_TOPGEN   3392
#define XCD_BAR_WORDS 3456
#define XB_SPIN_CAP (1u << 18)
#define LAS __attribute__((address_space(3)))

__device__ __forceinline__ unsigned xb_ld(unsigned* p)              { return __hip_atomic_load(p, __ATOMIC_RELAXED, __HIP_MEMORY_SCOPE_AGENT); }
__device__ __forceinline__ unsigned xb_add(unsigned* p, unsigned v) { return __hip_atomic_fetch_add(p, v, __ATOMIC_RELAXED, __HIP_MEMORY_SCOPE_AGENT); }
__device__ __forceinline__ unsigned xb_xcc_id() { return (unsigned)__builtin_amdgcn_s_getreg((3 << 11) | 20) & 0xFu; }
#define XB_SPIN(cond, bar) do { unsigned _sp = 0; while (cond) { __builtin_amdgcn_s_sleep(1); \
    if ((++_sp & 255u) == 0u) { if (xb_ld(&(bar)[XB_TMO])) break; if (_sp > XB_SPIN_CAP) { atomicAdd(&(bar)[XB_TMO], 1u); break; } } } } while (0)

struct XcdBarrier {
    unsigned* bar; unsigned x;
    volatile LAS unsigned* st;
};

__device__ __forceinline__ XcdBarrier xcd_barrier_post(unsigned* bar, volatile LAS unsigned* st) {
    XcdBarrier b; b.bar = bar; b.x = xb_xcc_id(); b.st = st;
    if (threadIdx.x == 0) (void)xb_add(&bar[XB_XCNT(b.x)], 1u);
    return b;
}
__device__ __forceinline__ void xcd_barrier_complete(unsigned* bar, unsigned x, unsigned& nloc, unsigned& nx) {
    const unsigned G = gridDim.x * gridDim.y * gridDim.z;
    unsigned sum, cnt, mine, sp = 0u;
    for (;;) {
        sum = 0u; cnt = 0u; mine = 0u;
#pragma unroll
        for (unsigned j = 0; j < 16; ++j) { const unsigned c = xb_ld(&bar[XB_XCNT(j)]); sum += c; cnt += (c > 0u) ? 1u : 0u; mine = (j == x) ? c : mine; }
        if (sum == G) break;
        __builtin_amdgcn_s_sleep(1);
        if ((++sp & 255u) == 0u) { if (xb_ld(&bar[XB_TMO])) break; if (sp > XB_SPIN_CAP) { atomicAdd(&bar[XB_TMO], 1u); break; } }
    }
    nloc = mine > 0u ? mine : 1u; nx = cnt > 0u ? cnt : 1u;
}

__device__ __forceinline__ void xcd_barrier(const XcdBarrier& b) {
    asm volatile("s_waitcnt vmcnt(0)" ::: "memory");
    __syncthreads();
    if (threadIdx.x == 0) {
        unsigned* bar = b.bar;
        __builtin_amdgcn_s_waitcnt(0);
        unsigned nloc = b.st[0], nx = b.st[1];
        if (nloc == 0u) { xcd_barrier_complete(bar, b.x, nloc, nx); b.st[0] = nloc; b.st[1] = nx; }
        const unsigned old = xb_add(&bar[XB_XSUB(b.x)], 1u);
        const unsigned gen = old / nloc;
        if (old + 1u == (gen + 1u) * nloc) {
            __builtin_amdgcn_fence(__ATOMIC_RELEASE, "agent");
            asm volatile("s_waitcnt vmcnt(0)" ::: "memory");
            const unsigned og = xb_add(&bar[XB_TOP], 1u);
            const unsigned tg = og / nx;
            if (og + 1u == (tg + 1u) * nx) xb_add(&bar[XB_TOPGEN], 1u);
            else XB_SPIN(xb_ld(&bar[XB_TOPGEN]) == tg, bar);
            __builtin_amdgcn_fence(__ATOMIC_ACQUIRE, "agent");
            xb_add(&bar[XB_XGEN(b.x)], 1u);
            asm volatile("s_waitcnt vmcnt(0)" ::: "memory");
        } else {
            XB_SPIN(xb_ld(&bar[XB_XGEN(b.x)]) == gen, bar);
            __builtin_amdgcn_fence(__ATOMIC_ACQUIRE, "agent");
            asm volatile("s_waitcnt vmcnt(0)" ::: "memory");
        }
    }
    __syncthreads();
}
constexpr int U0_MOD = 48  , U0_MOD_LATE = 144, U0_TR = 8912, U0_PEER = 2048, U0_ROPE = 192, U0_BIAS = 64, U0_K12 = 8, U0_ZERO = 8;
constexpr int U0_TOTAL = U0_MOD + U0_TR + U0_ROPE + U0_BIAS + U0_K12 + U0_ZERO;

struct TrDesc { int in_idx; size_t in_off; int K, N, Npad; size_t ws_off; int ntiles; };
__device__ __forceinline__ TrDesc tr_desc(int m) {
    switch (m) {
        case 0:  return TrDesc{6, 0, 2048, 3904, 4096, WS_WIN0, 2048};
        case 1:  return TrDesc{8, 0, 512, 1536, 1536, WS_WUQ, 192};
        case 2:  return TrDesc{10, 0, 256, 2048, 2048, WS_WUKV, 128};
        case 3:  return TrDesc{11, 0, 2048, 2048, 2048, WS_WOUT0, 1024};
        case 4:  return TrDesc{12, 0, 2048, 3632, 3840, WS_WNSAIN, 1920};
        case 5:  return TrDesc{15, 0, 4096, 256, 256, WS_W1K, 256};
        case 6:  return TrDesc{17, 0, 4096, 256, 256, WS_W1V, 256};
        case 7:  return TrDesc{16, 0, 256, 128, 128, WS_W2K, 8};
        case 8:  return TrDesc{18, 0, 256, 128, 128, WS_W2V, 8};
        case 9:  return TrDesc{19, 0, 2048, 2048, 2048, WS_WNSAOUT, 1024};
        case 10: return TrDesc{23, 0, 2048, 2048, 2048, WS_WPQ, 1024};
        default: return TrDesc{23, (size_t)2048 * 2048, 2048, 2048, 2048, WS_WPQ + (size_t)2048 * 2048 * 2, 1024};
    }
}

__device__ __forceinline__ void p0_mod_unit(const Args& A, unsigned char* lds, int u) {
    const int tid = opaque_tid();
    float* sc = (float*)lds;
    float* red = (float*)(lds + 16384);
    const int set = u / 48, cc = u % 48;
    const int layer = set >> 1, kind = set & 1;
    const float* w = (kind ? A.in[21] : A.in[4]) + (size_t)layer * 2048 * 6144;
    const float* bias = (kind ? A.in[22] : A.in[5]) + (size_t)layer * 6144;
    const float* c = A.in[1];
    for (int i = tid; i < 4096; i += NTHREADS) { const float v = c[i]; sc[i] = v / (1.f + __expf(-v)); }
    __syncthreads();
    const int l32 = tid & 31, kg = tid >> 5;
    const int col = cc * 128 + l32 * 4;
    float a0[4] = {0, 0, 0, 0}, a1[4] = {0, 0, 0, 0};
    const float* wp = w + (size_t)(kg * 128) * 6144 + col;
#pragma unroll 8
    for (int i = 0; i < 128; ++i) {
        const f32x4 wv = *(const f32x4*)(wp + (size_t)i * 6144);
        const float s0 = sc[kg * 128 + i], s1 = sc[2048 + kg * 128 + i];
#pragma unroll
        for (int j = 0; j < 4; ++j) { a0[j] += s0 * wv[j]; a1[j] += s1 * wv[j]; }
    }
#pragma unroll
    for (int j = 0; j < 4; ++j) { red[(kg * 2 + 0) * 128 + l32 * 4 + j] = a0[j]; red[(kg * 2 + 1) * 128 + l32 * 4 + j] = a1[j]; }
    __syncthreads();
    if (tid < 256) {
        const int b = tid >> 7, cl = tid & 127;
        float s = 0;
#pragma unroll
        for (int g = 0; g < 16; ++g) s += red[(g * 2 + b) * 128 + cl];
        float* mod = (float*)(WSP(A) + WS_MOD);
        mod[(size_t)(set * 2 + b) * 6144 + cc * 128 + cl] = s + bias[cc * 128 + cl];
    }
    __syncthreads();
}

__device__ __forceinline__ void p0_tr_unit(const Args& A, unsigned char* lds, int u) {
    const int tid = opaque_tid();
    int m = 0, tile = u;
    TrDesc d = tr_desc(0);
    while (tile >= d.ntiles) { tile -= d.ntiles; ++m; d = tr_desc(m); }
    const int nNt = d.Npad / 64;
    const int kt = tile / nNt, nt = tile % nNt;
    const float* src = A.in[d.in_idx] + d.in_off;
    bf16_t* dst = (bf16_t*)(WSP(A) + d.ws_off);
    float* ts = (float*)lds;
    {
        const int r = tid >> 3, cg = tid & 7;
        const int k = kt * 64 + r, n = nt * 64 + cg * 8;
        f32x4 v0 = {0, 0, 0, 0}, v1 = {0, 0, 0, 0};
        if (n < d.N) { const float* p = src + (size_t)k * d.N + n; v0 = *(const f32x4*)p; v1 = *(const f32x4*)(p + 4); }
#pragma unroll
        for (int j = 0; j < 4; ++j) { ts[r * 65 + cg * 8 + j] = v0[j]; ts[r * 65 + cg * 8 + 4 + j] = v1[j]; }
    }
    __syncthreads();
    {
        const int n = tid >> 3, kg = tid & 7;
        float v[8];
#pragma unroll
        for (int j = 0; j < 8; ++j) v[j] = ts[(kg * 8 + j) * 65 + n];
        u32x4 w = {cvtpk(v[0], v[1]), cvtpk(v[2], v[3]), cvtpk(v[4], v[5]), cvtpk(v[6], v[7])};
        *(u32x4*)(dst + (size_t)(nt * 64 + n) * d.K + kt * 64 + kg * 8) = w;
    }
    __syncthreads();
}

constexpr float PEER_USCALE = 90.5f, PEER_VSCALE = 5.65685f;
constexpr int PEER_UROW_BYTES = 2048 * 6 / 8, PEER_VROW_BYTES = 2048 * 4 / 8;
constexpr size_t PEER_U16_SLICE = (size_t)16384 * 128, PEER_U8_SLICE = (size_t)16384 * 64, PEER_V_SLICE = (size_t)16384 * 128;
constexpr size_t PEER_U_LAYER = (size_t)16384 * PEER_UROW_BYTES, PEER_U8_OFF = 8 * PEER_U16_SLICE, PEER_V_LAYER = (size_t)16384 * PEER_VROW_BYTES;
constexpr size_t WS_DP = WS_BIG;
constexpr size_t WS_PW = WS_DP + (size_t)8 * T * 128 * 4;
static_assert((size_t)9 * T * 128 * 4 <= (size_t)T * SBMLA_IN * 2, "PEER scratch must fit the BIG region");
typedef float f32x32 __attribute__((ext_vector_type(32)));
typedef unsigned u32x6 __attribute__((ext_vector_type(6)));
__device__ __forceinline__ void p0_peer_unit(const Args& A, int u) {
    const int tid = opaque_tid();
    const bool isv = u >= 1024;
    const int pu = isv ? u - 1024 : u;
    const float* src = (isv ? A.in[27] : A.in[26]) + (size_t)pu * 65536;
#pragma unroll 1
    for (int it = 0; it < 4; ++it) {
        const int grp = it * NTHREADS + tid;
        const float* p = src + grp * 32;
        if (!isv) {
            u32x4 w;
#pragma unroll
            for (int j = 0; j < 4; ++j) {
                const f32x4 v0 = *(const f32x4*)(p + 8 * j), v1 = *(const f32x4*)(p + 8 * j + 4);
                unsigned d = 0;
                d = __builtin_amdgcn_cvt_scalef32_pk_fp4_f32(d, v0[0] * PEER_USCALE, v0[1] * PEER_USCALE, 1.0f, 0);
                d = __builtin_amdgcn_cvt_scalef32_pk_fp4_f32(d, v0[2] * PEER_USCALE, v0[3] * PEER_USCALE, 1.0f, 1);
                d = __builtin_amdgcn_cvt_scalef32_pk_fp4_f32(d, v1[0] * PEER_USCALE, v1[1] * PEER_USCALE, 1.0f, 2);
                d = __builtin_amdgcn_cvt_scalef32_pk_fp4_f32(d, v1[2] * PEER_USCALE, v1[3] * PEER_USCALE, 1.0f, 3);
                w[j] = d;
            }
            const int R = pu * 32 + (grp >> 6), e = R & 16383, cb = grp & 63;
            *(u32x4*)(WSP(A) + WS_PU + (size_t)(R >> 14) * PEER_U_LAYER + (size_t)(cb >> 3) * PEER_U16_SLICE + (size_t)e * 128 + (cb & 7) * 16) = w;
        } else {
            u32x4 w;
#pragma unroll
            for (int j = 0; j < 4; ++j) {
                const f32x4 v0 = *(const f32x4*)(p + 8 * j), v1 = *(const f32x4*)(p + 8 * j + 4);
                unsigned d = 0;
                d = __builtin_amdgcn_cvt_scalef32_pk_fp4_f32(d, v0[0] * PEER_VSCALE, v0[1] * PEER_VSCALE, 1.0f, 0);
                d = __builtin_amdgcn_cvt_scalef32_pk_fp4_f32(d, v0[2] * PEER_VSCALE, v0[3] * PEER_VSCALE, 1.0f, 1);
                d = __builtin_amdgcn_cvt_scalef32_pk_fp4_f32(d, v1[0] * PEER_VSCALE, v1[1] * PEER_VSCALE, 1.0f, 2);
                d = __builtin_amdgcn_cvt_scalef32_pk_fp4_f32(d, v1[2] * PEER_VSCALE, v1[3] * PEER_VSCALE, 1.0f, 3);
                w[j] = d;
            }
            const int R = pu * 32 + (grp >> 6), e = R & 16383, cb = grp & 63;
            *(u32x4*)(WSP(A) + WS_PV + (size_t)(R >> 14) * PEER_V_LAYER + (size_t)(cb >> 3) * PEER_V_SLICE + (size_t)e * 128 + (cb & 7) * 16) = w;
        }
    }
}

__device__ __forceinline__ void p0_rope_unit(const Args& A, int u) {
    const int tid = opaque_tid();
    const int* pos = (const int*)A.in[2];
#pragma unroll 1
    for (int it = 0; it < 8; ++it) {
        const int e = u * 4096 + it * NTHREADS + tid;
        if (e < T * 32) {
            const int t = e >> 5, j = e & 31;
            const float inv = powf(500000.0f, -(float)j / 32.0f);
            const float ang = (float)pos[t] * inv;
            float s, c; sincosf(ang, &s, &c);
            ((f32x2*)(WSP(A) + WS_ROPE64))[e] = f32x2{c, s};
        } else {
            const int e2 = e - T * 32;
            const int t = e2 >> 4, j = e2 & 15;
            const float inv = powf(500000.0f, -(float)j / 16.0f);
            const float ang = (float)pos[t] * inv;
            float s, c; sincosf(ang, &s, &c);
            ((f32x2*)(WSP(A) + WS_ROPE32))[e2] = f32x2{c, s};
        }
    }
}

__device__ __forceinline__ void p0_bias_unit(const Args& A, unsigned char* lds, int u) {
    const int tid = opaque_tid();
    const int mat = u >> 5, chunk = u & 31;
    const float* pe = A.in[mat ? 14 : 13];
    const float* w1 = A.in[mat ? 17 : 15];
    const int col = tid & 255, half = tid >> 8;
    float acc = 0;
    const int r0 = chunk * 128 + half * 64;
#pragma unroll 8
    for (int i = 0; i < 64; ++i) acc += pe[r0 + i] * w1[(size_t)(r0 + i) * 256 + col];
    float* red = (float*)lds;
    if (half) red[col] = acc;
    __syncthreads();
    if (!half) ((float*)(WSP(A) + WS_BIASP))[(mat * 32 + chunk) * 256 + col] = acc + red[col];
    __syncthreads();
}

__device__ __forceinline__ void p0_k12_unit(const Args& A, int u) {
    const int tid = opaque_tid();
    bf16_t* dst = (bf16_t*)(WSP(A) + WS_K12);
#pragma unroll
    for (int it = 0; it < 2; ++it) {
        const int e = u * 8192 + (it * NTHREADS + tid) * 8;
        const int layer = e >> 15, which = (e >> 14) & 1, rem = e & 16383;
        const float* src = A.in[which ? 25 : 24] + layer * 16384 + rem;
        const f32x4 v0 = *(const f32x4*)src, v1 = *(const f32x4*)(src + 4);
        u32x4 w = {cvtpk(v0[0], v0[1]), cvtpk(v0[2], v0[3]), cvtpk(v1[0], v1[1]), cvtpk(v1[2], v1[3])};
        *(u32x4*)(dst + e) = w;
    }
}

__device__ __forceinline__ void phase_prologue(const Args& A, unsigned char* lds, int bid, int nb) {
    for (int u = bid; u < U0_TOTAL; u += nb) {
        int v = u;
        if (v < U0_MOD) { p0_mod_unit(A, lds, v); continue; }
        v -= U0_MOD;
        if (v < U0_TR) { p0_tr_unit(A, lds, v); continue; }
        v -= U0_TR;
        if (v < U0_ROPE) { p0_rope_unit(A, v); continue; }
        v -= U0_ROPE;
        if (v < U0_BIAS) { p0_bias_unit(A, lds, v); continue; }
        v -= U0_BIAS;
        if (v < U0_K12) { p0_k12_unit(A, v); continue; }
        v -= U0_K12;
        {
            u32x4* z = (u32x4*)(WSP(A) + WS_KCC) + (size_t)v * 8192;
            for (int i = opaque_tid(); i < 8192; i += NTHREADS) z[i] = u32x4{0u, 0u, 0u, 0u};
        }
    }
}

__device__ __forceinline__ void modnorm_row(const float* xr, const float* gain, const float* mod  , bf16_t* hr, int lane) {
    f32x4 v[8];
    float ss = 0;
#pragma unroll
    for (int i = 0; i < 8; ++i) { v[i] = *(const f32x4*)(xr + i * 256 + lane * 4); ss += v[i][0] * v[i][0] + v[i][1] * v[i][1] + v[i][2] * v[i][2] + v[i][3] * v[i][3]; }
    ss = wave_sum(ss);
    const float rinv = rsqrtf(ss * (1.0f / 2048.0f) + EPS);
#pragma unroll
    for (int i = 0; i < 8; ++i) {
        const int col = i * 256 + lane * 4;
        const f32x4 g = *(const f32x4*)(gain + col), sh = *(const f32x4*)(mod + col), scl = *(const f32x4*)(mod + 2048 + col);
        float y[4];
#pragma unroll
        for (int j = 0; j < 4; ++j) y[j] = v[i][j] * rinv * g[j] * (1.f + scl[j]) + sh[j];
        u32x2 w = {cvtpk(y[0], y[1]), cvtpk(y[2], y[3])};
        *(u32x2*)(hr + col) = w;
    }
}
__device__ __forceinline__ void phase_modnorm(const Args& A, const float* xin, const float* gain, int set, int bid, int nb) {
    const int tid = opaque_tid(), lane = tid & 63, wave = tid >> 6;
    const float* mod = (const float*)(WSP(A) + WS_MOD) + (size_t)set * 2 * 6144;
    bf16_t* H = (bf16_t*)(WSP(A) + WS_H);
    for (int u = bid; u < T / NWAVES; u += nb) {
        const int row = u * NWAVES + wave;
        modnorm_row(xin + (size_t)row * 2048, gain, mod + (row >> 13) * 6144, H + (size_t)row * 2048, lane);
    }
}

struct ALoadPlain {
    const bf16_t* A; int lda;
    __device__ __forceinline__ const bf16_t* ptr(int row, int k) const { return A + (size_t)row * lda + k; }
};
struct ALoadCmp {
    const bf16_t* base; int ld; int colbase;
    __device__ __forceinline__ const bf16_t* ptr(int row, int k) const {
        int r = row < 2 * BATCH * NCMP ? row : 2 * BATCH * NCMP - 1;
        const int g = r & 1; r >>= 1;
        const int b = r / NCMP, n = r - b * NCMP;
        const int l = k >> 7, d = k & 127;
        return base + (size_t)(b * SEQ + 16 * n + l) * ld + colbase + g * 128 + d;
    }
};

constexpr int GEMM_LDS = 98304;
template <class AL, class Epi>
__device__ __forceinline__ void gemm_unit(unsigned char* lds, const AL& al, const bf16_t* __restrict__ Bt, int ldb, int m0, int n0, int kt0, int nk, const Epi& epi, int tid) {
    const int lane = tid & 63, wave = tid >> 6, l31 = lane & 31, hi = lane >> 5;
    const int wm = wave >> 1, wn = wave & 1;
    const int swz = (l31 >> 1) & 7;
    f32x16 acc[2][2];
#pragma unroll
    for (int i = 0; i < 2; ++i)
#pragma unroll
        for (int j = 0; j < 2; ++j)
#pragma unroll
            for (int r = 0; r < 16; ++r) acc[i][j][r] = 0.f;
    u32x4 ra[4], rb[2];
    auto gload = [&](int kt) {
#pragma unroll
        for (int i = 0; i < 4; ++i) { const int q = tid + NTHREADS * i, row = q >> 3, c = q & 7; ra[i] = *(const u32x4*)al.ptr(m0 + row, (kt0 + kt) * 64 + c * 8); }
#pragma unroll
        for (int i = 0; i < 2; ++i) { const int q = tid + NTHREADS * i, row = q >> 3, c = q & 7; rb[i] = *(const u32x4*)(Bt + (size_t)(n0 + row) * ldb + (kt0 + kt) * 64 + c * 8); }
    };
    auto lstore = [&](int buf) {
        unsigned char* la = lds + buf * 32768; unsigned char* lb = lds + 65536 + buf * 16384;
#pragma unroll
        for (int i = 0; i < 4; ++i) { const int q = tid + NTHREADS * i, row = q >> 3, c = q & 7; *(u32x4*)(la + row * 128 + ((c ^ ((row >> 1) & 7)) << 4)) = ra[i]; }
#pragma unroll
        for (int i = 0; i < 2; ++i) { const int q = tid + NTHREADS * i, row = q >> 3, c = q & 7; *(u32x4*)(lb + row * 128 + ((c ^ ((row >> 1) & 7)) << 4)) = rb[i]; }
    };
    gload(0); lstore(0); __syncthreads();
    for (int kt = 0; kt < nk; ++kt) {
        if (kt + 1 < nk) gload(kt + 1);
        const unsigned char* la = lds + (kt & 1) * 32768 + (wm * 64 + l31) * 128;
        const unsigned char* lb = lds + 65536 + (kt & 1) * 16384 + (wn * 64 + l31) * 128;
#pragma unroll
        for (int ks = 0; ks < 4; ++ks) {
            const int co = ((ks * 2 + hi) ^ swz) << 4;
            const bf16x8 a0 = *(const bf16x8*)(la + co), a1 = *(const bf16x8*)(la + 32 * 128 + co);
            const bf16x8 b0 = *(const bf16x8*)(lb + co), b1 = *(const bf16x8*)(lb + 32 * 128 + co);
            acc[0][0] = __builtin_amdgcn_mfma_f32_32x32x16_bf16(a0, b0, acc[0][0], 0, 0, 0);
            acc[0][1] = __builtin_amdgcn_mfma_f32_32x32x16_bf16(a0, b1, acc[0][1], 0, 0, 0);
            acc[1][0] = __builtin_amdgcn_mfma_f32_32x32x16_bf16(a1, b0, acc[1][0], 0, 0, 0);
            acc[1][1] = __builtin_amdgcn_mfma_f32_32x32x16_bf16(a1, b1, acc[1][1], 0, 0, 0);
        }
        if (kt + 1 < nk) lstore((kt + 1) & 1);
        __syncthreads();
    }
    epi.template operator()<2>(acc, m0 + wm * 64, n0 + wn * 64, lane);
}

constexpr int GEMM256_LDS = 131072;
template <class Epi>
__device__ __forceinline__ void gemm256_phase(unsigned char* lds, const bf16_t* __restrict__ Ag, int lda, const bf16_t* __restrict__ Bt, int ldb, int M, int Npad, int K, const Epi epi, int bid, int nb) {
    const int tid = opaque_tid(), lane = tid & 63, wave = __builtin_amdgcn_readfirstlane(tid >> 6), l31 = lane & 31, hi = lane >> 5;
    const int wm = wave >> 2, wn = wave & 3;
    const int nNt = Npad / 256, nU = (M / 256) * nNt, nk = K / 64;
    const int swz = (l31 >> 1) & 7;
    unsigned aoff[4], boff[4];
#pragma unroll
    for (int i = 0; i < 4; ++i) {
        const int row = (wave * 4 + i) * 8 + (lane >> 3), c = (lane & 7) ^ ((row >> 1) & 7);
        aoff[i] = (unsigned)(row * lda + c * 8) * 2u; boff[i] = (unsigned)(row * ldb + c * 8) * 2u;
    }
    const int vcu = (nb % 8 == 0) ? (bid % 8) * (nb / 8) + bid / 8 : bid;
    auto issue = [&](const unsigned char* abase, const unsigned char* bbase, int kt, int stage) {
        unsigned char* la = lds + stage * 65536 + wave * 4096; unsigned char* lb = la + 32768;
#pragma unroll
        for (int i = 0; i < 4; ++i) {
            __builtin_amdgcn_global_load_lds((const unsigned*)(abase + aoff[i] + kt * 128), (unsigned*)(la + i * 1024), 16, 0, 0);
            __builtin_amdgcn_global_load_lds((const unsigned*)(bbase + boff[i] + kt * 128), (unsigned*)(lb + i * 1024), 16, 0, 0);
        }
    };
    if (vcu < nU) {
        const int mt = vcu / nNt, nt = vcu - mt * nNt;
        issue((const unsigned char*)(Ag + (size_t)mt * 256 * lda), (const unsigned char*)(Bt + (size_t)nt * 256 * ldb), 0, 0);
    }
    for (int u = vcu; u < nU; u += nb) {
        const int mt = u / nNt, nt = u - mt * nNt;
        const int m0 = mt * 256, n0 = nt * 256;
        const unsigned char* abase = (const unsigned char*)(Ag + (size_t)m0 * lda);
        const unsigned char* bbase = (const unsigned char*)(Bt + (size_t)n0 * ldb);
        f32x16 acc[4][2];
#pragma unroll
        for (int i = 0; i < 4; ++i)
#pragma unroll
            for (int j = 0; j < 2; ++j)
#pragma unroll
                for (int r = 0; r < 16; ++r) acc[i][j][r] = 0.f;
        asm volatile("s_waitcnt vmcnt(0)" ::: "memory");
        __syncthreads();
        for (int kt = 0; kt < nk; ++kt) {
            if (kt + 1 < nk) issue(abase, bbase, kt + 1, (kt + 1) & 1);
            const unsigned char* la = lds + (kt & 1) * 65536 + (wm * 128 + l31) * 128;
            const unsigned char* lb = lds + (kt & 1) * 65536 + 32768 + (wn * 64 + l31) * 128;
#pragma unroll
            for (int ks = 0; ks < 4; ++ks) {
                const int co = ((ks * 2 + hi) ^ swz) << 4;
                const bf16x8 b0 = *(const bf16x8*)(lb + co), b1 = *(const bf16x8*)(lb + 32 * 128 + co);
#pragma unroll
                for (int mi = 0; mi < 4; ++mi) {
                    const bf16x8 a = *(const bf16x8*)(la + mi * 32 * 128 + co);
                    acc[mi][0] = __builtin_amdgcn_mfma_f32_32x32x16_bf16(a, b0, acc[mi][0], 0, 0, 0);
                    acc[mi][1] = __builtin_amdgcn_mfma_f32_32x32x16_bf16(a, b1, acc[mi][1], 0, 0, 0);
                }
            }
            asm volatile("s_waitcnt vmcnt(0)" ::: "memory");
            __syncthreads();
        }
        if (u + nb < nU) {
            const int un = u + nb, mtn = un / nNt, ntn = un - mtn * nNt;
            issue((const unsigned char*)(Ag + (size_t)mtn * 256 * lda), (const unsigned char*)(Bt + (size_t)ntn * 256 * ldb), 0, 0);
        }
        epi.template operator()<4>(acc, m0 + wm * 128, n0 + wn * 64, lane);
    }
}

template <int MI>
__device__ __forceinline__ void store_bf16_tile(const f32x16 (&acc)[MI][2], bf16_t* C, int ldc, int N, int row0, int col0, int lane) {
    const int l31 = lane & 31, hi = lane >> 5;
#pragma unroll
    for (int ni = 0; ni < 2; ++ni) {
        const int col = col0 + ni * 32 + l31;
#pragma unroll
        for (int mi = 0; mi < MI; ++mi)
#pragma unroll
            for (int r = 0; r < 16; ++r) {
                const float v = acc[mi][ni][r];
                const float vn = __shfl_xor(v, 1);
                if ((l31 & 1) == 0 && col < N) *(unsigned*)(C + (size_t)(row0 + mi * 32 + crow(r, hi)) * ldc + col) = cvtpk(v, vn);
            }
    }
}
struct EpiBf16 {
    bf16_t* C; int ldc; int N;
    template <int MI> __device__ __forceinline__ void operator()(f32x16 (&acc)[MI][2], int row0, int col0, int lane) const { store_bf16_tile<MI>(acc, C, ldc, N, row0, col0, lane); }
};
struct EpiMlaQ {
    bf16_t* C; const f32x2* rope64;
    template <int MI> __device__ __forceinline__ void operator()(f32x16 (&acc)[MI][2], int row0, int col0, int lane) const {
        const int l31 = lane & 31, hi = lane >> 5;
        if ((col0 % 192) == 128) {
#pragma unroll
            for (int mi = 0; mi < MI; ++mi)
#pragma unroll
                for (int r = 0; r < 16; ++r) {
                    const int row = row0 + mi * 32 + crow(r, hi);
                    const f32x2 cs = rope64[(size_t)row * 32 + l31];
                    const float x1 = acc[mi][0][r], x2 = acc[mi][1][r];
                    acc[mi][0][r] = x1 * cs[0] - x2 * cs[1];
                    acc[mi][1][r] = x2 * cs[0] + x1 * cs[1];
                    if ((r & 3) == 3) __builtin_amdgcn_sched_barrier(0);
                }
        }
        store_bf16_tile<MI>(acc, C, 1536, 1536, row0, col0, lane);
    }
};
struct EpiNsaIn {
    bf16_t* C; const f32x2* rope32;
    template <int MI> __device__ __forceinline__ void operator()(f32x16 (&acc)[MI][2], int row0, int col0, int lane) const {
        const int l31 = lane & 31, hi = lane >> 5;
#pragma unroll
        for (int ni = 0; ni < 2; ++ni) {
            const int cb = col0 + ni * 32, hb = cb >> 7;
            const bool is_rope = ((cb & 127) == 0) && (hb < 18 || hb == 20 || hb == 21 || hb == 24 || hb == 25);
            if (is_rope) {
#pragma unroll
                for (int mi = 0; mi < MI; ++mi)
#pragma unroll
                    for (int r = 0; r < 16; ++r) {
                        const int row = row0 + mi * 32 + crow(r, hi);
                        const f32x2 cs = rope32[(size_t)row * 16 + (l31 & 15)];
                        const float own = acc[mi][ni][r];
                        const float oth = __shfl_xor(own, 16);
                        acc[mi][ni][r] = (l31 < 16) ? own * cs[0] - oth * cs[1] : own * cs[0] + oth * cs[1];
                    }
            }
            if (cb >= 3584) {
#pragma unroll
                for (int mi = 0; mi < MI; ++mi)
#pragma unroll
                    for (int r = 0; r < 16; ++r) acc[mi][ni][r] = 1.f / (1.f + __expf(-acc[mi][ni][r]));
            }
        }
        store_bf16_tile<MI>(acc, C, NSA_IN, NSA_IN, row0, col0, lane);
    }
};
struct EpiResid {
    const float* xin; float* xout; const float* gate; float gmul;
    template <int MI> __device__ __forceinline__ void operator()(f32x16 (&acc)[MI][2], int row0, int col0, int lane) const {
        const int l31 = lane & 31, hi = lane >> 5;
        const float* gp = gate + (row0 >> 13) * 6144 + col0 + l31;
        const float g0 = gp[0] * gmul, g1 = gp[32] * gmul;
        const size_t base = (size_t)(row0 + 4 * hi) * 2048 + col0 + l31;
#pragma unroll
        for (int mi = 0; mi < MI; ++mi) {
#pragma unroll
            for (int q = 0; q < 4; ++q) {
                float xv[8];
#pragma unroll
                for (int j = 0; j < 4; ++j) { const size_t o = base + (size_t)(mi * 32 + 8 * q + j) * 2048; xv[j] = xin[o]; xv[4 + j] = xin[o + 32]; }
#pragma unroll
                for (int j = 0; j < 4; ++j) { const size_t o = base + (size_t)(mi * 32 + 8 * q + j) * 2048; xout[o] = xv[j] + g0 * acc[mi][0][4 * q + j]; xout[o + 32] = xv[4 + j] + g1 * acc[mi][1][4 * q + j]; }
                __builtin_amdgcn_sched_barrier(0);
            }
        }
    }
};
struct EpiCmpHid {
    bf16_t* C; const float* biasp;
    template <int MI> __device__ __forceinline__ void operator()(f32x16 (&acc)[MI][2], int row0, int col0, int lane) const {
        const int l31 = lane & 31;
#pragma unroll
        for (int ni = 0; ni < 2; ++ni) {
            const int col = col0 + ni * 32 + l31;
            float b = 0;
#pragma unroll 8
            for (int c = 0; c < 32; ++c) b += biasp[c * 256 + col];
#pragma unroll
            for (int mi = 0; mi < MI; ++mi)
#pragma unroll
                for (int r = 0; r < 16; ++r) acc[mi][ni][r] = gelu_tanh(acc[mi][ni][r] + b);
        }
        store_bf16_tile<MI>(acc, C, 256, 256, row0, col0, lane);
    }
};
struct EpiCmpOut {
    bf16_t* C;
    template <int MI> __device__ __forceinline__ void operator()(f32x16 (&acc)[MI][2], int row0, int col0, int lane) const {
        const int l31 = lane & 31, hi = lane >> 5;
#pragma unroll
        for (int ni = 0; ni < 2; ++ni) {
            const int col = col0 + ni * 32 + l31;
#pragma unroll
            for (int mi = 0; mi < MI; ++mi)
#pragma unroll
                for (int r = 0; r < 16; ++r) {
                    const float v = acc[mi][ni][r];
                    const float vn = __shfl_xor(v, 1);
                    int rr = row0 + mi * 32 + crow(r, hi);
                    if ((l31 & 1) == 0 && rr < 2 * BATCH * NCMP) {
                        const int g = rr & 1; rr >>= 1;
                        const int b = rr / NCMP, n = rr - b * NCMP;
                        *(unsigned*)(C + (size_t)((b * NCMP_PAD + n) * 2 + g) * 128 + col) = cvtpk(v, vn);
                    }
                }
        }
    }
};

struct EpiPartF32 {
    float* P;
    template <int MI> __device__ __forceinline__ void operator()(f32x16 (&acc)[MI][2], int row0, int col0, int lane) const {
        const int l31 = lane & 31, hi = lane >> 5;
#pragma unroll
        for (int ni = 0; ni < 2; ++ni)
#pragma unroll
            for (int mi = 0; mi < MI; ++mi)
#pragma unroll
                for (int r = 0; r < 16; ++r) P[(size_t)(row0 + mi * 32 + crow(r, hi)) * 256 + col0 + ni * 32 + l31] = acc[mi][ni][r];
    }
};
__device__ __forceinline__ void phase_cmp_partial(const Args& A, unsigned char* lds, int bid, int nb) {
    const int tid = opaque_tid();
    const bf16_t* NS = (const bf16_t*)(WSP(A) + WS_BIG);
    float* PART = (float*)(WSP(A) + WS_CMPPART);
    for (int u = bid; u < 256; u += nb) {
        const int mat = u >> 7, ks = (u >> 4) & 7, mt = (u >> 1) & 7, nt = u & 1;
        const bf16_t* w1 = (const bf16_t*)(WSP(A) + (mat ? WS_W1V : WS_W1K));
        gemm_unit(lds, ALoadCmp{NS, NSA_IN, mat ? 2304 : 2048}, w1, 4096, mt * 256, nt * 128, ks * 8, 8, EpiPartF32{PART + (size_t)(mat * 8 + ks) * 2048 * 256}, tid);
    }
}
__device__ __forceinline__ void phase_cmp_out(const Args& A, unsigned char* lds, int bid, int nb) {
    const int tid = opaque_tid();
    const float* PART = (const float*)(WSP(A) + WS_CMPPART);
    bf16_t* HID = (bf16_t*)(WSP(A) + WS_HID);
    for (int u = bid; u < 16; u += nb) {
        const int mat = u >> 3, mt = u & 7;
        float* bias = (float*)lds;
        if (tid < 256) { const float* bp = (const float*)(WSP(A) + WS_BIASP) + mat * 32 * 256 + tid; float b = 0.f;
#pragma unroll 8
            for (int c = 0; c < 32; ++c) b += bp[c * 256];
            bias[tid] = b; }
        __syncthreads();
#pragma unroll 1
        for (int it = 0; it < 16; ++it) {
            const int q = it * NTHREADS + tid, row = mt * 256 + (q >> 5), col = (q & 31) * 8;
            float h[8];
#pragma unroll
            for (int j = 0; j < 8; ++j) h[j] = bias[col + j];
#pragma unroll
            for (int ks = 0; ks < 8; ++ks) {
                const float* pp = PART + ((size_t)(mat * 8 + ks) * 2048 + row) * 256 + col;
                const f32x4 a = *(const f32x4*)pp, b = *(const f32x4*)(pp + 4);
#pragma unroll
                for (int j = 0; j < 4; ++j) { h[j] += a[j]; h[4 + j] += b[j]; }
            }
            u32x4 w = {cvtpk(gelu_tanh(h[0]), gelu_tanh(h[1])), cvtpk(gelu_tanh(h[2]), gelu_tanh(h[3])), cvtpk(gelu_tanh(h[4]), gelu_tanh(h[5])), cvtpk(gelu_tanh(h[6]), gelu_tanh(h[7]))};
            *(u32x4*)(HID + ((size_t)mat * 2048 + row) * 256 + col) = w;
        }
        __threadfence_block();
        __syncthreads();
        gemm_unit(lds, ALoadPlain{HID + (size_t)mat * 2048 * 256, 256}, (const bf16_t*)(WSP(A) + (mat ? WS_W2V : WS_W2K)), 256, mt * 256, 0, 0, 4,
                  EpiCmpOut{(bf16_t*)(WSP(A) + (mat ? WS_VCC : WS_KCC))}, tid);
    }
}

__device__ __forceinline__ void phase_mla_prep(const Args& A, int bid, int nb) {
    const int tid = opaque_tid(), lane = tid & 63, wave = tid >> 6;
    const bf16_t* BIG = (const bf16_t*)(WSP(A) + WS_BIG);
    bf16_t* CQN = (bf16_t*)(WSP(A) + WS_CQN); bf16_t* CKVN = (bf16_t*)(WSP(A) + WS_CKVN); bf16_t* KVM = (bf16_t*)(WSP(A) + WS_KVM);
    const f32x2* rope64 = (const f32x2*)(WSP(A) + WS_ROPE64);
    const float* qn = A.in[7]; const float* kvn = A.in[9];
    for (int u = bid; u < T / NWAVES; u += nb) {
        const int t = u * NWAVES + wave;
        const bf16_t* row = BIG + (size_t)t * SBMLA_IN;
        {
            const u32x4 w = *(const u32x4*)(row + 3072 + lane * 8);
            float x[8] = {bflo(w[0]), bfhi(w[0]), bflo(w[1]), bfhi(w[1]), bflo(w[2]), bfhi(w[2]), bflo(w[3]), bfhi(w[3])};
            float ss = 0;
#pragma unroll
            for (int j = 0; j < 8; ++j) ss += x[j] * x[j];
            ss = wave_sum(ss);
            const float rinv = rsqrtf(ss * (1.f / 512.f) + EPS);
            const f32x4 g0 = *(const f32x4*)(qn + lane * 8), g1 = *(const f32x4*)(qn + lane * 8 + 4);
            u32x4 o = {cvtpk(x[0] * rinv * g0[0], x[1] * rinv * g0[1]), cvtpk(x[2] * rinv * g0[2], x[3] * rinv * g0[3]),
                       cvtpk(x[4] * rinv * g1[0], x[5] * rinv * g1[1]), cvtpk(x[6] * rinv * g1[2], x[7] * rinv * g1[3])};
            *(u32x4*)(CQN + (size_t)t * 512 + lane * 8) = o;
        }
        {
            const u32x2 w = *(const u32x2*)(row + 3584 + lane * 4);
            float x[4] = {bflo(w[0]), bfhi(w[0]), bflo(w[1]), bfhi(w[1])};
            float ss = x[0] * x[0] + x[1] * x[1] + x[2] * x[2] + x[3] * x[3];
            ss = wave_sum(ss);
            const float rinv = rsqrtf(ss * (1.f / 256.f) + EPS);
            const f32x4 g = *(const f32x4*)(kvn + lane * 4);
            u32x2 o = {cvtpk(x[0] * rinv * g[0], x[1] * rinv * g[1]), cvtpk(x[2] * rinv * g[2], x[3] * rinv * g[3])};
            *(u32x2*)(CKVN + (size_t)t * 256 + lane * 4) = o;
        }
        {
            const float x = bf2f(row[3840 + lane]);
            const float oth = __shfl_xor(x, 32);
            const f32x2 cs = rope64[(size_t)t * 32 + (lane & 31)];
            const float y = (lane < 32) ? x * cs[0] - oth * cs[1] : x * cs[0] + oth * cs[1];
            KVM[(size_t)t * KVM_LD + 2048 + lane] = (bf16_t)(cvtpk(y, y) & 0xFFFFu);
        }
    }
}
namespace pg8 {
#define PG8_LAS __attribute__((address_space(3)))
typedef unsigned short bf16_t;
typedef short bf16x8 __attribute__((ext_vector_type(8)));
typedef float f32x4 __attribute__((ext_vector_type(4)));
typedef unsigned u32x4 __attribute__((ext_vector_type(4)));
constexpr int BM = 256, BK = 64, HALF = 128, HTB = HALF * BK * 2  , STAGE_BYTES = 8 * HTB, NXCD = 8, WGM = 8;

__host__ __device__ __forceinline__ int lds_byte(int r, int c) { const int st = (r >> 4) * 2 + (c >> 5), rr = r & 15, cc = c & 31, ob = rr * 64 + cc * 2; return st * 1024 + (ob ^ (((ob >> 9) & 1) << 5)); }
__host__ __device__ __forceinline__ void stage_rc(int b, int& R, int& C) { const int st = b / 1024, sb = b % 1024, swz = sb ^ (((sb >> 9) & 1) << 5); R = (st >> 1) * 16 + swz / 64; C = (st & 1) * 32 + (swz % 64) / 2; }
__host__ __device__ __forceinline__ int perm32(int rho) { const int n = rho >> 4, i = rho & 15; return 8 * (i >> 2) + 4 * n + (i & 3); }

struct Unit { int pm, pn; };
struct Gemm { const bf16_t* A; const bf16_t* Bt; int M, N, K; };

struct StaticOrder {
    int nM, nN, nwg, G, c;
    __host__ __device__ void init(int M, int N, int G_, int c_) { nM = M / BM; nN = N / BM; nwg = nM * nN; G = G_; c = c_; }
    __host__ __device__ bool next(int i, Unit& u) const {
        const long L = (long)i * G + c; if (L >= nwg) return false;
        int wgid = (int)L; { const int q = nwg / NXCD, r = nwg % NXCD, xcd = wgid % NXCD, off = wgid / NXCD; wgid = (xcd < r ? xcd * (q + 1) : r * (q + 1) + (xcd - r) * q) + off; }
        const int nig = WGM * nN, gid = wgid / nig, fm = gid * WGM, gsz = (nM - fm) < WGM ? (nM - fm) : WGM;
        u.pm = fm + ((wgid % nig) % gsz); u.pn = (wgid % nig) / gsz; return true;
    }
    __device__ __forceinline__ void a_ready(const Unit&) const {}
    __device__ __forceinline__ void done(const Unit&) const {}
};
__device__ __forceinline__ unsigned cvt_pk_bf16(float lo, float hi) { return cvtpk(lo, hi); }
template <class Epi, class Sched, bool STAMP = false>
__device__ __forceinline__ void gemm_phase(PG8_LAS unsigned char* lds, const Gemm g, const Sched& S, const Epi& E, unsigned long long* stamps) {
    const int tid = opaque_tid(), wid = __builtin_amdgcn_readfirstlane(tid >> 6), lane = tid & 63, wr = wid >> 2, wc = wid & 3, fr = lane & 15, fq = lane >> 4;
    const int K = g.K, nt = K / BK;
    int ts_lo = 0, ts_hi = 0, nts = 0; const unsigned long long rt_entry = STAMP ? (unsigned long long)wall_clock64() : 0ull;
#define PG8_STAMP() do { if (STAMP && wid == 0 && nts < 64) { const unsigned long long _c = (unsigned long long)clock64(); \
        ts_lo = (lane == nts) ? (int)(unsigned)_c : ts_lo; ts_hi = (lane == nts) ? (int)(unsigned)(_c >> 32) : ts_hi; ++nts; } } while (0)
    PG8_STAMP();
    unsigned voffA[2], voffB[2];
#pragma unroll
    for (int i = 0; i < 2; ++i) { int R, C; stage_rc(tid * 16 + i * 8192, R, C); const int Rb = Epi::PERM ? ((R & ~31) + perm32(R & 31)) : R;
        voffA[i] = (unsigned)(R * K + C) * 2u; voffB[i] = (unsigned)(Rb * K + C) * 2u; }
    const size_t kstep = (size_t)(BK * 2);
    const size_t hstep = (size_t)HALF * K * 2;
    const size_t tstep = 2 * hstep;
    const unsigned ldsw = (unsigned)wid * 1024u;
    const int aoff = lds_byte(wr * 64 + fr, fq * 8), boff = lds_byte(wc * 32 + fr, fq * 8);
#define PG8_SA(b, h) (((b) * 2 + (h)) * HTB)
#define PG8_SB(b, h) ((4 + (b) * 2 + (h)) * HTB)
#define PG8_STAGE(bufoff, gbase, voff) do { _Pragma("unroll") for (int _i = 0; _i < 2; ++_i) \
        __builtin_amdgcn_global_load_lds((const unsigned*)((const char*)(gbase) + (voff)[_i]), (PG8_LAS unsigned*)(lds + (bufoff) + ldsw + _i * 8192), 16, 0, 0); } while (0)
#define PG8_LDA(dst, b, h) do { _Pragma("unroll") for (int m = 0; m < 4; ++m) _Pragma("unroll") for (int k = 0; k < 2; ++k) dst[m][k] = *(const PG8_LAS bf16x8*)(lds + PG8_SA(b, h) + aoff + m * 2048 + k * 1024); } while (0)
#define PG8_LDB(dst, b, h) do { _Pragma("unroll") for (int n = 0; n < 2; ++n) _Pragma("unroll") for (int k = 0; k < 2; ++k) dst[n][k] = *(const PG8_LAS bf16x8*)(lds + PG8_SB(b, h) + boff + n * 2048 + k * 1024); } while (0)
#define PG8_MMA(ai, bj, At, Bt) do { __builtin_amdgcn_s_setprio(1); _Pragma("unroll") for (int m = 0; m < 4; ++m) _Pragma("unroll") for (int n = 0; n < 2; ++n) _Pragma("unroll") for (int k = 0; k < 2; ++k) \
        acc[ai][bj][m][n] = __builtin_amdgcn_mfma_f32_16x16x32_bf16(Bt[n][k], At[m][k], acc[ai][bj][m][n], 0, 0, 0); __builtin_amdgcn_s_setprio(0); } while (0)
#define PG8_WAIT_V(n) asm volatile("s_waitcnt vmcnt(" #n ")" ::: "memory")
#define PG8_WAIT_L(n) asm volatile("s_waitcnt lgkmcnt(" #n ")" ::: "memory")
#define PG8_BAR __builtin_amdgcn_s_barrier()
#define PG8_SCHED __builtin_amdgcn_sched_barrier(0)
    Unit cur, nxt; int ui = 0;
    if (!S.next(0, cur)) return;
    f32x4 acc[2][2][4][2];
#pragma unroll
    for (int a = 0; a < 2; ++a)
#pragma unroll
        for (int b = 0; b < 2; ++b)
#pragma unroll
            for (int m = 0; m < 4; ++m)
#pragma unroll
                for (int n = 0; n < 2; ++n) acc[a][b][m][n] = (f32x4){0.f, 0.f, 0.f, 0.f};
    bf16x8 At[4][2], B0[2][2], B1[2][2];
    const char* cA = (const char*)g.A + (size_t)cur.pm * tstep; const char* cB = (const char*)g.Bt + (size_t)cur.pn * tstep;
    S.a_ready(cur);
    PG8_STAGE(PG8_SB(0, 0), cB, voffB); PG8_STAGE(PG8_SA(0, 0), cA, voffA); PG8_STAGE(PG8_SB(0, 1), cB + hstep, voffB); PG8_STAGE(PG8_SA(0, 1), cA + hstep, voffA);
    if (wr == 1) PG8_BAR;
    PG8_WAIT_V(4); PG8_BAR;
    PG8_STAGE(PG8_SB(1, 0), cB + kstep, voffB); PG8_STAGE(PG8_SA(1, 0), cA + kstep, voffA); PG8_STAGE(PG8_SB(1, 1), cB + hstep + kstep, voffB);
    PG8_WAIT_V(6); PG8_BAR;
    PG8_STAMP();
    for (;;) {
        const bool has_next = S.next(ui + 1, nxt);
        const char* nA = has_next ? (const char*)g.A + (size_t)nxt.pm * tstep : cA; const char* nB = has_next ? (const char*)g.Bt + (size_t)nxt.pn * tstep : cB;
        for (int t = 0; t < nt; t += 2) {
            const bool last = (t == nt - 2);
            const char* a1 = cA + (size_t)(t + 1) * kstep;
            const char* a2 = last ? nA : cA + (size_t)(t + 2) * kstep; const char* b2 = last ? nB : cB + (size_t)(t + 2) * kstep;
            const char* a3 = a2 + kstep; const char* b3 = b2 + kstep;
            if (last && has_next) S.a_ready(nxt);
            PG8_LDB(B0, 0, 0); PG8_SCHED; PG8_LDA(At, 0, 0); PG8_STAGE(PG8_SA(1, 1), a1 + hstep, voffA);
            PG8_WAIT_L(8); PG8_BAR; PG8_WAIT_L(0); PG8_MMA(0, 0, At, B0); PG8_BAR; PG8_SCHED;
            PG8_LDB(B1, 0, 1); PG8_STAGE(PG8_SB(0, 0), b2, voffB);
            PG8_BAR; PG8_WAIT_L(0); PG8_MMA(0, 1, At, B1); PG8_BAR;
            PG8_LDA(At, 0, 1); PG8_STAGE(PG8_SA(0, 0), a2, voffA);
            PG8_BAR; PG8_WAIT_L(0); PG8_MMA(1, 0, At, B0); PG8_BAR; PG8_SCHED;
            PG8_STAGE(PG8_SB(0, 1), b2 + hstep, voffB);
            PG8_WAIT_V(6); PG8_BAR; PG8_MMA(1, 1, At, B1); PG8_BAR;
            PG8_LDB(B0, 1, 0); PG8_SCHED; PG8_LDA(At, 1, 0); PG8_STAGE(PG8_SA(0, 1), a2 + hstep, voffA);
            PG8_WAIT_L(8); PG8_BAR; PG8_WAIT_L(0); PG8_MMA(0, 0, At, B0); PG8_BAR; PG8_SCHED;
            PG8_LDB(B1, 1, 1); PG8_STAGE(PG8_SB(1, 0), b3, voffB);
            PG8_BAR; PG8_WAIT_L(0); PG8_MMA(0, 1, At, B1); PG8_BAR;
            PG8_LDA(At, 1, 1); PG8_STAGE(PG8_SA(1, 0), a3, voffA);
            PG8_BAR; PG8_WAIT_L(0); PG8_MMA(1, 0, At, B0); PG8_BAR; PG8_SCHED;
            PG8_STAGE(PG8_SB(1, 1), b3 + hstep, voffB);
            PG8_WAIT_V(6); PG8_BAR; PG8_MMA(1, 1, At, B1); PG8_BAR;
        }
        PG8_STAMP();
        if constexpr (!Epi::AFTER_DRAIN) { E(acc, cur, wr, wc, fr, fq); S.done(cur); }
        PG8_STAMP();
        if (!has_next) break;
#pragma unroll
        for (int a = 0; a < 2; ++a)
#pragma unroll
            for (int b = 0; b < 2; ++b)
#pragma unroll
                for (int m = 0; m < 4; ++m)
#pragma unroll
                    for (int n = 0; n < 2; ++n) acc[a][b][m][n] = (f32x4){0.f, 0.f, 0.f, 0.f};
        cur = nxt; cA = nA; cB = nB; ++ui;
    }
    PG8_WAIT_V(0);
    if (wr == 0) PG8_BAR;
    PG8_BAR;
    if constexpr (Epi::AFTER_DRAIN) { E.fused(acc, cur, wr, wc, fr, fq, lds, wid, lane); S.done(cur); }
    PG8_STAMP();
    if (STAMP && wid == 0) { stamps[lane] = lane < nts ? (((unsigned long long)(unsigned)ts_hi << 32) | (unsigned)ts_lo) : 0ull;
        if (lane == 62) stamps[62] = rt_entry; if (lane == 63) stamps[63] = (unsigned long long)wall_clock64(); }
#undef PG8_STAMP
#undef PG8_SA
#undef PG8_SB
#undef PG8_STAGE
#undef PG8_LDA
#undef PG8_LDB
#undef PG8_MMA
#undef PG8_WAIT_V
#undef PG8_WAIT_L
#undef PG8_BAR
#undef PG8_SCHED
}

struct EpiStore {
    static constexpr bool PERM = true, AFTER_DRAIN = false;
    bf16_t* C; int ldc; int N;
    __device__ __forceinline__ void operator()(const f32x4 (&acc)[2][2][4][2], const Unit& u, int wr, int wc, int fr, int fq) const {
        const int row0 = u.pm * BM + wr * 64 + fr, col0 = u.pn * BM + wc * 32 + 8 * fq;
#pragma unroll
        for (int ai = 0; ai < 2; ++ai)
#pragma unroll
            for (int m = 0; m < 4; ++m) { bf16_t* rowp = C + (size_t)(row0 + ai * HALF + m * 16) * ldc + col0;
#pragma unroll
                for (int bj = 0; bj < 2; ++bj) if (col0 + bj * HALF < N) { const f32x4 v0 = acc[ai][bj][m][0], v1 = acc[ai][bj][m][1];
                    u32x4 w; w.x = cvt_pk_bf16(v0[0], v0[1]); w.y = cvt_pk_bf16(v0[2], v0[3]); w.z = cvt_pk_bf16(v1[0], v1[1]); w.w = cvt_pk_bf16(v1[2], v1[3]);
                    *(u32x4*)(rowp + bj * HALF) = w; } }
    }
};
struct EpiResidual {
    static constexpr bool PERM = false, AFTER_DRAIN = false;
    const float* xin; float* xout; const float* gate; float gmul;
    __device__ __forceinline__ void operator()(const f32x4 (&acc)[2][2][4][2], const Unit& u, int wr, int wc, int fr, int fq) const {
        const int row0 = u.pm * BM + wr * 64 + fr, col0 = u.pn * BM + wc * 32 + 4 * fq;
        const float* gp = gate + ((u.pm * BM) >> 13) * 6144 + col0;
        f32x4 gv[2][2];
#pragma unroll
        for (int bj = 0; bj < 2; ++bj)
#pragma unroll
            for (int n = 0; n < 2; ++n) gv[bj][n] = *(const f32x4*)(gp + bj * HALF + n * 16) * gmul;
#pragma unroll
        for (int ai = 0; ai < 2; ++ai)
#pragma unroll
            for (int m = 0; m < 4; ++m) { const size_t off = (size_t)(row0 + ai * HALF + m * 16) * 2048 + col0;
                f32x4 xv[2][2];
#pragma unroll
                for (int bj = 0; bj < 2; ++bj)
#pragma unroll
                    for (int n = 0; n < 2; ++n) xv[bj][n] = *(const f32x4*)(xin + off + bj * HALF + n * 16);
#pragma unroll
                for (int bj = 0; bj < 2; ++bj)
#pragma unroll
                    for (int n = 0; n < 2; ++n) *(f32x4*)(xout + off + bj * HALF + n * 16) = xv[bj][n] + gv[bj][n] * acc[ai][bj][m][n];
                asm volatile("" ::: "memory"); }
    }
};
struct EpiNsaIn {
    static constexpr bool PERM = false, AFTER_DRAIN = false;
    bf16_t* C; const f32x2* rope32;
    __device__ __forceinline__ void operator()(const f32x4 (&acc)[2][2][4][2], const Unit& u, int wr, int wc, int fr, int fq) const {
        const int row0 = u.pm * BM + wr * 64 + fr;
#pragma unroll
        for (int bj = 0; bj < 2; ++bj) {
            const int hb = u.pn * 2 + bj, cb = hb * 128 + wc * 32;
            const bool rope = (wc == 0) && (hb < 18 || hb == 20 || hb == 21 || hb == 24 || hb == 25);
            const bool gate = cb >= 3584;
#pragma unroll
            for (int ai = 0; ai < 2; ++ai)
#pragma unroll
                for (int m = 0; m < 4; ++m) { const int row = row0 + ai * HALF + m * 16;
                    f32x4 v0 = acc[ai][bj][m][0], v1 = acc[ai][bj][m][1];
                    if (rope) { const f32x4 c01 = *(const f32x4*)(rope32 + (size_t)row * 16 + 4 * fq), c23 = *(const f32x4*)(rope32 + (size_t)row * 16 + 4 * fq + 2);
                        const float cs[4] = {c01[0], c01[2], c23[0], c23[2]}, sn[4] = {c01[1], c01[3], c23[1], c23[3]};
#pragma unroll
                        for (int i = 0; i < 4; ++i) { const float x1 = v0[i], x2 = v1[i]; v0[i] = x1 * cs[i] - x2 * sn[i]; v1[i] = x2 * cs[i] + x1 * sn[i]; } }
                    if (gate) {
#pragma unroll
                        for (int i = 0; i < 4; ++i) { v0[i] = 1.f / (1.f + __expf(-v0[i])); v1[i] = 1.f / (1.f + __expf(-v1[i])); } }
                    bf16_t* rowp = C + (size_t)row * NSA_IN + cb + 4 * fq;
                    if (cb + 4 * fq < NSA_IN) { u32x2 w = {cvt_pk_bf16(v0[0], v0[1]), cvt_pk_bf16(v0[2], v0[3])}; *(u32x2*)rowp = w; }
                    if (cb + 16 + 4 * fq < NSA_IN) { u32x2 w = {cvt_pk_bf16(v1[0], v1[1]), cvt_pk_bf16(v1[2], v1[3])}; *(u32x2*)(rowp + 16) = w; } }
        }
    }
};
template <class Epi>
__device__ __forceinline__ void run(unsigned char* lds, const bf16_t* A, const bf16_t* Bt, int M, int N, int K, const Epi& E, int bid, int nb) {
    Gemm g{A, Bt, M, N, K}; StaticOrder S; S.init(M, N, nb, bid);
    gemm_phase<Epi, StaticOrder>((PG8_LAS unsigned char*)lds, g, S, E, nullptr);
}
}
constexpr int KSTR128 = 256, KSTR192 = 384, VSTR = 256;
template <int KSTR> __device__ __forceinline__ int kswz(int r, int c) { return KSTR == 256 ? (c ^ (r & 15)) : ((c & ~7) | ((c ^ (r >> 1)) & 7)); }
constexpr int ATT_K_BYTES = 64 * KSTR192;
constexpr int ATT_V_BYTES = 64 * VSTR;
constexpr int ATT_KOFF = 0, ATT_VOFF = 2 * ATT_K_BYTES, ATT_MISC = ATT_VOFF + 2 * ATT_V_BYTES;

__device__ __forceinline__ void dma16(const unsigned char* gsrc, unsigned char* ldst) {
    __builtin_amdgcn_global_load_lds((const unsigned*)gsrc, (unsigned*)ldst, 16, 0, 0);
}
#define DMA_WAIT() asm volatile("s_waitcnt vmcnt(0)" ::: "memory")
template <int NKS, int KSTR>
__device__ __forceinline__ void qk_tile(f32x16& p0, f32x16& p1, const unsigned char* kbuf, int l31, int hi, const bf16x8* qr) {
#pragma unroll
    for (int r = 0; r < 16; ++r) { p0[r] = 0.f; p1[r] = 0.f; }
    const unsigned char* krow = kbuf + l31 * KSTR;
#pragma unroll
    for (int ks = 0; ks < NKS; ++ks) {
        const int co = kswz<KSTR>(l31, ks * 2 + hi) << 4;
        const bf16x8 a0 = *(const bf16x8*)(krow + co);
        const bf16x8 a1 = *(const bf16x8*)(krow + 32 * KSTR + co);
        p0 = __builtin_amdgcn_mfma_f32_32x32x16_bf16(a0, qr[ks], p0, 0, 0, 0);
        p1 = __builtin_amdgcn_mfma_f32_32x32x16_bf16(a1, qr[ks], p1, 0, 0, 0);
        if ((ks & 3) == 3) __builtin_amdgcn_sched_barrier(0);
    }
}
__device__ __forceinline__ s16x4 tr_read(const unsigned char* p) {
    return __builtin_amdgcn_ds_read_tr16_b64_v4i16((LAS s16x4*)p);
}
__device__ __forceinline__ int vswz(int r) { return ((r & 3) << 2) | ((r >> 2) & 3); }
struct VLane { int b0, b1, q; };
__device__ __forceinline__ VLane vlane(int lane) {
    const int hi = lane >> 5, q = (lane >> 2) & 3, g1 = (lane >> 4) & 1, p = lane & 3;
    const int a0 = 256 * (4 * hi + q) + 8 * (p & 1), low2 = (2 * g1 + (p >> 1)) ^ hi;
    return VLane{a0 + (low2 << 4), a0 + ((low2 ^ 2) << 4) + 2048, q};
}
__device__ __forceinline__ void pv_tile(f32x16 (&o)[4], const unsigned char* vbuf, const VLane vl, const bf16x8 (&pb)[4]) {
    s16x4 lo[2][4], hh[2][4];
    auto rd = [&](int dt, int slot) {
        const int d64 = (dt ^ vl.q) << 6;
#pragma unroll
        for (int s = 0; s < 4; ++s) { lo[slot][s] = tr_read(vbuf + vl.b0 + d64 + 4096 * s); hh[slot][s] = tr_read(vbuf + vl.b1 + d64 + 4096 * s); }
    };
    rd(0, 0);
#pragma unroll
    for (int dt = 0; dt < 4; ++dt) {
        if (dt + 1 < 4) rd(dt + 1, (dt + 1) & 1);
#pragma unroll
        for (int s = 0; s < 4; ++s) {
            const s16x4 l_ = lo[dt & 1][s], h_ = hh[dt & 1][s];
            const bf16x8 a = {l_[0], l_[1], l_[2], l_[3], h_[0], h_[1], h_[2], h_[3]};
            o[dt] = __builtin_amdgcn_mfma_f32_32x32x16_bf16(a, pb[s], o[dt], 0, 0, 0);
        }
        __builtin_amdgcn_sched_barrier(0);
    }
}
__device__ __forceinline__ bf16x8 pack8f(const f32x16& p, int b) {
    u32x4 w = {cvtpk(p[b + 0], p[b + 1]), cvtpk(p[b + 2], p[b + 3]), cvtpk(p[b + 4], p[b + 5]), cvtpk(p[b + 6], p[b + 7])};
    return *reinterpret_cast<bf16x8*>(&w);
}
__device__ __forceinline__ void softmax_step(f32x16& p0, f32x16& p1, float& m, float& l, f32x16 (&o)[4], float c2, bf16x8 (&pb)[4], bool lane_on = true) {
    float mx = p0[0];
#pragma unroll
    for (int r = 1; r < 16; ++r) mx = fmaxf(mx, p0[r]);
#pragma unroll
    for (int r = 0; r < 16; ++r) mx = fmaxf(mx, p1[r]);
    mx = fmaxf(mx, __shfl_xor(mx, 32));
    mx = lane_on ? mx : -__builtin_inff();
    const bool keep = __all((mx - m) * c2 <= 8.f);
    const float mn = keep ? m : fmaxf(m, mx);
    const float alpha = keep ? 1.f : __builtin_amdgcn_exp2f((m - mn) * c2);
    const float mc = lane_on ? mn * c2 : __builtin_inff();
    float rs = 0.f;
#pragma unroll
    for (int r = 0; r < 16; ++r) { p0[r] = __builtin_amdgcn_exp2f(p0[r] * c2 - mc); rs += p0[r]; }
#pragma unroll
    for (int r = 0; r < 16; ++r) { p1[r] = __builtin_amdgcn_exp2f(p1[r] * c2 - mc); rs += p1[r]; }
    rs += __shfl_xor(rs, 32);
    l = l * alpha + rs;
    m = mn;
    if (!keep) {
#pragma unroll
        for (int dt = 0; dt < 4; ++dt)
#pragma unroll
            for (int r = 0; r < 16; ++r) o[dt][r] *= alpha;
    }
    pb[0] = pack8f(p0, 0); pb[1] = pack8f(p0, 8); pb[2] = pack8f(p1, 0); pb[3] = pack8f(p1, 8);
}
template <int NKS, int KSTR>
__device__ __forceinline__ void qk_slice(f32x16& n0, f32x16& n1, const unsigned char* krow, int l31, int hi, const bf16x8* qr, int ks) {
    const int co = kswz<KSTR>(l31, ks * 2 + hi) << 4;
    const bf16x8 a0 = *(const bf16x8*)(krow + co);
    const bf16x8 a1 = *(const bf16x8*)(krow + 32 * KSTR + co);
    n0 = __builtin_amdgcn_mfma_f32_32x32x16_bf16(a0, qr[ks], n0, 0, 0, 0);
    n1 = __builtin_amdgcn_mfma_f32_32x32x16_bf16(a1, qr[ks], n1, 0, 0, 0);
}
template <int NKS, int KSTR>
__device__ __forceinline__ void fused_qk_softmax(f32x16& n0, f32x16& n1, const unsigned char* knext, int l31, int hi, const bf16x8* qr,
                                                 f32x16& s0, f32x16& s1, float& m, float& l, f32x16 (&o)[4], float c2, bf16x8 (&pb)[4]) {
    const unsigned char* krow = knext + l31 * KSTR;
#pragma unroll
    for (int r = 0; r < 16; ++r) { n0[r] = 0.f; n1[r] = 0.f; }
    qk_slice<NKS, KSTR>(n0, n1, krow, l31, hi, qr, 0);
    qk_slice<NKS, KSTR>(n0, n1, krow, l31, hi, qr, 1);
    float mx = s0[0];
#pragma unroll
    for (int r = 1; r < 16; ++r) mx = fmaxf(mx, s0[r]);
#pragma unroll
    for (int r = 0; r < 16; ++r) mx = fmaxf(mx, s1[r]);
    mx = fmaxf(mx, __shfl_xor(mx, 32));
    const float mn = fmaxf(m, mx);
    const float alpha = __builtin_amdgcn_exp2f((m - mn) * c2);
    const float mc = mn * c2;
    __builtin_amdgcn_sched_barrier(0);
    float rs = 0.f;
    constexpr int NG = NKS - 2;
#pragma unroll
    for (int gi = 0; gi < NG; ++gi) {
        qk_slice<NKS, KSTR>(n0, n1, krow, l31, hi, qr, 2 + gi);
        const int e0 = (32 * gi) / NG, e1 = (32 * (gi + 1)) / NG;
#pragma unroll
        for (int e = e0; e < e1; ++e) {
            if (e < 16) { s0[e] = __builtin_amdgcn_exp2f(s0[e] * c2 - mc); rs += s0[e]; }
            else { s1[e - 16] = __builtin_amdgcn_exp2f(s1[e - 16] * c2 - mc); rs += s1[e - 16]; }
        }
        __builtin_amdgcn_sched_barrier(0);
    }
    rs += __shfl_xor(rs, 32);
    l = l * alpha + rs;
    m = mn;
    if (__any(alpha != 1.f)) {
#pragma unroll
        for (int dt = 0; dt < 4; ++dt)
#pragma unroll
            for (int r = 0; r < 16; ++r) o[dt][r] *= alpha;
    }
    pb[0] = pack8f(s0, 0); pb[1] = pack8f(s0, 8); pb[2] = pack8f(s1, 0); pb[3] = pack8f(s1, 8);
}
__device__ __forceinline__ void store_ot_bf16(const f32x16 (&o)[4], float sc, bf16_t* orow  , int hi) {
#pragma unroll
    for (int dt = 0; dt < 4; ++dt)
#pragma unroll
        for (int g = 0; g < 4; ++g) {
            u32x2 w = {cvtpk(o[dt][4 * g] * sc, o[dt][4 * g + 1] * sc), cvtpk(o[dt][4 * g + 2] * sc, o[dt][4 * g + 3] * sc)};
            *(u32x2*)(orow + dt * 32 + 8 * g + 4 * hi) = w;
        }
}

__device__ __forceinline__ void mla_item(const Args& A, unsigned char* lds, int b, int h, int qt) {
    const int tid = opaque_tid(), lane = tid & 63, wave = tid >> 6, l31 = lane & 31, hi = lane >> 5;
    const bf16_t* QM = (const bf16_t*)(WSP(A) + WS_QM); const bf16_t* KVM = (const bf16_t*)(WSP(A) + WS_KVM);
    bf16_t* O = (bf16_t*)(WSP(A) + WS_O);
    const int q0 = qt * 256, qw = q0 + wave * 32, t = qw + l31;
    const size_t tokb = (size_t)b * SEQ;
    bf16x8 qr[12];
    {
        const bf16_t* qp = QM + (tokb + t) * 1536 + h * 192 + hi * 8;
#pragma unroll
        for (int ks = 0; ks < 12; ++ks) qr[ks] = *(const bf16x8*)(qp + ks * 16);
        const f32x2* rp = (const f32x2*)(WSP(A) + WS_ROPE64) + (tokb + t) * 32 + hi * 8;
#pragma unroll
        for (int k2 = 0; k2 < 2; ++k2) {
#pragma unroll
            for (int e = 0; e < 8; ++e) {
                const f32x2 cs = rp[k2 * 16 + e];
                const float x1 = bf2f((unsigned short)qr[8 + k2][e]), x2 = bf2f((unsigned short)qr[10 + k2][e]);
                const unsigned w = cvtpk(x1 * cs[0] - x2 * cs[1], x2 * cs[0] + x1 * cs[1]);
                qr[8 + k2][e] = (short)(w & 0xFFFFu); qr[10 + k2][e] = (short)(w >> 16);
            }
        }
    }
    const int nkt = (q0 + 256) / 64;
    const int wv = __builtin_amdgcn_readfirstlane(wave);
    unsigned okb[3], ovb[2];
#pragma unroll
    for (int i = 0; i < 3; ++i) {
        const int B = (wv * 3 + i) * 1024 + lane * 16, row = B / KSTR192, pc = (B - row * KSTR192) >> 4;
        const int c = kswz<KSTR192>(row, pc);
        okb[i] = (unsigned)(row * KVM_LD + ((c < 16) ? h * 256 + c * 8 : 2048 + (c - 16) * 8)) * 2u;
    }
#pragma unroll
    for (int i = 0; i < 2; ++i) {
        const int row = (wv * 2 + i) * 4 + (lane >> 4), c = (lane & 15) ^ vswz(row);
        ovb[i] = (unsigned)(row * KVM_LD + h * 256 + 128 + c * 8) * 2u;
    }
    auto stage = [&](int kt, int buf) {
        const unsigned char* base = (const unsigned char*)(KVM + (tokb + (size_t)kt * 64) * KVM_LD);
        unsigned char* kb = lds + ATT_KOFF + buf * ATT_K_BYTES + wv * 3072; unsigned char* vb = lds + ATT_VOFF + buf * ATT_V_BYTES + wv * 2048;
#pragma unroll
        for (int i = 0; i < 3; ++i) dma16(base + okb[i], kb + i * 1024);
#pragma unroll
        for (int i = 0; i < 2; ++i) dma16(base + ovb[i], vb + i * 1024);
    };
    f32x16 o[4];
#pragma unroll
    for (int dt = 0; dt < 4; ++dt)
#pragma unroll
        for (int r = 0; r < 16; ++r) o[dt][r] = 0.f;
    float m = -1e30f, l = 0.f;
    const float c2 = 0.07216878364870322f * 1.4426950408889634f;
    const VLane vl = vlane(lane);
    stage(0, 0); DMA_WAIT(); __syncthreads();
    for (int kt = 0; kt < nkt; ++kt) {
        if (kt + 1 < nkt) stage(kt + 1, (kt + 1) & 1);
        if (kt * 64 <= qw + 31) {
            f32x16 p0, p1;
            qk_tile<12, KSTR192>(p0, p1, lds + ATT_KOFF + (kt & 1) * ATT_K_BYTES, l31, hi, qr);
            if (kt * 64 + 63 > qw) {
                const int dq = t - kt * 64 - 4 * hi;
#pragma unroll
                for (int r = 0; r < 16; ++r) {
                    const int cb = (r & 3) + 8 * (r >> 2);
                    if (cb > dq) p0[r] = -__builtin_inff();
                    if (cb + 32 > dq) p1[r] = -__builtin_inff();
                }
            }
            bf16x8 pb[4];
            softmax_step(p0, p1, m, l, o, c2, pb);
            pv_tile(o, lds + ATT_VOFF + (kt & 1) * ATT_V_BYTES, vl, pb);
        }
        DMA_WAIT();
        __syncthreads();
    }
    store_ot_bf16(o, ABL_MLA / l, O + (tokb + t) * 2048 + 1024 + h * 128, hi);
}

__device__ __forceinline__ void sb_item(const Args& A, unsigned char* lds, int b, int h, int qt) {
    const int tid = opaque_tid(), lane = tid & 63, wave = tid >> 6, l31 = lane & 31, hi = lane >> 5;
    const bf16_t* BIG = (const bf16_t*)(WSP(A) + WS_BIG);
    bf16_t* O = (bf16_t*)(WSP(A) + WS_O);
    volatile int* flags = (volatile int*)(lds + ATT_MISC);
    const int q0 = qt * 256, qw = q0 + wave * 32, t = qw + l31;
    const size_t tokb = (size_t)b * SEQ;
    bf16x8 qr[8];
    {
        const bf16_t* qp = BIG + (tokb + t) * SBMLA_IN + h * 128 + hi * 8;
#pragma unroll
        for (int ks = 0; ks < 8; ++ks) qr[ks] = *(const bf16x8*)(qp + ks * 16);
    }
    bf16x8 tri[2];
#pragma unroll
    for (int s2 = 0; s2 < 2; ++s2)
#pragma unroll
        for (int jj = 0; jj < 8; ++jj) tri[s2][jj] = (16 * s2 + 8 * (jj >> 2) + 4 * hi + (jj & 3) > l31) ? (short)0x3F80 : (short)0;
    const int wv = __builtin_amdgcn_readfirstlane(wave);
    unsigned okb[2], ovb[2];
#pragma unroll
    for (int i = 0; i < 2; ++i) {
        const int row = (wv * 2 + i) * 4 + (lane >> 4), pc = lane & 15;
        okb[i] = (unsigned)(row * SBMLA_IN + 1024 + (pc ^ (row & 15)) * 8) * 2u;
        ovb[i] = (unsigned)(row * SBMLA_IN + 2048 + (pc ^ vswz(row)) * 8) * 2u;
    }
    auto stage = [&](int kt, int buf) {
        const unsigned char* base = (const unsigned char*)(BIG + (tokb + (size_t)kt * 64) * SBMLA_IN + h * 128);
        unsigned char* kb = lds + ATT_KOFF + buf * ATT_K_BYTES + wv * 2048; unsigned char* vb = lds + ATT_VOFF + buf * ATT_V_BYTES + wv * 2048;
#pragma unroll
        for (int i = 0; i < 2; ++i) { dma16(base + okb[i], kb + i * 1024); dma16(base + ovb[i], vb + i * 1024); }
    };
    f32x16 o[4];
#pragma unroll
    for (int dt = 0; dt < 4; ++dt)
#pragma unroll
        for (int r = 0; r < 16; ++r) o[dt][r] = 0.f;
    float R = 0.f;
    bool done = false;
    const float scale = 0.08838834764831845f;
    const int kt_hi = (q0 + 254) / 64, ktw = (qw + 30) / 64;
    const VLane vl = vlane(lane);
    stage(kt_hi, 0); DMA_WAIT(); __syncthreads();
    int it = 0;
    for (int kt = kt_hi; kt >= 0; --kt, ++it) {
        if (kt > 0) stage(kt - 1, (it + 1) & 1);
        if (kt <= ktw && !done) {
            f32x16 p0, p1;
            qk_tile<8, KSTR128>(p0, p1, lds + ATT_KOFF + (it & 1) * ATT_K_BYTES, l31, hi, qr);
            const int dq = t - kt * 64 - 4 * hi;
            float tot0 = 0.f, tot1 = 0.f;
            u32x4 w0, w1, w2, w3;
            auto sbf = [&](float pz, bool v, float& tot, float& lbo) -> float {
                const float z = pz * scale;
                const float lp = __logf(1.f + __expf(-fabsf(z)));
                const float lb = fminf(z, 0.f) - lp;
                const float l1 = v ? lb - z : 0.f;
                tot += l1; lbo = v ? lb : -__builtin_inff();
                return l1;
            };
#pragma unroll
            for (int r = 0; r < 16; r += 2) {
                const int cb0 = (r & 3) + 8 * (r >> 2), cb1 = ((r + 1) & 3) + 8 * ((r + 1) >> 2);
                float t0_, t1_, t2_, t3_;
                const float a0 = sbf(p0[r], cb0 < dq, tot0, t0_), a1 = sbf(p0[r + 1], cb1 < dq, tot0, t1_);
                const float b0 = sbf(p1[r], cb0 + 32 < dq, tot1, t2_), b1 = sbf(p1[r + 1], cb1 + 32 < dq, tot1, t3_);
                p0[r] = t0_; p0[r + 1] = t1_; p1[r] = t2_; p1[r + 1] = t3_;
                const unsigned pa = cvtpk(a0, a1), pbb = cvtpk(b0, b1);
                if (r < 8) { w0[r >> 1] = pa; w2[r >> 1] = pbb; } else { w1[(r - 8) >> 1] = pa; w3[(r - 8) >> 1] = pbb; }
            }
            tot0 += __shfl_xor(tot0, 32); tot1 += __shfl_xor(tot1, 32);
            bf16x8 lf[4];
            lf[0] = *reinterpret_cast<bf16x8*>(&w0); lf[1] = *reinterpret_cast<bf16x8*>(&w1); lf[2] = *reinterpret_cast<bf16x8*>(&w2); lf[3] = *reinterpret_cast<bf16x8*>(&w3);
            f32x16 c0, c1;
            const float r1 = R + tot1;
#pragma unroll
            for (int r = 0; r < 16; ++r) { c1[r] = R; c0[r] = r1; }
            c1 = __builtin_amdgcn_mfma_f32_32x32x16_bf16(tri[0], lf[2], c1, 0, 0, 0);
            c1 = __builtin_amdgcn_mfma_f32_32x32x16_bf16(tri[1], lf[3], c1, 0, 0, 0);
            c0 = __builtin_amdgcn_mfma_f32_32x32x16_bf16(tri[0], lf[0], c0, 0, 0, 0);
            c0 = __builtin_amdgcn_mfma_f32_32x32x16_bf16(tri[1], lf[1], c0, 0, 0, 0);
#pragma unroll
            for (int r = 0; r < 16; ++r) { p0[r] = __expf(p0[r] + c0[r]); p1[r] = __expf(p1[r] + c1[r]); }
            R = r1 + tot0;
            bf16x8 pb[4] = {pack8f(p0, 0), pack8f(p0, 8), pack8f(p1, 0), pack8f(p1, 8)};
            pv_tile(o, lds + ATT_VOFF + (it & 1) * ATT_V_BYTES, vl, pb);
            done = __all(R < -104.f);
        }
        if (lane == 0) flags[(it & 1) * 8 + wave] = done ? 1 : 0;
        DMA_WAIT();
        __syncthreads();
        int nd = 0;
#pragma unroll
        for (int w = 0; w < 8; ++w) nd += flags[(it & 1) * 8 + w];
        if (nd == 8) break;
    }
    store_ot_bf16(o, ABL_SB, O + (tokb + t) * 2048 + h * 128, hi);
    __syncthreads();
}

__device__ __forceinline__ void phase_attn0(const Args& A, unsigned char* lds, int bid, int nb) {
    auto convert_share = [&]() {
        for (int v = bid; v < U0_PEER; v += nb) p0_peer_unit(A, v);
        for (int v = bid; v < U0_MOD_LATE; v += nb) p0_mod_unit(A, lds, U0_MOD + v);
    };
    const int slot = bid & 3;
    if (slot == 0) convert_share();
    for (int u = bid; u < 256; u += nb) {
        const int bh = u >> 4, p = u & 15;
        mla_item(A, lds, bh >> 3, bh & 7, 31 - p);
        if (slot == 1 && u == bid) convert_share();
        mla_item(A, lds, bh >> 3, bh & 7, p);
    }
    if (slot == 2 || (slot == 1 && bid >= 256)) convert_share();
    for (int v = bid; v < 512; v += nb) {
        const int bh = v >> 5, qt = v & 31;
        sb_item(A, lds, bh >> 3, bh & 7, qt);
    }
    if (slot == 3) convert_share();
}
__device__ __forceinline__ unsigned f2sort(float f) { const unsigned u = __float_as_uint(f); return u ^ ((u & 0x80000000u) ? 0xFFFFFFFFu : 0x80000000u); }
__device__ __forceinline__ float sort2f(unsigned s) { const unsigned u = (s & 0x80000000u) ? (s ^ 0x80000000u) : ~s; return __uint_as_float(u); }
__device__ __forceinline__ unsigned umax3(unsigned a, unsigned b, unsigned c) { return max(max(a, b), c); }

template <int N> __device__ __forceinline__ void bitonic_merge_desc(unsigned (&a)[N]) {
#pragma unroll
    for (int j = N >> 1; j > 0; j >>= 1)
#pragma unroll
        for (int i = 0; i < N; ++i) { const int l = i ^ j; if (l > i) { const unsigned hi_ = max(a[i], a[l]), lo_ = min(a[i], a[l]); a[i] = hi_; a[l] = lo_; } }
}
__device__ __forceinline__ void bitonic_sort16_desc(unsigned (&a)[16]) {
#pragma unroll
    for (int k = 2; k <= 16; k <<= 1)
#pragma unroll
        for (int j = k >> 1; j > 0; j >>= 1)
#pragma unroll
            for (int i = 0; i < 16; ++i) { const int l = i ^ j; if (l > i) { const bool desc = ((i & k) == 0);
                const unsigned hi_ = max(a[i], a[l]), lo_ = min(a[i], a[l]); a[i] = desc ? hi_ : lo_; a[l] = desc ? lo_ : hi_; } }
}
__device__ __forceinline__ void top16_merge(unsigned (&a)[16], const unsigned (&b)[16]) {
#pragma unroll
    for (int i = 0; i < 16; ++i) a[i] = max(a[i], b[15 - i]);
    bitonic_merge_desc<16>(a);
}
__device__ __forceinline__ void top16_of_64(const unsigned (&k)[64], unsigned (&r)[16]) {
    unsigned g1[16], g2[16], g3[16];
#pragma unroll
    for (int i = 0; i < 16; ++i) { r[i] = k[i]; g1[i] = k[16 + i]; g2[i] = k[32 + i]; g3[i] = k[48 + i]; }
    bitonic_sort16_desc(r); bitonic_sort16_desc(g1); bitonic_sort16_desc(g2); bitonic_sort16_desc(g3);
    top16_merge(r, g1); top16_merge(g2, g3); top16_merge(r, g2);
}
constexpr int PKSTR = 272;
constexpr int TOPK_STAGE = 2 * 128 * PKSTR;
constexpr int TOPK_LDS = TOPK_STAGE + 8 * 8192;
__device__ __forceinline__ void phase_topk(const Args& A, unsigned char* lds, int layer, int bid, int nb) {
    const int tid = opaque_tid(), lane = tid & 63, wave = tid >> 6, l31 = lane & 31, hi = lane >> 5;
    const bf16_t* PQ = (const bf16_t*)(WSP(A) + WS_PQ);
    const bf16_t* K12 = (const bf16_t*)(WSP(A) + WS_K12) + (size_t)layer * 2 * 16384;
    int* EXI = (int*)(WSP(A) + WS_EXI); float* EXG = (float*)(WSP(A) + WS_EXG);
    for (int q = tid; q < 2 * 128 * 16; q += NTHREADS) { const int row = q >> 4, c = q & 15; *(u32x4*)(lds + row * PKSTR + c * 16) = *(const u32x4*)(K12 + row * 128 + c * 8); }
    __syncthreads();
    for (int u = bid; u < T / 32; u += nb) {
        const int t = u * 32 + l31, h = wave;
        unsigned* wl = (unsigned*)(lds + TOPK_STAGE) + wave * 2048;
        unsigned lst[2][16];
#pragma unroll
        for (int side = 0; side < 2; ++side) {
            bf16x8 qr[8];
            const bf16_t* qp = PQ + (size_t)t * 2048 + h * 256 + side * 128 + hi * 8;
#pragma unroll
            for (int ks = 0; ks < 8; ++ks) qr[ks] = *(const bf16x8*)(qp + ks * 16);
            const unsigned char* kp = lds + side * 128 * PKSTR + l31 * PKSTR + hi * 16;
            unsigned keys[64];
#pragma unroll
            for (int mt = 0; mt < 4; ++mt) {
                f32x16 p;
#pragma unroll
                for (int r = 0; r < 16; ++r) p[r] = 0.f;
#pragma unroll
                for (int ks = 0; ks < 8; ++ks) {
                    const bf16x8 a = *(const bf16x8*)(kp + mt * 32 * PKSTR + ks * 32);
                    p = __builtin_amdgcn_mfma_f32_32x32x16_bf16(a, qr[ks], p, 0, 0, 0);
                }
#pragma unroll
                for (int r = 0; r < 16; ++r) {
                    const int key = mt * 32 + (r & 3) + 8 * (r >> 2) + 4 * hi;
                    keys[mt * 16 + r] = (f2sort(p[r]) & ~127u) | (unsigned)(127 - key);
                }
                __builtin_amdgcn_sched_barrier(0);
            }
            unsigned mine[16], oth[16];
            top16_of_64(keys, mine);
#pragma unroll
            for (int i = 0; i < 16; ++i) oth[i] = (unsigned)__shfl_xor((int)mine[i], 32);
            top16_merge(mine, oth);
#pragma unroll
            for (int i = 0; i < 16; ++i) { lst[side][i] = mine[i]; wl[side * 1024 + i * 64 + lane] = mine[i]; }
        }
        float v1[16], v2[16];
#pragma unroll
        for (int i = 0; i < 16; ++i) { v1[i] = sort2f(lst[0][i] & ~127u); v2[i] = sort2f(lst[1][i] & ~127u); }
        unsigned cand[64];
        {
            int c = 0;
#pragma unroll
            for (int i = 0; i < 16; ++i)
#pragma unroll
                for (int j = 0; j < 16; ++j)
                    if ((i + 1) * (j + 1) <= 16) { cand[c] = (f2sort(v1[i] + v2[j]) & ~255u) | (unsigned)(255 - (16 * i + j)); ++c; }
#pragma unroll
            for (int q = 50; q < 64; ++q) cand[q] = 0u;
        }
        unsigned best[16];
        top16_of_64(cand, best);
        float topv[16]; int tope[16];
#pragma unroll
        for (int it = 0; it < 16; ++it) {
            const unsigned flat = 255u - (best[it] & 255u);
            const unsigned l0 = wl[(flat >> 4) * 64 + lane], l1 = wl[1024 + (flat & 15u) * 64 + lane];
            tope[it] = (int)((127u - (l0 & 127u)) * 128u + (127u - (l1 & 127u)));
            topv[it] = sort2f(best[it] & ~255u);
        }
        const float mx0 = topv[0];
        float sum = 0.f;
#pragma unroll
        for (int it = 0; it < 16; ++it) { topv[it] = __expf(topv[it] - mx0); sum += topv[it]; }
        if (hi == 0) {
            const float inv = 1.f / sum;
            int* ei = EXI + (size_t)t * 128 + h * 16; float* eg = EXG + (size_t)t * 128 + h * 16;
#pragma unroll
            for (int q = 0; q < 4; ++q) {
                *(int4*)(ei + 4 * q) = make_int4(tope[4 * q], tope[4 * q + 1], tope[4 * q + 2], tope[4 * q + 3]);
                *(f32x4*)(eg + 4 * q) = f32x4{topv[4 * q] * inv, topv[4 * q + 1] * inv, topv[4 * q + 2] * inv, topv[4 * q + 3] * inv};
            }
        }
    }
    __syncthreads();
}
#define DPP_PERM(V, CTRL) __int_as_float(__builtin_amdgcn_update_dpp(0, __float_as_int(V), CTRL, 0xF, 0xF, false))
#define DPP_SEL(OLD, SRC, BANKS) __int_as_float(__builtin_amdgcn_update_dpp(__float_as_int(OLD), __float_as_int(SRC), 0xE4, 0xF, BANKS, false))
struct URow { u32x4 a; };

typedef int i32x8 __attribute__((ext_vector_type(8)));
__device__ __forceinline__ void phase_peer_dots(const Args& A, unsigned char* lds, int layer, int bid, int nb) {
    const int tid = opaque_tid(), lane = tid & 63, wave = __builtin_amdgcn_readfirstlane(tid >> 6);
    const int nb8 = nb & ~7;
    if (bid >= nb8) return;
    const int x = bid & 7, c = bid >> 3, nc = nb8 >> 3;
    const int m = lane & 15, kb = lane >> 4;
    const int g = m >> 1, ch = m & 1;
    const int gl = lane >> 3, jl = lane & 7;
    const int psrc = (4 * m + kb) * 4;
    const bf16_t* H = (const bf16_t*)(WSP(A) + WS_H);
    const unsigned char* U16 = WSP(A) + WS_PU + (size_t)layer * PEER_U_LAYER + (size_t)x * PEER_U16_SLICE;
    const unsigned char* U8 = WSP(A) + WS_PU + (size_t)layer * PEER_U_LAYER + PEER_U8_OFF + (size_t)x * PEER_U8_SLICE;
    const unsigned* EXU = (const unsigned*)(WSP(A) + WS_EXI);
    float* DP = (float*)(WSP(A) + WS_DP) + (size_t)x * T * 128;
    LAS unsigned* wbuf = (LAS unsigned*)lds + wave * 2048;
    const bool owner = (kb == (m >> 2)) && ch == 0;
    const float c0 = (m & 3) == 0 ? 1.f : 0.f, c1 = (m & 3) == 1 ? 1.f : 0.f, c2 = (m & 3) == 2 ? 1.f : 0.f, c3 = (m & 3) == 3 ? 1.f : 0.f;
    const int q0 = c * NWAVES + wave, qs = nc * NWAVES;
    if (q0 >= T / 8) return;
#pragma unroll
    for (int i = 0; i < 4; ++i) *(LAS u32x4*)(wbuf + (i * 64 + lane) * 4) = *(const u32x4*)(EXU + (size_t)q0 * 1024 + (i * 64 + lane) * 4);
    const int hoff = x * 256 + ch * 128 + kb * 16;
    u32x4 hn[4];
#pragma unroll
    for (int qq = 0; qq < 4; ++qq) hn[qq] = *(const u32x4*)(H + (size_t)(q0 * 8 + g) * 2048 + hoff + (qq >> 1) * 64 + (qq & 1) * 8);
    URow r0, r1, r2, r3, r4, r5, r6, r7, r8, r9, r10, r11, r12, r13, r14, r15;
    auto issue = [&](unsigned e, URow& r) {
        r.a = *(const u32x4*)(U16 + (e * 128u + jl * 16));
    };
    auto perm = [&](const URow& r) -> i32x8 {
        return i32x8{__builtin_amdgcn_ds_bpermute(psrc, (int)r.a[0]), __builtin_amdgcn_ds_bpermute(psrc, (int)r.a[1]), __builtin_amdgcn_ds_bpermute(psrc, (int)r.a[2]),
                     __builtin_amdgcn_ds_bpermute(psrc, (int)r.a[3]), 0, 0, 0, 0};
    };
    {
        const LAS unsigned* ig = wbuf + gl * 128;
        const u32x4 ia = *(const LAS u32x4*)(ig), ib = *(const LAS u32x4*)(ig + 4), ic = *(const LAS u32x4*)(ig + 8), id = *(const LAS u32x4*)(ig + 12);
        issue(ia[0], r0); issue(ia[1], r1); issue(ia[2], r2); issue(ia[3], r3); issue(ib[0], r4); issue(ib[1], r5); issue(ib[2], r6); issue(ib[3], r7);
        issue(ic[0], r8); issue(ic[1], r9); issue(ic[2], r10); issue(ic[3], r11); issue(id[0], r12); issue(id[1], r13); issue(id[2], r14); issue(id[3], r15);
    }
    i32x8 aopc = perm(r0);
    int par = 0;
    for (int q = q0; q < T / 8; q += qs, par ^= 1) {
        const int t0 = q * 8;
        const int qn = q + qs < T / 8 ? q + qs : q;
        LAS unsigned* cur = wbuf + par * 1024;
        LAS unsigned* alt = wbuf + (par ^ 1) * 1024;
        i32x8 bH, bL;
#pragma unroll
        for (int qq = 0; qq < 4; ++qq) {
            int hi0 = 0, hi1 = 0, lo0 = 0, lo1 = 0;
            {
                const float f0 = bflo(hn[qq][0]), f1 = bfhi(hn[qq][0]), f2 = bflo(hn[qq][1]), f3 = bfhi(hn[qq][1]);
                hi0 = __builtin_amdgcn_cvt_pk_fp8_f32(f0, f1, hi0, false); hi0 = __builtin_amdgcn_cvt_pk_fp8_f32(f2, f3, hi0, true);
                const f32x2 b0 = __builtin_amdgcn_cvt_pk_f32_fp8(hi0, false), b1 = __builtin_amdgcn_cvt_pk_f32_fp8(hi0, true);
                lo0 = __builtin_amdgcn_cvt_pk_fp8_f32((f0 - b0[0]) * 16.f, (f1 - b0[1]) * 16.f, lo0, false);
                lo0 = __builtin_amdgcn_cvt_pk_fp8_f32((f2 - b1[0]) * 16.f, (f3 - b1[1]) * 16.f, lo0, true);
            }
            {
                const float f0 = bflo(hn[qq][2]), f1 = bfhi(hn[qq][2]), f2 = bflo(hn[qq][3]), f3 = bfhi(hn[qq][3]);
                hi1 = __builtin_amdgcn_cvt_pk_fp8_f32(f0, f1, hi1, false); hi1 = __builtin_amdgcn_cvt_pk_fp8_f32(f2, f3, hi1, true);
                const f32x2 b0 = __builtin_amdgcn_cvt_pk_f32_fp8(hi1, false), b1 = __builtin_amdgcn_cvt_pk_f32_fp8(hi1, true);
                lo1 = __builtin_amdgcn_cvt_pk_fp8_f32((f0 - b0[0]) * 16.f, (f1 - b0[1]) * 16.f, lo1, false);
                lo1 = __builtin_amdgcn_cvt_pk_fp8_f32((f2 - b1[0]) * 16.f, (f3 - b1[1]) * 16.f, lo1, true);
            }
            bH[2 * qq] = hi0; bH[2 * qq + 1] = hi1; bL[2 * qq] = lo0; bL[2 * qq + 1] = lo1;
        }
        __builtin_amdgcn_sched_barrier(0);
#pragma unroll
        for (int qq = 0; qq < 4; ++qq) hn[qq] = *(const u32x4*)(H + (size_t)(qn * 8 + g) * 2048 + hoff + (qq >> 1) * 64 + (qq & 1) * 8);
        auto mm = [&](const i32x8& aop, f32x4& dh, f32x4& dl) {
            const f32x4 z = {0.f, 0.f, 0.f, 0.f};
            dh = __builtin_amdgcn_mfma_scale_f32_16x16x128_f8f6f4(aop, bH, z, 4  , 0  , 0, 0, 0, 0);
            dl = __builtin_amdgcn_mfma_scale_f32_16x16x128_f8f6f4(aop, bL, z, 4, 0, 0, 0, 0, 0);
        };
        auto ext = [&](const f32x4& dh, const f32x4& dl) -> float {
            float v = dh[0] * c0;
            v = __builtin_fmaf(dh[1], c1, v); v = __builtin_fmaf(dh[2], c2, v); v = __builtin_fmaf(dh[3], c3, v);
            v = __builtin_fmaf(dl[0], c0 * (1.f / 16.f), v); v = __builtin_fmaf(dl[1], c1 * (1.f / 16.f), v);
            v = __builtin_fmaf(dl[2], c2 * (1.f / 16.f), v); v = __builtin_fmaf(dl[3], c3 * (1.f / 16.f), v);
            return v + DPP_PERM(v, 0xB1);
        };
        const LAS unsigned* ig = cur + gl * 128;
        float* dpo = DP + (size_t)(t0 + g) * 128;
#define U_FIRST(E, R, RN) do { mm(aopc, dhp, dlp); issue(E, R); aopc = perm(RN); __builtin_amdgcn_sched_barrier(0); } while (0)
#define U_STEP(PPREV, E, R, RN) do { f32x4 dhc, dlc; mm(aopc, dhc, dlc); issue(E, R); PPREV = ext(dhp, dlp); dhp = dhc; dlp = dlc; aopc = perm(RN); __builtin_amdgcn_sched_barrier(0); } while (0)
        auto round = [&](const int k) {
            const int pc = k < 64 ? k >> 4 : 3;
            const u32x4 pre = *(const u32x4*)(EXU + (size_t)qn * 1024 + (pc * 64 + lane) * 4);
            const LAS unsigned* in_ = k < 112 ? ig + k + 16 : alt + gl * 128;
            const u32x4 ia = *(const LAS u32x4*)(in_), ib = *(const LAS u32x4*)(in_ + 4), ic = *(const LAS u32x4*)(in_ + 8), id = *(const LAS u32x4*)(in_ + 12);
            float p0, p1, p2, p3, p4, p5, p6, p7;
            f32x4 dhp, dlp;
            U_FIRST(ia[0], r0, r1); U_STEP(p0, ia[1], r1, r2); U_STEP(p1, ia[2], r2, r3); U_STEP(p2, ia[3], r3, r4);
            U_STEP(p3, ib[0], r4, r5); U_STEP(p4, ib[1], r5, r6); U_STEP(p5, ib[2], r6, r7); U_STEP(p6, ib[3], r7, r8);
            U_STEP(p7, ic[0], r8, r9);
            if (owner) { *(f32x4*)(dpo + k) = f32x4{p0, p1, p2, p3}; *(f32x4*)(dpo + k + 4) = f32x4{p4, p5, p6, p7}; }
            __builtin_amdgcn_sched_barrier(0);
            U_STEP(p0, ic[1], r9, r10); U_STEP(p1, ic[2], r10, r11); U_STEP(p2, ic[3], r11, r12);
            U_STEP(p3, id[0], r12, r13); U_STEP(p4, id[1], r13, r14); U_STEP(p5, id[2], r14, r15); U_STEP(p6, id[3], r15, r0);
            p7 = ext(dhp, dlp);
            if (owner) { *(f32x4*)(dpo + k + 8) = f32x4{p0, p1, p2, p3}; *(f32x4*)(dpo + k + 12) = f32x4{p4, p5, p6, p7}; }
            *(LAS u32x4*)(alt + (pc * 64 + lane) * 4) = pre;
            __builtin_amdgcn_sched_barrier(0);
        };
        round(0);
#pragma unroll 1
        for (int k = 16; k < 128; k += 16) round(k);
#undef U_STEP
#undef U_FIRST
    }
}

typedef _Float16 h16x2 __attribute__((ext_vector_type(2)));
constexpr float PEER_WF16 = 256.f;
__device__ __forceinline__ void phase_peer_weights(const Args& A, float gmul, int bid, int nb) {
    const int tid = opaque_tid();
    const f32x4* DP = (const f32x4*)(WSP(A) + WS_DP);
    const f32x4* EXG = (const f32x4*)(WSP(A) + WS_EXG);
    u32x4* PW = (u32x4*)(WSP(A) + WS_PW);
    for (int i = bid * NTHREADS + tid; i < T * 128 / 4; i += nb * NTHREADS) {
        f32x4 d = DP[i];
#pragma unroll
        for (int s = 1; s < 8; ++s) d += DP[(size_t)s * (T * 128 / 4) + i];
        const f32x4 gt = EXG[i];
        u32x4 w;
#pragma unroll
        for (int c = 0; c < 4; ++c) {
            const _Float16 hw = (_Float16)(gt[c] * gelu_tanh(d[c] * (1.f / PEER_USCALE)) * (gmul / PEER_VSCALE * PEER_WF16));
            w[c] = __builtin_bit_cast(unsigned, h16x2{hw, hw});
        }
        PW[i] = w;
    }
}

__device__ __forceinline__ void phase_peer_out(const Args& A, unsigned char* lds, int layer, const float* xin, float* xout, int gate_set, int bid, int nb) {
    const int tid = opaque_tid(), lane = tid & 63, wave = __builtin_amdgcn_readfirstlane(tid >> 6);
    const int nb8 = nb & ~7;
    if (bid >= nb8) return;
    const int x = bid & 7, c = bid >> 3, nc = nb8 >> 3;
    const int g = lane >> 3, j = lane & 7;
    const unsigned char* PV = WSP(A) + WS_PV + (size_t)layer * PEER_V_LAYER + (size_t)x * PEER_V_SLICE;
    const unsigned* EXI = (const unsigned*)(WSP(A) + WS_EXI);
    const unsigned* PW = (const unsigned*)(WSP(A) + WS_PW);
    const float* mod = (const float*)(WSP(A) + WS_MOD);
    LAS unsigned* wbuf = (LAS unsigned*)lds + wave * 4096;
    const int q0 = c * NWAVES + wave, qs = nc * NWAVES;
    if (q0 >= T / 8) return;
#pragma unroll
    for (int i = 0; i < 4; ++i) {
        *(LAS u32x4*)(wbuf + (i * 64 + lane) * 4) = *(const u32x4*)(EXI + (size_t)q0 * 1024 + (i * 64 + lane) * 4);
        *(LAS u32x4*)(wbuf + 1024 + (i * 64 + lane) * 4) = *(const u32x4*)(PW + (size_t)q0 * 1024 + (i * 64 + lane) * 4);
    }
    u32x4 v0, v1, v2, v3, v4, v5, v6, v7, v8, v9, v10, v11, v12, v13, v14, v15;
    auto issue = [&](unsigned e, u32x4& v) { v = *(const u32x4*)(PV + (e * 128u + j * 16)); };
    {
        const LAS unsigned* ig = wbuf + g * 128;
        const u32x4 ia = *(const LAS u32x4*)(ig), ib = *(const LAS u32x4*)(ig + 4), ic = *(const LAS u32x4*)(ig + 8), id = *(const LAS u32x4*)(ig + 12);
        issue(ia[0], v0); issue(ia[1], v1); issue(ia[2], v2); issue(ia[3], v3); issue(ib[0], v4); issue(ib[1], v5); issue(ib[2], v6); issue(ib[3], v7);
        issue(ic[0], v8); issue(ic[1], v9); issue(ic[2], v10); issue(ic[3], v11); issue(id[0], v12); issue(id[1], v13); issue(id[2], v14); issue(id[3], v15);
    }
    int par = 0;
    for (int q = q0; q < T / 8; q += qs, par ^= 1) {
        const int t0 = q * 8;
        const int qn = q + qs < T / 8 ? q + qs : q;
        LAS unsigned* cur = wbuf + par * 2048;
        LAS unsigned* alt = wbuf + (par ^ 1) * 2048;
        f32x4 xv4[8];
#pragma unroll
        for (int gg = 0; gg < 8; ++gg) xv4[gg] = *(const f32x4*)(xin + (size_t)(t0 + gg) * 2048 + x * 256 + lane * 4);
        const f32x4 gv = *(const f32x4*)(mod + (size_t)(gate_set * 2 + (t0 >> 13)) * 6144 + 4096 + x * 256 + lane * 4);
        f32x2 o2[16];
#pragma unroll
        for (int jj = 0; jj < 16; ++jj) o2[jj] = f32x2{0.f, 0.f};
        h16x2 a16[16];
#pragma unroll
        for (int jj = 0; jj < 16; ++jj) a16[jj] = h16x2{(_Float16)0, (_Float16)0};
        auto consume = [&](unsigned wb, const u32x4& v) {
            const h16x2 w2 = __builtin_bit_cast(h16x2, wb);
#define PEER_V2(J, S) a16[4 * J + S] = __builtin_elementwise_fma(w2, __builtin_bit_cast(h16x2, __builtin_amdgcn_cvt_scalef32_pk_f16_fp4(v[J], 1.0f, S)), a16[4 * J + S])
#define PEER_V8(J) do { PEER_V2(J, 0); PEER_V2(J, 1); PEER_V2(J, 2); PEER_V2(J, 3); } while (0)
            PEER_V8(0); PEER_V8(1); PEER_V8(2); PEER_V8(3);
#undef PEER_V8
#undef PEER_V2
        };
        auto flush = [&]() {
#pragma unroll
            for (int jj = 0; jj < 16; ++jj) {
                o2[jj][0] = __builtin_fmaf((float)a16[jj][0], 1.f / PEER_WF16, o2[jj][0]);
                o2[jj][1] = __builtin_fmaf((float)a16[jj][1], 1.f / PEER_WF16, o2[jj][1]);
                a16[jj] = h16x2{(_Float16)0, (_Float16)0};
            }
            __builtin_amdgcn_sched_barrier(0);
        };
        const LAS unsigned* ig = cur + g * 128;
        const LAS unsigned* wg = cur + 1024 + g * 128;
        auto stage_src = [&](int pc) { return (pc < 4 ? EXI : PW) + (size_t)qn * 1024 + ((pc & 3) * 64 + lane) * 4; };
#define V_STEP(W, E, R) do { consume(W, R); issue(E, R); __builtin_amdgcn_sched_barrier(0); } while (0)
        auto round = [&](const int k) {
            const int pc = k >> 4;
            const u32x4 pre = *(const u32x4*)stage_src(pc);
            const LAS unsigned* in_ = k < 112 ? ig + k + 16 : alt + g * 128;
            const u32x4 ia = *(const LAS u32x4*)(in_), ib = *(const LAS u32x4*)(in_ + 4), ic = *(const LAS u32x4*)(in_ + 8), id = *(const LAS u32x4*)(in_ + 12);
            const u32x4 wa = *(const LAS u32x4*)(wg + k), wb = *(const LAS u32x4*)(wg + k + 4), wc = *(const LAS u32x4*)(wg + k + 8), wd = *(const LAS u32x4*)(wg + k + 12);
            V_STEP(wa[0], ia[0], v0); V_STEP(wa[1], ia[1], v1); V_STEP(wa[2], ia[2], v2); V_STEP(wa[3], ia[3], v3);
            V_STEP(wb[0], ib[0], v4); V_STEP(wb[1], ib[1], v5); V_STEP(wb[2], ib[2], v6); V_STEP(wb[3], ib[3], v7);
            flush();
            V_STEP(wc[0], ic[0], v8); V_STEP(wc[1], ic[1], v9); V_STEP(wc[2], ic[2], v10); V_STEP(wc[3], ic[3], v11);
            V_STEP(wd[0], id[0], v12); V_STEP(wd[1], id[1], v13); V_STEP(wd[2], id[2], v14); V_STEP(wd[3], id[3], v15);
            flush();
            *(LAS u32x4*)(alt + (pc >> 2) * 1024 + ((pc & 3) * 64 + lane) * 4) = pre;
            __builtin_amdgcn_sched_barrier(0);
                };
        round(0);
#pragma unroll 1
        for (int k = 16; k < 128; k += 16) round(k);
#undef V_STEP
        LAS float* ot = (LAS float*)cur;
#pragma unroll
        for (int qq = 0; qq < 8; ++qq) {
            const f32x4 y = {o2[qq * 2][0], o2[qq * 2][1], o2[qq * 2 + 1][0], o2[qq * 2 + 1][1]};
            *(LAS f32x4*)(ot + g * 256 + j * 32 + ((qq ^ j ^ g) & 7) * 4) = y;
        }
#pragma unroll
        for (int gg = 0; gg < 8; ++gg) {
            const f32x4 o = *(const LAS f32x4*)(ot + gg * 256 + (lane >> 3) * 32 + (((lane & 7) ^ (lane >> 3) ^ gg) & 7) * 4);
            f32x4 y;
#pragma unroll
            for (int jj = 0; jj < 4; ++jj) y[jj] = xv4[gg][jj] + gv[jj] * o[jj];
            *(f32x4*)(xout + (size_t)(t0 + gg) * 2048 + x * 256 + lane * 4) = y;
        }
    }
}

__device__ __forceinline__ void phase_finalnorm(const Args& A, float* xio, const float* gain, int bid, int nb) {
    const int tid = opaque_tid(), lane = tid & 63, wave = tid >> 6;
    for (int u = bid; u < T / NWAVES; u += nb) {
        float* xr = xio + (size_t)(u * NWAVES + wave) * 2048;
        f32x4 v[8];
        float ss = 0.f;
#pragma unroll
        for (int i = 0; i < 8; ++i) { v[i] = *(const f32x4*)(xr + i * 256 + lane * 4); ss += v[i][0] * v[i][0] + v[i][1] * v[i][1] + v[i][2] * v[i][2] + v[i][3] * v[i][3]; }
        ss = wave_sum_dpp(ss);
        const float rinv = rsqrtf(ss * (1.0f / 2048.0f) + EPS);
#pragma unroll
        for (int i = 0; i < 8; ++i) {
            const f32x4 gn = *(const f32x4*)(gain + i * 256 + lane * 4);
            f32x4 y;
#pragma unroll
            for (int jj = 0; jj < 4; ++jj) y[jj] = v[i][jj] * rinv * gn[jj];
            *(f32x4*)(xr + i * 256 + lane * 4) = y;
        }
    }
}
constexpr int NSA_IMP = ATT_MISC;
constexpr int NSA_SELM = NSA_IMP + 32 * 128 * 4;
constexpr int NSA_KEYS = NSA_SELM + 512;
constexpr int LDS_BARW = NSA_KEYS + 8 * 128 * 4;
constexpr int LDS_BARW2 = (LDS_BARW > TOPK_LDS ? LDS_BARW : TOPK_LDS);
constexpr int LDS_TOTAL = ((LDS_BARW2 + 16 + 255) / 256) * 256;
static_assert(NWAVES * 16384 <= LDS_BARW2, "PEER staging (16 KB per wave) must stay below the barrier words");
static_assert(LDS_TOTAL <= 160 * 1024 && GEMM_LDS <= LDS_BARW2 && GEMM256_LDS <= LDS_BARW2, "LDS budget");

__device__ __forceinline__ int next_bit128(unsigned long long lo, unsigned long long hi, int from) {
    if (from < 64) { const unsigned long long mm = lo >> from; if (mm) return from + __builtin_ctzll(mm); from = 64; }
    if (from < 128) { const unsigned long long mm = hi >> (from - 64); if (mm) return from + __builtin_ctzll(mm); }
    return 128;
}
template <int MODE>
__device__ __forceinline__ void nsa_emit(const f32x16 (&o)[4], float sc, float* acc_row, bf16_t* o_row, int hi) {
#pragma unroll
    for (int dt = 0; dt < 4; ++dt)
#pragma unroll
        for (int g4 = 0; g4 < 4; ++g4) {
            const int d = dt * 32 + 8 * g4 + 4 * hi;
            f32x4 v = {o[dt][4 * g4] * sc, o[dt][4 * g4 + 1] * sc, o[dt][4 * g4 + 2] * sc, o[dt][4 * g4 + 3] * sc};
            if (MODE >= 1) { const f32x4 pv = *(const f32x4*)(acc_row + d); v += pv; }
            if (MODE <= 1) *(f32x4*)(acc_row + d) = v;
            else { u32x2 w = {cvtpk(v[0], v[1]), cvtpk(v[2], v[3])}; *(u32x2*)(o_row + d) = w; }
        }
}

__device__ __forceinline__ void nsa_item(const Args& A, unsigned char* lds, int b, int g, int tt) {
    const int tid = opaque_tid(), lane = tid & 63, wave = tid >> 6, l31 = lane & 31, hi = lane >> 5;
    const bf16_t* NS = (const bf16_t*)(WSP(A) + WS_BIG);
    const bf16_t* KCC = (const bf16_t*)(WSP(A) + WS_KCC); const bf16_t* VCC = (const bf16_t*)(WSP(A) + WS_VCC);
    float* OACC = (float*)(WSP(A) + WS_OACC); bf16_t* O = (bf16_t*)(WSP(A) + WS_O);
    int* IMP = (int*)(lds + NSA_IMP); unsigned* SELM = (unsigned*)(lds + NSA_SELM); int* KEYS = (int*)(lds + NSA_KEYS) + wave * 128;
    const int t0 = tt * 32, tok = wave * 4 + (l31 >> 3), t = t0 + tok, hd = g * 8 + (l31 & 7);
    const size_t tokb = (size_t)b * SEQ;
    const float c2 = 0.08838834764831845f * 1.4426950408889634f;
    bf16x8 qr[8];
    {
        const bf16_t* qp = NS + (tokb + t) * NSA_IN + hd * 128 + hi * 8;
#pragma unroll
        for (int ks = 0; ks < 8; ++ks) qr[ks] = *(const bf16x8*)(qp + ks * 16);
    }
    float gt[3];
    {
        const bf16_t* gp = NS + (tokb + t) * NSA_IN + 3584 + g * 24 + (l31 & 7) * 3;
        gt[0] = bf2f(gp[0]); gt[1] = bf2f(gp[1]); gt[2] = bf2f(gp[2]);
    }
    float* acc_row = OACC + (tokb + t) * 2048 + hd * 128;
    bf16_t* o_row = O + (tokb + t) * 2048 + hd * 128;
    const VLane vl = vlane(lane);
    const int wv = __builtin_amdgcn_readfirstlane(wave);
    unsigned ock[2], ocv[2], otk[2], otv[2];
#pragma unroll
    for (int i = 0; i < 2; ++i) {
        const int row = (wv * 2 + i) * 4 + (lane >> 4), pc = lane & 15, ck = pc ^ (row & 15), cv = pc ^ vswz(row);
        ock[i] = (unsigned)(row * 256 + ck * 8) * 2u; ocv[i] = (unsigned)(row * 256 + cv * 8) * 2u;
        otk[i] = (unsigned)(row * NSA_IN + ck * 8) * 2u; otv[i] = (unsigned)(row * NSA_IN + cv * 8) * 2u;
    }
    auto stageK = [&](const bf16_t* kbase, bool cmp, int buf) {
        unsigned char* kb = lds + ATT_KOFF + buf * ATT_K_BYTES + wv * 2048;
#pragma unroll
        for (int i = 0; i < 2; ++i) dma16((const unsigned char*)kbase + (cmp ? ock[i] : otk[i]), kb + i * 1024);
    };
    auto stageV = [&](const bf16_t* vbase, bool cmp, int buf) {
        unsigned char* vb = lds + ATT_VOFF + buf * ATT_V_BYTES + wv * 2048;
#pragma unroll
        for (int i = 0; i < 2; ++i) dma16((const unsigned char*)vbase + (cmp ? ocv[i] : otv[i]), vb + i * 1024);
    };
    f32x16 o[4];
    auto zero_o = [&]() {
#pragma unroll
        for (int dt = 0; dt < 4; ++dt)
#pragma unroll
            for (int r = 0; r < 16; ++r) o[dt][r] = 0.f;
    };

    for (int i = tid; i < 32 * 128; i += NTHREADS) IMP[i] = 0;
    const int nct = (tt >> 5) + 1;
    const int nv = (t >= 31) ? ((t - 31) >> 4) : -1;
    const bf16_t* kc0 = KCC + ((size_t)(b * NCMP_PAD) * 2 + g) * 128;
    const bf16_t* vc0 = VCC + ((size_t)(b * NCMP_PAD) * 2 + g) * 128;
    float m = -1e30f, l = 0.f;
    stageK(kc0, true, 0); DMA_WAIT(); __syncthreads();
    for (int ct = 0; ct < nct; ++ct) {
        if (ct + 1 < nct) stageK(kc0 + (size_t)(ct + 1) * 64 * 256, true, (ct + 1) & 1);
        {
            f32x16 p0, p1;
            qk_tile<8, KSTR128>(p0, p1, lds + ATT_KOFF + (ct & 1) * ATT_K_BYTES, l31, hi, qr);
            const int dq = nv - ct * 64 - 4 * hi;
            float mx = -__builtin_inff();
#pragma unroll
            for (int r = 0; r < 16; ++r) {
                const int cb = (r & 3) + 8 * (r >> 2);
                p0[r] = (cb <= dq) ? p0[r] : -__builtin_inff();
                p1[r] = (cb + 32 <= dq) ? p1[r] : -__builtin_inff();
                mx = fmaxf(mx, fmaxf(p0[r], p1[r]));
            }
            mx = fmaxf(mx, __shfl_xor(mx, 32));
            const float mn = fmaxf(m, mx);
            const float alpha = __builtin_amdgcn_exp2f((m - mn) * c2);
            const float mc = mn * c2;
            float rs = 0.f;
#pragma unroll
            for (int r = 0; r < 16; ++r) rs += __builtin_amdgcn_exp2f(p0[r] * c2 - mc) + __builtin_amdgcn_exp2f(p1[r] * c2 - mc);
            rs += __shfl_xor(rs, 32);
            l = l * alpha + rs; m = mn;
        }
        DMA_WAIT();
        __syncthreads();
    }
    const float inv_l = (l > 0.f) ? 1.f / l : 0.f;
    const float mcF = m * c2;
    zero_o();
    stageK(kc0, true, 0); stageV(vc0, true, 0); DMA_WAIT(); __syncthreads();
    for (int ct = 0; ct < nct; ++ct) {
        if (ct + 1 < nct) { stageK(kc0 + (size_t)(ct + 1) * 64 * 256, true, (ct + 1) & 1); stageV(vc0 + (size_t)(ct + 1) * 64 * 256, true, (ct + 1) & 1); }
        {
            f32x16 p0, p1;
            qk_tile<8, KSTR128>(p0, p1, lds + ATT_KOFF + (ct & 1) * ATT_K_BYTES, l31, hi, qr);
            const int dq = nv - ct * 64 - 4 * hi;
#pragma unroll
            for (int r = 0; r < 16; ++r) {
                const int cb = (r & 3) + 8 * (r >> 2);
                p0[r] = (cb <= dq) ? __builtin_amdgcn_exp2f(p0[r] * c2 - mcF) * inv_l : 0.f;
                p1[r] = (cb + 32 <= dq) ? __builtin_amdgcn_exp2f(p1[r] * c2 - mcF) * inv_l : 0.f;
            }
#pragma unroll
            for (int g4 = 0; g4 < 4; ++g4) {
                {
                    const int j = 16 * ct + 2 * g4 + hi;
                    const float mainv = 32.f * (p0[4 * g4] + p0[4 * g4 + 1] + p0[4 * g4 + 2]) + 16.f * p0[4 * g4 + 3];
                    const float spill = 16.f * p0[4 * g4 + 3];
                    atomicAdd(&IMP[tok * 128 + j], (int)(mainv * 1048576.f + 0.5f));
                    if (j + 1 < 128) atomicAdd(&IMP[tok * 128 + j + 1], (int)(spill * 1048576.f + 0.5f));
                }
                {
                    const int j = 16 * ct + 8 + 2 * g4 + hi;
                    const float mainv = 32.f * (p1[4 * g4] + p1[4 * g4 + 1] + p1[4 * g4 + 2]) + 16.f * p1[4 * g4 + 3];
                    const float spill = 16.f * p1[4 * g4 + 3];
                    atomicAdd(&IMP[tok * 128 + j], (int)(mainv * 1048576.f + 0.5f));
                    if (j + 1 < 128) atomicAdd(&IMP[tok * 128 + j + 1], (int)(spill * 1048576.f + 0.5f));
                }
            }
            bf16x8 pb[4] = {pack8f(p0, 0), pack8f(p0, 8), pack8f(p1, 0), pack8f(p1, 8)};
            pv_tile(o, lds + ATT_VOFF + (ct & 1) * ATT_V_BYTES, vl, pb);
        }
        DMA_WAIT();
        __syncthreads();
    }
    nsa_emit<0>(o, gt[0] * ABL_NC, acc_row, o_row, hi);

#pragma unroll 1
    for (int q = 0; q < 4; ++q) {
        const int ti = wave * 4 + q, tq = t0 + ti, cur = tq >> 6;
        int keyv[2];
#pragma unroll
        for (int half = 0; half < 2; ++half) {
            const int j = lane + 64 * half;
            const bool forced = (j == 0) || (j == cur) || (j == cur - 1);
            keyv[half] = forced ? 0x7FFFFFFF : ((j <= cur) ? IMP[ti * 128 + j] : -1);
            KEYS[j] = keyv[half];
        }
        __builtin_amdgcn_s_waitcnt(0xc07f);
        int rk0 = 0, rk1 = 0;
#pragma unroll 8
        for (int i = 0; i < 128; ++i) {
            const int ki = KEYS[i];
            rk0 += (ki > keyv[0] || (ki == keyv[0] && i < lane)) ? 1 : 0;
            rk1 += (ki > keyv[1] || (ki == keyv[1] && i < lane + 64)) ? 1 : 0;
        }
        const unsigned long long s0 = __ballot(keyv[0] >= 0 && rk0 < 16);
        const unsigned long long s1 = __ballot(keyv[1] >= 0 && rk1 < 16);
        if (lane == 0) { SELM[ti * 4 + 0] = (unsigned)s0; SELM[ti * 4 + 1] = (unsigned)(s0 >> 32); SELM[ti * 4 + 2] = (unsigned)s1; SELM[ti * 4 + 3] = (unsigned)(s1 >> 32); }
    }
    __syncthreads();
    unsigned msk[4], uni[4], wun[4];
#pragma unroll
    for (int w4 = 0; w4 < 4; ++w4) {
        msk[w4] = SELM[tok * 4 + w4];
        unsigned x = SELM[l31 * 4 + w4];
#pragma unroll
        for (int off = 16; off >= 1; off >>= 1) x |= (unsigned)__shfl_xor((int)x, off);
        uni[w4] = (unsigned)__builtin_amdgcn_readfirstlane((int)x);
        unsigned y = msk[w4];
        y |= (unsigned)__shfl_xor((int)y, 8); y |= (unsigned)__shfl_xor((int)y, 16);
        wun[w4] = (unsigned)__builtin_amdgcn_readfirstlane((int)y);
    }
    const unsigned long long ulo = ((unsigned long long)uni[1] << 32) | uni[0], uhi = ((unsigned long long)uni[3] << 32) | uni[2];

    const bf16_t* ks0 = NS + tokb * NSA_IN + 2560 + g * 128;
    const bf16_t* vs0 = NS + tokb * NSA_IN + 2816 + g * 128;
    zero_o(); m = -1e30f; l = 0.f;
    {
        int j = next_bit128(ulo, uhi, 0), it = 0;
        if (j < 128) { stageK(ks0 + (size_t)j * 64 * NSA_IN, false, 0); stageV(vs0 + (size_t)j * 64 * NSA_IN, false, 0); }
        DMA_WAIT(); __syncthreads();
        while (j < 128) {
            const int jn = next_bit128(ulo, uhi, j + 1);
            if (jn < 128) { stageK(ks0 + (size_t)jn * 64 * NSA_IN, false, (it + 1) & 1); stageV(vs0 + (size_t)jn * 64 * NSA_IN, false, (it + 1) & 1); }
            if ((wun[j >> 5] >> (j & 31)) & 1u) {
                f32x16 p0, p1;
                qk_tile<8, KSTR128>(p0, p1, lds + ATT_KOFF + (it & 1) * ATT_K_BYTES, l31, hi, qr);
                const bool sel = (msk[j >> 5] >> (j & 31)) & 1u;
                if (j == (t0 >> 6)) {
                    const int dq = t - j * 64 - 4 * hi;
#pragma unroll
                    for (int r = 0; r < 16; ++r) {
                        const int cb = (r & 3) + 8 * (r >> 2);
                        p0[r] = (cb <= dq) ? p0[r] : -__builtin_inff();
                        p1[r] = (cb + 32 <= dq) ? p1[r] : -__builtin_inff();
                    }
                }
                bf16x8 pb[4];
                softmax_step(p0, p1, m, l, o, c2, pb, sel);
                pv_tile(o, lds + ATT_VOFF + (it & 1) * ATT_V_BYTES, vl, pb);
            }
            DMA_WAIT();
            __syncthreads();
            j = jn; ++it;
        }
    }
    nsa_emit<1>(o, (l > 0.f) ? ABL_NS * gt[1] / l : 0.f, acc_row, o_row, hi);

    const bf16_t* kw0 = NS + tokb * NSA_IN + 3072 + g * 128;
    const bf16_t* vw0 = NS + tokb * NSA_IN + 3328 + g * 128;
    zero_o(); m = -1e30f; l = 0.f;
    {
        const int kt_lo = (t0 >= 511) ? ((t0 - 511) >> 6) : 0, kt_hi = t0 >> 6;
        stageK(kw0 + (size_t)kt_lo * 64 * NSA_IN, false, 0); stageV(vw0 + (size_t)kt_lo * 64 * NSA_IN, false, 0);
        DMA_WAIT(); __syncthreads();
        int it = 0;
        for (int kt = kt_lo; kt <= kt_hi; ++kt, ++it) {
            if (kt < kt_hi) { stageK(kw0 + (size_t)(kt + 1) * 64 * NSA_IN, false, (it + 1) & 1); stageV(vw0 + (size_t)(kt + 1) * 64 * NSA_IN, false, (it + 1) & 1); }
            {
                f32x16 p0, p1;
                qk_tile<8, KSTR128>(p0, p1, lds + ATT_KOFF + (it & 1) * ATT_K_BYTES, l31, hi, qr);
                if (!(kt * 64 + 63 <= t0 && kt * 64 > t0 + 31 - 512)) {
                    const int dq = t - kt * 64 - 4 * hi;
#pragma unroll
                    for (int r = 0; r < 16; ++r) {
                        const int cb = (r & 3) + 8 * (r >> 2);
                        p0[r] = ((unsigned)(dq - cb) < 512u) ? p0[r] : -__builtin_inff();
                        p1[r] = ((unsigned)(dq - cb - 32) < 512u) ? p1[r] : -__builtin_inff();
                    }
                }
                bf16x8 pb[4];
                softmax_step(p0, p1, m, l, o, c2, pb);
                pv_tile(o, lds + ATT_VOFF + (it & 1) * ATT_V_BYTES, vl, pb);
            }
            DMA_WAIT();
            __syncthreads();
        }
    }
    nsa_emit<2>(o, (l > 0.f) ? ABL_NW * gt[2] / l : 0.f, acc_row, o_row, hi);
}

__device__ __forceinline__ void phase_nsa(const Args& A, unsigned char* lds, int bid, int nb) {
    for (int u = bid; u < 1024; u += nb) {
        const int bg = u & 3, s = (u >> 2) & 63, r = u >> 8;
        const int tt = (r == 0) ? 255 - s : (r == 1) ? 128 + s : (r == 2) ? 127 - s : s;
        nsa_item(A, lds, bg >> 1, bg & 1, tt);
    }
}
constexpr int N_PHASES = 26;
#ifndef ABL_M0
#define ABL_M0 1.f
#endif
#ifndef ABL_M1
#define ABL_M1 1.f
#endif
#ifndef ABL_P0
#define ABL_P0 1.f
#endif
#ifndef ABL_P1
#define ABL_P1 1.f
#endif
__global__ void __launch_bounds__(NTHREADS, 2) fwd_kernel(Args a) {
    extern __shared__ __attribute__((aligned(16))) unsigned char lds[];
    const int bid = blockIdx.x, nb = gridDim.x;
    const bool multi = (a.ph_hi - a.ph_lo) > 1;
    XcdBarrier bar; bar.bar = (unsigned*)(a.ws + WS_CTL); bar.x = 0; bar.st = (volatile LAS unsigned*)(lds + LDS_BARW2);
    if (multi) {
        if (threadIdx.x == 0) *(uint4*)(lds + LDS_BARW2) = make_uint4(0u, 0u, 0u, 0u);
        __syncthreads();
        bar = xcd_barrier_post((unsigned*)(a.ws + WS_CTL), (volatile LAS unsigned*)(lds + LDS_BARW2));
    }
#ifdef ONLY
#define IN(k) ((k) == ONLY && a.ph_lo <= (k) && (k) < a.ph_hi)
#else
#define IN(k) (a.ph_lo <= (k) && (k) < a.ph_hi)
#endif
#define SEAM(k) do { if (IN(k) && IN((k) + 1)) xcd_barrier(bar); } while (0)
#define ws WSP(a)
#define MOD ((const float*)(ws + WS_MOD))
#define H ((bf16_t*)(ws + WS_H))
#define BIG ((bf16_t*)(ws + WS_BIG))
#define Ob ((bf16_t*)(ws + WS_O))
#define XA ((float*)(ws + WS_XA))
#define XB ((float*)(ws + WS_XB))

    if (IN(0)) phase_prologue(a, lds, bid, nb);
    SEAM(0);
    if (IN(1)) phase_modnorm(a, a.in[0], a.in[3], 0, bid, nb);
    SEAM(1);
    if (IN(2)) pg8::run(lds, H, (const bf16_t*)(ws + WS_WIN0), T, SBMLA_IN_PAD, 2048, pg8::EpiStore{BIG, SBMLA_IN, SBMLA_IN}, bid, nb);
    SEAM(2);
    if (IN(3)) phase_mla_prep(a, bid, nb);
    SEAM(3);
    if (IN(4)) {
        pg8::run(lds, (const bf16_t*)(ws + WS_CQN), (const bf16_t*)(ws + WS_WUQ), T, 1536, 512, pg8::EpiStore{(bf16_t*)(ws + WS_QM), 1536, 1536}, bid, nb);
        pg8::run(lds, (const bf16_t*)(ws + WS_CKVN), (const bf16_t*)(ws + WS_WUKV), T, 2048, 256, pg8::EpiStore{(bf16_t*)(ws + WS_KVM), KVM_LD, 2048}, bid, nb);
    }
    SEAM(4);
    if (IN(5)) phase_attn0(a, lds, bid, nb);
    SEAM(5);
    if (IN(6)) pg8::run(lds, Ob, (const bf16_t*)(ws + WS_WOUT0), T, 2048, 2048, pg8::EpiResidual{a.in[0], XA, MOD + 0 * 2 * 6144 + 4096, ABL_M0}, bid, nb);
    SEAM(6);
    if (IN(7)) phase_modnorm(a, XA, a.in[20], 1, bid, nb);
    SEAM(7);
    if (IN(8)) pg8::run(lds, H, (const bf16_t*)(ws + WS_WPQ), T, 2048, 2048, pg8::EpiStore{(bf16_t*)(ws + WS_PQ), 2048, 2048}, bid, nb);
    SEAM(8);
    if (IN(9)) phase_topk(a, lds, 0, bid, nb);
    SEAM(9);
    if (IN(10)) phase_peer_dots(a, lds, 0, bid, nb);
    SEAM(10);
    if (IN(11)) phase_peer_weights(a, ABL_P0, bid, nb);
    SEAM(11);
    if (IN(12)) phase_peer_out(a, lds, 0, XA, XB, 1, bid, nb);
    SEAM(12);
    if (IN(13)) phase_modnorm(a, XB, a.in[3] + 2048, 2, bid, nb);
    SEAM(13);
    if (IN(14)) pg8::run(lds, H, (const bf16_t*)(ws + WS_WNSAIN), T, NSA_IN_PAD, 2048, pg8::EpiNsaIn{BIG, (const f32x2*)(ws + WS_ROPE32)}, bid, nb);
    SEAM(14);
    if (IN(15)) phase_cmp_partial(a, lds, bid, nb);
    SEAM(15);
    if (IN(16)) phase_cmp_out(a, lds, bid, nb);
    SEAM(16);
    if (IN(17)) phase_nsa(a, lds, bid, nb);
    SEAM(17);
    if (IN(18)) pg8::run(lds, Ob, (const bf16_t*)(ws + WS_WNSAOUT), T, 2048, 2048, pg8::EpiResidual{XB, XA, MOD + 2 * 2 * 6144 + 4096, ABL_M1}, bid, nb);
    SEAM(18);
    if (IN(19)) phase_modnorm(a, XA, a.in[20] + 2048, 3, bid, nb);
    SEAM(19);
    if (IN(20)) pg8::run(lds, H, (const bf16_t*)(ws + WS_WPQ) + (size_t)2048 * 2048, T, 2048, 2048, pg8::EpiStore{(bf16_t*)(ws + WS_PQ), 2048, 2048}, bid, nb);
    SEAM(20);
    if (IN(21)) phase_topk(a, lds, 1, bid, nb);
    SEAM(21);
    if (IN(22)) phase_peer_dots(a, lds, 1, bid, nb);
    SEAM(22);
    if (IN(23)) phase_peer_weights(a, ABL_P1, bid, nb);
    SEAM(23);
    if (IN(24)) phase_peer_out(a, lds, 1, XA, a.out, 3, bid, nb);
    SEAM(24);
    if (IN(25)) phase_finalnorm(a, a.out, a.in[28], bid, nb);
    if (a.ph_lo == 99) {
        const bf16_t* raw = (const bf16_t*)(ws + (size_t)a.ph_hi * 16384);
        for (size_t i = (size_t)bid * NTHREADS + threadIdx.x; i < (size_t)T * 2048; i += (size_t)nb * NTHREADS) a.out[i] = bf2f(raw[i]);
    }
#undef IN
#undef SEAM
#undef ws
#undef MOD
#undef H
#undef BIG
#undef Ob
#undef XA
#undef XB
}

#ifndef MK_ONE_LAUNCH
#define MK_ONE_LAUNCH 1
#endif
extern "C" void kernel_launch(void* const* d_in, const int* in_sizes, int n_in, void* d_out, int out_size, void* d_ws, size_t ws_size, hipStream_t stream) {
    static int grid = 0;
    if (grid == 0) {
        if (n_in != 29 || out_size != T * D_MODEL || ws_size < WS_END) { fprintf(stderr, "kernel_launch: unexpected shapes (n_in %d out %d ws %zu need %zu)\n", n_in, out_size, ws_size, (size_t)WS_END); grid = -1; return; }
        int dev = 0, cus = 0, per_cu = 0;
        if (hipGetDevice(&dev) != hipSuccess || hipDeviceGetAttribute(&cus, hipDeviceAttributeMultiprocessorCount, dev) != hipSuccess) { grid = -1; return; }
        if (hipFuncSetAttribute((const void*)fwd_kernel, hipFuncAttributeMaxDynamicSharedMemorySize, LDS_TOTAL) != hipSuccess) { fprintf(stderr, "kernel_launch: hipFuncSetAttribute failed\n"); grid = -1; return; }
        if (hipOccupancyMaxActiveBlocksPerMultiprocessor(&per_cu, (const void*)fwd_kernel, NTHREADS, LDS_TOTAL) != hipSuccess || per_cu < 1) { fprintf(stderr, "kernel_launch: occupancy query says %d\n", per_cu); }
        (void)hipGetLastError();
        grid = cus;
    }
    if (grid < 0) return;
    (void)hipMemsetAsync((char*)d_ws + WS_CTL, 0, 16384, stream);
    Args a{};
    for (int i = 0; i < 29; ++i) a.in[i] = (const float*)d_in[i];
    a.out = (float*)d_out; a.ws = (unsigned char*)d_ws;
#if MK_ONE_LAUNCH
    a.ph_lo = 0; a.ph_hi = N_PHASES;
    hipLaunchKernelGGL(fwd_kernel, dim3(grid), dim3(NTHREADS), LDS_TOTAL, stream, a);
#else
#ifdef DBG_UPTO
    for (int p = 0; p <= DBG_UPTO; ++p) {
        a.ph_lo = p; a.ph_hi = p + 1;
        hipLaunchKernelGGL(fwd_kernel, dim3(grid), dim3(NTHREADS), LDS_TOTAL, stream, a);
    }
    a.ph_lo = 99; a.ph_hi = (int)(DBG_OFF / 16384);
    hipLaunchKernelGGL(fwd_kernel, dim3(grid), dim3(NTHREADS), LDS_TOTAL, stream, a);
#else
    for (int p = 0; p < N_PHASES; ++p) {
        a.ph_lo = p; a.ph_hi = p + 1;
        hipLaunchKernelGGL(fwd_kernel, dim3(grid), dim3(NTHREADS), LDS_TOTAL, stream, a);
#ifdef REPEAT_LIST
        { const int rl[] = REPEAT_LIST; for (int q : rl) if (q == p) hipLaunchKernelGGL(fwd_kernel, dim3(grid), dim3(NTHREADS), LDS_TOTAL, stream, a); }
#endif
    }
#endif
#endif
}
```

```cpp
#include <hip/hip_runtime.h>
#include <stdint.h>
#include <stdio.h>

typedef unsigned short bf16_t;
typedef short bf16x8 __attribute__((ext_vector_type(8)));
typedef short s16x4 __attribute__((ext_vector_type(4)));
typedef float f32x16 __attribute__((ext_vector_type(16)));
typedef float f32x4 __attribute__((ext_vector_type(4)));
typedef float f32x2 __attribute__((ext_vector_type(2)));
typedef unsigned u32x4 __attribute__((ext_vector_type(4)));
typedef unsigned u32x2 __attribute__((ext_vector_type(2)));
typedef __bf16 bf16x2_t __attribute__((ext_vector_type(2)));
#define LAS __attribute__((address_space(3)))

constexpr int D_MODEL = 2048, BATCH = 2, SEQ = 8192, T = BATCH * SEQ;
constexpr float EPS = 1e-6f;
constexpr int SBMLA_IN = 3904, SBMLA_IN_PAD = 4096;
constexpr int NSA_IN = 3632, NSA_IN_PAD = 3840;
constexpr int NCMP = 511, NCMP_PAD = 512;
constexpr int NTHREADS = 512, NWAVES = 8;
constexpr int KVM_LD = 2112;

constexpr size_t al256(size_t x) { return (x + 255) & ~(size_t)255; }
constexpr size_t WS_CTL   = 0;
constexpr size_t WS_MOD   = 16384;
constexpr size_t WS_BIASP = WS_MOD + al256((size_t)4 * 2 * 6144 * 4);
constexpr size_t WS_ROPE64 = WS_BIASP + al256((size_t)2 * 32 * 256 * 4);
constexpr size_t WS_ROPE32 = WS_ROPE64 + (size_t)T * 32 * 8;
constexpr size_t WS_WIN0  = WS_ROPE32 + (size_t)T * 16 * 8;
constexpr size_t WS_WUQ   = WS_WIN0 + (size_t)SBMLA_IN_PAD * 2048 * 2;
constexpr size_t WS_WUKV  = WS_WUQ + (size_t)1536 * 512 * 2;
constexpr size_t WS_WOUT0 = WS_WUKV + (size_t)2048 * 256 * 2;
constexpr size_t WS_WNSAIN = WS_WOUT0 + (size_t)2048 * 2048 * 2;
constexpr size_t WS_W1K   = WS_WNSAIN + (size_t)NSA_IN_PAD * 2048 * 2;
constexpr size_t WS_W1V   = WS_W1K + (size_t)256 * 4096 * 2;
constexpr size_t WS_W2K   = WS_W1V + (size_t)256 * 4096 * 2;
constexpr size_t WS_W2V   = WS_W2K + (size_t)128 * 256 * 2;
constexpr size_t WS_WNSAOUT = WS_W2V + (size_t)128 * 256 * 2;
constexpr size_t WS_WPQ   = WS_WNSAOUT + (size_t)2048 * 2048 * 2;
constexpr size_t WS_K12   = WS_WPQ + (size_t)2 * 2048 * 2048 * 2;
constexpr size_t WS_PU    = WS_K12 + (size_t)4 * 128 * 128 * 2;
constexpr size_t WS_PV    = WS_PU + (size_t)2 * 16384 * 1536;
constexpr size_t WS_H     = WS_PV + (size_t)2 * 16384 * 1024;
constexpr size_t WS_BIG   = WS_H + (size_t)T * 2048 * 2;
constexpr size_t WS_O     = WS_BIG + (size_t)T * SBMLA_IN * 2;
constexpr size_t WS_XA    = WS_O + (size_t)T * 2048 * 2;
constexpr size_t WS_XB    = WS_XA + (size_t)T * 2048 * 4;
constexpr size_t WS_CQN   = WS_XA;
constexpr size_t WS_CKVN  = WS_CQN + (size_t)T * 512 * 2;
constexpr size_t WS_CMPPART = WS_XA;
constexpr size_t WS_OACC  = WS_XA;
constexpr size_t WS_QM    = WS_XB;
constexpr size_t WS_KVM   = WS_QM + (size_t)T * 1536 * 2;
constexpr size_t WS_PQ    = WS_XB;
static_assert((size_t)T * 1536 * 2 + (size_t)T * KVM_LD * 2 <= (size_t)T * 2048 * 4, "QM + KVM must fit the XB region");
constexpr size_t WS_EXI   = WS_XB + (size_t)T * 2048 * 4;
constexpr size_t WS_EXG   = WS_EXI + (size_t)T * 128 * 4;
constexpr size_t WS_HID   = WS_EXG + (size_t)T * 128 * 4;
constexpr size_t WS_KCC   = WS_HID + (size_t)2 * 2048 * 256 * 2;
constexpr size_t WS_VCC   = WS_KCC + (size_t)BATCH * NCMP_PAD * 2 * 128 * 2;
constexpr size_t WS_END   = WS_VCC + (size_t)BATCH * NCMP_PAD * 2 * 128 * 2;

struct Args {
    const float* in[29];
    float* out;
    unsigned char* ws;
    int ph_lo, ph_hi;
};

__device__ __forceinline__ unsigned cvtpk(float lo, float hi) {
    bf16x2_t v = {(__bf16)lo, (__bf16)hi};
    return __builtin_bit_cast(unsigned, v);
}
__device__ __forceinline__ float bf2f(unsigned short h) { return __uint_as_float(((unsigned)h) << 16); }
__device__ __forceinline__ float bflo(unsigned w) { return __uint_as_float(w << 16); }
__device__ __forceinline__ float bfhi(unsigned w) { return __uint_as_float(w & 0xFFFF0000u); }
__device__ __forceinline__ int crow(int r, int hi) { return (r & 3) + 8 * (r >> 2) + 4 * hi; }
__device__ __forceinline__ float wave_sum(float v) {
#pragma unroll
    for (int o = 32; o >= 1; o >>= 1) v += __shfl_xor(v, o);
    return v;
}
__device__ __forceinline__ float wave_sum_dpp(float v) {
#define WS_DPP(ctrl, rmask) v += __int_as_float(__builtin_amdgcn_update_dpp(0, __float_as_int(v), ctrl, rmask, 0xF, false))
    WS_DPP(0xB1, 0xF);
    WS_DPP(0x4E, 0xF);
    WS_DPP(0x141, 0xF);
    WS_DPP(0x140, 0xF);
    WS_DPP(0x142, 0xA);
    WS_DPP(0x143, 0xC);
#undef WS_DPP
    return __int_as_float(__builtin_amdgcn_readlane(__float_as_int(v), 63));
}
__device__ __forceinline__ float gelu_tanh(float x) {
    const float u = 0.7978845608028654f * (x + 0.044715f * x * x * x);
    const float e = __expf(2.f * u);
    const float th = 1.f - 2.f / (e + 1.f);
    return 0.5f * x * (1.f + th);
}
__device__ __forceinline__ int opaque_tid() { int t = threadIdx.x; asm volatile("" : "+v"(t)); return t; }
__device__ __forceinline__ unsigned char* WSP(const Args& A) {
    size_t z = 0; asm volatile("" : "+s"(z));
    return A.ws + z;
}
#ifndef ABL_SB
#define ABL_SB 1.f
#endif
#ifndef ABL_MLA
#define ABL_MLA 1.f
#endif
#ifndef ABL_NC
#define ABL_NC 1.f
#endif
#ifndef ABL_NS
#define ABL_NS 1.f
#endif
#ifndef ABL_NW
#define ABL_NW 1.f
#endif
#define XB_TMO      128
#define XB_XCNT(j)  (256  + 64 * (j))
#define XB_XSUB(j)  (1280 + 64 * (j))
#define XB_XGEN(j)  (2304 + 64 * (j))
#define XB_TOP      3328
#define XB_TOPGEN   3392
#define XCD_BAR_WORDS 3456
#define XB_SPIN_CAP (1u << 18)
#define LAS __attribute__((address_space(3)))

__device__ __forceinline__ unsigned xb_ld(unsigned* p)              { return __hip_atomic_load(p, __ATOMIC_RELAXED, __HIP_MEMORY_SCOPE_AGENT); }
__device__ __forceinline__ unsigned xb_add(unsigned* p, unsigned v) { return __hip_atomic_fetch_add(p, v, __ATOMIC_RELAXED, __HIP_MEMORY_SCOPE_AGENT); }
__device__ __forceinline__ unsigned xb_xcc_id() { return (unsigned)__builtin_amdgcn_s_getreg((3 << 11) | 20) & 0xFu; }
#define XB_SPIN(cond, bar) do { unsigned _sp = 0; while (cond) { __builtin_amdgcn_s_sleep(1); \
    if ((++_sp & 255u) == 0u) { if (xb_ld(&(bar)[XB_TMO])) break; if (_sp > XB_SPIN_CAP) { atomicAdd(&(bar)[XB_TMO], 1u); break; } } } } while (0)

struct XcdBarrier {
    unsigned* bar; unsigned x;
    volatile LAS unsigned* st;
};

__device__ __forceinline__ XcdBarrier xcd_barrier_post(unsigned* bar, volatile LAS unsigned* st) {
    XcdBarrier b; b.bar = bar; b.x = xb_xcc_id(); b.st = st;
    if (threadIdx.x == 0) (void)xb_add(&bar[XB_XCNT(b.x)], 1u);
    return b;
}
__device__ __forceinline__ void xcd_barrier_complete(unsigned* bar, unsigned x, unsigned& nloc, unsigned& nx) {
    const unsigned G = gridDim.x * gridDim.y * gridDim.z;
    unsigned sum, cnt, mine, sp = 0u;
    for (;;) {
        sum = 0u; cnt = 0u; mine = 0u;
#pragma unroll
        for (unsigned j = 0; j < 16; ++j) { const unsigned c = xb_ld(&bar[XB_XCNT(j)]); sum += c; cnt += (c > 0u) ? 1u : 0u; mine = (j == x) ? c : mine; }
        if (sum == G) break;
        __builtin_amdgcn_s_sleep(1);
        if ((++sp & 255u) == 0u) { if (xb_ld(&bar[XB_TMO])) break; if (sp > XB_SPIN_CAP) { atomicAdd(&bar[XB_TMO], 1u); break; } }
    }
    nloc = mine > 0u ? mine : 1u; nx = cnt > 0u ? cnt : 1u;
}

__device__ __forceinline__ void xcd_barrier(const XcdBarrier& b) {
    asm volatile("s_waitcnt vmcnt(0)" ::: "memory");
    __syncthreads();
    if (threadIdx.x == 0) {
        unsigned* bar = b.bar;
        __builtin_amdgcn_s_waitcnt(0);
        unsigned nloc = b.st[0], nx = b.st[1];
        if (nloc == 0u) { xcd_barrier_complete(bar, b.x, nloc, nx); b.st[0] = nloc; b.st[1] = nx; }
        const unsigned old = xb_add(&bar[XB_XSUB(b.x)], 1u);
        const unsigned gen = old / nloc;
        if (old + 1u == (gen + 1u) * nloc) {
            __builtin_amdgcn_fence(__ATOMIC_RELEASE, "agent");
            asm volatile("s_waitcnt vmcnt(0)" ::: "memory");
            const unsigned og = xb_add(&bar[XB_TOP], 1u);
            const unsigned tg = og / nx;
            if (og + 1u == (tg + 1u) * nx) xb_add(&bar[XB_TOPGEN], 1u);
            else XB_SPIN(xb_ld(&bar[XB_TOPGEN]) == tg, bar);
            __builtin_amdgcn_fence(__ATOMIC_ACQUIRE, "agent");
            xb_add(&bar[XB_XGEN(b.x)], 1u);
            asm volatile("s_waitcnt vmcnt(0)" ::: "memory");
        } else {
            XB_SPIN(xb_ld(&bar[XB_XGEN(b.x)]) == gen, bar);
            __builtin_amdgcn_fence(__ATOMIC_ACQUIRE, "agent");
            asm volatile("s_waitcnt vmcnt(0)" ::: "memory");
        }
    }
    __syncthreads();
}
constexpr int U0_MOD = 48  , U0_MOD_LATE = 144, U0_TR = 8912, U0_PEER = 2048, U0_ROPE = 192, U0_BIAS = 64, U0_K12 = 8, U0_ZERO = 8;
constexpr int U0_TOTAL = U0_MOD + U0_TR + U0_ROPE + U0_BIAS + U0_K12 + U0_ZERO;

struct TrDesc { int in_idx; size_t in_off; int K, N, Npad; size_t ws_off; int ntiles; };
__device__ __forceinline__ TrDesc tr_desc(int m) {
    switch (m) {
        case 0:  return TrDesc{6, 0, 2048, 3904, 4096, WS_WIN0, 2048};
        case 1:  return TrDesc{8, 0, 512, 1536, 1536, WS_WUQ, 192};
        case 2:  return TrDesc{10, 0, 256, 2048, 2048, WS_WUKV, 128};
        case 3:  return TrDesc{11, 0, 2048, 2048, 2048, WS_WOUT0, 1024};
        case 4:  return TrDesc{12, 0, 2048, 3632, 3840, WS_WNSAIN, 1920};
        case 5:  return TrDesc{15, 0, 4096, 256, 256, WS_W1K, 256};
        case 6:  return TrDesc{17, 0, 4096, 256, 256, WS_W1V, 256};
        case 7:  return TrDesc{16, 0, 256, 128, 128, WS_W2K, 8};
        case 8:  return TrDesc{18, 0, 256, 128, 128, WS_W2V, 8};
        case 9:  return TrDesc{19, 0, 2048, 2048, 2048, WS_WNSAOUT, 1024};
        case 10: return TrDesc{23, 0, 2048, 2048, 2048, WS_WPQ, 1024};
        default: return TrDesc{23, (size_t)2048 * 2048, 2048, 2048, 2048, WS_WPQ + (size_t)2048 * 2048 * 2, 1024};
    }
}

__device__ __forceinline__ void p0_mod_unit(const Args& A, unsigned char* lds, int u) {
    const int tid = opaque_tid();
    float* sc = (float*)lds;
    float* red = (float*)(lds + 16384);
    const int set = u / 48, cc = u % 48;
    const int layer = set >> 1, kind = set & 1;
    const float* w = (kind ? A.in[21] : A.in[4]) + (size_t)layer * 2048 * 6144;
    const float* bias = (kind ? A.in[22] : A.in[5]) + (size_t)layer * 6144;
    const float* c = A.in[1];
    for (int i = tid; i < 4096; i += NTHREADS) { const float v = c[i]; sc[i] = v / (1.f + __expf(-v)); }
    __syncthreads();
    const int l32 = tid & 31, kg = tid >> 5;
    const int col = cc * 128 + l32 * 4;
    float a0[4] = {0, 0, 0, 0}, a1[4] = {0, 0, 0, 0};
    const float* wp = w + (size_t)(kg * 128) * 6144 + col;
#pragma unroll 8
    for (int i = 0; i < 128; ++i) {
        const f32x4 wv = *(const f32x4*)(wp + (size_t)i * 6144);
        const float s0 = sc[kg * 128 + i], s1 = sc[2048 + kg * 128 + i];
#pragma unroll
        for (int j = 0; j < 4; ++j) { a0[j] += s0 * wv[j]; a1[j] += s1 * wv[j]; }
    }
#pragma unroll
    for (int j = 0; j < 4; ++j) { red[(kg * 2 + 0) * 128 + l32 * 4 + j] = a0[j]; red[(kg * 2 + 1) * 128 + l32 * 4 + j] = a1[j]; }
    __syncthreads();
    if (tid < 256) {
        const int b = tid >> 7, cl = tid & 127;
        float s = 0;
#pragma unroll
        for (int g = 0; g < 16; ++g) s += red[(g * 2 + b) * 128 + cl];
        float* mod = (float*)(WSP(A) + WS_MOD);
        mod[(size_t)(set * 2 + b) * 6144 + cc * 128 + cl] = s + bias[cc * 128 + cl];
    }
    __syncthreads();
}

__device__ __forceinline__ void p0_tr_unit(const Args& A, unsigned char* lds, int u) {
    const int tid = opaque_tid();
    int m = 0, tile = u;
    TrDesc d = tr_desc(0);
    while (tile >= d.ntiles) { tile -= d.ntiles; ++m; d = tr_desc(m); }
    const int nNt = d.Npad / 64;
    const int kt = tile / nNt, nt = tile % nNt;
    const float* src = A.in[d.in_idx] + d.in_off;
    bf16_t* dst = (bf16_t*)(WSP(A) + d.ws_off);
    float* ts = (float*)lds;
    {
        const int r = tid >> 3, cg = tid & 7;
        const int k = kt * 64 + r, n = nt * 64 + cg * 8;
        f32x4 v0 = {0, 0, 0, 0}, v1 = {0, 0, 0, 0};
        if (n < d.N) { const float* p = src + (size_t)k * d.N + n; v0 = *(const f32x4*)p; v1 = *(const f32x4*)(p + 4); }
#pragma unroll
        for (int j = 0; j < 4; ++j) { ts[r * 65 + cg * 8 + j] = v0[j]; ts[r * 65 + cg * 8 + 4 + j] = v1[j]; }
    }
    __syncthreads();
    {
        const int n = tid >> 3, kg = tid & 7;
        float v[8];
#pragma unroll
        for (int j = 0; j < 8; ++j) v[j] = ts[(kg * 8 + j) * 65 + n];
        u32x4 w = {cvtpk(v[0], v[1]), cvtpk(v[2], v[3]), cvtpk(v[4], v[5]), cvtpk(v[6], v[7])};
        *(u32x4*)(dst + (size_t)(nt * 64 + n) * d.K + kt * 64 + kg * 8) = w;
    }
    __syncthreads();
}

constexpr float PEER_USCALE = 90.5f, PEER_VSCALE = 5.65685f;
constexpr float PEER_UQ = 113.137f  , PEER_HQ = 96.f  ;
constexpr int PEER_UROW_BYTES = 2048 * 6 / 8, PEER_VROW_BYTES = 2048 * 4 / 8;
constexpr size_t PEER_U16_SLICE = (size_t)16384 * 128, PEER_U8_SLICE = (size_t)16384 * 64, PEER_V_SLICE = (size_t)16384 * 128;
constexpr size_t PEER_U_LAYER = (size_t)16384 * PEER_UROW_BYTES, PEER_U8_OFF = 8 * PEER_U16_SLICE, PEER_V_LAYER = (size_t)16384 * PEER_VROW_BYTES;
constexpr size_t WS_DP = WS_BIG;
constexpr size_t WS_PW = WS_DP + (size_t)8 * T * 128 * 4;
static_assert((size_t)9 * T * 128 * 4 <= (size_t)T * SBMLA_IN * 2, "PEER scratch must fit the BIG region");
typedef float f32x32 __attribute__((ext_vector_type(32)));
typedef unsigned u32x6 __attribute__((ext_vector_type(6)));
__device__ __forceinline__ void p0_peer_unit(const Args& A, int u) {
    const int tid = opaque_tid();
    const bool isv = u >= 1024;
    const int pu = isv ? u - 1024 : u;
    const float* src = (isv ? A.in[27] : A.in[26]) + (size_t)pu * 65536;
#pragma unroll 1
    for (int it = 0; it < 4; ++it) {
        const int grp = it * NTHREADS + tid;
        const float* p = src + grp * 32;
        if (!isv) {
            u32x4 w;
#pragma unroll
            for (int j = 0; j < 4; ++j) {
                const f32x4 v0 = *(const f32x4*)(p + 8 * j), v1 = *(const f32x4*)(p + 8 * j + 4);
                unsigned d = 0;
#pragma unroll
                for (int i = 0; i < 8; ++i) {
                    const float f = (i < 4 ? v0[i] : v1[i - 4]) * PEER_UQ;
                    const int n = (int)__builtin_rintf(fminf(fmaxf(f, -7.f), 7.f));
                    d |= ((unsigned)n & 15u) << (4 * i);
                }
                w[j] = d;
            }
            const int R = pu * 32 + (grp >> 6), e = R & 16383, cb = grp & 63;
            *(u32x4*)(WSP(A) + WS_PU + (size_t)(R >> 14) * PEER_U_LAYER + (size_t)(cb >> 3) * PEER_U16_SLICE + (size_t)e * 128 + (cb & 7) * 16) = w;
        } else {
            u32x4 w;
#pragma unroll
            for (int j = 0; j < 4; ++j) {
                const f32x4 v0 = *(const f32x4*)(p + 8 * j), v1 = *(const f32x4*)(p + 8 * j + 4);
                unsigned d = 0;
                d = __builtin_amdgcn_cvt_scalef32_pk_fp4_f32(d, v0[0] * PEER_VSCALE, v0[1] * PEER_VSCALE, 1.0f, 0);
                d = __builtin_amdgcn_cvt_scalef32_pk_fp4_f32(d, v0[2] * PEER_VSCALE, v0[3] * PEER_VSCALE, 1.0f, 1);
                d = __builtin_amdgcn_cvt_scalef32_pk_fp4_f32(d, v1[0] * PEER_VSCALE, v1[1] * PEER_VSCALE, 1.0f, 2);
                d = __builtin_amdgcn_cvt_scalef32_pk_fp4_f32(d, v1[2] * PEER_VSCALE, v1[3] * PEER_VSCALE, 1.0f, 3);
                w[j] = d;
            }
            const int R = pu * 32 + (grp >> 6), e = R & 16383, cb = grp & 63;
            *(u32x4*)(WSP(A) + WS_PV + (size_t)(R >> 14) * PEER_V_LAYER + (size_t)(cb >> 3) * PEER_V_SLICE + (size_t)e * 128 + (cb & 7) * 16) = w;
        }
    }
}

__device__ __forceinline__ void p0_rope_unit(const Args& A, int u) {
    const int tid = opaque_tid();
    const int* pos = (const int*)A.in[2];
#pragma unroll 1
    for (int it = 0; it < 8; ++it) {
        const int e = u * 4096 + it * NTHREADS + tid;
        if (e < T * 32) {
            const int t = e >> 5, j = e & 31;
            const float inv = powf(500000.0f, -(float)j / 32.0f);
            const float ang = (float)pos[t] * inv;
            float s, c; sincosf(ang, &s, &c);
            ((f32x2*)(WSP(A) + WS_ROPE64))[e] = f32x2{c, s};
        } else {
            const int e2 = e - T * 32;
            const int t = e2 >> 4, j = e2 & 15;
            const float inv = powf(500000.0f, -(float)j / 16.0f);
            const float ang = (float)pos[t] * inv;
            float s, c; sincosf(ang, &s, &c);
            ((f32x2*)(WSP(A) + WS_ROPE32))[e2] = f32x2{c, s};
        }
    }
}

__device__ __forceinline__ void p0_bias_unit(const Args& A, unsigned char* lds, int u) {
    const int tid = opaque_tid();
    const int mat = u >> 5, chunk = u & 31;
    const float* pe = A.in[mat ? 14 : 13];
    const float* w1 = A.in[mat ? 17 : 15];
    const int col = tid & 255, half = tid >> 8;
    float acc = 0;
    const int r0 = chunk * 128 + half * 64;
#pragma unroll 8
    for (int i = 0; i < 64; ++i) acc += pe[r0 + i] * w1[(size_t)(r0 + i) * 256 + col];
    float* red = (float*)lds;
    if (half) red[col] = acc;
    __syncthreads();
    if (!half) ((float*)(WSP(A) + WS_BIASP))[(mat * 32 + chunk) * 256 + col] = acc + red[col];
    __syncthreads();
}

__device__ __forceinline__ void p0_k12_unit(const Args& A, int u) {
    const int tid = opaque_tid();
    bf16_t* dst = (bf16_t*)(WSP(A) + WS_K12);
#pragma unroll
    for (int it = 0; it < 2; ++it) {
        const int e = u * 8192 + (it * NTHREADS + tid) * 8;
        const int layer = e >> 15, which = (e >> 14) & 1, rem = e & 16383;
        const float* src = A.in[which ? 25 : 24] + layer * 16384 + rem;
        const f32x4 v0 = *(const f32x4*)src, v1 = *(const f32x4*)(src + 4);
        u32x4 w = {cvtpk(v0[0], v0[1]), cvtpk(v0[2], v0[3]), cvtpk(v1[0], v1[1]), cvtpk(v1[2], v1[3])};
        *(u32x4*)(dst + e) = w;
    }
}

__device__ __forceinline__ void phase_prologue(const Args& A, unsigned char* lds, int bid, int nb) {
    for (int u = bid; u < U0_TOTAL; u += nb) {
        int v = u;
        if (v < U0_MOD) { p0_mod_unit(A, lds, v); continue; }
        v -= U0_MOD;
        if (v < U0_TR) { p0_tr_unit(A, lds, v); continue; }
        v -= U0_TR;
        if (v < U0_ROPE) { p0_rope_unit(A, v); continue; }
        v -= U0_ROPE;
        if (v < U0_BIAS) { p0_bias_unit(A, lds, v); continue; }
        v -= U0_BIAS;
        if (v < U0_K12) { p0_k12_unit(A, v); continue; }
        v -= U0_K12;
        {
            u32x4* z = (u32x4*)(WSP(A) + WS_KCC) + (size_t)v * 8192;
            for (int i = opaque_tid(); i < 8192; i += NTHREADS) z[i] = u32x4{0u, 0u, 0u, 0u};
        }
    }
}

__device__ __forceinline__ void modnorm_row(const float* xr, const float* gain, const float* mod  , bf16_t* hr, int lane) {
    f32x4 v[8];
    float ss = 0;
#pragma unroll
    for (int i = 0; i < 8; ++i) { v[i] = *(const f32x4*)(xr + i * 256 + lane * 4); ss += v[i][0] * v[i][0] + v[i][1] * v[i][1] + v[i][2] * v[i][2] + v[i][3] * v[i][3]; }
    ss = wave_sum(ss);
    const float rinv = rsqrtf(ss * (1.0f / 2048.0f) + EPS);
#pragma unroll
    for (int i = 0; i < 8; ++i) {
        const int col = i * 256 + lane * 4;
        const f32x4 g = *(const f32x4*)(gain + col), sh = *(const f32x4*)(mod + col), scl = *(const f32x4*)(mod + 2048 + col);
        float y[4];
#pragma unroll
        for (int j = 0; j < 4; ++j) y[j] = v[i][j] * rinv * g[j] * (1.f + scl[j]) + sh[j];
        u32x2 w = {cvtpk(y[0], y[1]), cvtpk(y[2], y[3])};
        *(u32x2*)(hr + col) = w;
    }
}
__device__ __forceinline__ void phase_modnorm(const Args& A, const float* xin, const float* gain, int set, int bid, int nb) {
    const int tid = opaque_tid(), lane = tid & 63, wave = tid >> 6;
    const float* mod = (const float*)(WSP(A) + WS_MOD) + (size_t)set * 2 * 6144;
    bf16_t* H = (bf16_t*)(WSP(A) + WS_H);
    for (int u = bid; u < T / NWAVES; u += nb) {
        const int row = u * NWAVES + wave;
        modnorm_row(xin + (size_t)row * 2048, gain, mod + (row >> 13) * 6144, H + (size_t)row * 2048, lane);
    }
}

struct ALoadPlain {
    const bf16_t* A; int lda;
    __device__ __forceinline__ const bf16_t* ptr(int row, int k) const { return A + (size_t)row * lda + k; }
};
struct ALoadCmp {
    const bf16_t* base; int ld; int colbase;
    __device__ __forceinline__ const bf16_t* ptr(int row, int k) const {
        int r = row < 2 * BATCH * NCMP ? row : 2 * BATCH * NCMP - 1;
        const int g = r & 1; r >>= 1;
        const int b = r / NCMP, n = r - b * NCMP;
        const int l = k >> 7, d = k & 127;
        return base + (size_t)(b * SEQ + 16 * n + l) * ld + colbase + g * 128 + d;
    }
};

constexpr int GEMM_LDS = 98304;
template <class AL, class Epi>
__device__ __forceinline__ void gemm_unit(unsigned char* lds, const AL& al, const bf16_t* __restrict__ Bt, int ldb, int m0, int n0, int kt0, int nk, const Epi& epi, int tid) {
    const int lane = tid & 63, wave = tid >> 6, l31 = lane & 31, hi = lane >> 5;
    const int wm = wave >> 1, wn = wave & 1;
    const int swz = (l31 >> 1) & 7;
    f32x16 acc[2][2];
#pragma unroll
    for (int i = 0; i < 2; ++i)
#pragma unroll
        for (int j = 0; j < 2; ++j)
#pragma unroll
            for (int r = 0; r < 16; ++r) acc[i][j][r] = 0.f;
    u32x4 ra[4], rb[2];
    auto gload = [&](int kt) {
#pragma unroll
        for (int i = 0; i < 4; ++i) { const int q = tid + NTHREADS * i, row = q >> 3, c = q & 7; ra[i] = *(const u32x4*)al.ptr(m0 + row, (kt0 + kt) * 64 + c * 8); }
#pragma unroll
        for (int i = 0; i < 2; ++i) { const int q = tid + NTHREADS * i, row = q >> 3, c = q & 7; rb[i] = *(const u32x4*)(Bt + (size_t)(n0 + row) * ldb + (kt0 + kt) * 64 + c * 8); }
    };
    auto lstore = [&](int buf) {
        unsigned char* la = lds + buf * 32768; unsigned char* lb = lds + 65536 + buf * 16384;
#pragma unroll
        for (int i = 0; i < 4; ++i) { const int q = tid + NTHREADS * i, row = q >> 3, c = q & 7; *(u32x4*)(la + row * 128 + ((c ^ ((row >> 1) & 7)) << 4)) = ra[i]; }
#pragma unroll
        for (int i = 0; i < 2; ++i) { const int q = tid + NTHREADS * i, row = q >> 3, c = q & 7; *(u32x4*)(lb + row * 128 + ((c ^ ((row >> 1) & 7)) << 4)) = rb[i]; }
    };
    gload(0); lstore(0); __syncthreads();
    for (int kt = 0; kt < nk; ++kt) {
        if (kt + 1 < nk) gload(kt + 1);
        const unsigned char* la = lds + (kt & 1) * 32768 + (wm * 64 + l31) * 128;
        const unsigned char* lb = lds + 65536 + (kt & 1) * 16384 + (wn * 64 + l31) * 128;
#pragma unroll
        for (int ks = 0; ks < 4; ++ks) {
            const int co = ((ks * 2 + hi) ^ swz) << 4;
            const bf16x8 a0 = *(const bf16x8*)(la + co), a1 = *(const bf16x8*)(la + 32 * 128 + co);
            const bf16x8 b0 = *(const bf16x8*)(lb + co), b1 = *(const bf16x8*)(lb + 32 * 128 + co);
            acc[0][0] = __builtin_amdgcn_mfma_f32_32x32x16_bf16(a0, b0, acc[0][0], 0, 0, 0);
            acc[0][1] = __builtin_amdgcn_mfma_f32_32x32x16_bf16(a0, b1, acc[0][1], 0, 0, 0);
            acc[1][0] = __builtin_amdgcn_mfma_f32_32x32x16_bf16(a1, b0, acc[1][0], 0, 0, 0);
            acc[1][1] = __builtin_amdgcn_mfma_f32_32x32x16_bf16(a1, b1, acc[1][1], 0, 0, 0);
        }
        if (kt + 1 < nk) lstore((kt + 1) & 1);
        __syncthreads();
    }
    epi.template operator()<2>(acc, m0 + wm * 64, n0 + wn * 64, lane);
}

constexpr int GEMM256_LDS = 131072;
template <class Epi>
__device__ __forceinline__ void gemm256_phase(unsigned char* lds, const bf16_t* __restrict__ Ag, int lda, const bf16_t* __restrict__ Bt, int ldb, int M, int Npad, int K, const Epi epi, int bid, int nb) {
    const int tid = opaque_tid(), lane = tid & 63, wave = __builtin_amdgcn_readfirstlane(tid >> 6), l31 = lane & 31, hi = lane >> 5;
    const int wm = wave >> 2, wn = wave & 3;
    const int nNt = Npad / 256, nU = (M / 256) * nNt, nk = K / 64;
    const int swz = (l31 >> 1) & 7;
    unsigned aoff[4], boff[4];
#pragma unroll
    for (int i = 0; i < 4; ++i) {
        const int row = (wave * 4 + i) * 8 + (lane >> 3), c = (lane & 7) ^ ((row >> 1) & 7);
        aoff[i] = (unsigned)(row * lda + c * 8) * 2u; boff[i] = (unsigned)(row * ldb + c * 8) * 2u;
    }
    const int vcu = (nb % 8 == 0) ? (bid % 8) * (nb / 8) + bid / 8 : bid;
    auto issue = [&](const unsigned char* abase, const unsigned char* bbase, int kt, int stage) {
        unsigned char* la = lds + stage * 65536 + wave * 4096; unsigned char* lb = la + 32768;
#pragma unroll
        for (int i = 0; i < 4; ++i) {
            __builtin_amdgcn_global_load_lds((const unsigned*)(abase + aoff[i] + kt * 128), (unsigned*)(la + i * 1024), 16, 0, 0);
            __builtin_amdgcn_global_load_lds((const unsigned*)(bbase + boff[i] + kt * 128), (unsigned*)(lb + i * 1024), 16, 0, 0);
        }
    };
    if (vcu < nU) {
        const int mt = vcu / nNt, nt = vcu - mt * nNt;
        issue((const unsigned char*)(Ag + (size_t)mt * 256 * lda), (const unsigned char*)(Bt + (size_t)nt * 256 * ldb), 0, 0);
    }
    for (int u = vcu; u < nU; u += nb) {
        const int mt = u / nNt, nt = u - mt * nNt;
        const int m0 = mt * 256, n0 = nt * 256;
        const unsigned char* abase = (const unsigned char*)(Ag + (size_t)m0 * lda);
        const unsigned char* bbase = (const unsigned char*)(Bt + (size_t)n0 * ldb);
        f32x16 acc[4][2];
#pragma unroll
        for (int i = 0; i < 4; ++i)
#pragma unroll
            for (int j = 0; j < 2; ++j)
#pragma unroll
                for (int r = 0; r < 16; ++r) acc[i][j][r] = 0.f;
        asm volatile("s_waitcnt vmcnt(0)" ::: "memory");
        __syncthreads();
        for (int kt = 0; kt < nk; ++kt) {
            if (kt + 1 < nk) issue(abase, bbase, kt + 1, (kt + 1) & 1);
            const unsigned char* la = lds + (kt & 1) * 65536 + (wm * 128 + l31) * 128;
            const unsigned char* lb = lds + (kt & 1) * 65536 + 32768 + (wn * 64 + l31) * 128;
#pragma unroll
            for (int ks = 0; ks < 4; ++ks) {
                const int co = ((ks * 2 + hi) ^ swz) << 4;
                const bf16x8 b0 = *(const bf16x8*)(lb + co), b1 = *(const bf16x8*)(lb + 32 * 128 + co);
#pragma unroll
                for (int mi = 0; mi < 4; ++mi) {
                    const bf16x8 a = *(const bf16x8*)(la + mi * 32 * 128 + co);
                    acc[mi][0] = __builtin_amdgcn_mfma_f32_32x32x16_bf16(a, b0, acc[mi][0], 0, 0, 0);
                    acc[mi][1] = __builtin_amdgcn_mfma_f32_32x32x16_bf16(a, b1, acc[mi][1], 0, 0, 0);
                }
            }
            asm volatile("s_waitcnt vmcnt(0)" ::: "memory");
            __syncthreads();
        }
        if (u + nb < nU) {
            const int un = u + nb, mtn = un / nNt, ntn = un - mtn * nNt;
            issue((const unsigned char*)(Ag + (size_t)mtn * 256 * lda), (const unsigned char*)(Bt + (size_t)ntn * 256 * ldb), 0, 0);
        }
        epi.template operator()<4>(acc, m0 + wm * 128, n0 + wn * 64, lane);
    }
}

template <int MI>
__device__ __forceinline__ void store_bf16_tile(const f32x16 (&acc)[MI][2], bf16_t* C, int ldc, int N, int row0, int col0, int lane) {
    const int l31 = lane & 31, hi = lane >> 5;
#pragma unroll
    for (int ni = 0; ni < 2; ++ni) {
        const int col = col0 + ni * 32 + l31;
#pragma unroll
        for (int mi = 0; mi < MI; ++mi)
#pragma unroll
            for (int r = 0; r < 16; ++r) {
                const float v = acc[mi][ni][r];
                const float vn = __shfl_xor(v, 1);
                if ((l31 & 1) == 0 && col < N) *(unsigned*)(C + (size_t)(row0 + mi * 32 + crow(r, hi)) * ldc + col) = cvtpk(v, vn);
            }
    }
}
struct EpiBf16 {
    bf16_t* C; int ldc; int N;
    template <int MI> __device__ __forceinline__ void operator()(f32x16 (&acc)[MI][2], int row0, int col0, int lane) const { store_bf16_tile<MI>(acc, C, ldc, N, row0, col0, lane); }
};
struct EpiMlaQ {
    bf16_t* C; const f32x2* rope64;
    template <int MI> __device__ __forceinline__ void operator()(f32x16 (&acc)[MI][2], int row0, int col0, int lane) const {
        const int l31 = lane & 31, hi = lane >> 5;
        if ((col0 % 192) == 128) {
#pragma unroll
            for (int mi = 0; mi < MI; ++mi)
#pragma unroll
                for (int r = 0; r < 16; ++r) {
                    const int row = row0 + mi * 32 + crow(r, hi);
                    const f32x2 cs = rope64[(size_t)row * 32 + l31];
                    const float x1 = acc[mi][0][r], x2 = acc[mi][1][r];
                    acc[mi][0][r] = x1 * cs[0] - x2 * cs[1];
                    acc[mi][1][r] = x2 * cs[0] + x1 * cs[1];
                    if ((r & 3) == 3) __builtin_amdgcn_sched_barrier(0);
                }
        }
        store_bf16_tile<MI>(acc, C, 1536, 1536, row0, col0, lane);
    }
};
struct EpiNsaIn {
    bf16_t* C; const f32x2* rope32;
    template <int MI> __device__ __forceinline__ void operator()(f32x16 (&acc)[MI][2], int row0, int col0, int lane) const {
        const int l31 = lane & 31, hi = lane >> 5;
#pragma unroll
        for (int ni = 0; ni < 2; ++ni) {
            const int cb = col0 + ni * 32, hb = cb >> 7;
            const bool is_rope = ((cb & 127) == 0) && (hb < 18 || hb == 20 || hb == 21 || hb == 24 || hb == 25);
            if (is_rope) {
#pragma unroll
                for (int mi = 0; mi < MI; ++mi)
#pragma unroll
                    for (int r = 0; r < 16; ++r) {
                        const int row = row0 + mi * 32 + crow(r, hi);
                        const f32x2 cs = rope32[(size_t)row * 16 + (l31 & 15)];
                        const float own = acc[mi][ni][r];
                        const float oth = __shfl_xor(own, 16);
                        acc[mi][ni][r] = (l31 < 16) ? own * cs[0] - oth * cs[1] : own * cs[0] + oth * cs[1];
                    }
            }
            if (cb >= 3584) {
#pragma unroll
                for (int mi = 0; mi < MI; ++mi)
#pragma unroll
                    for (int r = 0; r < 16; ++r) acc[mi][ni][r] = 1.f / (1.f + __expf(-acc[mi][ni][r]));
            }
        }
        store_bf16_tile<MI>(acc, C, NSA_IN, NSA_IN, row0, col0, lane);
    }
};
struct EpiResid {
    const float* xin; float* xout; const float* gate; float gmul;
    template <int MI> __device__ __forceinline__ void operator()(f32x16 (&acc)[MI][2], int row0, int col0, int lane) const {
        const int l31 = lane & 31, hi = lane >> 5;
        const float* gp = gate + (row0 >> 13) * 6144 + col0 + l31;
        const float g0 = gp[0] * gmul, g1 = gp[32] * gmul;
        const size_t base = (size_t)(row0 + 4 * hi) * 2048 + col0 + l31;
#pragma unroll
        for (int mi = 0; mi < MI; ++mi) {
#pragma unroll
            for (int q = 0; q < 4; ++q) {
                float xv[8];
#pragma unroll
                for (int j = 0; j < 4; ++j) { const size_t o = base + (size_t)(mi * 32 + 8 * q + j) * 2048; xv[j] = xin[o]; xv[4 + j] = xin[o + 32]; }
#pragma unroll
                for (int j = 0; j < 4; ++j) { const size_t o = base + (size_t)(mi * 32 + 8 * q + j) * 2048; xout[o] = xv[j] + g0 * acc[mi][0][4 * q + j]; xout[o + 32] = xv[4 + j] + g1 * acc[mi][1][4 * q + j]; }
                __builtin_amdgcn_sched_barrier(0);
            }
        }
    }
};
struct EpiCmpHid {
    bf16_t* C; const float* biasp;
    template <int MI> __device__ __forceinline__ void operator()(f32x16 (&acc)[MI][2], int row0, int col0, int lane) const {
        const int l31 = lane & 31;
#pragma unroll
        for (int ni = 0; ni < 2; ++ni) {
            const int col = col0 + ni * 32 + l31;
            float b = 0;
#pragma unroll 8
            for (int c = 0; c < 32; ++c) b += biasp[c * 256 + col];
#pragma unroll
            for (int mi = 0; mi < MI; ++mi)
#pragma unroll
                for (int r = 0; r < 16; ++r) acc[mi][ni][r] = gelu_tanh(acc[mi][ni][r] + b);
        }
        store_bf16_tile<MI>(acc, C, 256, 256, row0, col0, lane);
    }
};
struct EpiCmpOut {
    bf16_t* C;
    template <int MI> __device__ __forceinline__ void operator()(f32x16 (&acc)[MI][2], int row0, int col0, int lane) const {
        const int l31 = lane & 31, hi = lane >> 5;
#pragma unroll
        for (int ni = 0; ni < 2; ++ni) {
            const int col = col0 + ni * 32 + l31;
#pragma unroll
            for (int mi = 0; mi < MI; ++mi)
#pragma unroll
                for (int r = 0; r < 16; ++r) {
                    const float v = acc[mi][ni][r];
                    const float vn = __shfl_xor(v, 1);
                    int rr = row0 + mi * 32 + crow(r, hi);
                    if ((l31 & 1) == 0 && rr < 2 * BATCH * NCMP) {
                        const int g = rr & 1; rr >>= 1;
                        const int b = rr / NCMP, n = rr - b * NCMP;
                        *(unsigned*)(C + (size_t)((b * NCMP_PAD + n) * 2 + g) * 128 + col) = cvtpk(v, vn);
                    }
                }
        }
    }
};

struct EpiPartF32 {
    float* P;
    template <int MI> __device__ __forceinline__ void operator()(f32x16 (&acc)[MI][2], int row0, int col0, int lane) const {
        const int l31 = lane & 31, hi = lane >> 5;
#pragma unroll
        for (int ni = 0; ni < 2; ++ni)
#pragma unroll
            for (int mi = 0; mi < MI; ++mi)
#pragma unroll
                for (int r = 0; r < 16; ++r) P[(size_t)(row0 + mi * 32 + crow(r, hi)) * 256 + col0 + ni * 32 + l31] = acc[mi][ni][r];
    }
};
__device__ __forceinline__ void phase_cmp_partial(const Args& A, unsigned char* lds, int bid, int nb) {
    const int tid = opaque_tid();
    const bf16_t* NS = (const bf16_t*)(WSP(A) + WS_BIG);
    float* PART = (float*)(WSP(A) + WS_CMPPART);
    for (int u = bid; u < 256; u += nb) {
        const int mat = u >> 7, ks = (u >> 4) & 7, mt = (u >> 1) & 7, nt = u & 1;
        const bf16_t* w1 = (const bf16_t*)(WSP(A) + (mat ? WS_W1V : WS_W1K));
        gemm_unit(lds, ALoadCmp{NS, NSA_IN, mat ? 2304 : 2048}, w1, 4096, mt * 256, nt * 128, ks * 8, 8, EpiPartF32{PART + (size_t)(mat * 8 + ks) * 2048 * 256}, tid);
    }
}
__device__ __forceinline__ void phase_cmp_out(const Args& A, unsigned char* lds, int bid, int nb) {
    const int tid = opaque_tid();
    const float* PART = (const float*)(WSP(A) + WS_CMPPART);
    bf16_t* HID = (bf16_t*)(WSP(A) + WS_HID);
    for (int u = bid; u < 16; u += nb) {
        const int mat = u >> 3, mt = u & 7;
        float* bias = (float*)lds;
        if (tid < 256) { const float* bp = (const float*)(WSP(A) + WS_BIASP) + mat * 32 * 256 + tid; float b = 0.f;
#pragma unroll 8
            for (int c = 0; c < 32; ++c) b += bp[c * 256];
            bias[tid] = b; }
        __syncthreads();
#pragma unroll 1
        for (int it = 0; it < 16; ++it) {
            const int q = it * NTHREADS + tid, row = mt * 256 + (q >> 5), col = (q & 31) * 8;
            float h[8];
#pragma unroll
            for (int j = 0; j < 8; ++j) h[j] = bias[col + j];
#pragma unroll
            for (int ks = 0; ks < 8; ++ks) {
                const float* pp = PART + ((size_t)(mat * 8 + ks) * 2048 + row) * 256 + col;
                const f32x4 a = *(const f32x4*)pp, b = *(const f32x4*)(pp + 4);
#pragma unroll
                for (int j = 0; j < 4; ++j) { h[j] += a[j]; h[4 + j] += b[j]; }
            }
            u32x4 w = {cvtpk(gelu_tanh(h[0]), gelu_tanh(h[1])), cvtpk(gelu_tanh(h[2]), gelu_tanh(h[3])), cvtpk(gelu_tanh(h[4]), gelu_tanh(h[5])), cvtpk(gelu_tanh(h[6]), gelu_tanh(h[7]))};
            *(u32x4*)(HID + ((size_t)mat * 2048 + row) * 256 + col) = w;
        }
        __threadfence_block();
        __syncthreads();
        gemm_unit(lds, ALoadPlain{HID + (size_t)mat * 2048 * 256, 256}, (const bf16_t*)(WSP(A) + (mat ? WS_W2V : WS_W2K)), 256, mt * 256, 0, 0, 4,
                  EpiCmpOut{(bf16_t*)(WSP(A) + (mat ? WS_VCC : WS_KCC))}, tid);
    }
}

__device__ __forceinline__ void phase_mla_prep(const Args& A, int bid, int nb) {
    const int tid = opaque_tid(), lane = tid & 63, wave = tid >> 6;
    const bf16_t* BIG = (const bf16_t*)(WSP(A) + WS_BIG);
    bf16_t* CQN = (bf16_t*)(WSP(A) + WS_CQN); bf16_t* CKVN = (bf16_t*)(WSP(A) + WS_CKVN); bf16_t* KVM = (bf16_t*)(WSP(A) + WS_KVM);
    const f32x2* rope64 = (const f32x2*)(WSP(A) + WS_ROPE64);
    const float* qn = A.in[7]; const float* kvn = A.in[9];
    for (int u = bid; u < T / NWAVES; u += nb) {
        const int t = u * NWAVES + wave;
        const bf16_t* row = BIG + (size_t)t * SBMLA_IN;
        {
            const u32x4 w = *(const u32x4*)(row + 3072 + lane * 8);
            float x[8] = {bflo(w[0]), bfhi(w[0]), bflo(w[1]), bfhi(w[1]), bflo(w[2]), bfhi(w[2]), bflo(w[3]), bfhi(w[3])};
            float ss = 0;
#pragma unroll
            for (int j = 0; j < 8; ++j) ss += x[j] * x[j];
            ss = wave_sum(ss);
            const float rinv = rsqrtf(ss * (1.f / 512.f) + EPS);
            const f32x4 g0 = *(const f32x4*)(qn + lane * 8), g1 = *(const f32x4*)(qn + lane * 8 + 4);
            u32x4 o = {cvtpk(x[0] * rinv * g0[0], x[1] * rinv * g0[1]), cvtpk(x[2] * rinv * g0[2], x[3] * rinv * g0[3]),
                       cvtpk(x[4] * rinv * g1[0], x[5] * rinv * g1[1]), cvtpk(x[6] * rinv * g1[2], x[7] * rinv * g1[3])};
            *(u32x4*)(CQN + (size_t)t * 512 + lane * 8) = o;
        }
        {
            const u32x2 w = *(const u32x2*)(row + 3584 + lane * 4);
            float x[4] = {bflo(w[0]), bfhi(w[0]), bflo(w[1]), bfhi(w[1])};
            float ss = x[0] * x[0] + x[1] * x[1] + x[2] * x[2] + x[3] * x[3];
            ss = wave_sum(ss);
            const float rinv = rsqrtf(ss * (1.f / 256.f) + EPS);
            const f32x4 g = *(const f32x4*)(kvn + lane * 4);
            u32x2 o = {cvtpk(x[0] * rinv * g[0], x[1] * rinv * g[1]), cvtpk(x[2] * rinv * g[2], x[3] * rinv * g[3])};
            *(u32x2*)(CKVN + (size_t)t * 256 + lane * 4) = o;
        }
        {
            const float x = bf2f(row[3840 + lane]);
            const float oth = __shfl_xor(x, 32);
            const f32x2 cs = rope64[(size_t)t * 32 + (lane & 31)];
            const float y = (lane < 32) ? x * cs[0] - oth * cs[1] : x * cs[0] + oth * cs[1];
            KVM[(size_t)t * KVM_LD + 2048 + lane] = (bf16_t)(cvtpk(y, y) & 0xFFFFu);
        }
    }
}
namespace pg8 {
#define PG8_LAS __attribute__((address_space(3)))
typedef unsigned short bf16_t;
typedef short bf16x8 __attribute__((ext_vector_type(8)));
typedef float f32x4 __attribute__((ext_vector_type(4)));
typedef unsigned u32x4 __attribute__((ext_vector_type(4)));
constexpr int BM = 256, BK = 64, HALF = 128, HTB = HALF * BK * 2  , STAGE_BYTES = 8 * HTB, NXCD = 8, WGM = 8;

__host__ __device__ __forceinline__ int lds_byte(int r, int c) { const int st = (r >> 4) * 2 + (c >> 5), rr = r & 15, cc = c & 31, ob = rr * 64 + cc * 2; return st * 1024 + (ob ^ (((ob >> 9) & 1) << 5)); }
__host__ __device__ __forceinline__ void stage_rc(int b, int& R, int& C) { const int st = b / 1024, sb = b % 1024, swz = sb ^ (((sb >> 9) & 1) << 5); R = (st >> 1) * 16 + swz / 64; C = (st & 1) * 32 + (swz % 64) / 2; }
__host__ __device__ __forceinline__ int perm32(int rho) { const int n = rho >> 4, i = rho & 15; return 8 * (i >> 2) + 4 * n + (i & 3); }

struct Unit { int pm, pn; };
struct Gemm { const bf16_t* A; const bf16_t* Bt; int M, N, K; };

struct StaticOrder {
    int nM, nN, nwg, G, c;
    __host__ __device__ void init(int M, int N, int G_, int c_) { nM = M / BM; nN = N / BM; nwg = nM * nN; G = G_; c = c_; }
    __host__ __device__ bool next(int i, Unit& u) const {
        const long L = (long)i * G + c; if (L >= nwg) return false;
        int wgid = (int)L; { const int q = nwg / NXCD, r = nwg % NXCD, xcd = wgid % NXCD, off = wgid / NXCD; wgid = (xcd < r ? xcd * (q + 1) : r * (q + 1) + (xcd - r) * q) + off; }
        const int nig = WGM * nN, gid = wgid / nig, fm = gid * WGM, gsz = (nM - fm) < WGM ? (nM - fm) : WGM;
        u.pm = fm + ((wgid % nig) % gsz); u.pn = (wgid % nig) / gsz; return true;
    }
    __device__ __forceinline__ void a_ready(const Unit&) const {}
    __device__ __forceinline__ void done(const Unit&) const {}
};
__device__ __forceinline__ unsigned cvt_pk_bf16(float lo, float hi) { return cvtpk(lo, hi); }
template <class Epi, class Sched, bool STAMP = false>
__device__ __forceinline__ void gemm_phase(PG8_LAS unsigned char* lds, const Gemm g, const Sched& S, const Epi& E, unsigned long long* stamps) {
    const int tid = opaque_tid(), wid = __builtin_amdgcn_readfirstlane(tid >> 6), lane = tid & 63, wr = wid >> 2, wc = wid & 3, fr = lane & 15, fq = lane >> 4;
    const int K = g.K, nt = K / BK;
    int ts_lo = 0, ts_hi = 0, nts = 0; const unsigned long long rt_entry = STAMP ? (unsigned long long)wall_clock64() : 0ull;
#define PG8_STAMP() do { if (STAMP && wid == 0 && nts < 64) { const unsigned long long _c = (unsigned long long)clock64(); \
        ts_lo = (lane == nts) ? (int)(unsigned)_c : ts_lo; ts_hi = (lane == nts) ? (int)(unsigned)(_c >> 32) : ts_hi; ++nts; } } while (0)
    PG8_STAMP();
    unsigned voffA[2], voffB[2];
#pragma unroll
    for (int i = 0; i < 2; ++i) { int R, C; stage_rc(tid * 16 + i * 8192, R, C); const int Rb = Epi::PERM ? ((R & ~31) + perm32(R & 31)) : R;
        voffA[i] = (unsigned)(R * K + C) * 2u; voffB[i] = (unsigned)(Rb * K + C) * 2u; }
    const size_t kstep = (size_t)(BK * 2);
    const size_t hstep = (size_t)HALF * K * 2;
    const size_t tstep = 2 * hstep;
    const unsigned ldsw = (unsigned)wid * 1024u;
    const int aoff = lds_byte(wr * 64 + fr, fq * 8), boff = lds_byte(wc * 32 + fr, fq * 8);
#define PG8_SA(b, h) (((b) * 2 + (h)) * HTB)
#define PG8_SB(b, h) ((4 + (b) * 2 + (h)) * HTB)
#define PG8_STAGE(bufoff, gbase, voff) do { _Pragma("unroll") for (int _i = 0; _i < 2; ++_i) \
        __builtin_amdgcn_global_load_lds((const unsigned*)((const char*)(gbase) + (voff)[_i]), (PG8_LAS unsigned*)(lds + (bufoff) + ldsw + _i * 8192), 16, 0, 0); } while (0)
#define PG8_LDA(dst, b, h) do { _Pragma("unroll") for (int m = 0; m < 4; ++m) _Pragma("unroll") for (int k = 0; k < 2; ++k) dst[m][k] = *(const PG8_LAS bf16x8*)(lds + PG8_SA(b, h) + aoff + m * 2048 + k * 1024); } while (0)
#define PG8_LDB(dst, b, h) do { _Pragma("unroll") for (int n = 0; n < 2; ++n) _Pragma("unroll") for (int k = 0; k < 2; ++k) dst[n][k] = *(const PG8_LAS bf16x8*)(lds + PG8_SB(b, h) + boff + n * 2048 + k * 1024); } while (0)
#define PG8_MMA(ai, bj, At, Bt) do { __builtin_amdgcn_s_setprio(1); _Pragma("unroll") for (int m = 0; m < 4; ++m) _Pragma("unroll") for (int n = 0; n < 2; ++n) _Pragma("unroll") for (int k = 0; k < 2; ++k) \
        acc[ai][bj][m][n] = __builtin_amdgcn_mfma_f32_16x16x32_bf16(Bt[n][k], At[m][k], acc[ai][bj][m][n], 0, 0, 0); __builtin_amdgcn_s_setprio(0); } while (0)
#define PG8_WAIT_V(n) asm volatile("s_waitcnt vmcnt(" #n ")" ::: "memory")
#define PG8_WAIT_L(n) asm volatile("s_waitcnt lgkmcnt(" #n ")" ::: "memory")
#define PG8_BAR __builtin_amdgcn_s_barrier()
#define PG8_SCHED __builtin_amdgcn_sched_barrier(0)
    Unit cur, nxt; int ui = 0;
    if (!S.next(0, cur)) return;
    f32x4 acc[2][2][4][2];
#pragma unroll
    for (int a = 0; a < 2; ++a)
#pragma unroll
        for (int b = 0; b < 2; ++b)
#pragma unroll
            for (int m = 0; m < 4; ++m)
#pragma unroll
                for (int n = 0; n < 2; ++n) acc[a][b][m][n] = (f32x4){0.f, 0.f, 0.f, 0.f};
    bf16x8 At[4][2], B0[2][2], B1[2][2];
    const char* cA = (const char*)g.A + (size_t)cur.pm * tstep; const char* cB = (const char*)g.Bt + (size_t)cur.pn * tstep;
    S.a_ready(cur);
    PG8_STAGE(PG8_SB(0, 0), cB, voffB); PG8_STAGE(PG8_SA(0, 0), cA, voffA); PG8_STAGE(PG8_SB(0, 1), cB + hstep, voffB); PG8_STAGE(PG8_SA(0, 1), cA + hstep, voffA);
    if (wr == 1) PG8_BAR;
    PG8_WAIT_V(4); PG8_BAR;
    PG8_STAGE(PG8_SB(1, 0), cB + kstep, voffB); PG8_STAGE(PG8_SA(1, 0), cA + kstep, voffA); PG8_STAGE(PG8_SB(1, 1), cB + hstep + kstep, voffB);
    PG8_WAIT_V(6); PG8_BAR;
    PG8_STAMP();
    for (;;) {
        const bool has_next = S.next(ui + 1, nxt);
        const char* nA = has_next ? (const char*)g.A + (size_t)nxt.pm * tstep : cA; const char* nB = has_next ? (const char*)g.Bt + (size_t)nxt.pn * tstep : cB;
        for (int t = 0; t < nt; t += 2) {
            const bool last = (t == nt - 2);
            const char* a1 = cA + (size_t)(t + 1) * kstep;
            const char* a2 = last ? nA : cA + (size_t)(t + 2) * kstep; const char* b2 = last ? nB : cB + (size_t)(t + 2) * kstep;
            const char* a3 = a2 + kstep; const char* b3 = b2 + kstep;
            if (last && has_next) S.a_ready(nxt);
            PG8_LDB(B0, 0, 0); PG8_SCHED; PG8_LDA(At, 0, 0); PG8_STAGE(PG8_SA(1, 1), a1 + hstep, voffA);
            PG8_WAIT_L(8); PG8_BAR; PG8_WAIT_L(0); PG8_MMA(0, 0, At, B0); PG8_BAR; PG8_SCHED;
            PG8_LDB(B1, 0, 1); PG8_STAGE(PG8_SB(0, 0), b2, voffB);
            PG8_BAR; PG8_WAIT_L(0); PG8_MMA(0, 1, At, B1); PG8_BAR;
            PG8_LDA(At, 0, 1); PG8_STAGE(PG8_SA(0, 0), a2, voffA);
            PG8_BAR; PG8_WAIT_L(0); PG8_MMA(1, 0, At, B0); PG8_BAR; PG8_SCHED;
            PG8_STAGE(PG8_SB(0, 1), b2 + hstep, voffB);
            PG8_WAIT_V(6); PG8_BAR; PG8_MMA(1, 1, At, B1); PG8_BAR;
            PG8_LDB(B0, 1, 0); PG8_SCHED; PG8_LDA(At, 1, 0); PG8_STAGE(PG8_SA(0, 1), a2 + hstep, voffA);
            PG8_WAIT_L(8); PG8_BAR; PG8_WAIT_L(0); PG8_MMA(0, 0, At, B0); PG8_BAR; PG8_SCHED;
            PG8_LDB(B1, 1, 1); PG8_STAGE(PG8_SB(1, 0), b3, voffB);
            PG8_BAR; PG8_WAIT_L(0); PG8_MMA(0, 1, At, B1); PG8_BAR;
            PG8_LDA(At, 1, 1); PG8_STAGE(PG8_SA(1, 0), a3, voffA);
            PG8_BAR; PG8_WAIT_L(0); PG8_MMA(1, 0, At, B0); PG8_BAR; PG8_SCHED;
            PG8_STAGE(PG8_SB(1, 1), b3 + hstep, voffB);
            PG8_WAIT_V(6); PG8_BAR; PG8_MMA(1, 1, At, B1); PG8_BAR;
        }
        PG8_STAMP();
        if constexpr (!Epi::AFTER_DRAIN) { E(acc, cur, wr, wc, fr, fq); S.done(cur); }
        PG8_STAMP();
        if (!has_next) break;
#pragma unroll
        for (int a = 0; a < 2; ++a)
#pragma unroll
            for (int b = 0; b < 2; ++b)
#pragma unroll
                for (int m = 0; m < 4; ++m)
#pragma unroll
                    for (int n = 0; n < 2; ++n) acc[a][b][m][n] = (f32x4){0.f, 0.f, 0.f, 0.f};
        cur = nxt; cA = nA; cB = nB; ++ui;
    }
    PG8_WAIT_V(0);
    if (wr == 0) PG8_BAR;
    PG8_BAR;
    if constexpr (Epi::AFTER_DRAIN) { E.fused(acc, cur, wr, wc, fr, fq, lds, wid, lane); S.done(cur); }
    PG8_STAMP();
    if (STAMP && wid == 0) { stamps[lane] = lane < nts ? (((unsigned long long)(unsigned)ts_hi << 32) | (unsigned)ts_lo) : 0ull;
        if (lane == 62) stamps[62] = rt_entry; if (lane == 63) stamps[63] = (unsigned long long)wall_clock64(); }
#undef PG8_STAMP
#undef PG8_SA
#undef PG8_SB
#undef PG8_STAGE
#undef PG8_LDA
#undef PG8_LDB
#undef PG8_MMA
#undef PG8_WAIT_V
#undef PG8_WAIT_L
#undef PG8_BAR
#undef PG8_SCHED
}

struct EpiStore {
    static constexpr bool PERM = true, AFTER_DRAIN = false;
    bf16_t* C; int ldc; int N;
    __device__ __forceinline__ void operator()(const f32x4 (&acc)[2][2][4][2], const Unit& u, int wr, int wc, int fr, int fq) const {
        const int row0 = u.pm * BM + wr * 64 + fr, col0 = u.pn * BM + wc * 32 + 8 * fq;
#pragma unroll
        for (int ai = 0; ai < 2; ++ai)
#pragma unroll
            for (int m = 0; m < 4; ++m) { bf16_t* rowp = C + (size_t)(row0 + ai * HALF + m * 16) * ldc + col0;
#pragma unroll
                for (int bj = 0; bj < 2; ++bj) if (col0 + bj * HALF < N) { const f32x4 v0 = acc[ai][bj][m][0], v1 = acc[ai][bj][m][1];
                    u32x4 w; w.x = cvt_pk_bf16(v0[0], v0[1]); w.y = cvt_pk_bf16(v0[2], v0[3]); w.z = cvt_pk_bf16(v1[0], v1[1]); w.w = cvt_pk_bf16(v1[2], v1[3]);
                    *(u32x4*)(rowp + bj * HALF) = w; } }
    }
};
struct EpiResidual {
    static constexpr bool PERM = false, AFTER_DRAIN = false;
    const float* xin; float* xout; const float* gate; float gmul;
    __device__ __forceinline__ void operator()(const f32x4 (&acc)[2][2][4][2], const Unit& u, int wr, int wc, int fr, int fq) const {
        const int row0 = u.pm * BM + wr * 64 + fr, col0 = u.pn * BM + wc * 32 + 4 * fq;
        const float* gp = gate + ((u.pm * BM) >> 13) * 6144 + col0;
        f32x4 gv[2][2];
#pragma unroll
        for (int bj = 0; bj < 2; ++bj)
#pragma unroll
            for (int n = 0; n < 2; ++n) gv[bj][n] = *(const f32x4*)(gp + bj * HALF + n * 16) * gmul;
#pragma unroll
        for (int ai = 0; ai < 2; ++ai)
#pragma unroll
            for (int m = 0; m < 4; ++m) { const size_t off = (size_t)(row0 + ai * HALF + m * 16) * 2048 + col0;
                f32x4 xv[2][2];
#pragma unroll
                for (int bj = 0; bj < 2; ++bj)
#pragma unroll
                    for (int n = 0; n < 2; ++n) xv[bj][n] = *(const f32x4*)(xin + off + bj * HALF + n * 16);
#pragma unroll
                for (int bj = 0; bj < 2; ++bj)
#pragma unroll
                    for (int n = 0; n < 2; ++n) *(f32x4*)(xout + off + bj * HALF + n * 16) = xv[bj][n] + gv[bj][n] * acc[ai][bj][m][n];
                asm volatile("" ::: "memory"); }
    }
};
struct EpiNsaIn {
    static constexpr bool PERM = false, AFTER_DRAIN = false;
    bf16_t* C; const f32x2* rope32;
    __device__ __forceinline__ void operator()(const f32x4 (&acc)[2][2][4][2], const Unit& u, int wr, int wc, int fr, int fq) const {
        const int row0 = u.pm * BM + wr * 64 + fr;
#pragma unroll
        for (int bj = 0; bj < 2; ++bj) {
            const int hb = u.pn * 2 + bj, cb = hb * 128 + wc * 32;
            const bool rope = (wc == 0) && (hb < 18 || hb == 20 || hb == 21 || hb == 24 || hb == 25);
            const bool gate = cb >= 3584;
#pragma unroll
            for (int ai = 0; ai < 2; ++ai)
#pragma unroll
                for (int m = 0; m < 4; ++m) { const int row = row0 + ai * HALF + m * 16;
                    f32x4 v0 = acc[ai][bj][m][0], v1 = acc[ai][bj][m][1];
                    if (rope) { const f32x4 c01 = *(const f32x4*)(rope32 + (size_t)row * 16 + 4 * fq), c23 = *(const f32x4*)(rope32 + (size_t)row * 16 + 4 * fq + 2);
                        const float cs[4] = {c01[0], c01[2], c23[0], c23[2]}, sn[4] = {c01[1], c01[3], c23[1], c23[3]};
#pragma unroll
                        for (int i = 0; i < 4; ++i) { const float x1 = v0[i], x2 = v1[i]; v0[i] = x1 * cs[i] - x2 * sn[i]; v1[i] = x2 * cs[i] + x1 * sn[i]; } }
                    if (gate) {
#pragma unroll
                        for (int i = 0; i < 4; ++i) { v0[i] = 1.f / (1.f + __expf(-v0[i])); v1[i] = 1.f / (1.f + __expf(-v1[i])); } }
                    bf16_t* rowp = C + (size_t)row * NSA_IN + cb + 4 * fq;
                    if (cb + 4 * fq < NSA_IN) { u32x2 w = {cvt_pk_bf16(v0[0], v0[1]), cvt_pk_bf16(v0[2], v0[3])}; *(u32x2*)rowp = w; }
                    if (cb + 16 + 4 * fq < NSA_IN) { u32x2 w = {cvt_pk_bf16(v1[0], v1[1]), cvt_pk_bf16(v1[2], v1[3])}; *(u32x2*)(rowp + 16) = w; } }
        }
    }
};
template <class Epi>
__device__ __forceinline__ void run(unsigned char* lds, const bf16_t* A, const bf16_t* Bt, int M, int N, int K, const Epi& E, int bid, int nb) {
    Gemm g{A, Bt, M, N, K}; StaticOrder S; S.init(M, N, nb, bid);
    gemm_phase<Epi, StaticOrder>((PG8_LAS unsigned char*)lds, g, S, E, nullptr);
}
}
constexpr int KSTR128 = 256, KSTR192 = 384, VSTR = 256;
template <int KSTR> __device__ __forceinline__ int kswz(int r, int c) { return KSTR == 256 ? (c ^ (r & 15)) : ((c & ~7) | ((c ^ (r >> 1)) & 7)); }
constexpr int ATT_K_BYTES = 64 * KSTR192;
constexpr int ATT_V_BYTES = 64 * VSTR;
constexpr int ATT_KOFF = 0, ATT_VOFF = 2 * ATT_K_BYTES, ATT_MISC = ATT_VOFF + 2 * ATT_V_BYTES;

__device__ __forceinline__ void dma16(const unsigned char* gsrc, unsigned char* ldst) {
    __builtin_amdgcn_global_load_lds((const unsigned*)gsrc, (unsigned*)ldst, 16, 0, 0);
}
#define DMA_WAIT() asm volatile("s_waitcnt vmcnt(0)" ::: "memory")
template <int NKS, int KSTR>
__device__ __forceinline__ void qk_tile(f32x16& p0, f32x16& p1, const unsigned char* kbuf, int l31, int hi, const bf16x8* qr) {
#pragma unroll
    for (int r = 0; r < 16; ++r) { p0[r] = 0.f; p1[r] = 0.f; }
    const unsigned char* krow = kbuf + l31 * KSTR;
#pragma unroll
    for (int ks = 0; ks < NKS; ++ks) {
        const int co = kswz<KSTR>(l31, ks * 2 + hi) << 4;
        const bf16x8 a0 = *(const bf16x8*)(krow + co);
        const bf16x8 a1 = *(const bf16x8*)(krow + 32 * KSTR + co);
        p0 = __builtin_amdgcn_mfma_f32_32x32x16_bf16(a0, qr[ks], p0, 0, 0, 0);
        p1 = __builtin_amdgcn_mfma_f32_32x32x16_bf16(a1, qr[ks], p1, 0, 0, 0);
        if ((ks & 3) == 3) __builtin_amdgcn_sched_barrier(0);
    }
}
__device__ __forceinline__ s16x4 tr_read(const unsigned char* p) {
    return __builtin_amdgcn_ds_read_tr16_b64_v4i16((LAS s16x4*)p);
}
__device__ __forceinline__ int vswz(int r) { return ((r & 3) << 2) | ((r >> 2) & 3); }
struct VLane { int b0, b1, q; };
__device__ __forceinline__ VLane vlane(int lane) {
    const int hi = lane >> 5, q = (lane >> 2) & 3, g1 = (lane >> 4) & 1, p = lane & 3;
    const int a0 = 256 * (4 * hi + q) + 8 * (p & 1), low2 = (2 * g1 + (p >> 1)) ^ hi;
    return VLane{a0 + (low2 << 4), a0 + ((low2 ^ 2) << 4) + 2048, q};
}
__device__ __forceinline__ void pv_tile(f32x16 (&o)[4], const unsigned char* vbuf, const VLane vl, const bf16x8 (&pb)[4]) {
    s16x4 lo[2][4], hh[2][4];
    auto rd = [&](int dt, int slot) {
        const int d64 = (dt ^ vl.q) << 6;
#pragma unroll
        for (int s = 0; s < 4; ++s) { lo[slot][s] = tr_read(vbuf + vl.b0 + d64 + 4096 * s); hh[slot][s] = tr_read(vbuf + vl.b1 + d64 + 4096 * s); }
    };
    rd(0, 0);
#pragma unroll
    for (int dt = 0; dt < 4; ++dt) {
        if (dt + 1 < 4) rd(dt + 1, (dt + 1) & 1);
#pragma unroll
        for (int s = 0; s < 4; ++s) {
            const s16x4 l_ = lo[dt & 1][s], h_ = hh[dt & 1][s];
            const bf16x8 a = {l_[0], l_[1], l_[2], l_[3], h_[0], h_[1], h_[2], h_[3]};
            o[dt] = __builtin_amdgcn_mfma_f32_32x32x16_bf16(a, pb[s], o[dt], 0, 0, 0);
        }
        __builtin_amdgcn_sched_barrier(0);
    }
}
__device__ __forceinline__ bf16x8 pack8f(const f32x16& p, int b) {
    u32x4 w = {cvtpk(p[b + 0], p[b + 1]), cvtpk(p[b + 2], p[b + 3]), cvtpk(p[b + 4], p[b + 5]), cvtpk(p[b + 6], p[b + 7])};
    return *reinterpret_cast<bf16x8*>(&w);
}
__device__ __forceinline__ void softmax_step(f32x16& p0, f32x16& p1, float& m, float& l, f32x16 (&o)[4], float c2, bf16x8 (&pb)[4], bool lane_on = true) {
    float mx = p0[0];
#pragma unroll
    for (int r = 1; r < 16; ++r) mx = fmaxf(mx, p0[r]);
#pragma unroll
    for (int r = 0; r < 16; ++r) mx = fmaxf(mx, p1[r]);
    mx = fmaxf(mx, __shfl_xor(mx, 32));
    mx = lane_on ? mx : -__builtin_inff();
    const bool keep = __all((mx - m) * c2 <= 8.f);
    const float mn = keep ? m : fmaxf(m, mx);
    const float alpha = keep ? 1.f : __builtin_amdgcn_exp2f((m - mn) * c2);
    const float mc = lane_on ? mn * c2 : __builtin_inff();
    float rs = 0.f;
#pragma unroll
    for (int r = 0; r < 16; ++r) { p0[r] = __builtin_amdgcn_exp2f(p0[r] * c2 - mc); rs += p0[r]; }
#pragma unroll
    for (int r = 0; r < 16; ++r) { p1[r] = __builtin_amdgcn_exp2f(p1[r] * c2 - mc); rs += p1[r]; }
    rs += __shfl_xor(rs, 32);
    l = l * alpha + rs;
    m = mn;
    if (!keep) {
#pragma unroll
        for (int dt = 0; dt < 4; ++dt)
#pragma unroll
            for (int r = 0; r < 16; ++r) o[dt][r] *= alpha;
    }
    pb[0] = pack8f(p0, 0); pb[1] = pack8f(p0, 8); pb[2] = pack8f(p1, 0); pb[3] = pack8f(p1, 8);
}
template <int NKS, int KSTR>
__device__ __forceinline__ void qk_slice(f32x16& n0, f32x16& n1, const unsigned char* krow, int l31, int hi, const bf16x8* qr, int ks) {
    const int co = kswz<KSTR>(l31, ks * 2 + hi) << 4;
    const bf16x8 a0 = *(const bf16x8*)(krow + co);
    const bf16x8 a1 = *(const bf16x8*)(krow + 32 * KSTR + co);
    n0 = __builtin_amdgcn_mfma_f32_32x32x16_bf16(a0, qr[ks], n0, 0, 0, 0);
    n1 = __builtin_amdgcn_mfma_f32_32x32x16_bf16(a1, qr[ks], n1, 0, 0, 0);
}
template <int NKS, int KSTR>
__device__ __forceinline__ void fused_qk_softmax(f32x16& n0, f32x16& n1, const unsigned char* knext, int l31, int hi, const bf16x8* qr,
                                                 f32x16& s0, f32x16& s1, float& m, float& l, f32x16 (&o)[4], float c2, bf16x8 (&pb)[4]) {
    const unsigned char* krow = knext + l31 * KSTR;
#pragma unroll
    for (int r = 0; r < 16; ++r) { n0[r] = 0.f; n1[r] = 0.f; }
    qk_slice<NKS, KSTR>(n0, n1, krow, l31, hi, qr, 0);
    qk_slice<NKS, KSTR>(n0, n1, krow, l31, hi, qr, 1);
    float mx = s0[0];
#pragma unroll
    for (int r = 1; r < 16; ++r) mx = fmaxf(mx, s0[r]);
#pragma unroll
    for (int r = 0; r < 16; ++r) mx = fmaxf(mx, s1[r]);
    mx = fmaxf(mx, __shfl_xor(mx, 32));
    const float mn = fmaxf(m, mx);
    const float alpha = __builtin_amdgcn_exp2f((m - mn) * c2);
    const float mc = mn * c2;
    __builtin_amdgcn_sched_barrier(0);
    float rs = 0.f;
    constexpr int NG = NKS - 2;
#pragma unroll
    for (int gi = 0; gi < NG; ++gi) {
        qk_slice<NKS, KSTR>(n0, n1, krow, l31, hi, qr, 2 + gi);
        const int e0 = (32 * gi) / NG, e1 = (32 * (gi + 1)) / NG;
#pragma unroll
        for (int e = e0; e < e1; ++e) {
            if (e < 16) { s0[e] = __builtin_amdgcn_exp2f(s0[e] * c2 - mc); rs += s0[e]; }
            else { s1[e - 16] = __builtin_amdgcn_exp2f(s1[e - 16] * c2 - mc); rs += s1[e - 16]; }
        }
        __builtin_amdgcn_sched_barrier(0);
    }
    rs += __shfl_xor(rs, 32);
    l = l * alpha + rs;
    m = mn;
    if (__any(alpha != 1.f)) {
#pragma unroll
        for (int dt = 0; dt < 4; ++dt)
#pragma unroll
            for (int r = 0; r < 16; ++r) o[dt][r] *= alpha;
    }
    pb[0] = pack8f(s0, 0); pb[1] = pack8f(s0, 8); pb[2] = pack8f(s1, 0); pb[3] = pack8f(s1, 8);
}
__device__ __forceinline__ void store_ot_bf16(const f32x16 (&o)[4], float sc, bf16_t* orow  , int hi) {
#pragma unroll
    for (int dt = 0; dt < 4; ++dt)
#pragma unroll
        for (int g = 0; g < 4; ++g) {
            u32x2 w = {cvtpk(o[dt][4 * g] * sc, o[dt][4 * g + 1] * sc), cvtpk(o[dt][4 * g + 2] * sc, o[dt][4 * g + 3] * sc)};
            *(u32x2*)(orow + dt * 32 + 8 * g + 4 * hi) = w;
        }
}

__device__ __forceinline__ void mla_item(const Args& A, unsigned char* lds, int b, int h, int qt) {
    const int tid = opaque_tid(), lane = tid & 63, wave = tid >> 6, l31 = lane & 31, hi = lane >> 5;
    const bf16_t* QM = (const bf16_t*)(WSP(A) + WS_QM); const bf16_t* KVM = (const bf16_t*)(WSP(A) + WS_KVM);
    bf16_t* O = (bf16_t*)(WSP(A) + WS_O);
    const int q0 = qt * 256, qw = q0 + wave * 32, t = qw + l31;
    const size_t tokb = (size_t)b * SEQ;
    bf16x8 qr[12];
    {
        const bf16_t* qp = QM + (tokb + t) * 1536 + h * 192 + hi * 8;
#pragma unroll
        for (int ks = 0; ks < 12; ++ks) qr[ks] = *(const bf16x8*)(qp + ks * 16);
        const f32x2* rp = (const f32x2*)(WSP(A) + WS_ROPE64) + (tokb + t) * 32 + hi * 8;
#pragma unroll
        for (int k2 = 0; k2 < 2; ++k2) {
#pragma unroll
            for (int e = 0; e < 8; ++e) {
                const f32x2 cs = rp[k2 * 16 + e];
                const float x1 = bf2f((unsigned short)qr[8 + k2][e]), x2 = bf2f((unsigned short)qr[10 + k2][e]);
                const unsigned w = cvtpk(x1 * cs[0] - x2 * cs[1], x2 * cs[0] + x1 * cs[1]);
                qr[8 + k2][e] = (short)(w & 0xFFFFu); qr[10 + k2][e] = (short)(w >> 16);
            }
        }
    }
    const int nkt = (q0 + 256) / 64;
    const int wv = __builtin_amdgcn_readfirstlane(wave);
    unsigned okb[3], ovb[2];
#pragma unroll
    for (int i = 0; i < 3; ++i) {
        const int B = (wv * 3 + i) * 1024 + lane * 16, row = B / KSTR192, pc = (B - row * KSTR192) >> 4;
        const int c = kswz<KSTR192>(row, pc);
        okb[i] = (unsigned)(row * KVM_LD + ((c < 16) ? h * 256 + c * 8 : 2048 + (c - 16) * 8)) * 2u;
    }
#pragma unroll
    for (int i = 0; i < 2; ++i) {
        const int row = (wv * 2 + i) * 4 + (lane >> 4), c = (lane & 15) ^ vswz(row);
        ovb[i] = (unsigned)(row * KVM_LD + h * 256 + 128 + c * 8) * 2u;
    }
    auto stage = [&](int kt, int buf) {
        const unsigned char* base = (const unsigned char*)(KVM + (tokb + (size_t)kt * 64) * KVM_LD);
        unsigned char* kb = lds + ATT_KOFF + buf * ATT_K_BYTES + wv * 3072; unsigned char* vb = lds + ATT_VOFF + buf * ATT_V_BYTES + wv * 2048;
#pragma unroll
        for (int i = 0; i < 3; ++i) dma16(base + okb[i], kb + i * 1024);
#pragma unroll
        for (int i = 0; i < 2; ++i) dma16(base + ovb[i], vb + i * 1024);
    };
    f32x16 o[4];
#pragma unroll
    for (int dt = 0; dt < 4; ++dt)
#pragma unroll
        for (int r = 0; r < 16; ++r) o[dt][r] = 0.f;
    float m = -1e30f, l = 0.f;
    const float c2 = 0.07216878364870322f * 1.4426950408889634f;
    const VLane vl = vlane(lane);
    stage(0, 0); DMA_WAIT(); __syncthreads();
    for (int kt = 0; kt < nkt; ++kt) {
        if (kt + 1 < nkt) stage(kt + 1, (kt + 1) & 1);
        if (kt * 64 <= qw + 31) {
            f32x16 p0, p1;
            qk_tile<12, KSTR192>(p0, p1, lds + ATT_KOFF + (kt & 1) * ATT_K_BYTES, l31, hi, qr);
            if (kt * 64 + 63 > qw) {
                const int dq = t - kt * 64 - 4 * hi;
#pragma unroll
                for (int r = 0; r < 16; ++r) {
                    const int cb = (r & 3) + 8 * (r >> 2);
                    if (cb > dq) p0[r] = -__builtin_inff();
                    if (cb + 32 > dq) p1[r] = -__builtin_inff();
                }
            }
            bf16x8 pb[4];
            softmax_step(p0, p1, m, l, o, c2, pb);
            pv_tile(o, lds + ATT_VOFF + (kt & 1) * ATT_V_BYTES, vl, pb);
        }
        DMA_WAIT();
        __syncthreads();
    }
    store_ot_bf16(o, ABL_MLA / l, O + (tokb + t) * 2048 + 1024 + h * 128, hi);
}

__device__ __forceinline__ void sb_item(const Args& A, unsigned char* lds, int b, int h, int qt) {
    const int tid = opaque_tid(), lane = tid & 63, wave = tid >> 6, l31 = lane & 31, hi = lane >> 5;
    const bf16_t* BIG = (const bf16_t*)(WSP(A) + WS_BIG);
    bf16_t* O = (bf16_t*)(WSP(A) + WS_O);
    volatile int* flags = (volatile int*)(lds + ATT_MISC);
    const int q0 = qt * 256, qw = q0 + wave * 32, t = qw + l31;
    const size_t tokb = (size_t)b * SEQ;
    bf16x8 qr[8];
    {
        const bf16_t* qp = BIG + (tokb + t) * SBMLA_IN + h * 128 + hi * 8;
#pragma unroll
        for (int ks = 0; ks < 8; ++ks) qr[ks] = *(const bf16x8*)(qp + ks * 16);
    }
    bf16x8 tri[2];
#pragma unroll
    for (int s2 = 0; s2 < 2; ++s2)
#pragma unroll
        for (int jj = 0; jj < 8; ++jj) tri[s2][jj] = (16 * s2 + 8 * (jj >> 2) + 4 * hi + (jj & 3) > l31) ? (short)0x3F80 : (short)0;
    const int wv = __builtin_amdgcn_readfirstlane(wave);
    unsigned okb[2], ovb[2];
#pragma unroll
    for (int i = 0; i < 2; ++i) {
        const int row = (wv * 2 + i) * 4 + (lane >> 4), pc = lane & 15;
        okb[i] = (unsigned)(row * SBMLA_IN + 1024 + (pc ^ (row & 15)) * 8) * 2u;
        ovb[i] = (unsigned)(row * SBMLA_IN + 2048 + (pc ^ vswz(row)) * 8) * 2u;
    }
    auto stage = [&](int kt, int buf) {
        const unsigned char* base = (const unsigned char*)(BIG + (tokb + (size_t)kt * 64) * SBMLA_IN + h * 128);
        unsigned char* kb = lds + ATT_KOFF + buf * ATT_K_BYTES + wv * 2048; unsigned char* vb = lds + ATT_VOFF + buf * ATT_V_BYTES + wv * 2048;
#pragma unroll
        for (int i = 0; i < 2; ++i) { dma16(base + okb[i], kb + i * 1024); dma16(base + ovb[i], vb + i * 1024); }
    };
    f32x16 o[4];
#pragma unroll
    for (int dt = 0; dt < 4; ++dt)
#pragma unroll
        for (int r = 0; r < 16; ++r) o[dt][r] = 0.f;
    float R = 0.f;
    bool done = false;
    const float scale = 0.08838834764831845f;
    const int kt_hi = (q0 + 254) / 64, ktw = (qw + 30) / 64;
    const VLane vl = vlane(lane);
    stage(kt_hi, 0); DMA_WAIT(); __syncthreads();
    int it = 0;
    for (int kt = kt_hi; kt >= 0; --kt, ++it) {
        if (kt > 0) stage(kt - 1, (it + 1) & 1);
        if (kt <= ktw && !done) {
            f32x16 p0, p1;
            qk_tile<8, KSTR128>(p0, p1, lds + ATT_KOFF + (it & 1) * ATT_K_BYTES, l31, hi, qr);
            const int dq = t - kt * 64 - 4 * hi;
            float tot0 = 0.f, tot1 = 0.f;
            u32x4 w0, w1, w2, w3;
            auto sbf = [&](float pz, bool v, float& tot, float& lbo) -> float {
                const float z = pz * scale;
                const float lp = __logf(1.f + __expf(-fabsf(z)));
                const float lb = fminf(z, 0.f) - lp;
                const float l1 = v ? lb - z : 0.f;
                tot += l1; lbo = v ? lb : -__builtin_inff();
                return l1;
            };
#pragma unroll
            for (int r = 0; r < 16; r += 2) {
                const int cb0 = (r & 3) + 8 * (r >> 2), cb1 = ((r + 1) & 3) + 8 * ((r + 1) >> 2);
                float t0_, t1_, t2_, t3_;
                const float a0 = sbf(p0[r], cb0 < dq, tot0, t0_), a1 = sbf(p0[r + 1], cb1 < dq, tot0, t1_);
                const float b0 = sbf(p1[r], cb0 + 32 < dq, tot1, t2_), b1 = sbf(p1[r + 1], cb1 + 32 < dq, tot1, t3_);
                p0[r] = t0_; p0[r + 1] = t1_; p1[r] = t2_; p1[r + 1] = t3_;
                const unsigned pa = cvtpk(a0, a1), pbb = cvtpk(b0, b1);
                if (r < 8) { w0[r >> 1] = pa; w2[r >> 1] = pbb; } else { w1[(r - 8) >> 1] = pa; w3[(r - 8) >> 1] = pbb; }
            }
            tot0 += __shfl_xor(tot0, 32); tot1 += __shfl_xor(tot1, 32);
            bf16x8 lf[4];
            lf[0] = *reinterpret_cast<bf16x8*>(&w0); lf[1] = *reinterpret_cast<bf16x8*>(&w1); lf[2] = *reinterpret_cast<bf16x8*>(&w2); lf[3] = *reinterpret_cast<bf16x8*>(&w3);
            f32x16 c0, c1;
            const float r1 = R + tot1;
#pragma unroll
            for (int r = 0; r < 16; ++r) { c1[r] = R; c0[r] = r1; }
            c1 = __builtin_amdgcn_mfma_f32_32x32x16_bf16(tri[0], lf[2], c1, 0, 0, 0);
            c1 = __builtin_amdgcn_mfma_f32_32x32x16_bf16(tri[1], lf[3], c1, 0, 0, 0);
            c0 = __builtin_amdgcn_mfma_f32_32x32x16_bf16(tri[0], lf[0], c0, 0, 0, 0);
            c0 = __builtin_amdgcn_mfma_f32_32x32x16_bf16(tri[1], lf[1], c0, 0, 0, 0);
#pragma unroll
            for (int r = 0; r < 16; ++r) { p0[r] = __expf(p0[r] + c0[r]); p1[r] = __expf(p1[r] + c1[r]); }
            R = r1 + tot0;
            bf16x8 pb[4] = {pack8f(p0, 0), pack8f(p0, 8), pack8f(p1, 0), pack8f(p1, 8)};
            pv_tile(o, lds + ATT_VOFF + (it & 1) * ATT_V_BYTES, vl, pb);
            done = __all(R < -104.f);
        }
        if (lane == 0) flags[(it & 1) * 8 + wave] = done ? 1 : 0;
        DMA_WAIT();
        __syncthreads();
        int nd = 0;
#pragma unroll
        for (int w = 0; w < 8; ++w) nd += flags[(it & 1) * 8 + w];
        if (nd == 8) break;
    }
    store_ot_bf16(o, ABL_SB, O + (tokb + t) * 2048 + h * 128, hi);
    __syncthreads();
}

__device__ __forceinline__ void phase_attn0(const Args& A, unsigned char* lds, int bid, int nb) {
    auto convert_share = [&]() {
        for (int v = bid; v < U0_PEER; v += nb) p0_peer_unit(A, v);
        for (int v = bid; v < U0_MOD_LATE; v += nb) p0_mod_unit(A, lds, U0_MOD + v);
    };
    const int slot = bid & 3;
    if (slot == 0) convert_share();
    for (int u = bid; u < 256; u += nb) {
        const int bh = u >> 4, p = u & 15;
        mla_item(A, lds, bh >> 3, bh & 7, 31 - p);
        if (slot == 1 && u == bid) convert_share();
        mla_item(A, lds, bh >> 3, bh & 7, p);
    }
    if (slot == 2 || (slot == 1 && bid >= 256)) convert_share();
    for (int v = bid; v < 512; v += nb) {
        const int bh = v >> 5, qt = v & 31;
        sb_item(A, lds, bh >> 3, bh & 7, qt);
    }
    if (slot == 3) convert_share();
}
__device__ __forceinline__ unsigned f2sort(float f) { const unsigned u = __float_as_uint(f); return u ^ ((u & 0x80000000u) ? 0xFFFFFFFFu : 0x80000000u); }
__device__ __forceinline__ float sort2f(unsigned s) { const unsigned u = (s & 0x80000000u) ? (s ^ 0x80000000u) : ~s; return __uint_as_float(u); }
__device__ __forceinline__ unsigned umax3(unsigned a, unsigned b, unsigned c) { return max(max(a, b), c); }

template <int N> __device__ __forceinline__ void bitonic_merge_desc(unsigned (&a)[N]) {
#pragma unroll
    for (int j = N >> 1; j > 0; j >>= 1)
#pragma unroll
        for (int i = 0; i < N; ++i) { const int l = i ^ j; if (l > i) { const unsigned hi_ = max(a[i], a[l]), lo_ = min(a[i], a[l]); a[i] = hi_; a[l] = lo_; } }
}
__device__ __forceinline__ void bitonic_sort16_desc(unsigned (&a)[16]) {
#pragma unroll
    for (int k = 2; k <= 16; k <<= 1)
#pragma unroll
        for (int j = k >> 1; j > 0; j >>= 1)
#pragma unroll
            for (int i = 0; i < 16; ++i) { const int l = i ^ j; if (l > i) { const bool desc = ((i & k) == 0);
                const unsigned hi_ = max(a[i], a[l]), lo_ = min(a[i], a[l]); a[i] = desc ? hi_ : lo_; a[l] = desc ? lo_ : hi_; } }
}
__device__ __forceinline__ void top16_merge(unsigned (&a)[16], const unsigned (&b)[16]) {
#pragma unroll
    for (int i = 0; i < 16; ++i) a[i] = max(a[i], b[15 - i]);
    bitonic_merge_desc<16>(a);
}
__device__ __forceinline__ void top16_of_64(const unsigned (&k)[64], unsigned (&r)[16]) {
    unsigned g1[16], g2[16], g3[16];
#pragma unroll
    for (int i = 0; i < 16; ++i) { r[i] = k[i]; g1[i] = k[16 + i]; g2[i] = k[32 + i]; g3[i] = k[48 + i]; }
    bitonic_sort16_desc(r); bitonic_sort16_desc(g1); bitonic_sort16_desc(g2); bitonic_sort16_desc(g3);
    top16_merge(r, g1); top16_merge(g2, g3); top16_merge(r, g2);
}
constexpr int PKSTR = 272;
constexpr int TOPK_STAGE = 2 * 128 * PKSTR;
constexpr int TOPK_LDS = TOPK_STAGE + 8 * 8192;
__device__ __forceinline__ void phase_topk(const Args& A, unsigned char* lds, int layer, int bid, int nb) {
    const int tid = opaque_tid(), lane = tid & 63, wave = tid >> 6, l31 = lane & 31, hi = lane >> 5;
    const bf16_t* PQ = (const bf16_t*)(WSP(A) + WS_PQ);
    const bf16_t* K12 = (const bf16_t*)(WSP(A) + WS_K12) + (size_t)layer * 2 * 16384;
    int* EXI = (int*)(WSP(A) + WS_EXI); float* EXG = (float*)(WSP(A) + WS_EXG);
    for (int q = tid; q < 2 * 128 * 16; q += NTHREADS) { const int row = q >> 4, c = q & 15; *(u32x4*)(lds + row * PKSTR + c * 16) = *(const u32x4*)(K12 + row * 128 + c * 8); }
    __syncthreads();
    for (int u = bid; u < T / 32; u += nb) {
        const int t = u * 32 + l31, h = wave;
        unsigned* wl = (unsigned*)(lds + TOPK_STAGE) + wave * 2048;
        unsigned lst[2][16];
#pragma unroll
        for (int side = 0; side < 2; ++side) {
            bf16x8 qr[8];
            const bf16_t* qp = PQ + (size_t)t * 2048 + h * 256 + side * 128 + hi * 8;
#pragma unroll
            for (int ks = 0; ks < 8; ++ks) qr[ks] = *(const bf16x8*)(qp + ks * 16);
            const unsigned char* kp = lds + side * 128 * PKSTR + l31 * PKSTR + hi * 16;
            unsigned keys[64];
#pragma unroll
            for (int mt = 0; mt < 4; ++mt) {
                f32x16 p;
#pragma unroll
                for (int r = 0; r < 16; ++r) p[r] = 0.f;
#pragma unroll
                for (int ks = 0; ks < 8; ++ks) {
                    const bf16x8 a = *(const bf16x8*)(kp + mt * 32 * PKSTR + ks * 32);
                    p = __builtin_amdgcn_mfma_f32_32x32x16_bf16(a, qr[ks], p, 0, 0, 0);
                }
#pragma unroll
                for (int r = 0; r < 16; ++r) {
                    const int key = mt * 32 + (r & 3) + 8 * (r >> 2) + 4 * hi;
                    keys[mt * 16 + r] = (f2sort(p[r]) & ~127u) | (unsigned)(127 - key);
                }
                __builtin_amdgcn_sched_barrier(0);
            }
            unsigned mine[16], oth[16];
            top16_of_64(keys, mine);
#pragma unroll
            for (int i = 0; i < 16; ++i) oth[i] = (unsigned)__shfl_xor((int)mine[i], 32);
            top16_merge(mine, oth);
#pragma unroll
            for (int i = 0; i < 16; ++i) { lst[side][i] = mine[i]; wl[side * 1024 + i * 64 + lane] = mine[i]; }
        }
        float v1[16], v2[16];
#pragma unroll
        for (int i = 0; i < 16; ++i) { v1[i] = sort2f(lst[0][i] & ~127u); v2[i] = sort2f(lst[1][i] & ~127u); }
        unsigned cand[64];
        {
            int c = 0;
#pragma unroll
            for (int i = 0; i < 16; ++i)
#pragma unroll
                for (int j = 0; j < 16; ++j)
                    if ((i + 1) * (j + 1) <= 16) { cand[c] = (f2sort(v1[i] + v2[j]) & ~255u) | (unsigned)(255 - (16 * i + j)); ++c; }
#pragma unroll
            for (int q = 50; q < 64; ++q) cand[q] = 0u;
        }
        unsigned best[16];
        top16_of_64(cand, best);
        float topv[16]; int tope[16];
#pragma unroll
        for (int it = 0; it < 16; ++it) {
            const unsigned flat = 255u - (best[it] & 255u);
            const unsigned l0 = wl[(flat >> 4) * 64 + lane], l1 = wl[1024 + (flat & 15u) * 64 + lane];
            tope[it] = (int)((127u - (l0 & 127u)) * 128u + (127u - (l1 & 127u)));
            topv[it] = sort2f(best[it] & ~255u);
        }
        const float mx0 = topv[0];
        float sum = 0.f;
#pragma unroll
        for (int it = 0; it < 16; ++it) { topv[it] = __expf(topv[it] - mx0); sum += topv[it]; }
        if (hi == 0) {
            const float inv = 1.f / sum;
            int* ei = EXI + (size_t)t * 128 + h * 16; float* eg = EXG + (size_t)t * 128 + h * 16;
#pragma unroll
            for (int q = 0; q < 4; ++q) {
                *(int4*)(ei + 4 * q) = make_int4(tope[4 * q], tope[4 * q + 1], tope[4 * q + 2], tope[4 * q + 3]);
                *(f32x4*)(eg + 4 * q) = f32x4{topv[4 * q] * inv, topv[4 * q + 1] * inv, topv[4 * q + 2] * inv, topv[4 * q + 3] * inv};
            }
        }
    }
    __syncthreads();
}
#define DPP_PERM(V, CTRL) __int_as_float(__builtin_amdgcn_update_dpp(0, __float_as_int(V), CTRL, 0xF, 0xF, false))
#define DPP_SEL(OLD, SRC, BANKS) __int_as_float(__builtin_amdgcn_update_dpp(__float_as_int(OLD), __float_as_int(SRC), 0xE4, 0xF, BANKS, false))
struct URow { u32x4 a; };
typedef _Float16 h16x2 __attribute__((ext_vector_type(2)));

__device__ __forceinline__ void phase_peer_dots(const Args& A, unsigned char* lds, int layer, int bid, int nb) {
    const int tid = opaque_tid(), lane = tid & 63, wave = __builtin_amdgcn_readfirstlane(tid >> 6);
    const int nb8 = nb & ~7;
    if (bid >= nb8) return;
    const int x = bid & 7, c = bid >> 3, nc = nb8 >> 3;
    const int g = lane >> 3, j = lane & 7;
    const bf16_t* H = (const bf16_t*)(WSP(A) + WS_H);
    const unsigned char* U16 = WSP(A) + WS_PU + (size_t)layer * PEER_U_LAYER + (size_t)x * PEER_U16_SLICE;
    const unsigned char* U8 = WSP(A) + WS_PU + (size_t)layer * PEER_U_LAYER + PEER_U8_OFF + (size_t)x * PEER_U8_SLICE;
    const int* EXI = (const int*)(WSP(A) + WS_EXI);
    float* DP = (float*)(WSP(A) + WS_DP) + (size_t)x * T * 128;
    LAS unsigned* wbuf = (LAS unsigned*)lds + wave * 2048;
    const bool lb0 = lane & 1, lb1 = lane & 2;
    const int own = ((lane >> 2) & 1) + 2 * (lane & 1) + 4 * ((lane >> 1) & 1);
    const int q0 = c * NWAVES + wave, qs = nc * NWAVES;
    if (q0 >= T / 8) return;
    const unsigned* EXU = (const unsigned*)EXI;
#pragma unroll
    for (int i = 0; i < 4; ++i) *(LAS u32x4*)(wbuf + (i * 64 + lane) * 4) = *(const u32x4*)(EXU + (size_t)q0 * 1024 + (i * 64 + lane) * 4);
    u32x4 hn[4];
#pragma unroll
    for (int qq = 0; qq < 4; ++qq) hn[qq] = *(const u32x4*)(H + (size_t)(q0 * 8 + g) * 2048 + x * 256 + j * 32 + qq * 8);
    URow r0, r1, r2, r3, r4, r5, r6, r7, r8, r9, r10, r11, r12, r13, r14, r15;
    auto issue = [&](unsigned e, URow& r) {
        r.a = *(const u32x4*)(U16 + (e * 128u + j * 16));
    };
    {
        const LAS unsigned* ig = wbuf + g * 128;
        const u32x4 ia = *(const LAS u32x4*)(ig), ib = *(const LAS u32x4*)(ig + 4), ic = *(const LAS u32x4*)(ig + 8), id = *(const LAS u32x4*)(ig + 12);
        issue(ia[0], r0); issue(ia[1], r1); issue(ia[2], r2); issue(ia[3], r3); issue(ib[0], r4); issue(ib[1], r5); issue(ib[2], r6); issue(ib[3], r7);
        issue(ic[0], r8); issue(ic[1], r9); issue(ic[2], r10); issue(ic[3], r11); issue(id[0], r12); issue(id[1], r13); issue(id[2], r14); issue(id[3], r15);
    }
    int par = 0;
    for (int q = q0; q < T / 8; q += qs, par ^= 1) {
        const int t0 = q * 8;
        const int qn = q + qs < T / 8 ? q + qs : q;
        LAS unsigned* cur = wbuf + par * 1024;
        LAS unsigned* alt = wbuf + (par ^ 1) * 1024;
        int hq0[4], hq1[4], hq2[4];
#pragma unroll
        for (int qq = 0; qq < 4; ++qq) {
            unsigned p0 = 0, p1 = 0, p2 = 0;
#pragma unroll
            for (int i = 0; i < 8; ++i) {
                const unsigned w_ = hn[qq][i >> 1];
                const float f = (i & 1) ? bfhi(w_) : bflo(w_);
                const int hi_ = (int)__builtin_rintf(fminf(fmaxf(f * PEER_HQ, -1900.f), 1900.f));
                const int d0 = ((hi_ + 8) & 15) - 8, r1 = (hi_ - d0) >> 4;
                const int d1 = ((r1 + 8) & 15) - 8, d2 = (r1 - d1) >> 4;
                p0 |= ((unsigned)d0 & 15u) << (4 * i); p1 |= ((unsigned)d1 & 15u) << (4 * i); p2 |= ((unsigned)d2 & 15u) << (4 * i);
            }
            hq0[qq] = (int)p0; hq1[qq] = (int)p1; hq2[qq] = (int)p2;
        }
        __builtin_amdgcn_sched_barrier(0);
#pragma unroll
        for (int qq = 0; qq < 4; ++qq) hn[qq] = *(const u32x4*)(H + (size_t)(qn * 8 + g) * 2048 + x * 256 + j * 32 + qq * 8);
        auto dot = [&](const URow& r) -> float {
            int a0 = 0, a1 = 0, a2 = 0;
#pragma unroll
            for (int qq = 0; qq < 4; ++qq) {
                a0 = __builtin_amdgcn_sdot8((int)r.a[qq], hq0[qq], a0, false);
                a1 = __builtin_amdgcn_sdot8((int)r.a[qq], hq1[qq], a1, false);
                a2 = __builtin_amdgcn_sdot8((int)r.a[qq], hq2[qq], a2, false);
            }
            return (float)(a0 + 16 * a1 + 256 * a2) * (PEER_USCALE / (PEER_UQ * PEER_HQ));
        };
        auto reduce8 = [&](float p0, float p1, float p2, float p3, float p4, float p5, float p6, float p7) -> float {
            const float s0 = p0 + DPP_PERM(p0, 0x141), s1 = p1 + DPP_PERM(p1, 0x141), s2 = p2 + DPP_PERM(p2, 0x141), s3 = p3 + DPP_PERM(p3, 0x141);
            const float s4 = p4 + DPP_PERM(p4, 0x141), s5 = p5 + DPP_PERM(p5, 0x141), s6 = p6 + DPP_PERM(p6, 0x141), s7 = p7 + DPP_PERM(p7, 0x141);
            const float a0 = DPP_SEL(s0, s1, 0xA), a1 = DPP_SEL(s2, s3, 0xA), a2 = DPP_SEL(s4, s5, 0xA), a3 = DPP_SEL(s6, s7, 0xA);
            const float t0_ = a0 + DPP_PERM(a0, 0xB1), t1_ = a1 + DPP_PERM(a1, 0xB1), t2_ = a2 + DPP_PERM(a2, 0xB1), t3_ = a3 + DPP_PERM(a3, 0xB1);
            const float b0_ = lb0 ? t1_ : t0_, b1_ = lb0 ? t3_ : t2_;
            const float u0_ = b0_ + DPP_PERM(b0_, 0x4E), u1_ = b1_ + DPP_PERM(b1_, 0x4E);
            return lb1 ? u1_ : u0_;
        };
        const LAS unsigned* ig = cur + g * 128;
        float* dpo = DP + (size_t)(t0 + g) * 128 + own;
#define U_STEP(P, E, R) do { P = dot(R); issue(E, R); __builtin_amdgcn_sched_barrier(0); } while (0)
        auto round = [&](const int k) {
            const int pc = k < 64 ? k >> 4 : 3;
            const u32x4 pre = *(const u32x4*)(EXU + (size_t)qn * 1024 + (pc * 64 + lane) * 4);
            const LAS unsigned* in_ = k < 112 ? ig + k + 16 : alt + g * 128;
            const u32x4 ia = *(const LAS u32x4*)(in_), ib = *(const LAS u32x4*)(in_ + 4), ic = *(const LAS u32x4*)(in_ + 8), id = *(const LAS u32x4*)(in_ + 12);
            float p0, p1, p2, p3, p4, p5, p6, p7;
            U_STEP(p0, ia[0], r0); U_STEP(p1, ia[1], r1); U_STEP(p2, ia[2], r2); U_STEP(p3, ia[3], r3);
            U_STEP(p4, ib[0], r4); U_STEP(p5, ib[1], r5); U_STEP(p6, ib[2], r6); U_STEP(p7, ib[3], r7);
            dpo[k] = reduce8(p0, p1, p2, p3, p4, p5, p6, p7);
            __builtin_amdgcn_sched_barrier(0);
            U_STEP(p0, ic[0], r8); U_STEP(p1, ic[1], r9); U_STEP(p2, ic[2], r10); U_STEP(p3, ic[3], r11);
            U_STEP(p4, id[0], r12); U_STEP(p5, id[1], r13); U_STEP(p6, id[2], r14); U_STEP(p7, id[3], r15);
            dpo[k + 8] = reduce8(p0, p1, p2, p3, p4, p5, p6, p7);
            *(LAS u32x4*)(alt + (pc * 64 + lane) * 4) = pre;
            __builtin_amdgcn_sched_barrier(0);
        };
        round(0);
#pragma unroll 1
        for (int k = 16; k < 128; k += 16) round(k);
#undef U_STEP
    }
}

constexpr float PEER_WF16 = 256.f;
__device__ __forceinline__ void phase_peer_weights(const Args& A, float gmul, int bid, int nb) {
    const int tid = opaque_tid();
    const f32x4* DP = (const f32x4*)(WSP(A) + WS_DP);
    const f32x4* EXG = (const f32x4*)(WSP(A) + WS_EXG);
    u32x4* PW = (u32x4*)(WSP(A) + WS_PW);
    for (int i = bid * NTHREADS + tid; i < T * 128 / 4; i += nb * NTHREADS) {
        f32x4 d = DP[i];
#pragma unroll
        for (int s = 1; s < 8; ++s) d += DP[(size_t)s * (T * 128 / 4) + i];
        const f32x4 gt = EXG[i];
        u32x4 w;
#pragma unroll
        for (int c = 0; c < 4; ++c) {
            const _Float16 hw = (_Float16)(gt[c] * gelu_tanh(d[c] * (1.f / PEER_USCALE)) * (gmul / PEER_VSCALE * PEER_WF16));
            w[c] = __builtin_bit_cast(unsigned, h16x2{hw, hw});
        }
        PW[i] = w;
    }
}

__device__ __forceinline__ void phase_peer_out(const Args& A, unsigned char* lds, int layer, const float* xin, float* xout, int gate_set, int bid, int nb) {
    const int tid = opaque_tid(), lane = tid & 63, wave = __builtin_amdgcn_readfirstlane(tid >> 6);
    const int nb8 = nb & ~7;
    if (bid >= nb8) return;
    const int x = bid & 7, c = bid >> 3, nc = nb8 >> 3;
    const int g = lane >> 3, j = lane & 7;
    const unsigned char* PV = WSP(A) + WS_PV + (size_t)layer * PEER_V_LAYER + (size_t)x * PEER_V_SLICE;
    const unsigned* EXI = (const unsigned*)(WSP(A) + WS_EXI);
    const unsigned* PW = (const unsigned*)(WSP(A) + WS_PW);
    const float* mod = (const float*)(WSP(A) + WS_MOD);
    LAS unsigned* wbuf = (LAS unsigned*)lds + wave * 4096;
    const int q0 = c * NWAVES + wave, qs = nc * NWAVES;
    if (q0 >= T / 8) return;
#pragma unroll
    for (int i = 0; i < 4; ++i) {
        *(LAS u32x4*)(wbuf + (i * 64 + lane) * 4) = *(const u32x4*)(EXI + (size_t)q0 * 1024 + (i * 64 + lane) * 4);
        *(LAS u32x4*)(wbuf + 1024 + (i * 64 + lane) * 4) = *(const u32x4*)(PW + (size_t)q0 * 1024 + (i * 64 + lane) * 4);
    }
    u32x4 v0, v1, v2, v3, v4, v5, v6, v7, v8, v9, v10, v11, v12, v13, v14, v15;
    auto issue = [&](unsigned e, u32x4& v) { v = *(const u32x4*)(PV + (e * 128u + j * 16)); };
    {
        const LAS unsigned* ig = wbuf + g * 128;
        const u32x4 ia = *(const LAS u32x4*)(ig), ib = *(const LAS u32x4*)(ig + 4), ic = *(const LAS u32x4*)(ig + 8), id = *(const LAS u32x4*)(ig + 12);
        issue(ia[0], v0); issue(ia[1], v1); issue(ia[2], v2); issue(ia[3], v3); issue(ib[0], v4); issue(ib[1], v5); issue(ib[2], v6); issue(ib[3], v7);
        issue(ic[0], v8); issue(ic[1], v9); issue(ic[2], v10); issue(ic[3], v11); issue(id[0], v12); issue(id[1], v13); issue(id[2], v14); issue(id[3], v15);
    }
    int par = 0;
    for (int q = q0; q < T / 8; q += qs, par ^= 1) {
        const int t0 = q * 8;
        const int qn = q + qs < T / 8 ? q + qs : q;
        LAS unsigned* cur = wbuf + par * 2048;
        LAS unsigned* alt = wbuf + (par ^ 1) * 2048;
        f32x4 xv4[8];
#pragma unroll
        for (int gg = 0; gg < 8; ++gg) xv4[gg] = *(const f32x4*)(xin + (size_t)(t0 + gg) * 2048 + x * 256 + lane * 4);
        const f32x4 gv = *(const f32x4*)(mod + (size_t)(gate_set * 2 + (t0 >> 13)) * 6144 + 4096 + x * 256 + lane * 4);
        f32x2 o2[16];
#pragma unroll
        for (int jj = 0; jj < 16; ++jj) o2[jj] = f32x2{0.f, 0.f};
        h16x2 a16[16];
#pragma unroll
        for (int jj = 0; jj < 16; ++jj) a16[jj] = h16x2{(_Float16)0, (_Float16)0};
        auto consume = [&](unsigned wb, const u32x4& v) {
            const h16x2 w2 = __builtin_bit_cast(h16x2, wb);
#define PEER_V2(J, S) a16[4 * J + S] = __builtin_elementwise_fma(w2, __builtin_bit_cast(h16x2, __builtin_amdgcn_cvt_scalef32_pk_f16_fp4(v[J], 1.0f, S)), a16[4 * J + S])
#define PEER_V8(J) do { PEER_V2(J, 0); PEER_V2(J, 1); PEER_V2(J, 2); PEER_V2(J, 3); } while (0)
            PEER_V8(0); PEER_V8(1); PEER_V8(2); PEER_V8(3);
#undef PEER_V8
#undef PEER_V2
        };
        auto flush = [&]() {
#pragma unroll
            for (int jj = 0; jj < 16; ++jj) {
                o2[jj][0] = __builtin_fmaf((float)a16[jj][0], 1.f / PEER_WF16, o2[jj][0]);
                o2[jj][1] = __builtin_fmaf((float)a16[jj][1], 1.f / PEER_WF16, o2[jj][1]);
                a16[jj] = h16x2{(_Float16)0, (_Float16)0};
            }
            __builtin_amdgcn_sched_barrier(0);
        };
        const LAS unsigned* ig = cur + g * 128;
        const LAS unsigned* wg = cur + 1024 + g * 128;
        auto stage_src = [&](int pc) { return (pc < 4 ? EXI : PW) + (size_t)qn * 1024 + ((pc & 3) * 64 + lane) * 4; };
#define V_STEP(W, E, R) do { consume(W, R); issue(E, R); __builtin_amdgcn_sched_barrier(0); } while (0)
        auto round = [&](const int k) {
            const int pc = k >> 4;
            const u32x4 pre = *(const u32x4*)stage_src(pc);
            const LAS unsigned* in_ = k < 112 ? ig + k + 16 : alt + g * 128;
            const u32x4 ia = *(const LAS u32x4*)(in_), ib = *(const LAS u32x4*)(in_ + 4), ic = *(const LAS u32x4*)(in_ + 8), id = *(const LAS u32x4*)(in_ + 12);
            const u32x4 wa = *(const LAS u32x4*)(wg + k), wb = *(const LAS u32x4*)(wg + k + 4), wc = *(const LAS u32x4*)(wg + k + 8), wd = *(const LAS u32x4*)(wg + k + 12);
            V_STEP(wa[0], ia[0], v0); V_STEP(wa[1], ia[1], v1); V_STEP(wa[2], ia[2], v2); V_STEP(wa[3], ia[3], v3);
            V_STEP(wb[0], ib[0], v4); V_STEP(wb[1], ib[1], v5); V_STEP(wb[2], ib[2], v6); V_STEP(wb[3], ib[3], v7);
            flush();
            V_STEP(wc[0], ic[0], v8); V_STEP(wc[1], ic[1], v9); V_STEP(wc[2], ic[2], v10); V_STEP(wc[3], ic[3], v11);
            V_STEP(wd[0], id[0], v12); V_STEP(wd[1], id[1], v13); V_STEP(wd[2], id[2], v14); V_STEP(wd[3], id[3], v15);
            flush();
            *(LAS u32x4*)(alt + (pc >> 2) * 1024 + ((pc & 3) * 64 + lane) * 4) = pre;
            __builtin_amdgcn_sched_barrier(0);
                };
        round(0);
#pragma unroll 1
        for (int k = 16; k < 128; k += 16) round(k);
#undef V_STEP
        LAS float* ot = (LAS float*)cur;
#pragma unroll
        for (int qq = 0; qq < 8; ++qq) {
            const f32x4 y = {o2[qq * 2][0], o2[qq * 2][1], o2[qq * 2 + 1][0], o2[qq * 2 + 1][1]};
            *(LAS f32x4*)(ot + g * 256 + j * 32 + ((qq ^ j ^ g) & 7) * 4) = y;
        }
#pragma unroll
        for (int gg = 0; gg < 8; ++gg) {
            const f32x4 o = *(const LAS f32x4*)(ot + gg * 256 + (lane >> 3) * 32 + (((lane & 7) ^ (lane >> 3) ^ gg) & 7) * 4);
            f32x4 y;
#pragma unroll
            for (int jj = 0; jj < 4; ++jj) y[jj] = xv4[gg][jj] + gv[jj] * o[jj];
            *(f32x4*)(xout + (size_t)(t0 + gg) * 2048 + x * 256 + lane * 4) = y;
        }
    }
}

__device__ __forceinline__ void phase_finalnorm(const Args& A, float* xio, const float* gain, int bid, int nb) {
    const int tid = opaque_tid(), lane = tid & 63, wave = tid >> 6;
    for (int u = bid; u < T / NWAVES; u += nb) {
        float* xr = xio + (size_t)(u * NWAVES + wave) * 2048;
        f32x4 v[8];
        float ss = 0.f;
#pragma unroll
        for (int i = 0; i < 8; ++i) { v[i] = *(const f32x4*)(xr + i * 256 + lane * 4); ss += v[i][0] * v[i][0] + v[i][1] * v[i][1] + v[i][2] * v[i][2] + v[i][3] * v[i][3]; }
        ss = wave_sum_dpp(ss);
        const float rinv = rsqrtf(ss * (1.0f / 2048.0f) + EPS);
#pragma unroll
        for (int i = 0; i < 8; ++i) {
            const f32x4 gn = *(const f32x4*)(gain + i * 256 + lane * 4);
            f32x4 y;
#pragma unroll
            for (int jj = 0; jj < 4; ++jj) y[jj] = v[i][jj] * rinv * gn[jj];
            *(f32x4*)(xr + i * 256 + lane * 4) = y;
        }
    }
}
constexpr int NSA_IMP = ATT_MISC;
constexpr int NSA_SELM = NSA_IMP + 32 * 128 * 4;
constexpr int NSA_KEYS = NSA_SELM + 512;
constexpr int LDS_BARW = NSA_KEYS + 8 * 128 * 4;
constexpr int LDS_BARW2 = (LDS_BARW > TOPK_LDS ? LDS_BARW : TOPK_LDS);
constexpr int LDS_TOTAL = ((LDS_BARW2 + 16 + 255) / 256) * 256;
static_assert(NWAVES * 16384 <= LDS_BARW2, "PEER staging (16 KB per wave) must stay below the barrier words");
static_assert(LDS_TOTAL <= 160 * 1024 && GEMM_LDS <= LDS_BARW2 && GEMM256_LDS <= LDS_BARW2, "LDS budget");

__device__ __forceinline__ int next_bit128(unsigned long long lo, unsigned long long hi, int from) {
    if (from < 64) { const unsigned long long mm = lo >> from; if (mm) return from + __builtin_ctzll(mm); from = 64; }
    if (from < 128) { const unsigned long long mm = hi >> (from - 64); if (mm) return from + __builtin_ctzll(mm); }
    return 128;
}
template <int MODE>
__device__ __forceinline__ void nsa_emit(const f32x16 (&o)[4], float sc, float* acc_row, bf16_t* o_row, int hi) {
#pragma unroll
    for (int dt = 0; dt < 4; ++dt)
#pragma unroll
        for (int g4 = 0; g4 < 4; ++g4) {
            const int d = dt * 32 + 8 * g4 + 4 * hi;
            f32x4 v = {o[dt][4 * g4] * sc, o[dt][4 * g4 + 1] * sc, o[dt][4 * g4 + 2] * sc, o[dt][4 * g4 + 3] * sc};
            if (MODE >= 1) { const f32x4 pv = *(const f32x4*)(acc_row + d); v += pv; }
            if (MODE <= 1) *(f32x4*)(acc_row + d) = v;
            else { u32x2 w = {cvtpk(v[0], v[1]), cvtpk(v[2], v[3])}; *(u32x2*)(o_row + d) = w; }
        }
}

__device__ __forceinline__ void nsa_item(const Args& A, unsigned char* lds, int b, int g, int tt) {
    const int tid = opaque_tid(), lane = tid & 63, wave = tid >> 6, l31 = lane & 31, hi = lane >> 5;
    const bf16_t* NS = (const bf16_t*)(WSP(A) + WS_BIG);
    const bf16_t* KCC = (const bf16_t*)(WSP(A) + WS_KCC); const bf16_t* VCC = (const bf16_t*)(WSP(A) + WS_VCC);
    float* OACC = (float*)(WSP(A) + WS_OACC); bf16_t* O = (bf16_t*)(WSP(A) + WS_O);
    int* IMP = (int*)(lds + NSA_IMP); unsigned* SELM = (unsigned*)(lds + NSA_SELM); int* KEYS = (int*)(lds + NSA_KEYS) + wave * 128;
    const int t0 = tt * 32, tok = wave * 4 + (l31 >> 3), t = t0 + tok, hd = g * 8 + (l31 & 7);
    const size_t tokb = (size_t)b * SEQ;
    const float c2 = 0.08838834764831845f * 1.4426950408889634f;
    bf16x8 qr[8];
    {
        const bf16_t* qp = NS + (tokb + t) * NSA_IN + hd * 128 + hi * 8;
#pragma unroll
        for (int ks = 0; ks < 8; ++ks) qr[ks] = *(const bf16x8*)(qp + ks * 16);
    }
    float gt[3];
    {
        const bf16_t* gp = NS + (tokb + t) * NSA_IN + 3584 + g * 24 + (l31 & 7) * 3;
        gt[0] = bf2f(gp[0]); gt[1] = bf2f(gp[1]); gt[2] = bf2f(gp[2]);
    }
    float* acc_row = OACC + (tokb + t) * 2048 + hd * 128;
    bf16_t* o_row = O + (tokb + t) * 2048 + hd * 128;
    const VLane vl = vlane(lane);
    const int wv = __builtin_amdgcn_readfirstlane(wave);
    unsigned ock[2], ocv[2], otk[2], otv[2];
#pragma unroll
    for (int i = 0; i < 2; ++i) {
        const int row = (wv * 2 + i) * 4 + (lane >> 4), pc = lane & 15, ck = pc ^ (row & 15), cv = pc ^ vswz(row);
        ock[i] = (unsigned)(row * 256 + ck * 8) * 2u; ocv[i] = (unsigned)(row * 256 + cv * 8) * 2u;
        otk[i] = (unsigned)(row * NSA_IN + ck * 8) * 2u; otv[i] = (unsigned)(row * NSA_IN + cv * 8) * 2u;
    }
    auto stageK = [&](const bf16_t* kbase, bool cmp, int buf) {
        unsigned char* kb = lds + ATT_KOFF + buf * ATT_K_BYTES + wv * 2048;
#pragma unroll
        for (int i = 0; i < 2; ++i) dma16((const unsigned char*)kbase + (cmp ? ock[i] : otk[i]), kb + i * 1024);
    };
    auto stageV = [&](const bf16_t* vbase, bool cmp, int buf) {
        unsigned char* vb = lds + ATT_VOFF + buf * ATT_V_BYTES + wv * 2048;
#pragma unroll
        for (int i = 0; i < 2; ++i) dma16((const unsigned char*)vbase + (cmp ? ocv[i] : otv[i]), vb + i * 1024);
    };
    f32x16 o[4];
    auto zero_o = [&]() {
#pragma unroll
        for (int dt = 0; dt < 4; ++dt)
#pragma unroll
            for (int r = 0; r < 16; ++r) o[dt][r] = 0.f;
    };

    for (int i = tid; i < 32 * 128; i += NTHREADS) IMP[i] = 0;
    const int nct = (tt >> 5) + 1;
    const int nv = (t >= 31) ? ((t - 31) >> 4) : -1;
    const bf16_t* kc0 = KCC + ((size_t)(b * NCMP_PAD) * 2 + g) * 128;
    const bf16_t* vc0 = VCC + ((size_t)(b * NCMP_PAD) * 2 + g) * 128;
    float m = -1e30f, l = 0.f;
    stageK(kc0, true, 0); DMA_WAIT(); __syncthreads();
    for (int ct = 0; ct < nct; ++ct) {
        if (ct + 1 < nct) stageK(kc0 + (size_t)(ct + 1) * 64 * 256, true, (ct + 1) & 1);
        {
            f32x16 p0, p1;
            qk_tile<8, KSTR128>(p0, p1, lds + ATT_KOFF + (ct & 1) * ATT_K_BYTES, l31, hi, qr);
            const int dq = nv - ct * 64 - 4 * hi;
            float mx = -__builtin_inff();
#pragma unroll
            for (int r = 0; r < 16; ++r) {
                const int cb = (r & 3) + 8 * (r >> 2);
                p0[r] = (cb <= dq) ? p0[r] : -__builtin_inff();
                p1[r] = (cb + 32 <= dq) ? p1[r] : -__builtin_inff();
                mx = fmaxf(mx, fmaxf(p0[r], p1[r]));
            }
            mx = fmaxf(mx, __shfl_xor(mx, 32));
            const float mn = fmaxf(m, mx);
            const float alpha = __builtin_amdgcn_exp2f((m - mn) * c2);
            const float mc = mn * c2;
            float rs = 0.f;
#pragma unroll
            for (int r = 0; r < 16; ++r) rs += __builtin_amdgcn_exp2f(p0[r] * c2 - mc) + __builtin_amdgcn_exp2f(p1[r] * c2 - mc);
            rs += __shfl_xor(rs, 32);
            l = l * alpha + rs; m = mn;
        }
        DMA_WAIT();
        __syncthreads();
    }
    const float inv_l = (l > 0.f) ? 1.f / l : 0.f;
    const float mcF = m * c2;
    zero_o();
    stageK(kc0, true, 0); stageV(vc0, true, 0); DMA_WAIT(); __syncthreads();
    for (int ct = 0; ct < nct; ++ct) {
        if (ct + 1 < nct) { stageK(kc0 + (size_t)(ct + 1) * 64 * 256, true, (ct + 1) & 1); stageV(vc0 + (size_t)(ct + 1) * 64 * 256, true, (ct + 1) & 1); }
        {
            f32x16 p0, p1;
            qk_tile<8, KSTR128>(p0, p1, lds + ATT_KOFF + (ct & 1) * ATT_K_BYTES, l31, hi, qr);
            const int dq = nv - ct * 64 - 4 * hi;
#pragma unroll
            for (int r = 0; r < 16; ++r) {
                const int cb = (r & 3) + 8 * (r >> 2);
                p0[r] = (cb <= dq) ? __builtin_amdgcn_exp2f(p0[r] * c2 - mcF) * inv_l : 0.f;
                p1[r] = (cb + 32 <= dq) ? __builtin_amdgcn_exp2f(p1[r] * c2 - mcF) * inv_l : 0.f;
            }
#pragma unroll
            for (int g4 = 0; g4 < 4; ++g4) {
                {
                    const int j = 16 * ct + 2 * g4 + hi;
                    const float mainv = 32.f * (p0[4 * g4] + p0[4 * g4 + 1] + p0[4 * g4 + 2]) + 16.f * p0[4 * g4 + 3];
                    const float spill = 16.f * p0[4 * g4 + 3];
                    atomicAdd(&IMP[tok * 128 + j], (int)(mainv * 1048576.f + 0.5f));
                    if (j + 1 < 128) atomicAdd(&IMP[tok * 128 + j + 1], (int)(spill * 1048576.f + 0.5f));
                }
                {
                    const int j = 16 * ct + 8 + 2 * g4 + hi;
                    const float mainv = 32.f * (p1[4 * g4] + p1[4 * g4 + 1] + p1[4 * g4 + 2]) + 16.f * p1[4 * g4 + 3];
                    const float spill = 16.f * p1[4 * g4 + 3];
                    atomicAdd(&IMP[tok * 128 + j], (int)(mainv * 1048576.f + 0.5f));
                    if (j + 1 < 128) atomicAdd(&IMP[tok * 128 + j + 1], (int)(spill * 1048576.f + 0.5f));
                }
            }
            bf16x8 pb[4] = {pack8f(p0, 0), pack8f(p0, 8), pack8f(p1, 0), pack8f(p1, 8)};
            pv_tile(o, lds + ATT_VOFF + (ct & 1) * ATT_V_BYTES, vl, pb);
        }
        DMA_WAIT();
        __syncthreads();
    }
    nsa_emit<0>(o, gt[0] * ABL_NC, acc_row, o_row, hi);

#pragma unroll 1
    for (int q = 0; q < 4; ++q) {
        const int ti = wave * 4 + q, tq = t0 + ti, cur = tq >> 6;
        int keyv[2];
#pragma unroll
        for (int half = 0; half < 2; ++half) {
            const int j = lane + 64 * half;
            const bool forced = (j == 0) || (j == cur) || (j == cur - 1);
            keyv[half] = forced ? 0x7FFFFFFF : ((j <= cur) ? IMP[ti * 128 + j] : -1);
            KEYS[j] = keyv[half];
        }
        __builtin_amdgcn_s_waitcnt(0xc07f);
        int rk0 = 0, rk1 = 0;
#pragma unroll 8
        for (int i = 0; i < 128; ++i) {
            const int ki = KEYS[i];
            rk0 += (ki > keyv[0] || (ki == keyv[0] && i < lane)) ? 1 : 0;
            rk1 += (ki > keyv[1] || (ki == keyv[1] && i < lane + 64)) ? 1 : 0;
        }
        const unsigned long long s0 = __ballot(keyv[0] >= 0 && rk0 < 16);
        const unsigned long long s1 = __ballot(keyv[1] >= 0 && rk1 < 16);
        if (lane == 0) { SELM[ti * 4 + 0] = (unsigned)s0; SELM[ti * 4 + 1] = (unsigned)(s0 >> 32); SELM[ti * 4 + 2] = (unsigned)s1; SELM[ti * 4 + 3] = (unsigned)(s1 >> 32); }
    }
    __syncthreads();
    unsigned msk[4], uni[4], wun[4];
#pragma unroll
    for (int w4 = 0; w4 < 4; ++w4) {
        msk[w4] = SELM[tok * 4 + w4];
        unsigned x = SELM[l31 * 4 + w4];
#pragma unroll
        for (int off = 16; off >= 1; off >>= 1) x |= (unsigned)__shfl_xor((int)x, off);
        uni[w4] = (unsigned)__builtin_amdgcn_readfirstlane((int)x);
        unsigned y = msk[w4];
        y |= (unsigned)__shfl_xor((int)y, 8); y |= (unsigned)__shfl_xor((int)y, 16);
        wun[w4] = (unsigned)__builtin_amdgcn_readfirstlane((int)y);
    }
    const unsigned long long ulo = ((unsigned long long)uni[1] << 32) | uni[0], uhi = ((unsigned long long)uni[3] << 32) | uni[2];

    const bf16_t* ks0 = NS + tokb * NSA_IN + 2560 + g * 128;
    const bf16_t* vs0 = NS + tokb * NSA_IN + 2816 + g * 128;
    zero_o(); m = -1e30f; l = 0.f;
    {
        int j = next_bit128(ulo, uhi, 0), it = 0;
        if (j < 128) { stageK(ks0 + (size_t)j * 64 * NSA_IN, false, 0); stageV(vs0 + (size_t)j * 64 * NSA_IN, false, 0); }
        DMA_WAIT(); __syncthreads();
        while (j < 128) {
            const int jn = next_bit128(ulo, uhi, j + 1);
            if (jn < 128) { stageK(ks0 + (size_t)jn * 64 * NSA_IN, false, (it + 1) & 1); stageV(vs0 + (size_t)jn * 64 * NSA_IN, false, (it + 1) & 1); }
            if ((wun[j >> 5] >> (j & 31)) & 1u) {
                f32x16 p0, p1;
                qk_tile<8, KSTR128>(p0, p1, lds + ATT_KOFF + (it & 1) * ATT_K_BYTES, l31, hi, qr);
                const bool sel = (msk[j >> 5] >> (j & 31)) & 1u;
                if (j == (t0 >> 6)) {
                    const int dq = t - j * 64 - 4 * hi;
#pragma unroll
                    for (int r = 0; r < 16; ++r) {
                        const int cb = (r & 3) + 8 * (r >> 2);
                        p0[r] = (cb <= dq) ? p0[r] : -__builtin_inff();
                        p1[r] = (cb + 32 <= dq) ? p1[r] : -__builtin_inff();
                    }
                }
                bf16x8 pb[4];
                softmax_step(p0, p1, m, l, o, c2, pb, sel);
                pv_tile(o, lds + ATT_VOFF + (it & 1) * ATT_V_BYTES, vl, pb);
            }
            DMA_WAIT();
            __syncthreads();
            j = jn; ++it;
        }
    }
    nsa_emit<1>(o, (l > 0.f) ? ABL_NS * gt[1] / l : 0.f, acc_row, o_row, hi);

    const bf16_t* kw0 = NS + tokb * NSA_IN + 3072 + g * 128;
    const bf16_t* vw0 = NS + tokb * NSA_IN + 3328 + g * 128;
    zero_o(); m = -1e30f; l = 0.f;
    {
        const int kt_lo = (t0 >= 511) ? ((t0 - 511) >> 6) : 0, kt_hi = t0 >> 6;
        stageK(kw0 + (size_t)kt_lo * 64 * NSA_IN, false, 0); stageV(vw0 + (size_t)kt_lo * 64 * NSA_IN, false, 0);
        DMA_WAIT(); __syncthreads();
        int it = 0;
        for (int kt = kt_lo; kt <= kt_hi; ++kt, ++it) {
            if (kt < kt_hi) { stageK(kw0 + (size_t)(kt + 1) * 64 * NSA_IN, false, (it + 1) & 1); stageV(vw0 + (size_t)(kt + 1) * 64 * NSA_IN, false, (it + 1) & 1); }
            {
                f32x16 p0, p1;
                qk_tile<8, KSTR128>(p0, p1, lds + ATT_KOFF + (it & 1) * ATT_K_BYTES, l31, hi, qr);
                if (!(kt * 64 + 63 <= t0 && kt * 64 > t0 + 31 - 512)) {
                    const int dq = t - kt * 64 - 4 * hi;
#pragma unroll
                    for (int r = 0; r < 16; ++r) {
                        const int cb = (r & 3) + 8 * (r >> 2);
                        p0[r] = ((unsigned)(dq - cb) < 512u) ? p0[r] : -__builtin_inff();
                        p1[r] = ((unsigned)(dq - cb - 32) < 512u) ? p1[r] : -__builtin_inff();
                    }
                }
                bf16x8 pb[4];
                softmax_step(p0, p1, m, l, o, c2, pb);
                pv_tile(o, lds + ATT_VOFF + (it & 1) * ATT_V_BYTES, vl, pb);
            }
            DMA_WAIT();
            __syncthreads();
        }
    }
    nsa_emit<2>(o, (l > 0.f) ? ABL_NW * gt[2] / l : 0.f, acc_row, o_row, hi);
}

__device__ __forceinline__ void phase_nsa(const Args& A, unsigned char* lds, int bid, int nb) {
    for (int u = bid; u < 1024; u += nb) {
        const int bg = u & 3, s = (u >> 2) & 63, r = u >> 8;
        const int tt = (r == 0) ? 255 - s : (r == 1) ? 128 + s : (r == 2) ? 127 - s : s;
        nsa_item(A, lds, bg >> 1, bg & 1, tt);
    }
}
constexpr int N_PHASES = 26;
#ifndef ABL_M0
#define ABL_M0 1.f
#endif
#ifndef ABL_M1
#define ABL_M1 1.f
#endif
#ifndef ABL_P0
#define ABL_P0 1.f
#endif
#ifndef ABL_P1
#define ABL_P1 1.f
#endif
__global__ void __launch_bounds__(NTHREADS, 2) fwd_kernel(Args a) {
    extern __shared__ __attribute__((aligned(16))) unsigned char lds[];
    const int bid = blockIdx.x, nb = gridDim.x;
    const bool multi = (a.ph_hi - a.ph_lo) > 1;
    XcdBarrier bar; bar.bar = (unsigned*)(a.ws + WS_CTL); bar.x = 0; bar.st = (volatile LAS unsigned*)(lds + LDS_BARW2);
    if (multi) {
        if (threadIdx.x == 0) *(uint4*)(lds + LDS_BARW2) = make_uint4(0u, 0u, 0u, 0u);
        __syncthreads();
        bar = xcd_barrier_post((unsigned*)(a.ws + WS_CTL), (volatile LAS unsigned*)(lds + LDS_BARW2));
    }
#ifdef ONLY
#define IN(k) ((k) == ONLY && a.ph_lo <= (k) && (k) < a.ph_hi)
#else
#define IN(k) (a.ph_lo <= (k) && (k) < a.ph_hi)
#endif
#define SEAM(k) do { if (IN(k) && IN((k) + 1)) xcd_barrier(bar); } while (0)
#define ws WSP(a)
#define MOD ((const float*)(ws + WS_MOD))
#define H ((bf16_t*)(ws + WS_H))
#define BIG ((bf16_t*)(ws + WS_BIG))
#define Ob ((bf16_t*)(ws + WS_O))
#define XA ((float*)(ws + WS_XA))
#define XB ((float*)(ws + WS_XB))

    if (IN(0)) phase_prologue(a, lds, bid, nb);
    SEAM(0);
    if (IN(1)) phase_modnorm(a, a.in[0], a.in[3], 0, bid, nb);
    SEAM(1);
    if (IN(2)) pg8::run(lds, H, (const bf16_t*)(ws + WS_WIN0), T, SBMLA_IN_PAD, 2048, pg8::EpiStore{BIG, SBMLA_IN, SBMLA_IN}, bid, nb);
    SEAM(2);
    if (IN(3)) phase_mla_prep(a, bid, nb);
    SEAM(3);
    if (IN(4)) {
        pg8::run(lds, (const bf16_t*)(ws + WS_CQN), (const bf16_t*)(ws + WS_WUQ), T, 1536, 512, pg8::EpiStore{(bf16_t*)(ws + WS_QM), 1536, 1536}, bid, nb);
        pg8::run(lds, (const bf16_t*)(ws + WS_CKVN), (const bf16_t*)(ws + WS_WUKV), T, 2048, 256, pg8::EpiStore{(bf16_t*)(ws + WS_KVM), KVM_LD, 2048}, bid, nb);
    }
    SEAM(4);
    if (IN(5)) phase_attn0(a, lds, bid, nb);
    SEAM(5);
    if (IN(6)) pg8::run(lds, Ob, (const bf16_t*)(ws + WS_WOUT0), T, 2048, 2048, pg8::EpiResidual{a.in[0], XA, MOD + 0 * 2 * 6144 + 4096, ABL_M0}, bid, nb);
    SEAM(6);
    if (IN(7)) phase_modnorm(a, XA, a.in[20], 1, bid, nb);
    SEAM(7);
    if (IN(8)) pg8::run(lds, H, (const bf16_t*)(ws + WS_WPQ), T, 2048, 2048, pg8::EpiStore{(bf16_t*)(ws + WS_PQ), 2048, 2048}, bid, nb);
    SEAM(8);
    if (IN(9)) phase_topk(a, lds, 0, bid, nb);
    SEAM(9);
    if (IN(10)) phase_peer_dots(a, lds, 0, bid, nb);
    SEAM(10);
    if (IN(11)) phase_peer_weights(a, ABL_P0, bid, nb);
    SEAM(11);
    if (IN(12)) phase_peer_out(a, lds, 0, XA, XB, 1, bid, nb);
    SEAM(12);
    if (IN(13)) phase_modnorm(a, XB, a.in[3] + 2048, 2, bid, nb);
    SEAM(13);
    if (IN(14)) pg8::run(lds, H, (const bf16_t*)(ws + WS_WNSAIN), T, NSA_IN_PAD, 2048, pg8::EpiNsaIn{BIG, (const f32x2*)(ws + WS_ROPE32)}, bid, nb);
    SEAM(14);
    if (IN(15)) phase_cmp_partial(a, lds, bid, nb);
    SEAM(15);
    if (IN(16)) phase_cmp_out(a, lds, bid, nb);
    SEAM(16);
    if (IN(17)) phase_nsa(a, lds, bid, nb);
    SEAM(17);
    if (IN(18)) pg8::run(lds, Ob, (const bf16_t*)(ws + WS_WNSAOUT), T, 2048, 2048, pg8::EpiResidual{XB, XA, MOD + 2 * 2 * 6144 + 4096, ABL_M1}, bid, nb);
    SEAM(18);
    if (IN(19)) phase_modnorm(a, XA, a.in[20] + 2048, 3, bid, nb);
    SEAM(19);
    if (IN(20)) pg8::run(lds, H, (const bf16_t*)(ws + WS_WPQ) + (size_t)2048 * 2048, T, 2048, 2048, pg8::EpiStore{(bf16_t*)(ws + WS_PQ), 2048, 2048}, bid, nb);
    SEAM(20);
    if (IN(21)) phase_topk(a, lds, 1, bid, nb);
    SEAM(21);
    if (IN(22)) phase_peer_dots(a, lds, 1, bid, nb);
    SEAM(22);
    if (IN(23)) phase_peer_weights(a, ABL_P1, bid, nb);
    SEAM(23);
    if (IN(24)) phase_peer_out(a, lds, 1, XA, a.out, 3, bid, nb);
    SEAM(24);
    if (IN(25)) phase_finalnorm(a, a.out, a.in[28], bid, nb);
    if (a.ph_lo == 99) {
        const bf16_t* raw = (const bf16_t*)(ws + (size_t)a.ph_hi * 16384);
        for (size_t i = (size_t)bid * NTHREADS + threadIdx.x; i < (size_t)T * 2048; i += (size_t)nb * NTHREADS) a.out[i] = bf2f(raw[i]);
    }
#undef IN
#undef SEAM
#undef ws
#undef MOD
#undef H
#undef BIG
#undef Ob
#undef XA
#undef XB
}

#ifndef MK_ONE_LAUNCH
#define MK_ONE_LAUNCH 1
#endif
extern "C" void kernel_launch(void* const* d_in, const int* in_sizes, int n_in, void* d_out, int out_size, void* d_ws, size_t ws_size, hipStream_t stream) {
    static int grid = 0;
    if (grid == 0) {
        if (n_in != 29 || out_size != T * D_MODEL || ws_size < WS_END) { fprintf(stderr, "kernel_launch: unexpected shapes (n_in %d out %d ws %zu need %zu)\n", n_in, out_size, ws_size, (size_t)WS_END); grid = -1; return; }
        int dev = 0, cus = 0, per_cu = 0;
        if (hipGetDevice(&dev) != hipSuccess || hipDeviceGetAttribute(&cus, hipDeviceAttributeMultiprocessorCount, dev) != hipSuccess) { grid = -1; return; }
        if (hipFuncSetAttribute((const void*)fwd_kernel, hipFuncAttributeMaxDynamicSharedMemorySize, LDS_TOTAL) != hipSuccess) { fprintf(stderr, "kernel_launch: hipFuncSetAttribute failed\n"); grid = -1; return; }
        if (hipOccupancyMaxActiveBlocksPerMultiprocessor(&per_cu, (const void*)fwd_kernel, NTHREADS, LDS_TOTAL) != hipSuccess || per_cu < 1) { fprintf(stderr, "kernel_launch: occupancy query says %d\n", per_cu); }
        (void)hipGetLastError();
        grid = cus;
    }
    if (grid < 0) return;
    (void)hipMemsetAsync((char*)d_ws + WS_CTL, 0, 16384, stream);
    Args a{};
    for (int i = 0; i < 29; ++i) a.in[i] = (const float*)d_in[i];
    a.out = (float*)d_out; a.ws = (unsigned char*)d_ws;
#if MK_ONE_LAUNCH
    a.ph_lo = 0; a.ph_hi = N_PHASES;
    hipLaunchKernelGGL(fwd_kernel, dim3(grid), dim3(NTHREADS), LDS_TOTAL, stream, a);
#else
#ifdef DBG_UPTO
    for (int p = 0; p <= DBG_UPTO; ++p) {
        a.ph_lo = p; a.ph_hi = p + 1;
        hipLaunchKernelGGL(fwd_kernel, dim3(grid), dim3(NTHREADS), LDS_TOTAL, stream, a);
    }
    a.ph_lo = 99; a.ph_hi = (int)(DBG_OFF / 16384);
    hipLaunchKernelGGL(fwd_kernel, dim3(grid), dim3(NTHREADS), LDS_TOTAL, stream, a);
#else
    for (int p = 0; p < N_PHASES; ++p) {
        a.ph_lo = p; a.ph_hi = p + 1;
        hipLaunchKernelGGL(fwd_kernel, dim3(grid), dim3(NTHREADS), LDS_TOTAL, stream, a);
#ifdef REPEAT_LIST
        { const int rl[] = REPEAT_LIST; for (int q : rl) if (q == p) hipLaunchKernelGGL(fwd_kernel, dim3(grid), dim3(NTHREADS), LDS_TOTAL, stream, a); }
#endif
    }
#endif
#endif
}
```

```cpp
#include <hip/hip_runtime.h>
#include <stdint.h>
#include <stdio.h>

typedef unsigned short bf16_t;
typedef short bf16x8 __attribute__((ext_vector_type(8)));
typedef short s16x4 __attribute__((ext_vector_type(4)));
typedef float f32x16 __attribute__((ext_vector_type(16)));
typedef float f32x4 __attribute__((ext_vector_type(4)));
typedef float f32x2 __attribute__((ext_vector_type(2)));
typedef unsigned u32x4 __attribute__((ext_vector_type(4)));
typedef unsigned u32x2 __attribute__((ext_vector_type(2)));
typedef __bf16 bf16x2_t __attribute__((ext_vector_type(2)));
#define LAS __attribute__((address_space(3)))

constexpr int D_MODEL = 2048, BATCH = 2, SEQ = 8192, T = BATCH * SEQ;
constexpr float EPS = 1e-6f;
constexpr int SBMLA_IN = 3904, SBMLA_IN_PAD = 4096;
constexpr int NSA_IN = 3632, NSA_IN_PAD = 3840;
constexpr int NCMP = 511, NCMP_PAD = 512;
constexpr int NTHREADS = 512, NWAVES = 8;
constexpr int KVM_LD = 2112;

constexpr size_t al256(size_t x) { return (x + 255) & ~(size_t)255; }
constexpr size_t WS_CTL   = 0;
constexpr size_t WS_MOD   = 16384;
constexpr size_t WS_BIASP = WS_MOD + al256((size_t)4 * 2 * 6144 * 4);
constexpr size_t WS_ROPE64 = WS_BIASP + al256((size_t)2 * 32 * 256 * 4);
constexpr size_t WS_ROPE32 = WS_ROPE64 + (size_t)T * 32 * 8;
constexpr size_t WS_WIN0  = WS_ROPE32 + (size_t)T * 16 * 8;
constexpr size_t WS_WUQ   = WS_WIN0 + (size_t)SBMLA_IN_PAD * 2048 * 2;
constexpr size_t WS_WUKV  = WS_WUQ + (size_t)1536 * 512 * 2;
constexpr size_t WS_WOUT0 = WS_WUKV + (size_t)2048 * 256 * 2;
constexpr size_t WS_WNSAIN = WS_WOUT0 + (size_t)2048 * 2048 * 2;
constexpr size_t WS_W1K   = WS_WNSAIN + (size_t)NSA_IN_PAD * 2048 * 2;
constexpr size_t WS_W1V   = WS_W1K + (size_t)256 * 4096 * 2;
constexpr size_t WS_W2K   = WS_W1V + (size_t)256 * 4096 * 2;
constexpr size_t WS_W2V   = WS_W2K + (size_t)128 * 256 * 2;
constexpr size_t WS_WNSAOUT = WS_W2V + (size_t)128 * 256 * 2;
constexpr size_t WS_WPQ   = WS_WNSAOUT + (size_t)2048 * 2048 * 2;
constexpr size_t WS_K12   = WS_WPQ + (size_t)2 * 2048 * 2048 * 2;
constexpr size_t WS_PU    = WS_K12 + (size_t)4 * 128 * 128 * 2;
constexpr size_t WS_PV    = WS_PU + (size_t)2 * 16384 * 1536;
constexpr size_t WS_H     = WS_PV + (size_t)2 * 16384 * 1024;
constexpr size_t WS_BIG   = WS_H + (size_t)T * 2048 * 2;
constexpr size_t WS_O     = WS_BIG + (size_t)T * SBMLA_IN * 2;
constexpr size_t WS_XA    = WS_O + (size_t)T * 2048 * 2;
constexpr size_t WS_XB    = WS_XA + (size_t)T * 2048 * 4;
constexpr size_t WS_CQN   = WS_XA;
constexpr size_t WS_CKVN  = WS_CQN + (size_t)T * 512 * 2;
constexpr size_t WS_CMPPART = WS_XA;
constexpr size_t WS_OACC  = WS_XA;
constexpr size_t WS_QM    = WS_XB;
constexpr size_t WS_KVM   = WS_QM + (size_t)T * 1536 * 2;
constexpr size_t WS_PQ    = WS_XB;
static_assert((size_t)T * 1536 * 2 + (size_t)T * KVM_LD * 2 <= (size_t)T * 2048 * 4, "QM + KVM must fit the XB region");
constexpr size_t WS_EXI   = WS_XB + (size_t)T * 2048 * 4;
constexpr size_t WS_EXG   = WS_EXI + (size_t)T * 128 * 4;
constexpr size_t WS_HID   = WS_EXG + (size_t)T * 128 * 4;
constexpr size_t WS_KCC   = WS_HID + (size_t)2 * 2048 * 256 * 2;
constexpr size_t WS_VCC   = WS_KCC + (size_t)BATCH * NCMP_PAD * 2 * 128 * 2;
constexpr size_t WS_END   = WS_VCC + (size_t)BATCH * NCMP_PAD * 2 * 128 * 2;

struct Args {
    const float* in[29];
    float* out;
    unsigned char* ws;
    int ph_lo, ph_hi;
};

__device__ __forceinline__ unsigned cvtpk(float lo, float hi) {
    bf16x2_t v = {(__bf16)lo, (__bf16)hi};
    return __builtin_bit_cast(unsigned, v);
}
__device__ __forceinline__ float bf2f(unsigned short h) { return __uint_as_float(((unsigned)h) << 16); }
__device__ __forceinline__ float bflo(unsigned w) { return __uint_as_float(w << 16); }
__device__ __forceinline__ float bfhi(unsigned w) { return __uint_as_float(w & 0xFFFF0000u); }
__device__ __forceinline__ int crow(int r, int hi) { return (r & 3) + 8 * (r >> 2) + 4 * hi; }
__device__ __forceinline__ float wave_sum(float v) {
#pragma unroll
    for (int o = 32; o >= 1; o >>= 1) v += __shfl_xor(v, o);
    return v;
}
__device__ __forceinline__ float wave_sum_dpp(float v) {
#define WS_DPP(ctrl, rmask) v += __int_as_float(__builtin_amdgcn_update_dpp(0, __float_as_int(v), ctrl, rmask, 0xF, false))
    WS_DPP(0xB1, 0xF);
    WS_DPP(0x4E, 0xF);
    WS_DPP(0x141, 0xF);
    WS_DPP(0x140, 0xF);
    WS_DPP(0x142, 0xA);
    WS_DPP(0x143, 0xC);
#undef WS_DPP
    return __int_as_float(__builtin_amdgcn_readlane(__float_as_int(v), 63));
}
__device__ __forceinline__ float gelu_tanh(float x) {
    const float u = 0.7978845608028654f * (x + 0.044715f * x * x * x);
    const float e = __expf(2.f * u);
    const float th = 1.f - 2.f / (e + 1.f);
    return 0.5f * x * (1.f + th);
}
__device__ __forceinline__ int opaque_tid() { int t = threadIdx.x; asm volatile("" : "+v"(t)); return t; }
__device__ __forceinline__ unsigned char* WSP(const Args& A) {
    size_t z = 0; asm volatile("" : "+s"(z));
    return A.ws + z;
}
#ifndef ABL_SB
#define ABL_SB 1.f
#endif
#ifndef ABL_MLA
#define ABL_MLA 1.f
#endif
#ifndef ABL_NC
#define ABL_NC 1.f
#endif
#ifndef ABL_NS
#define ABL_NS 1.f
#endif
#ifndef ABL_NW
#define ABL_NW 1.f
#endif
#define XB_TMO      128
#define XB_XCNT(j)  (256  + 64 * (j))
#define XB_XSUB(j)  (1280 + 64 * (j))
#define XB_XGEN(j)  (2304 + 64 * (j))
#define XB_TOP      3328
#define XB_TOPGEN   3392
#define XCD_BAR_WORDS 3456
#define XB_SPIN_CAP (1u << 18)
#define LAS __attribute__((address_space(3)))

__device__ __forceinline__ unsigned xb_ld(unsigned* p)              { return __hip_atomic_load(p, __ATOMIC_RELAXED, __HIP_MEMORY_SCOPE_AGENT); }
__device__ __forceinline__ unsigned xb_add(unsigned* p, unsigned v) { return __hip_atomic_fetch_add(p, v, __ATOMIC_RELAXED, __HIP_MEMORY_SCOPE_AGENT); }
__device__ __forceinline__ unsigned xb_xcc_id() { return (unsigned)__builtin_amdgcn_s_getreg((3 << 11) | 20) & 0xFu; }
#define XB_SPIN(cond, bar) do { unsigned _sp = 0; while (cond) { __builtin_amdgcn_s_sleep(1); \
    if ((++_sp & 255u) == 0u) { if (xb_ld(&(bar)[XB_TMO])) break; if (_sp > XB_SPIN_CAP) { atomicAdd(&(bar)[XB_TMO], 1u); break; } } } } while (0)

struct XcdBarrier {
    unsigned* bar; unsigned x;
    volatile LAS unsigned* st;
};

__device__ __forceinline__ XcdBarrier xcd_barrier_post(unsigned* bar, volatile LAS unsigned* st) {
    XcdBarrier b; b.bar = bar; b.x = xb_xcc_id(); b.st = st;
    if (threadIdx.x == 0) (void)xb_add(&bar[XB_XCNT(b.x)], 1u);
    return b;
}
__device__ __forceinline__ void xcd_barrier_complete(unsigned* bar, unsigned x, unsigned& nloc, unsigned& nx) {
    const unsigned G = gridDim.x * gridDim.y * gridDim.z;
    unsigned sum, cnt, mine, sp = 0u;
    for (;;) {
        sum = 0u; cnt = 0u; mine = 0u;
#pragma unroll
        for (unsigned j = 0; j < 16; ++j) { const unsigned c = xb_ld(&bar[XB_XCNT(j)]); sum += c; cnt += (c > 0u) ? 1u : 0u; mine = (j == x) ? c : mine; }
        if (sum == G) break;
        __builtin_amdgcn_s_sleep(1);
        if ((++sp & 255u) == 0u) { if (xb_ld(&bar[XB_TMO])) break; if (sp > XB_SPIN_CAP) { atomicAdd(&bar[XB_TMO], 1u); break; } }
    }
    nloc = mine > 0u ? mine : 1u; nx = cnt > 0u ? cnt : 1u;
}

__device__ __forceinline__ void xcd_barrier(const XcdBarrier& b) {
    asm volatile("s_waitcnt vmcnt(0)" ::: "memory");
    __syncthreads();
    if (threadIdx.x == 0) {
        unsigned* bar = b.bar;
        __builtin_amdgcn_s_waitcnt(0);
        unsigned nloc = b.st[0], nx = b.st[1];
        if (nloc == 0u) { xcd_barrier_complete(bar, b.x, nloc, nx); b.st[0] = nloc; b.st[1] = nx; }
        const unsigned old = xb_add(&bar[XB_XSUB(b.x)], 1u);
        const unsigned gen = old / nloc;
        if (old + 1u == (gen + 1u) * nloc) {
            __builtin_amdgcn_fence(__ATOMIC_RELEASE, "agent");
            asm volatile("s_waitcnt vmcnt(0)" ::: "memory");
            const unsigned og = xb_add(&bar[XB_TOP], 1u);
            const unsigned tg = og / nx;
            if (og + 1u == (tg + 1u) * nx) xb_add(&bar[XB_TOPGEN], 1u);
            else XB_SPIN(xb_ld(&bar[XB_TOPGEN]) == tg, bar);
            __builtin_amdgcn_fence(__ATOMIC_ACQUIRE, "agent");
            xb_add(&bar[XB_XGEN(b.x)], 1u);
            asm volatile("s_waitcnt vmcnt(0)" ::: "memory");
        } else {
            XB_SPIN(xb_ld(&bar[XB_XGEN(b.x)]) == gen, bar);
            __builtin_amdgcn_fence(__ATOMIC_ACQUIRE, "agent");
            asm volatile("s_waitcnt vmcnt(0)" ::: "memory");
        }
    }
    __syncthreads();
}
constexpr int U0_MOD = 48  , U0_MOD_LATE = 144, U0_TR = 8912, U0_PEER = 2048, U0_ROPE = 192, U0_BIAS = 64, U0_K12 = 8, U0_ZERO = 8;
constexpr int U0_TOTAL = U0_MOD + U0_TR + U0_ROPE + U0_BIAS + U0_K12 + U0_ZERO;

struct TrDesc { int in_idx; size_t in_off; int K, N, Npad; size_t ws_off; int ntiles; };
__device__ __forceinline__ TrDesc tr_desc(int m) {
    switch (m) {
        case 0:  return TrDesc{6, 0, 2048, 3904, 4096, WS_WIN0, 2048};
        case 1:  return TrDesc{8, 0, 512, 1536, 1536, WS_WUQ, 192};
        case 2:  return TrDesc{10, 0, 256, 2048, 2048, WS_WUKV, 128};
        case 3:  return TrDesc{11, 0, 2048, 2048, 2048, WS_WOUT0, 1024};
        case 4:  return TrDesc{12, 0, 2048, 3632, 3840, WS_WNSAIN, 1920};
        case 5:  return TrDesc{15, 0, 4096, 256, 256, WS_W1K, 256};
        case 6:  return TrDesc{17, 0, 4096, 256, 256, WS_W1V, 256};
        case 7:  return TrDesc{16, 0, 256, 128, 128, WS_W2K, 8};
        case 8:  return TrDesc{18, 0, 256, 128, 128, WS_W2V, 8};
        case 9:  return TrDesc{19, 0, 2048, 2048, 2048, WS_WNSAOUT, 1024};
        case 10: return TrDesc{23, 0, 2048, 2048, 2048, WS_WPQ, 1024};
        default: return TrDesc{23, (size_t)2048 * 2048, 2048, 2048, 2048, WS_WPQ + (size_t)2048 * 2048 * 2, 1024};
    }
}

__device__ __forceinline__ void p0_mod_unit(const Args& A, unsigned char* lds, int u) {
    const int tid = opaque_tid();
    float* sc = (float*)lds;
    float* red = (float*)(lds + 16384);
    const int set = u / 48, cc = u % 48;
    const int layer = set >> 1, kind = set & 1;
    const float* w = (kind ? A.in[21] : A.in[4]) + (size_t)layer * 2048 * 6144;
    const float* bias = (kind ? A.in[22] : A.in[5]) + (size_t)layer * 6144;
    const float* c = A.in[1];
    for (int i = tid; i < 4096; i += NTHREADS) { const float v = c[i]; sc[i] = v / (1.f + __expf(-v)); }
    __syncthreads();
    const int l32 = tid & 31, kg = tid >> 5;
    const int col = cc * 128 + l32 * 4;
    float a0[4] = {0, 0, 0, 0}, a1[4] = {0, 0, 0, 0};
    const float* wp = w + (size_t)(kg * 128) * 6144 + col;
#pragma unroll 16
    for (int i = 0; i < 128; ++i) {
        const f32x4 wv = *(const f32x4*)(wp + (size_t)i * 6144);
        const float s0 = sc[kg * 128 + i], s1 = sc[2048 + kg * 128 + i];
#pragma unroll
        for (int j = 0; j < 4; ++j) { a0[j] += s0 * wv[j]; a1[j] += s1 * wv[j]; }
    }
#pragma unroll
    for (int j = 0; j < 4; ++j) { red[(kg * 2 + 0) * 128 + l32 * 4 + j] = a0[j]; red[(kg * 2 + 1) * 128 + l32 * 4 + j] = a1[j]; }
    __syncthreads();
    if (tid < 256) {
        const int b = tid >> 7, cl = tid & 127;
        float s = 0;
#pragma unroll
        for (int g = 0; g < 16; ++g) s += red[(g * 2 + b) * 128 + cl];
        float* mod = (float*)(WSP(A) + WS_MOD);
        mod[(size_t)(set * 2 + b) * 6144 + cc * 128 + cl] = s + bias[cc * 128 + cl];
    }
    __syncthreads();
}

__device__ __forceinline__ void p0_tr_unit(const Args& A, unsigned char* lds, int u) {
    const int tid = opaque_tid();
    int m = 0, tile = u;
    TrDesc d = tr_desc(0);
    while (tile >= d.ntiles) { tile -= d.ntiles; ++m; d = tr_desc(m); }
    const int nNt = d.Npad / 64;
    const int kt = tile / nNt, nt = tile % nNt;
    const float* src = A.in[d.in_idx] + d.in_off;
    bf16_t* dst = (bf16_t*)(WSP(A) + d.ws_off);
    float* ts = (float*)lds;
    {
        const int r = tid >> 3, cg = tid & 7;
        const int k = kt * 64 + r, n = nt * 64 + cg * 8;
        f32x4 v0 = {0, 0, 0, 0}, v1 = {0, 0, 0, 0};
        if (n < d.N) { const float* p = src + (size_t)k * d.N + n; v0 = *(const f32x4*)p; v1 = *(const f32x4*)(p + 4); }
#pragma unroll
        for (int j = 0; j < 4; ++j) { ts[r * 65 + cg * 8 + j] = v0[j]; ts[r * 65 + cg * 8 + 4 + j] = v1[j]; }
    }
    __syncthreads();
    {
        const int n = tid >> 3, kg = tid & 7;
        float v[8];
#pragma unroll
        for (int j = 0; j < 8; ++j) v[j] = ts[(kg * 8 + j) * 65 + n];
        u32x4 w = {cvtpk(v[0], v[1]), cvtpk(v[2], v[3]), cvtpk(v[4], v[5]), cvtpk(v[6], v[7])};
        *(u32x4*)(dst + (size_t)(nt * 64 + n) * d.K + kt * 64 + kg * 8) = w;
    }
    __syncthreads();
}

constexpr float PEER_USCALE = 90.5f, PEER_VSCALE = 5.65685f;
constexpr float PEER_UQ = 124.84f  , PEER_HQ = 15.f  ;
constexpr int PEER_UROW_BYTES = 2048 * 6 / 8, PEER_VROW_BYTES = 2048 * 4 / 8;
constexpr size_t PEER_U16_SLICE = (size_t)16384 * 128, PEER_U8_SLICE = (size_t)16384 * 64, PEER_V_SLICE = (size_t)16384 * 128;
constexpr size_t PEER_U_LAYER = (size_t)16384 * PEER_UROW_BYTES, PEER_U8_OFF = 8 * PEER_U16_SLICE, PEER_V_LAYER = (size_t)16384 * PEER_VROW_BYTES;
constexpr size_t WS_DP = WS_BIG;
constexpr size_t WS_PW = WS_DP + (size_t)8 * T * 128 * 4;
static_assert((size_t)9 * T * 128 * 4 <= (size_t)T * SBMLA_IN * 2, "PEER scratch must fit the BIG region");
typedef float f32x32 __attribute__((ext_vector_type(32)));
typedef unsigned u32x6 __attribute__((ext_vector_type(6)));
__device__ __forceinline__ void p0_peer_unit(const Args& A, int u) {
    const int tid = opaque_tid();
    const bool isv = u >= 1024;
    const int pu = isv ? u - 1024 : u;
    const float* src = (isv ? A.in[27] : A.in[26]) + (size_t)pu * 65536;
#pragma unroll 1
    for (int it = 0; it < 4; ++it) {
        const int grp = it * NTHREADS + tid;
        const float* p = src + grp * 32;
        if (!isv) {
            u32x4 w;
#pragma unroll
            for (int j = 0; j < 4; ++j) {
                const f32x4 v0 = *(const f32x4*)(p + 8 * j), v1 = *(const f32x4*)(p + 8 * j + 4);
                unsigned d = 0;
#pragma unroll
                for (int i = 0; i < 8; ++i) {
                    const float f = (i < 4 ? v0[i] : v1[i - 4]) * PEER_UQ;
                    const int n = (int)__builtin_floorf(fminf(fmaxf(f, -8.f), 7.5f));
                    d |= ((unsigned)n & 15u) << (4 * i);
                }
                w[j] = d;
            }
            const int R = pu * 32 + (grp >> 6), e = R & 16383, cb = grp & 63;
            *(u32x4*)(WSP(A) + WS_PU + (size_t)(R >> 14) * PEER_U_LAYER + (size_t)(cb >> 3) * PEER_U16_SLICE + (size_t)e * 128 + (cb & 7) * 16) = w;
        } else {
            u32x4 w;
#pragma unroll
            for (int j = 0; j < 4; ++j) {
                const f32x4 v0 = *(const f32x4*)(p + 8 * j), v1 = *(const f32x4*)(p + 8 * j + 4);
                unsigned d = 0;
                d = __builtin_amdgcn_cvt_scalef32_pk_fp4_f32(d, v0[0] * PEER_VSCALE, v0[1] * PEER_VSCALE, 1.0f, 0);
                d = __builtin_amdgcn_cvt_scalef32_pk_fp4_f32(d, v0[2] * PEER_VSCALE, v0[3] * PEER_VSCALE, 1.0f, 1);
                d = __builtin_amdgcn_cvt_scalef32_pk_fp4_f32(d, v1[0] * PEER_VSCALE, v1[1] * PEER_VSCALE, 1.0f, 2);
                d = __builtin_amdgcn_cvt_scalef32_pk_fp4_f32(d, v1[2] * PEER_VSCALE, v1[3] * PEER_VSCALE, 1.0f, 3);
                w[j] = d;
            }
            const int R = pu * 32 + (grp >> 6), e = R & 16383, cb = grp & 63;
            *(u32x4*)(WSP(A) + WS_PV + (size_t)(R >> 14) * PEER_V_LAYER + (size_t)(cb >> 3) * PEER_V_SLICE + (size_t)e * 128 + (cb & 7) * 16) = w;
        }
    }
}

__device__ __forceinline__ void p0_rope_unit(const Args& A, int u) {
    const int tid = opaque_tid();
    const int* pos = (const int*)A.in[2];
#pragma unroll 1
    for (int it = 0; it < 8; ++it) {
        const int e = u * 4096 + it * NTHREADS + tid;
        if (e < T * 32) {
            const int t = e >> 5, j = e & 31;
            const float inv = powf(500000.0f, -(float)j / 32.0f);
            const float ang = (float)pos[t] * inv;
            float s, c; sincosf(ang, &s, &c);
            ((f32x2*)(WSP(A) + WS_ROPE64))[e] = f32x2{c, s};
        } else {
            const int e2 = e - T * 32;
            const int t = e2 >> 4, j = e2 & 15;
            const float inv = powf(500000.0f, -(float)j / 16.0f);
            const float ang = (float)pos[t] * inv;
            float s, c; sincosf(ang, &s, &c);
            ((f32x2*)(WSP(A) + WS_ROPE32))[e2] = f32x2{c, s};
        }
    }
}

__device__ __forceinline__ void p0_bias_unit(const Args& A, unsigned char* lds, int u) {
    const int tid = opaque_tid();
    const int mat = u >> 5, chunk = u & 31;
    const float* pe = A.in[mat ? 14 : 13];
    const float* w1 = A.in[mat ? 17 : 15];
    const int col = tid & 255, half = tid >> 8;
    float acc = 0;
    const int r0 = chunk * 128 + half * 64;
#pragma unroll 8
    for (int i = 0; i < 64; ++i) acc += pe[r0 + i] * w1[(size_t)(r0 + i) * 256 + col];
    float* red = (float*)lds;
    if (half) red[col] = acc;
    __syncthreads();
    if (!half) ((float*)(WSP(A) + WS_BIASP))[(mat * 32 + chunk) * 256 + col] = acc + red[col];
    __syncthreads();
}

__device__ __forceinline__ void p0_k12_unit(const Args& A, int u) {
    const int tid = opaque_tid();
    bf16_t* dst = (bf16_t*)(WSP(A) + WS_K12);
#pragma unroll
    for (int it = 0; it < 2; ++it) {
        const int e = u * 8192 + (it * NTHREADS + tid) * 8;
        const int layer = e >> 15, which = (e >> 14) & 1, rem = e & 16383;
        const float* src = A.in[which ? 25 : 24] + layer * 16384 + rem;
        const f32x4 v0 = *(const f32x4*)src, v1 = *(const f32x4*)(src + 4);
        u32x4 w = {cvtpk(v0[0], v0[1]), cvtpk(v0[2], v0[3]), cvtpk(v1[0], v1[1]), cvtpk(v1[2], v1[3])};
        *(u32x4*)(dst + e) = w;
    }
}

struct TrTile { const float* src; bf16_t* dst; int N, K, kt, nt; };
__device__ __forceinline__ TrTile tr_tile(const Args& A, int u) {
    int m = 0, tile = u;
    TrDesc d = tr_desc(0);
    while (tile >= d.ntiles) { tile -= d.ntiles; ++m; d = tr_desc(m); }
    const int nNt = d.Npad / 64;
    return TrTile{A.in[d.in_idx] + d.in_off, (bf16_t*)(WSP(A) + d.ws_off), d.N, d.K, tile / nNt, tile % nNt};
}
__device__ __forceinline__ void tr_fetch(const TrTile& t, int tid, f32x4& v0, f32x4& v1) {
    const int r = tid >> 3, cg = tid & 7;
    const int k = t.kt * 64 + r, n = t.nt * 64 + cg * 8;
    v0 = f32x4{0, 0, 0, 0}; v1 = f32x4{0, 0, 0, 0};
    if (n < t.N) { const float* p = t.src + (size_t)k * t.N + n; v0 = *(const f32x4*)p; v1 = *(const f32x4*)(p + 4); }
}
__device__ __forceinline__ void phase_prologue(const Args& A, unsigned char* lds, int bid, int nb) {
    const int tid = opaque_tid();
    const bool modblk = bid < U0_MOD && nb > 2 * U0_MOD;
    if (modblk) p0_mod_unit(A, lds, bid);
    else if (nb <= 2 * U0_MOD) { for (int v = bid; v < U0_MOD; v += nb) p0_mod_unit(A, lds, v); }
    {
        const int nmod = nb > 2 * U0_MOD ? U0_MOD : 0;
        const int S = nmod + 2 * (nb - nmod) - (nmod ? 0 : nb);
        const int wgt = nmod ? (bid < nmod ? 1 : 2) : 1;
        const int base = nmod ? (bid < nmod ? bid : nmod + 2 * (bid - nmod)) : bid;
        auto unit_at = [&](int i) { return (i / wgt) * S + base + (i % wgt); };
        int i = 0;
        int u = unit_at(0);
        f32x4 v0, v1;
        TrTile cur{};
        if (u < U0_TR) { cur = tr_tile(A, u); tr_fetch(cur, tid, v0, v1); }
        int par = 0;
        while (u < U0_TR) {
            float* ts = (float*)lds + par * (64 * 65);
            {
                const int r = tid >> 3, cg = tid & 7;
#pragma unroll
                for (int j = 0; j < 4; ++j) { ts[r * 65 + cg * 8 + j] = v0[j]; ts[r * 65 + cg * 8 + 4 + j] = v1[j]; }
            }
            const TrTile done = cur;
            ++i; u = unit_at(i);
            if (u < U0_TR) { cur = tr_tile(A, u); tr_fetch(cur, tid, v0, v1); }
            __syncthreads();
            {
                const int n = tid >> 3, kg = tid & 7;
                float v[8];
#pragma unroll
                for (int j = 0; j < 8; ++j) v[j] = ts[(kg * 8 + j) * 65 + n];
                u32x4 w = {cvtpk(v[0], v[1]), cvtpk(v[2], v[3]), cvtpk(v[4], v[5]), cvtpk(v[6], v[7])};
                *(u32x4*)(done.dst + (size_t)(done.nt * 64 + n) * done.K + done.kt * 64 + kg * 8) = w;
            }
            par ^= 1;
        }
        __syncthreads();
    }
    for (int u = bid; u < U0_ROPE + U0_BIAS + U0_K12 + U0_ZERO; u += nb) {
        int v = u;
        if (v < U0_ROPE) { p0_rope_unit(A, v); continue; }
        v -= U0_ROPE;
        if (v < U0_BIAS) { p0_bias_unit(A, lds, v); continue; }
        v -= U0_BIAS;
        if (v < U0_K12) { p0_k12_unit(A, v); continue; }
        v -= U0_K12;
        {
            u32x4* z = (u32x4*)(WSP(A) + WS_KCC) + (size_t)v * 8192;
            for (int k = opaque_tid(); k < 8192; k += NTHREADS) z[k] = u32x4{0u, 0u, 0u, 0u};
        }
    }
}

__device__ __forceinline__ void modnorm_row(const float* xr, const float* gain, const float* mod  , bf16_t* hr, int lane) {
    f32x4 v[8];
    float ss = 0;
#pragma unroll
    for (int i = 0; i < 8; ++i) { v[i] = *(const f32x4*)(xr + i * 256 + lane * 4); ss += v[i][0] * v[i][0] + v[i][1] * v[i][1] + v[i][2] * v[i][2] + v[i][3] * v[i][3]; }
    ss = wave_sum(ss);
    const float rinv = rsqrtf(ss * (1.0f / 2048.0f) + EPS);
#pragma unroll
    for (int i = 0; i < 8; ++i) {
        const int col = i * 256 + lane * 4;
        const f32x4 g = *(const f32x4*)(gain + col), sh = *(const f32x4*)(mod + col), scl = *(const f32x4*)(mod + 2048 + col);
        float y[4];
#pragma unroll
        for (int j = 0; j < 4; ++j) y[j] = v[i][j] * rinv * g[j] * (1.f + scl[j]) + sh[j];
        u32x2 w = {cvtpk(y[0], y[1]), cvtpk(y[2], y[3])};
        *(u32x2*)(hr + col) = w;
    }
}
__device__ __forceinline__ void phase_modnorm(const Args& A, const float* xin, const float* gain, int set, int bid, int nb) {
    const int tid = opaque_tid(), lane = tid & 63, wave = tid >> 6;
    const float* mod = (const float*)(WSP(A) + WS_MOD) + (size_t)set * 2 * 6144;
    bf16_t* H = (bf16_t*)(WSP(A) + WS_H);
    for (int u = bid; u < T / NWAVES; u += nb) {
        const int row = u * NWAVES + wave;
        modnorm_row(xin + (size_t)row * 2048, gain, mod + (row >> 13) * 6144, H + (size_t)row * 2048, lane);
    }
}

struct ALoadPlain {
    const bf16_t* A; int lda;
    __device__ __forceinline__ const bf16_t* ptr(int row, int k) const { return A + (size_t)row * lda + k; }
};
struct ALoadCmp {
    const bf16_t* base; int ld; int colbase;
    __device__ __forceinline__ const bf16_t* ptr(int row, int k) const {
        int r = row < 2 * BATCH * NCMP ? row : 2 * BATCH * NCMP - 1;
        const int g = r & 1; r >>= 1;
        const int b = r / NCMP, n = r - b * NCMP;
        const int l = k >> 7, d = k & 127;
        return base + (size_t)(b * SEQ + 16 * n + l) * ld + colbase + g * 128 + d;
    }
};

constexpr int GEMM_LDS = 98304;
template <class AL, class Epi>
__device__ __forceinline__ void gemm_unit(unsigned char* lds, const AL& al, const bf16_t* __restrict__ Bt, int ldb, int m0, int n0, int kt0, int nk, const Epi& epi, int tid) {
    const int lane = tid & 63, wave = tid >> 6, l31 = lane & 31, hi = lane >> 5;
    const int wm = wave >> 1, wn = wave & 1;
    const int swz = (l31 >> 1) & 7;
    f32x16 acc[2][2];
#pragma unroll
    for (int i = 0; i < 2; ++i)
#pragma unroll
        for (int j = 0; j < 2; ++j)
#pragma unroll
            for (int r = 0; r < 16; ++r) acc[i][j][r] = 0.f;
    u32x4 ra[4], rb[2];
    auto gload = [&](int kt) {
#pragma unroll
        for (int i = 0; i < 4; ++i) { const int q = tid + NTHREADS * i, row = q >> 3, c = q & 7; ra[i] = *(const u32x4*)al.ptr(m0 + row, (kt0 + kt) * 64 + c * 8); }
#pragma unroll
        for (int i = 0; i < 2; ++i) { const int q = tid + NTHREADS * i, row = q >> 3, c = q & 7; rb[i] = *(const u32x4*)(Bt + (size_t)(n0 + row) * ldb + (kt0 + kt) * 64 + c * 8); }
    };
    auto lstore = [&](int buf) {
        unsigned char* la = lds + buf * 32768; unsigned char* lb = lds + 65536 + buf * 16384;
#pragma unroll
        for (int i = 0; i < 4; ++i) { const int q = tid + NTHREADS * i, row = q >> 3, c = q & 7; *(u32x4*)(la + row * 128 + ((c ^ ((row >> 1) & 7)) << 4)) = ra[i]; }
#pragma unroll
        for (int i = 0; i < 2; ++i) { const int q = tid + NTHREADS * i, row = q >> 3, c = q & 7; *(u32x4*)(lb + row * 128 + ((c ^ ((row >> 1) & 7)) << 4)) = rb[i]; }
    };
    gload(0); lstore(0); __syncthreads();
    for (int kt = 0; kt < nk; ++kt) {
        if (kt + 1 < nk) gload(kt + 1);
        const unsigned char* la = lds + (kt & 1) * 32768 + (wm * 64 + l31) * 128;
        const unsigned char* lb = lds + 65536 + (kt & 1) * 16384 + (wn * 64 + l31) * 128;
#pragma unroll
        for (int ks = 0; ks < 4; ++ks) {
            const int co = ((ks * 2 + hi) ^ swz) << 4;
            const bf16x8 a0 = *(const bf16x8*)(la + co), a1 = *(const bf16x8*)(la + 32 * 128 + co);
            const bf16x8 b0 = *(const bf16x8*)(lb + co), b1 = *(const bf16x8*)(lb + 32 * 128 + co);
            acc[0][0] = __builtin_amdgcn_mfma_f32_32x32x16_bf16(a0, b0, acc[0][0], 0, 0, 0);
            acc[0][1] = __builtin_amdgcn_mfma_f32_32x32x16_bf16(a0, b1, acc[0][1], 0, 0, 0);
            acc[1][0] = __builtin_amdgcn_mfma_f32_32x32x16_bf16(a1, b0, acc[1][0], 0, 0, 0);
            acc[1][1] = __builtin_amdgcn_mfma_f32_32x32x16_bf16(a1, b1, acc[1][1], 0, 0, 0);
        }
        if (kt + 1 < nk) lstore((kt + 1) & 1);
        __syncthreads();
    }
    epi.template operator()<2>(acc, m0 + wm * 64, n0 + wn * 64, lane);
}

constexpr int GEMM256_LDS = 131072;
template <class Epi>
__device__ __forceinline__ void gemm256_phase(unsigned char* lds, const bf16_t* __restrict__ Ag, int lda, const bf16_t* __restrict__ Bt, int ldb, int M, int Npad, int K, const Epi epi, int bid, int nb) {
    const int tid = opaque_tid(), lane = tid & 63, wave = __builtin_amdgcn_readfirstlane(tid >> 6), l31 = lane & 31, hi = lane >> 5;
    const int wm = wave >> 2, wn = wave & 3;
    const int nNt = Npad / 256, nU = (M / 256) * nNt, nk = K / 64;
    const int swz = (l31 >> 1) & 7;
    unsigned aoff[4], boff[4];
#pragma unroll
    for (int i = 0; i < 4; ++i) {
        const int row = (wave * 4 + i) * 8 + (lane >> 3), c = (lane & 7) ^ ((row >> 1) & 7);
        aoff[i] = (unsigned)(row * lda + c * 8) * 2u; boff[i] = (unsigned)(row * ldb + c * 8) * 2u;
    }
    const int vcu = (nb % 8 == 0) ? (bid % 8) * (nb / 8) + bid / 8 : bid;
    auto issue = [&](const unsigned char* abase, const unsigned char* bbase, int kt, int stage) {
        unsigned char* la = lds + stage * 65536 + wave * 4096; unsigned char* lb = la + 32768;
#pragma unroll
        for (int i = 0; i < 4; ++i) {
            __builtin_amdgcn_global_load_lds((const unsigned*)(abase + aoff[i] + kt * 128), (unsigned*)(la + i * 1024), 16, 0, 0);
            __builtin_amdgcn_global_load_lds((const unsigned*)(bbase + boff[i] + kt * 128), (unsigned*)(lb + i * 1024), 16, 0, 0);
        }
    };
    if (vcu < nU) {
        const int mt = vcu / nNt, nt = vcu - mt * nNt;
        issue((const unsigned char*)(Ag + (size_t)mt * 256 * lda), (const unsigned char*)(Bt + (size_t)nt * 256 * ldb), 0, 0);
    }
    for (int u = vcu; u < nU; u += nb) {
        const int mt = u / nNt, nt = u - mt * nNt;
        const int m0 = mt * 256, n0 = nt * 256;
        const unsigned char* abase = (const unsigned char*)(Ag + (size_t)m0 * lda);
        const unsigned char* bbase = (const unsigned char*)(Bt + (size_t)n0 * ldb);
        f32x16 acc[4][2];
#pragma unroll
        for (int i = 0; i < 4; ++i)
#pragma unroll
            for (int j = 0; j < 2; ++j)
#pragma unroll
                for (int r = 0; r < 16; ++r) acc[i][j][r] = 0.f;
        asm volatile("s_waitcnt vmcnt(0)" ::: "memory");
        __syncthreads();
        for (int kt = 0; kt < nk; ++kt) {
            if (kt + 1 < nk) issue(abase, bbase, kt + 1, (kt + 1) & 1);
            const unsigned char* la = lds + (kt & 1) * 65536 + (wm * 128 + l31) * 128;
            const unsigned char* lb = lds + (kt & 1) * 65536 + 32768 + (wn * 64 + l31) * 128;
#pragma unroll
            for (int ks = 0; ks < 4; ++ks) {
                const int co = ((ks * 2 + hi) ^ swz) << 4;
                const bf16x8 b0 = *(const bf16x8*)(lb + co), b1 = *(const bf16x8*)(lb + 32 * 128 + co);
#pragma unroll
                for (int mi = 0; mi < 4; ++mi) {
                    const bf16x8 a = *(const bf16x8*)(la + mi * 32 * 128 + co);
                    acc[mi][0] = __builtin_amdgcn_mfma_f32_32x32x16_bf16(a, b0, acc[mi][0], 0, 0, 0);
                    acc[mi][1] = __builtin_amdgcn_mfma_f32_32x32x16_bf16(a, b1, acc[mi][1], 0, 0, 0);
                }
            }
            asm volatile("s_waitcnt vmcnt(0)" ::: "memory");
            __syncthreads();
        }
        if (u + nb < nU) {
            const int un = u + nb, mtn = un / nNt, ntn = un - mtn * nNt;
            issue((const unsigned char*)(Ag + (size_t)mtn * 256 * lda), (const unsigned char*)(Bt + (size_t)ntn * 256 * ldb), 0, 0);
        }
        epi.template operator()<4>(acc, m0 + wm * 128, n0 + wn * 64, lane);
    }
}

template <int MI>
__device__ __forceinline__ void store_bf16_tile(const f32x16 (&acc)[MI][2], bf16_t* C, int ldc, int N, int row0, int col0, int lane) {
    const int l31 = lane & 31, hi = lane >> 5;
#pragma unroll
    for (int ni = 0; ni < 2; ++ni) {
        const int col = col0 + ni * 32 + l31;
#pragma unroll
        for (int mi = 0; mi < MI; ++mi)
#pragma unroll
            for (int r = 0; r < 16; ++r) {
                const float v = acc[mi][ni][r];
                const float vn = __shfl_xor(v, 1);
                if ((l31 & 1) == 0 && col < N) *(unsigned*)(C + (size_t)(row0 + mi * 32 + crow(r, hi)) * ldc + col) = cvtpk(v, vn);
            }
    }
}
struct EpiBf16 {
    bf16_t* C; int ldc; int N;
    template <int MI> __device__ __forceinline__ void operator()(f32x16 (&acc)[MI][2], int row0, int col0, int lane) const { store_bf16_tile<MI>(acc, C, ldc, N, row0, col0, lane); }
};
struct EpiMlaQ {
    bf16_t* C; const f32x2* rope64;
    template <int MI> __device__ __forceinline__ void operator()(f32x16 (&acc)[MI][2], int row0, int col0, int lane) const {
        const int l31 = lane & 31, hi = lane >> 5;
        if ((col0 % 192) == 128) {
#pragma unroll
            for (int mi = 0; mi < MI; ++mi)
#pragma unroll
                for (int r = 0; r < 16; ++r) {
                    const int row = row0 + mi * 32 + crow(r, hi);
                    const f32x2 cs = rope64[(size_t)row * 32 + l31];
                    const float x1 = acc[mi][0][r], x2 = acc[mi][1][r];
                    acc[mi][0][r] = x1 * cs[0] - x2 * cs[1];
                    acc[mi][1][r] = x2 * cs[0] + x1 * cs[1];
                    if ((r & 3) == 3) __builtin_amdgcn_sched_barrier(0);
                }
        }
        store_bf16_tile<MI>(acc, C, 1536, 1536, row0, col0, lane);
    }
};
struct EpiNsaIn {
    bf16_t* C; const f32x2* rope32;
    template <int MI> __device__ __forceinline__ void operator()(f32x16 (&acc)[MI][2], int row0, int col0, int lane) const {
        const int l31 = lane & 31, hi = lane >> 5;
#pragma unroll
        for (int ni = 0; ni < 2; ++ni) {
            const int cb = col0 + ni * 32, hb = cb >> 7;
            const bool is_rope = ((cb & 127) == 0) && (hb < 18 || hb == 20 || hb == 21 || hb == 24 || hb == 25);
            if (is_rope) {
#pragma unroll
                for (int mi = 0; mi < MI; ++mi)
#pragma unroll
                    for (int r = 0; r < 16; ++r) {
                        const int row = row0 + mi * 32 + crow(r, hi);
                        const f32x2 cs = rope32[(size_t)row * 16 + (l31 & 15)];
                        const float own = acc[mi][ni][r];
                        const float oth = __shfl_xor(own, 16);
                        acc[mi][ni][r] = (l31 < 16) ? own * cs[0] - oth * cs[1] : own * cs[0] + oth * cs[1];
                    }
            }
            if (cb >= 3584) {
#pragma unroll
                for (int mi = 0; mi < MI; ++mi)
#pragma unroll
                    for (int r = 0; r < 16; ++r) acc[mi][ni][r] = 1.f / (1.f + __expf(-acc[mi][ni][r]));
            }
        }
        store_bf16_tile<MI>(acc, C, NSA_IN, NSA_IN, row0, col0, lane);
    }
};
struct EpiResid {
    const float* xin; float* xout; const float* gate; float gmul;
    template <int MI> __device__ __forceinline__ void operator()(f32x16 (&acc)[MI][2], int row0, int col0, int lane) const {
        const int l31 = lane & 31, hi = lane >> 5;
        const float* gp = gate + (row0 >> 13) * 6144 + col0 + l31;
        const float g0 = gp[0] * gmul, g1 = gp[32] * gmul;
        const size_t base = (size_t)(row0 + 4 * hi) * 2048 + col0 + l31;
#pragma unroll
        for (int mi = 0; mi < MI; ++mi) {
#pragma unroll
            for (int q = 0; q < 4; ++q) {
                float xv[8];
#pragma unroll
                for (int j = 0; j < 4; ++j) { const size_t o = base + (size_t)(mi * 32 + 8 * q + j) * 2048; xv[j] = xin[o]; xv[4 + j] = xin[o + 32]; }
#pragma unroll
                for (int j = 0; j < 4; ++j) { const size_t o = base + (size_t)(mi * 32 + 8 * q + j) * 2048; xout[o] = xv[j] + g0 * acc[mi][0][4 * q + j]; xout[o + 32] = xv[4 + j] + g1 * acc[mi][1][4 * q + j]; }
                __builtin_amdgcn_sched_barrier(0);
            }
        }
    }
};
struct EpiCmpHid {
    bf16_t* C; const float* biasp;
    template <int MI> __device__ __forceinline__ void operator()(f32x16 (&acc)[MI][2], int row0, int col0, int lane) const {
        const int l31 = lane & 31;
#pragma unroll
        for (int ni = 0; ni < 2; ++ni) {
            const int col = col0 + ni * 32 + l31;
            float b = 0;
#pragma unroll 8
            for (int c = 0; c < 32; ++c) b += biasp[c * 256 + col];
#pragma unroll
            for (int mi = 0; mi < MI; ++mi)
#pragma unroll
                for (int r = 0; r < 16; ++r) acc[mi][ni][r] = gelu_tanh(acc[mi][ni][r] + b);
        }
        store_bf16_tile<MI>(acc, C, 256, 256, row0, col0, lane);
    }
};
struct EpiCmpOut {
    bf16_t* C;
    template <int MI> __device__ __forceinline__ void operator()(f32x16 (&acc)[MI][2], int row0, int col0, int lane) const {
        const int l31 = lane & 31, hi = lane >> 5;
#pragma unroll
        for (int ni = 0; ni < 2; ++ni) {
            const int col = col0 + ni * 32 + l31;
#pragma unroll
            for (int mi = 0; mi < MI; ++mi)
#pragma unroll
                for (int r = 0; r < 16; ++r) {
                    const float v = acc[mi][ni][r];
                    const float vn = __shfl_xor(v, 1);
                    int rr = row0 + mi * 32 + crow(r, hi);
                    if ((l31 & 1) == 0 && rr < 2 * BATCH * NCMP) {
                        const int g = rr & 1; rr >>= 1;
                        const int b = rr / NCMP, n = rr - b * NCMP;
                        *(unsigned*)(C + (size_t)((b * NCMP_PAD + n) * 2 + g) * 128 + col) = cvtpk(v, vn);
                    }
                }
        }
    }
};

struct EpiPartF32 {
    float* P;
    template <int MI> __device__ __forceinline__ void operator()(f32x16 (&acc)[MI][2], int row0, int col0, int lane) const {
        const int l31 = lane & 31, hi = lane >> 5;
#pragma unroll
        for (int ni = 0; ni < 2; ++ni)
#pragma unroll
            for (int mi = 0; mi < MI; ++mi)
#pragma unroll
                for (int r = 0; r < 16; ++r) P[(size_t)(row0 + mi * 32 + crow(r, hi)) * 256 + col0 + ni * 32 + l31] = acc[mi][ni][r];
    }
};
__device__ __forceinline__ void phase_cmp_partial(const Args& A, unsigned char* lds, int bid, int nb) {
    const int tid = opaque_tid();
    const bf16_t* NS = (const bf16_t*)(WSP(A) + WS_BIG);
    float* PART = (float*)(WSP(A) + WS_CMPPART);
    for (int u = bid; u < 256; u += nb) {
        const int mat = u >> 7, ks = (u >> 4) & 7, mt = (u >> 1) & 7, nt = u & 1;
        const bf16_t* w1 = (const bf16_t*)(WSP(A) + (mat ? WS_W1V : WS_W1K));
        gemm_unit(lds, ALoadCmp{NS, NSA_IN, mat ? 2304 : 2048}, w1, 4096, mt * 256, nt * 128, ks * 8, 8, EpiPartF32{PART + (size_t)(mat * 8 + ks) * 2048 * 256}, tid);
    }
}
__device__ __forceinline__ void phase_cmp_out(const Args& A, unsigned char* lds, int bid, int nb) {
    const int tid = opaque_tid(), lane = tid & 63, wave = tid >> 6;
    const float* PART = (const float*)(WSP(A) + WS_CMPPART);
    constexpr int HSTR = 264;
    float* bias = (float*)lds;
    bf16_t* hid = (bf16_t*)(lds + 1024);
    for (int u = bid; u < 128; u += nb) {
        const int mat = u >> 6, rt = u & 63;
        if (tid < 256) { const float* bp = (const float*)(WSP(A) + WS_BIASP) + mat * 32 * 256 + tid; float bsum = 0.f;
#pragma unroll 8
            for (int c = 0; c < 32; ++c) bsum += bp[c * 256];
            bias[tid] = bsum; }
        __syncthreads();
#pragma unroll
        for (int it = 0; it < 2; ++it) {
            const int q = it * NTHREADS + tid, r = q >> 5, col = (q & 31) * 8, row = rt * 32 + r;
            float h[8];
#pragma unroll
            for (int j = 0; j < 8; ++j) h[j] = bias[col + j];
#pragma unroll
            for (int ks = 0; ks < 8; ++ks) {
                const float* pp = PART + ((size_t)(mat * 8 + ks) * 2048 + row) * 256 + col;
                const f32x4 a_ = *(const f32x4*)pp, b_ = *(const f32x4*)(pp + 4);
#pragma unroll
                for (int j = 0; j < 4; ++j) { h[j] += a_[j]; h[4 + j] += b_[j]; }
            }
            u32x4 w = {cvtpk(gelu_tanh(h[0]), gelu_tanh(h[1])), cvtpk(gelu_tanh(h[2]), gelu_tanh(h[3])), cvtpk(gelu_tanh(h[4]), gelu_tanh(h[5])), cvtpk(gelu_tanh(h[6]), gelu_tanh(h[7]))};
            *(u32x4*)(hid + r * HSTR + col) = w;
        }
        __syncthreads();
        {
            const bf16_t* w2 = (const bf16_t*)(WSP(A) + (mat ? WS_W2V : WS_W2K));
            bf16_t* C = (bf16_t*)(WSP(A) + (mat ? WS_VCC : WS_KCC));
            const int m = lane & 15, kq = lane >> 4;
            f32x4 acc0 = {0.f, 0.f, 0.f, 0.f}, acc1 = {0.f, 0.f, 0.f, 0.f};
#pragma unroll
            for (int ks = 0; ks < 8; ++ks) {
                const bf16x8 bfrag = *(const bf16x8*)(w2 + (size_t)(wave * 16 + m) * 256 + ks * 32 + kq * 8);
                const bf16x8 a0 = *(const bf16x8*)(hid + m * HSTR + ks * 32 + kq * 8), a1 = *(const bf16x8*)(hid + (16 + m) * HSTR + ks * 32 + kq * 8);
                acc0 = __builtin_amdgcn_mfma_f32_16x16x32_bf16(a0, bfrag, acc0, 0, 0, 0);
                acc1 = __builtin_amdgcn_mfma_f32_16x16x32_bf16(a1, bfrag, acc1, 0, 0, 0);
            }
            const int col = wave * 16 + m;
#pragma unroll
            for (int mb = 0; mb < 2; ++mb)
#pragma unroll
                for (int r = 0; r < 4; ++r) {
                    const float v = mb ? acc1[r] : acc0[r];
                    const float vn = __shfl_xor(v, 1);
                    int rr = rt * 32 + mb * 16 + kq * 4 + r;
                    if ((m & 1) == 0 && rr < 2 * BATCH * NCMP) {
                        const int g = rr & 1; rr >>= 1;
                        const int b_ = rr / NCMP, n = rr - b_ * NCMP;
                        *(unsigned*)(C + (size_t)((b_ * NCMP_PAD + n) * 2 + g) * 128 + col) = cvtpk(v, vn);
                    }
                }
        }
        __syncthreads();
    }
}

__device__ __forceinline__ void phase_mla_prep(const Args& A, int bid, int nb) {
    const int tid = opaque_tid(), lane = tid & 63, wave = tid >> 6;
    const bf16_t* BIG = (const bf16_t*)(WSP(A) + WS_BIG);
    bf16_t* CQN = (bf16_t*)(WSP(A) + WS_CQN); bf16_t* CKVN = (bf16_t*)(WSP(A) + WS_CKVN); bf16_t* KVM = (bf16_t*)(WSP(A) + WS_KVM);
    const f32x2* rope64 = (const f32x2*)(WSP(A) + WS_ROPE64);
    const float* qn = A.in[7]; const float* kvn = A.in[9];
    int u = bid;
    if (u >= T / NWAVES) return;
    const f32x4 g0 = *(const f32x4*)(qn + lane * 8), g1 = *(const f32x4*)(qn + lane * 8 + 4), gk = *(const f32x4*)(kvn + lane * 4);
    u32x4 nq; u32x2 nkv; unsigned short nkr; f32x2 ncs;
    auto fetch = [&](int t) {
        const bf16_t* row = BIG + (size_t)t * SBMLA_IN;
        nq = *(const u32x4*)(row + 3072 + lane * 8); nkv = *(const u32x2*)(row + 3584 + lane * 4); nkr = row[3840 + lane];
        ncs = rope64[(size_t)t * 32 + (lane & 31)];
    };
    fetch(u * NWAVES + wave);
    for (; u < T / NWAVES; u += nb) {
        const int t = u * NWAVES + wave;
        const u32x4 w = nq; const u32x2 w2 = nkv; const float xr = bf2f(nkr); const f32x2 cs = ncs;
        fetch((u + nb < T / NWAVES ? u + nb : u) * NWAVES + wave);
        {
            float x[8] = {bflo(w[0]), bfhi(w[0]), bflo(w[1]), bfhi(w[1]), bflo(w[2]), bfhi(w[2]), bflo(w[3]), bfhi(w[3])};
            float ss = 0;
#pragma unroll
            for (int j = 0; j < 8; ++j) ss += x[j] * x[j];
            ss = wave_sum(ss);
            const float rinv = rsqrtf(ss * (1.f / 512.f) + EPS);
            u32x4 o = {cvtpk(x[0] * rinv * g0[0], x[1] * rinv * g0[1]), cvtpk(x[2] * rinv * g0[2], x[3] * rinv * g0[3]),
                       cvtpk(x[4] * rinv * g1[0], x[5] * rinv * g1[1]), cvtpk(x[6] * rinv * g1[2], x[7] * rinv * g1[3])};
            *(u32x4*)(CQN + (size_t)t * 512 + lane * 8) = o;
        }
        {
            float x[4] = {bflo(w2[0]), bfhi(w2[0]), bflo(w2[1]), bfhi(w2[1])};
            float ss = x[0] * x[0] + x[1] * x[1] + x[2] * x[2] + x[3] * x[3];
            ss = wave_sum(ss);
            const float rinv = rsqrtf(ss * (1.f / 256.f) + EPS);
            u32x2 o = {cvtpk(x[0] * rinv * gk[0], x[1] * rinv * gk[1]), cvtpk(x[2] * rinv * gk[2], x[3] * rinv * gk[3])};
            *(u32x2*)(CKVN + (size_t)t * 256 + lane * 4) = o;
        }
        {
            const float oth = __shfl_xor(xr, 32);
            const float y = (lane < 32) ? xr * cs[0] - oth * cs[1] : xr * cs[0] + oth * cs[1];
            KVM[(size_t)t * KVM_LD + 2048 + lane] = (bf16_t)(cvtpk(y, y) & 0xFFFFu);
        }
    }
}
namespace pg8 {
#define PG8_LAS __attribute__((address_space(3)))
typedef unsigned short bf16_t;
typedef short bf16x8 __attribute__((ext_vector_type(8)));
typedef float f32x4 __attribute__((ext_vector_type(4)));
typedef unsigned u32x4 __attribute__((ext_vector_type(4)));
constexpr int BM = 256, BK = 64, HALF = 128, HTB = HALF * BK * 2  , STAGE_BYTES = 8 * HTB, NXCD = 8, WGM = 8;

__host__ __device__ __forceinline__ int lds_byte(int r, int c) { const int st = (r >> 4) * 2 + (c >> 5), rr = r & 15, cc = c & 31, ob = rr * 64 + cc * 2; return st * 1024 + (ob ^ (((ob >> 9) & 1) << 5)); }
__host__ __device__ __forceinline__ void stage_rc(int b, int& R, int& C) { const int st = b / 1024, sb = b % 1024, swz = sb ^ (((sb >> 9) & 1) << 5); R = (st >> 1) * 16 + swz / 64; C = (st & 1) * 32 + (swz % 64) / 2; }
__host__ __device__ __forceinline__ int perm32(int rho) { const int n = rho >> 4, i = rho & 15; return 8 * (i >> 2) + 4 * n + (i & 3); }

struct Unit { int pm, pn; };
struct Gemm { const bf16_t* A; const bf16_t* Bt; int M, N, K; };

struct StaticOrder {
    int nM, nN, nwg, G, c;
    __host__ __device__ void init(int M, int N, int G_, int c_) { nM = M / BM; nN = N / BM; nwg = nM * nN; G = G_; c = c_; }
    __host__ __device__ bool next(int i, Unit& u) const {
        const long L = (long)i * G + c; if (L >= nwg) return false;
        int wgid = (int)L; { const int q = nwg / NXCD, r = nwg % NXCD, xcd = wgid % NXCD, off = wgid / NXCD; wgid = (xcd < r ? xcd * (q + 1) : r * (q + 1) + (xcd - r) * q) + off; }
        const int nig = WGM * nN, gid = wgid / nig, fm = gid * WGM, gsz = (nM - fm) < WGM ? (nM - fm) : WGM;
        u.pm = fm + ((wgid % nig) % gsz); u.pn = (wgid % nig) / gsz; return true;
    }
    __device__ __forceinline__ void a_ready(const Unit&) const {}
    __device__ __forceinline__ void done(const Unit&) const {}
};
__device__ __forceinline__ unsigned cvt_pk_bf16(float lo, float hi) { return cvtpk(lo, hi); }
template <class Epi, class Sched, bool STAMP = false>
__device__ __forceinline__ void gemm_phase(PG8_LAS unsigned char* lds, const Gemm g, const Sched& S, const Epi& E, unsigned long long* stamps) {
    const int tid = opaque_tid(), wid = __builtin_amdgcn_readfirstlane(tid >> 6), lane = tid & 63, wr = wid >> 2, wc = wid & 3, fr = lane & 15, fq = lane >> 4;
    const int K = g.K, nt = K / BK;
    int ts_lo = 0, ts_hi = 0, nts = 0; const unsigned long long rt_entry = STAMP ? (unsigned long long)wall_clock64() : 0ull;
#define PG8_STAMP() do { if (STAMP && wid == 0 && nts < 64) { const unsigned long long _c = (unsigned long long)clock64(); \
        ts_lo = (lane == nts) ? (int)(unsigned)_c : ts_lo; ts_hi = (lane == nts) ? (int)(unsigned)(_c >> 32) : ts_hi; ++nts; } } while (0)
    PG8_STAMP();
    unsigned voffA[2], voffB[2];
#pragma unroll
    for (int i = 0; i < 2; ++i) { int R, C; stage_rc(tid * 16 + i * 8192, R, C); const int Rb = Epi::PERM ? ((R & ~31) + perm32(R & 31)) : R;
        voffA[i] = (unsigned)(R * K + C) * 2u; voffB[i] = (unsigned)(Rb * K + C) * 2u; }
    const size_t kstep = (size_t)(BK * 2);
    const size_t hstep = (size_t)HALF * K * 2;
    const size_t tstep = 2 * hstep;
    const unsigned ldsw = (unsigned)wid * 1024u;
    const int aoff = lds_byte(wr * 64 + fr, fq * 8), boff = lds_byte(wc * 32 + fr, fq * 8);
#define PG8_SA(b, h) (((b) * 2 + (h)) * HTB)
#define PG8_SB(b, h) ((4 + (b) * 2 + (h)) * HTB)
#define PG8_STAGE(bufoff, gbase, voff) do { _Pragma("unroll") for (int _i = 0; _i < 2; ++_i) \
        __builtin_amdgcn_global_load_lds((const unsigned*)((const char*)(gbase) + (voff)[_i]), (PG8_LAS unsigned*)(lds + (bufoff) + ldsw + _i * 8192), 16, 0, 0); } while (0)
#define PG8_LDA(dst, b, h) do { _Pragma("unroll") for (int m = 0; m < 4; ++m) _Pragma("unroll") for (int k = 0; k < 2; ++k) dst[m][k] = *(const PG8_LAS bf16x8*)(lds + PG8_SA(b, h) + aoff + m * 2048 + k * 1024); } while (0)
#define PG8_LDB(dst, b, h) do { _Pragma("unroll") for (int n = 0; n < 2; ++n) _Pragma("unroll") for (int k = 0; k < 2; ++k) dst[n][k] = *(const PG8_LAS bf16x8*)(lds + PG8_SB(b, h) + boff + n * 2048 + k * 1024); } while (0)
#define PG8_MMA(ai, bj, At, Bt) do { __builtin_amdgcn_s_setprio(1); _Pragma("unroll") for (int m = 0; m < 4; ++m) _Pragma("unroll") for (int n = 0; n < 2; ++n) _Pragma("unroll") for (int k = 0; k < 2; ++k) \
        acc[ai][bj][m][n] = __builtin_amdgcn_mfma_f32_16x16x32_bf16(Bt[n][k], At[m][k], acc[ai][bj][m][n], 0, 0, 0); __builtin_amdgcn_s_setprio(0); } while (0)
#define PG8_WAIT_V(n) asm volatile("s_waitcnt vmcnt(" #n ")" ::: "memory")
#define PG8_WAIT_L(n) asm volatile("s_waitcnt lgkmcnt(" #n ")" ::: "memory")
#define PG8_BAR __builtin_amdgcn_s_barrier()
#define PG8_SCHED __builtin_amdgcn_sched_barrier(0)
    Unit cur, nxt; int ui = 0;
    if (!S.next(0, cur)) return;
    f32x4 acc[2][2][4][2];
#pragma unroll
    for (int a = 0; a < 2; ++a)
#pragma unroll
        for (int b = 0; b < 2; ++b)
#pragma unroll
            for (int m = 0; m < 4; ++m)
#pragma unroll
                for (int n = 0; n < 2; ++n) acc[a][b][m][n] = (f32x4){0.f, 0.f, 0.f, 0.f};
    bf16x8 At[4][2], B0[2][2], B1[2][2];
    const char* cA = (const char*)g.A + (size_t)cur.pm * tstep; const char* cB = (const char*)g.Bt + (size_t)cur.pn * tstep;
    S.a_ready(cur);
    PG8_STAGE(PG8_SB(0, 0), cB, voffB); PG8_STAGE(PG8_SA(0, 0), cA, voffA); PG8_STAGE(PG8_SB(0, 1), cB + hstep, voffB); PG8_STAGE(PG8_SA(0, 1), cA + hstep, voffA);
    if (wr == 1) PG8_BAR;
    PG8_WAIT_V(4); PG8_BAR;
    PG8_STAGE(PG8_SB(1, 0), cB + kstep, voffB); PG8_STAGE(PG8_SA(1, 0), cA + kstep, voffA); PG8_STAGE(PG8_SB(1, 1), cB + hstep + kstep, voffB);
    PG8_WAIT_V(6); PG8_BAR;
    PG8_STAMP();
    for (;;) {
        const bool has_next = S.next(ui + 1, nxt);
        const char* nA = has_next ? (const char*)g.A + (size_t)nxt.pm * tstep : cA; const char* nB = has_next ? (const char*)g.Bt + (size_t)nxt.pn * tstep : cB;
        for (int t = 0; t < nt; t += 2) {
            const bool last = (t == nt - 2);
            const char* a1 = cA + (size_t)(t + 1) * kstep;
            const char* a2 = last ? nA : cA + (size_t)(t + 2) * kstep; const char* b2 = last ? nB : cB + (size_t)(t + 2) * kstep;
            const char* a3 = a2 + kstep; const char* b3 = b2 + kstep;
            if (last && has_next) S.a_ready(nxt);
            PG8_LDB(B0, 0, 0); PG8_SCHED; PG8_LDA(At, 0, 0); PG8_STAGE(PG8_SA(1, 1), a1 + hstep, voffA);
            PG8_WAIT_L(8); PG8_BAR; PG8_WAIT_L(0); PG8_MMA(0, 0, At, B0); PG8_BAR; PG8_SCHED;
            PG8_LDB(B1, 0, 1); PG8_STAGE(PG8_SB(0, 0), b2, voffB);
            PG8_BAR; PG8_WAIT_L(0); PG8_MMA(0, 1, At, B1); PG8_BAR;
            PG8_LDA(At, 0, 1); PG8_STAGE(PG8_SA(0, 0), a2, voffA);
            PG8_BAR; PG8_WAIT_L(0); PG8_MMA(1, 0, At, B0); PG8_BAR; PG8_SCHED;
            PG8_STAGE(PG8_SB(0, 1), b2 + hstep, voffB);
            PG8_WAIT_V(6); PG8_BAR; PG8_MMA(1, 1, At, B1); PG8_BAR;
            PG8_LDB(B0, 1, 0); PG8_SCHED; PG8_LDA(At, 1, 0); PG8_STAGE(PG8_SA(0, 1), a2 + hstep, voffA);
            PG8_WAIT_L(8); PG8_BAR; PG8_WAIT_L(0); PG8_MMA(0, 0, At, B0); PG8_BAR; PG8_SCHED;
            PG8_LDB(B1, 1, 1); PG8_STAGE(PG8_SB(1, 0), b3, voffB);
            PG8_BAR; PG8_WAIT_L(0); PG8_MMA(0, 1, At, B1); PG8_BAR;
            PG8_LDA(At, 1, 1); PG8_STAGE(PG8_SA(1, 0), a3, voffA);
            PG8_BAR; PG8_WAIT_L(0); PG8_MMA(1, 0, At, B0); PG8_BAR; PG8_SCHED;
            PG8_STAGE(PG8_SB(1, 1), b3 + hstep, voffB);
            PG8_WAIT_V(6); PG8_BAR; PG8_MMA(1, 1, At, B1); PG8_BAR;
        }
        PG8_STAMP();
        if constexpr (!Epi::AFTER_DRAIN) { E(acc, cur, wr, wc, fr, fq); S.done(cur); }
        PG8_STAMP();
        if (!has_next) break;
#pragma unroll
        for (int a = 0; a < 2; ++a)
#pragma unroll
            for (int b = 0; b < 2; ++b)
#pragma unroll
                for (int m = 0; m < 4; ++m)
#pragma unroll
                    for (int n = 0; n < 2; ++n) acc[a][b][m][n] = (f32x4){0.f, 0.f, 0.f, 0.f};
        cur = nxt; cA = nA; cB = nB; ++ui;
    }
    PG8_WAIT_V(0);
    if (wr == 0) PG8_BAR;
    PG8_BAR;
    if constexpr (Epi::AFTER_DRAIN) { E.fused(acc, cur, wr, wc, fr, fq, lds, wid, lane); S.done(cur); }
    PG8_STAMP();
    if (STAMP && wid == 0) { stamps[lane] = lane < nts ? (((unsigned long long)(unsigned)ts_hi << 32) | (unsigned)ts_lo) : 0ull;
        if (lane == 62) stamps[62] = rt_entry; if (lane == 63) stamps[63] = (unsigned long long)wall_clock64(); }
#undef PG8_STAMP
#undef PG8_SA
#undef PG8_SB
#undef PG8_STAGE
#undef PG8_LDA
#undef PG8_LDB
#undef PG8_MMA
#undef PG8_WAIT_V
#undef PG8_WAIT_L
#undef PG8_BAR
#undef PG8_SCHED
}

struct EpiStore {
    static constexpr bool PERM = true, AFTER_DRAIN = false;
    bf16_t* C; int ldc; int N;
    __device__ __forceinline__ void operator()(const f32x4 (&acc)[2][2][4][2], const Unit& u, int wr, int wc, int fr, int fq) const {
        const int row0 = u.pm * BM + wr * 64 + fr, col0 = u.pn * BM + wc * 32 + 8 * fq;
#pragma unroll
        for (int ai = 0; ai < 2; ++ai)
#pragma unroll
            for (int m = 0; m < 4; ++m) { bf16_t* rowp = C + (size_t)(row0 + ai * HALF + m * 16) * ldc + col0;
#pragma unroll
                for (int bj = 0; bj < 2; ++bj) if (col0 + bj * HALF < N) { const f32x4 v0 = acc[ai][bj][m][0], v1 = acc[ai][bj][m][1];
                    u32x4 w; w.x = cvt_pk_bf16(v0[0], v0[1]); w.y = cvt_pk_bf16(v0[2], v0[3]); w.z = cvt_pk_bf16(v1[0], v1[1]); w.w = cvt_pk_bf16(v1[2], v1[3]);
                    *(u32x4*)(rowp + bj * HALF) = w; } }
    }
};
struct EpiResidual {
    static constexpr bool PERM = false, AFTER_DRAIN = false;
    const float* xin; float* xout; const float* gate; float gmul;
    __device__ __forceinline__ void operator()(const f32x4 (&acc)[2][2][4][2], const Unit& u, int wr, int wc, int fr, int fq) const {
        const int row0 = u.pm * BM + wr * 64 + fr, col0 = u.pn * BM + wc * 32 + 4 * fq;
        const float* gp = gate + ((u.pm * BM) >> 13) * 6144 + col0;
        f32x4 gv[2][2];
#pragma unroll
        for (int bj = 0; bj < 2; ++bj)
#pragma unroll
            for (int n = 0; n < 2; ++n) gv[bj][n] = *(const f32x4*)(gp + bj * HALF + n * 16) * gmul;
#pragma unroll
        for (int ai = 0; ai < 2; ++ai)
#pragma unroll
            for (int m = 0; m < 4; ++m) { const size_t off = (size_t)(row0 + ai * HALF + m * 16) * 2048 + col0;
                f32x4 xv[2][2];
#pragma unroll
                for (int bj = 0; bj < 2; ++bj)
#pragma unroll
                    for (int n = 0; n < 2; ++n) xv[bj][n] = *(const f32x4*)(xin + off + bj * HALF + n * 16);
#pragma unroll
                for (int bj = 0; bj < 2; ++bj)
#pragma unroll
                    for (int n = 0; n < 2; ++n) *(f32x4*)(xout + off + bj * HALF + n * 16) = xv[bj][n] + gv[bj][n] * acc[ai][bj][m][n];
                asm volatile("" ::: "memory"); }
    }
};
struct EpiNsaIn {
    static constexpr bool PERM = false, AFTER_DRAIN = false;
    bf16_t* C; const f32x2* rope32;
    __device__ __forceinline__ void operator()(const f32x4 (&acc)[2][2][4][2], const Unit& u, int wr, int wc, int fr, int fq) const {
        const int row0 = u.pm * BM + wr * 64 + fr;
#pragma unroll
        for (int bj = 0; bj < 2; ++bj) {
            const int hb = u.pn * 2 + bj, cb = hb * 128 + wc * 32;
            const bool rope = (wc == 0) && (hb < 18 || hb == 20 || hb == 21 || hb == 24 || hb == 25);
            const bool gate = cb >= 3584;
#pragma unroll
            for (int ai = 0; ai < 2; ++ai)
#pragma unroll
                for (int m = 0; m < 4; ++m) { const int row = row0 + ai * HALF + m * 16;
                    f32x4 v0 = acc[ai][bj][m][0], v1 = acc[ai][bj][m][1];
                    if (rope) { const f32x4 c01 = *(const f32x4*)(rope32 + (size_t)row * 16 + 4 * fq), c23 = *(const f32x4*)(rope32 + (size_t)row * 16 + 4 * fq + 2);
                        const float cs[4] = {c01[0], c01[2], c23[0], c23[2]}, sn[4] = {c01[1], c01[3], c23[1], c23[3]};
#pragma unroll
                        for (int i = 0; i < 4; ++i) { const float x1 = v0[i], x2 = v1[i]; v0[i] = x1 * cs[i] - x2 * sn[i]; v1[i] = x2 * cs[i] + x1 * sn[i]; } }
                    if (gate) {
#pragma unroll
                        for (int i = 0; i < 4; ++i) { v0[i] = 1.f / (1.f + __expf(-v0[i])); v1[i] = 1.f / (1.f + __expf(-v1[i])); } }
                    bf16_t* rowp = C + (size_t)row * NSA_IN + cb + 4 * fq;
                    if (cb + 4 * fq < NSA_IN) { u32x2 w = {cvt_pk_bf16(v0[0], v0[1]), cvt_pk_bf16(v0[2], v0[3])}; *(u32x2*)rowp = w; }
                    if (cb + 16 + 4 * fq < NSA_IN) { u32x2 w = {cvt_pk_bf16(v1[0], v1[1]), cvt_pk_bf16(v1[2], v1[3])}; *(u32x2*)(rowp + 16) = w; } }
        }
    }
};
template <class Epi>
__device__ __forceinline__ void run(unsigned char* lds, const bf16_t* A, const bf16_t* Bt, int M, int N, int K, const Epi& E, int bid, int nb) {
    Gemm g{A, Bt, M, N, K}; StaticOrder S; S.init(M, N, nb, bid);
    gemm_phase<Epi, StaticOrder>((PG8_LAS unsigned char*)lds, g, S, E, nullptr);
}
}
constexpr int KSTR128 = 256, KSTR192 = 384, VSTR = 256;
template <int KSTR> __device__ __forceinline__ int kswz(int r, int c) { return KSTR == 256 ? (c ^ (r & 15)) : ((c & ~7) | ((c ^ (r >> 1)) & 7)); }
constexpr int ATT_K_BYTES = 64 * KSTR192;
constexpr int ATT_V_BYTES = 64 * VSTR;
constexpr int ATT_KOFF = 0, ATT_VOFF = 2 * ATT_K_BYTES, ATT_MISC = ATT_VOFF + 2 * ATT_V_BYTES;

__device__ __forceinline__ void dma16(const unsigned char* gsrc, unsigned char* ldst) {
    __builtin_amdgcn_global_load_lds((const unsigned*)gsrc, (unsigned*)ldst, 16, 0, 0);
}
#define DMA_WAIT() asm volatile("s_waitcnt vmcnt(0)" ::: "memory")
template <int NKS, int KSTR>
__device__ __forceinline__ void qk_tile(f32x16& p0, f32x16& p1, const unsigned char* kbuf, int l31, int hi, const bf16x8* qr) {
#pragma unroll
    for (int r = 0; r < 16; ++r) { p0[r] = 0.f; p1[r] = 0.f; }
    const unsigned char* krow = kbuf + l31 * KSTR;
#pragma unroll
    for (int ks = 0; ks < NKS; ++ks) {
        const int co = kswz<KSTR>(l31, ks * 2 + hi) << 4;
        const bf16x8 a0 = *(const bf16x8*)(krow + co);
        const bf16x8 a1 = *(const bf16x8*)(krow + 32 * KSTR + co);
        p0 = __builtin_amdgcn_mfma_f32_32x32x16_bf16(a0, qr[ks], p0, 0, 0, 0);
        p1 = __builtin_amdgcn_mfma_f32_32x32x16_bf16(a1, qr[ks], p1, 0, 0, 0);
        if ((ks & 3) == 3) __builtin_amdgcn_sched_barrier(0);
    }
}
__device__ __forceinline__ s16x4 tr_read(const unsigned char* p) {
    return __builtin_amdgcn_ds_read_tr16_b64_v4i16((LAS s16x4*)p);
}
__device__ __forceinline__ int vswz(int r) { return ((r & 3) << 2) | ((r >> 2) & 3); }
struct VLane { int b0, b1, q; };
__device__ __forceinline__ VLane vlane(int lane) {
    const int hi = lane >> 5, q = (lane >> 2) & 3, g1 = (lane >> 4) & 1, p = lane & 3;
    const int a0 = 256 * (4 * hi + q) + 8 * (p & 1), low2 = (2 * g1 + (p >> 1)) ^ hi;
    return VLane{a0 + (low2 << 4), a0 + ((low2 ^ 2) << 4) + 2048, q};
}
__device__ __forceinline__ void pv_tile(f32x16 (&o)[4], const unsigned char* vbuf, const VLane vl, const bf16x8 (&pb)[4]) {
    s16x4 lo[2][4], hh[2][4];
    auto rd = [&](int dt, int slot) {
        const int d64 = (dt ^ vl.q) << 6;
#pragma unroll
        for (int s = 0; s < 4; ++s) { lo[slot][s] = tr_read(vbuf + vl.b0 + d64 + 4096 * s); hh[slot][s] = tr_read(vbuf + vl.b1 + d64 + 4096 * s); }
    };
    rd(0, 0);
#pragma unroll
    for (int dt = 0; dt < 4; ++dt) {
        if (dt + 1 < 4) rd(dt + 1, (dt + 1) & 1);
#pragma unroll
        for (int s = 0; s < 4; ++s) {
            const s16x4 l_ = lo[dt & 1][s], h_ = hh[dt & 1][s];
            const bf16x8 a = {l_[0], l_[1], l_[2], l_[3], h_[0], h_[1], h_[2], h_[3]};
            o[dt] = __builtin_amdgcn_mfma_f32_32x32x16_bf16(a, pb[s], o[dt], 0, 0, 0);
        }
        __builtin_amdgcn_sched_barrier(0);
    }
}
__device__ __forceinline__ bf16x8 pack8f(const f32x16& p, int b) {
    u32x4 w = {cvtpk(p[b + 0], p[b + 1]), cvtpk(p[b + 2], p[b + 3]), cvtpk(p[b + 4], p[b + 5]), cvtpk(p[b + 6], p[b + 7])};
    return *reinterpret_cast<bf16x8*>(&w);
}
__device__ __forceinline__ void softmax_step(f32x16& p0, f32x16& p1, float& m, float& l, f32x16 (&o)[4], float c2, bf16x8 (&pb)[4], bool lane_on = true) {
    float mx = p0[0];
#pragma unroll
    for (int r = 1; r < 16; ++r) mx = fmaxf(mx, p0[r]);
#pragma unroll
    for (int r = 0; r < 16; ++r) mx = fmaxf(mx, p1[r]);
    mx = fmaxf(mx, __shfl_xor(mx, 32));
    mx = lane_on ? mx : -__builtin_inff();
    const bool keep = __all((mx - m) * c2 <= 8.f);
    const float mn = keep ? m : fmaxf(m, mx);
    const float alpha = keep ? 1.f : __builtin_amdgcn_exp2f((m - mn) * c2);
    const float mc = lane_on ? mn * c2 : __builtin_inff();
    float rs = 0.f;
#pragma unroll
    for (int r = 0; r < 16; ++r) { p0[r] = __builtin_amdgcn_exp2f(p0[r] * c2 - mc); rs += p0[r]; }
#pragma unroll
    for (int r = 0; r < 16; ++r) { p1[r] = __builtin_amdgcn_exp2f(p1[r] * c2 - mc); rs += p1[r]; }
    rs += __shfl_xor(rs, 32);
    l = l * alpha + rs;
    m = mn;
    if (!keep) {
#pragma unroll
        for (int dt = 0; dt < 4; ++dt)
#pragma unroll
            for (int r = 0; r < 16; ++r) o[dt][r] *= alpha;
    }
    pb[0] = pack8f(p0, 0); pb[1] = pack8f(p0, 8); pb[2] = pack8f(p1, 0); pb[3] = pack8f(p1, 8);
}
template <int NKS, int KSTR>
__device__ __forceinline__ void qk_slice(f32x16& n0, f32x16& n1, const unsigned char* krow, int l31, int hi, const bf16x8* qr, int ks) {
    const int co = kswz<KSTR>(l31, ks * 2 + hi) << 4;
    const bf16x8 a0 = *(const bf16x8*)(krow + co);
    const bf16x8 a1 = *(const bf16x8*)(krow + 32 * KSTR + co);
    n0 = __builtin_amdgcn_mfma_f32_32x32x16_bf16(a0, qr[ks], n0, 0, 0, 0);
    n1 = __builtin_amdgcn_mfma_f32_32x32x16_bf16(a1, qr[ks], n1, 0, 0, 0);
}
template <int NKS, int KSTR>
__device__ __forceinline__ void fused_qk_softmax(f32x16& n0, f32x16& n1, const unsigned char* knext, int l31, int hi, const bf16x8* qr,
                                                 f32x16& s0, f32x16& s1, float& m, float& l, f32x16 (&o)[4], float c2, bf16x8 (&pb)[4]) {
    const unsigned char* krow = knext + l31 * KSTR;
#pragma unroll
    for (int r = 0; r < 16; ++r) { n0[r] = 0.f; n1[r] = 0.f; }
    qk_slice<NKS, KSTR>(n0, n1, krow, l31, hi, qr, 0);
    qk_slice<NKS, KSTR>(n0, n1, krow, l31, hi, qr, 1);
    float mx = s0[0];
#pragma unroll
    for (int r = 1; r < 16; ++r) mx = fmaxf(mx, s0[r]);
#pragma unroll
    for (int r = 0; r < 16; ++r) mx = fmaxf(mx, s1[r]);
    mx = fmaxf(mx, __shfl_xor(mx, 32));
    const float mn = fmaxf(m, mx);
    const float alpha = __builtin_amdgcn_exp2f((m - mn) * c2);
    const float mc = mn * c2;
    __builtin_amdgcn_sched_barrier(0);
    float rs = 0.f;
    constexpr int NG = NKS - 2;
#pragma unroll
    for (int gi = 0; gi < NG; ++gi) {
        qk_slice<NKS, KSTR>(n0, n1, krow, l31, hi, qr, 2 + gi);
        const int e0 = (32 * gi) / NG, e1 = (32 * (gi + 1)) / NG;
#pragma unroll
        for (int e = e0; e < e1; ++e) {
            if (e < 16) { s0[e] = __builtin_amdgcn_exp2f(s0[e] * c2 - mc); rs += s0[e]; }
            else { s1[e - 16] = __builtin_amdgcn_exp2f(s1[e - 16] * c2 - mc); rs += s1[e - 16]; }
        }
        __builtin_amdgcn_sched_barrier(0);
    }
    rs += __shfl_xor(rs, 32);
    l = l * alpha + rs;
    m = mn;
    if (__any(alpha != 1.f)) {
#pragma unroll
        for (int dt = 0; dt < 4; ++dt)
#pragma unroll
            for (int r = 0; r < 16; ++r) o[dt][r] *= alpha;
    }
    pb[0] = pack8f(s0, 0); pb[1] = pack8f(s0, 8); pb[2] = pack8f(s1, 0); pb[3] = pack8f(s1, 8);
}
__device__ __forceinline__ void store_ot_bf16(const f32x16 (&o)[4], float sc, bf16_t* orow  , int hi) {
#pragma unroll
    for (int dt = 0; dt < 4; ++dt)
#pragma unroll
        for (int g = 0; g < 4; ++g) {
            u32x2 w = {cvtpk(o[dt][4 * g] * sc, o[dt][4 * g + 1] * sc), cvtpk(o[dt][4 * g + 2] * sc, o[dt][4 * g + 3] * sc)};
            *(u32x2*)(orow + dt * 32 + 8 * g + 4 * hi) = w;
        }
}

__device__ __forceinline__ void mla_item(const Args& A, unsigned char* lds, int b, int h, int qt) {
    const int tid = opaque_tid(), lane = tid & 63, wave = tid >> 6, l31 = lane & 31, hi = lane >> 5;
    const bf16_t* QM = (const bf16_t*)(WSP(A) + WS_QM); const bf16_t* KVM = (const bf16_t*)(WSP(A) + WS_KVM);
    bf16_t* O = (bf16_t*)(WSP(A) + WS_O);
    const int q0 = qt * 256, qw = q0 + wave * 32, t = qw + l31;
    const size_t tokb = (size_t)b * SEQ;
    bf16x8 qr[12];
    {
        const bf16_t* qp = QM + (tokb + t) * 1536 + h * 192 + hi * 8;
#pragma unroll
        for (int ks = 0; ks < 12; ++ks) qr[ks] = *(const bf16x8*)(qp + ks * 16);
        const f32x2* rp = (const f32x2*)(WSP(A) + WS_ROPE64) + (tokb + t) * 32 + hi * 8;
#pragma unroll
        for (int k2 = 0; k2 < 2; ++k2) {
#pragma unroll
            for (int e = 0; e < 8; ++e) {
                const f32x2 cs = rp[k2 * 16 + e];
                const float x1 = bf2f((unsigned short)qr[8 + k2][e]), x2 = bf2f((unsigned short)qr[10 + k2][e]);
                const unsigned w = cvtpk(x1 * cs[0] - x2 * cs[1], x2 * cs[0] + x1 * cs[1]);
                qr[8 + k2][e] = (short)(w & 0xFFFFu); qr[10 + k2][e] = (short)(w >> 16);
            }
        }
    }
    const int nkt = (q0 + 256) / 64;
    const int wv = __builtin_amdgcn_readfirstlane(wave);
    unsigned okb[3], ovb[2];
#pragma unroll
    for (int i = 0; i < 3; ++i) {
        const int B = (wv * 3 + i) * 1024 + lane * 16, row = B / KSTR192, pc = (B - row * KSTR192) >> 4;
        const int c = kswz<KSTR192>(row, pc);
        okb[i] = (unsigned)(row * KVM_LD + ((c < 16) ? h * 256 + c * 8 : 2048 + (c - 16) * 8)) * 2u;
    }
#pragma unroll
    for (int i = 0; i < 2; ++i) {
        const int row = (wv * 2 + i) * 4 + (lane >> 4), c = (lane & 15) ^ vswz(row);
        ovb[i] = (unsigned)(row * KVM_LD + h * 256 + 128 + c * 8) * 2u;
    }
    auto stage = [&](int kt, int buf) {
        const unsigned char* base = (const unsigned char*)(KVM + (tokb + (size_t)kt * 64) * KVM_LD);
        unsigned char* kb = lds + ATT_KOFF + buf * ATT_K_BYTES + wv * 3072; unsigned char* vb = lds + ATT_VOFF + buf * ATT_V_BYTES + wv * 2048;
#pragma unroll
        for (int i = 0; i < 3; ++i) dma16(base + okb[i], kb + i * 1024);
#pragma unroll
        for (int i = 0; i < 2; ++i) dma16(base + ovb[i], vb + i * 1024);
    };
    f32x16 o[4];
#pragma unroll
    for (int dt = 0; dt < 4; ++dt)
#pragma unroll
        for (int r = 0; r < 16; ++r) o[dt][r] = 0.f;
    float m = -1e30f, l = 0.f;
    const float c2 = 0.07216878364870322f * 1.4426950408889634f;
    const VLane vl = vlane(lane);
    stage(0, 0); DMA_WAIT(); __syncthreads();
    for (int kt = 0; kt < nkt; ++kt) {
        if (kt + 1 < nkt) stage(kt + 1, (kt + 1) & 1);
        if (kt * 64 <= qw + 31) {
            f32x16 p0, p1;
            qk_tile<12, KSTR192>(p0, p1, lds + ATT_KOFF + (kt & 1) * ATT_K_BYTES, l31, hi, qr);
            if (kt * 64 + 63 > qw) {
                const int dq = t - kt * 64 - 4 * hi;
#pragma unroll
                for (int r = 0; r < 16; ++r) {
                    const int cb = (r & 3) + 8 * (r >> 2);
                    if (cb > dq) p0[r] = -__builtin_inff();
                    if (cb + 32 > dq) p1[r] = -__builtin_inff();
                }
            }
            bf16x8 pb[4];
            softmax_step(p0, p1, m, l, o, c2, pb);
            pv_tile(o, lds + ATT_VOFF + (kt & 1) * ATT_V_BYTES, vl, pb);
        }
        DMA_WAIT();
        __syncthreads();
    }
    store_ot_bf16(o, ABL_MLA / l, O + (tokb + t) * 2048 + 1024 + h * 128, hi);
}

__device__ __forceinline__ void sb_item(const Args& A, unsigned char* lds, int b, int h, int qt) {
    const int tid = opaque_tid(), lane = tid & 63, wave = tid >> 6, l31 = lane & 31, hi = lane >> 5;
    const bf16_t* BIG = (const bf16_t*)(WSP(A) + WS_BIG);
    bf16_t* O = (bf16_t*)(WSP(A) + WS_O);
    volatile int* flags = (volatile int*)(lds + ATT_MISC);
    const int q0 = qt * 256, qw = q0 + wave * 32, t = qw + l31;
    const size_t tokb = (size_t)b * SEQ;
    bf16x8 qr[8];
    {
        const bf16_t* qp = BIG + (tokb + t) * SBMLA_IN + h * 128 + hi * 8;
#pragma unroll
        for (int ks = 0; ks < 8; ++ks) qr[ks] = *(const bf16x8*)(qp + ks * 16);
    }
    bf16x8 tri[2];
#pragma unroll
    for (int s2 = 0; s2 < 2; ++s2)
#pragma unroll
        for (int jj = 0; jj < 8; ++jj) tri[s2][jj] = (16 * s2 + 8 * (jj >> 2) + 4 * hi + (jj & 3) > l31) ? (short)0x3F80 : (short)0;
    const int wv = __builtin_amdgcn_readfirstlane(wave);
    unsigned okb[2], ovb[2];
#pragma unroll
    for (int i = 0; i < 2; ++i) {
        const int row = (wv * 2 + i) * 4 + (lane >> 4), pc = lane & 15;
        okb[i] = (unsigned)(row * SBMLA_IN + 1024 + (pc ^ (row & 15)) * 8) * 2u;
        ovb[i] = (unsigned)(row * SBMLA_IN + 2048 + (pc ^ vswz(row)) * 8) * 2u;
    }
    auto stage = [&](int kt, int buf) {
        const unsigned char* base = (const unsigned char*)(BIG + (tokb + (size_t)kt * 64) * SBMLA_IN + h * 128);
        unsigned char* kb = lds + ATT_KOFF + buf * ATT_K_BYTES + wv * 2048; unsigned char* vb = lds + ATT_VOFF + buf * ATT_V_BYTES + wv * 2048;
#pragma unroll
        for (int i = 0; i < 2; ++i) { dma16(base + okb[i], kb + i * 1024); dma16(base + ovb[i], vb + i * 1024); }
    };
    f32x16 o[4];
#pragma unroll
    for (int dt = 0; dt < 4; ++dt)
#pragma unroll
        for (int r = 0; r < 16; ++r) o[dt][r] = 0.f;
    float R = 0.f;
    bool done = false;
    const float scale = 0.08838834764831845f;
    const int kt_hi = (q0 + 254) / 64, ktw = (qw + 30) / 64;
    const VLane vl = vlane(lane);
    stage(kt_hi, 0); DMA_WAIT(); __syncthreads();
    int it = 0;
    for (int kt = kt_hi; kt >= 0; --kt, ++it) {
        if (kt > 0) stage(kt - 1, (it + 1) & 1);
        if (kt <= ktw && !done) {
            f32x16 p0, p1;
            qk_tile<8, KSTR128>(p0, p1, lds + ATT_KOFF + (it & 1) * ATT_K_BYTES, l31, hi, qr);
            const int dq = t - kt * 64 - 4 * hi;
            float tot0 = 0.f, tot1 = 0.f;
            u32x4 w0, w1, w2, w3;
            auto sbf = [&](float pz, bool v, float& tot, float& lbo) -> float {
                const float z = pz * scale;
                const float lp = __logf(1.f + __expf(-fabsf(z)));
                const float lb = fminf(z, 0.f) - lp;
                const float l1 = v ? lb - z : 0.f;
                tot += l1; lbo = v ? lb : -__builtin_inff();
                return l1;
            };
#pragma unroll
            for (int r = 0; r < 16; r += 2) {
                const int cb0 = (r & 3) + 8 * (r >> 2), cb1 = ((r + 1) & 3) + 8 * ((r + 1) >> 2);
                float t0_, t1_, t2_, t3_;
                const float a0 = sbf(p0[r], cb0 < dq, tot0, t0_), a1 = sbf(p0[r + 1], cb1 < dq, tot0, t1_);
                const float b0 = sbf(p1[r], cb0 + 32 < dq, tot1, t2_), b1 = sbf(p1[r + 1], cb1 + 32 < dq, tot1, t3_);
                p0[r] = t0_; p0[r + 1] = t1_; p1[r] = t2_; p1[r + 1] = t3_;
                const unsigned pa = cvtpk(a0, a1), pbb = cvtpk(b0, b1);
                if (r < 8) { w0[r >> 1] = pa; w2[r >> 1] = pbb; } else { w1[(r - 8) >> 1] = pa; w3[(r - 8) >> 1] = pbb; }
            }
            tot0 += __shfl_xor(tot0, 32); tot1 += __shfl_xor(tot1, 32);
            bf16x8 lf[4];
            lf[0] = *reinterpret_cast<bf16x8*>(&w0); lf[1] = *reinterpret_cast<bf16x8*>(&w1); lf[2] = *reinterpret_cast<bf16x8*>(&w2); lf[3] = *reinterpret_cast<bf16x8*>(&w3);
            f32x16 c0, c1;
            const float r1 = R + tot1;
#pragma unroll
            for (int r = 0; r < 16; ++r) { c1[r] = R; c0[r] = r1; }
            c1 = __builtin_amdgcn_mfma_f32_32x32x16_bf16(tri[0], lf[2], c1, 0, 0, 0);
            c1 = __builtin_amdgcn_mfma_f32_32x32x16_bf16(tri[1], lf[3], c1, 0, 0, 0);
            c0 = __builtin_amdgcn_mfma_f32_32x32x16_bf16(tri[0], lf[0], c0, 0, 0, 0);
            c0 = __builtin_amdgcn_mfma_f32_32x32x16_bf16(tri[1], lf[1], c0, 0, 0, 0);
#pragma unroll
            for (int r = 0; r < 16; ++r) { p0[r] = __expf(p0[r] + c0[r]); p1[r] = __expf(p1[r] + c1[r]); }
            R = r1 + tot0;
            bf16x8 pb[4] = {pack8f(p0, 0), pack8f(p0, 8), pack8f(p1, 0), pack8f(p1, 8)};
            pv_tile(o, lds + ATT_VOFF + (it & 1) * ATT_V_BYTES, vl, pb);
            done = __all(R < -104.f);
        }
        if (lane == 0) flags[(it & 1) * 8 + wave] = done ? 1 : 0;
        DMA_WAIT();
        __syncthreads();
        int nd = 0;
#pragma unroll
        for (int w = 0; w < 8; ++w) nd += flags[(it & 1) * 8 + w];
        if (nd == 8) break;
    }
    store_ot_bf16(o, ABL_SB, O + (tokb + t) * 2048 + h * 128, hi);
    __syncthreads();
}

__device__ __forceinline__ void phase_attn0(const Args& A, unsigned char* lds, int bid, int nb) {
    auto convert_share = [&]() {
        {
            const int nmod = nb > U0_MOD_LATE ? U0_MOD_LATE : 0;
            const int S = nmod ? nmod + 2 * (nb - nmod) : nb, wgt = nmod ? (bid < nmod ? 1 : 2) : 1;
            const int base = nmod ? (bid < nmod ? bid : nmod + 2 * (bid - nmod)) : bid;
            for (int i = 0;; ++i) { const int v = (i / wgt) * S + base + (i % wgt); if (v >= U0_PEER) break; p0_peer_unit(A, v); }
        }
        for (int v = bid; v < U0_MOD_LATE; v += nb) p0_mod_unit(A, lds, U0_MOD + v);
    };
    const int slot = bid & 3;
    if (slot == 0) convert_share();
    for (int u = bid; u < 256; u += nb) {
        const int bh = u >> 4, p = u & 15;
        mla_item(A, lds, bh >> 3, bh & 7, 31 - p);
        if (slot == 1 && u == bid) convert_share();
        mla_item(A, lds, bh >> 3, bh & 7, p);
    }
    if (slot == 2 || (slot == 1 && bid >= 256)) convert_share();
    for (int v = bid; v < 512; v += nb) {
        const int bh = v >> 5, qt = (v & 256) ? 31 - (v & 31) : (v & 31);
        sb_item(A, lds, bh >> 3, bh & 7, qt);
    }
    if (slot == 3) convert_share();
}
__device__ __forceinline__ unsigned f2sort(float f) { const unsigned u = __float_as_uint(f); return u ^ ((u & 0x80000000u) ? 0xFFFFFFFFu : 0x80000000u); }
__device__ __forceinline__ float sort2f(unsigned s) { const unsigned u = (s & 0x80000000u) ? (s ^ 0x80000000u) : ~s; return __uint_as_float(u); }
__device__ __forceinline__ unsigned umax3(unsigned a, unsigned b, unsigned c) { return max(max(a, b), c); }

template <int N> __device__ __forceinline__ void bitonic_merge_desc(unsigned (&a)[N]) {
#pragma unroll
    for (int j = N >> 1; j > 0; j >>= 1)
#pragma unroll
        for (int i = 0; i < N; ++i) { const int l = i ^ j; if (l > i) { const unsigned hi_ = max(a[i], a[l]), lo_ = min(a[i], a[l]); a[i] = hi_; a[l] = lo_; } }
}
__device__ __forceinline__ void bitonic_sort16_desc(unsigned (&a)[16]) {
#pragma unroll
    for (int k = 2; k <= 16; k <<= 1)
#pragma unroll
        for (int j = k >> 1; j > 0; j >>= 1)
#pragma unroll
            for (int i = 0; i < 16; ++i) { const int l = i ^ j; if (l > i) { const bool desc = ((i & k) == 0);
                const unsigned hi_ = max(a[i], a[l]), lo_ = min(a[i], a[l]); a[i] = desc ? hi_ : lo_; a[l] = desc ? lo_ : hi_; } }
}
__device__ __forceinline__ void top16_merge(unsigned (&a)[16], const unsigned (&b)[16]) {
#pragma unroll
    for (int i = 0; i < 16; ++i) a[i] = max(a[i], b[15 - i]);
    bitonic_merge_desc<16>(a);
}
__device__ __forceinline__ void top16_of_64(const unsigned (&k)[64], unsigned (&r)[16]) {
    unsigned g1[16], g2[16], g3[16];
#pragma unroll
    for (int i = 0; i < 16; ++i) { r[i] = k[i]; g1[i] = k[16 + i]; g2[i] = k[32 + i]; g3[i] = k[48 + i]; }
    bitonic_sort16_desc(r); bitonic_sort16_desc(g1); bitonic_sort16_desc(g2); bitonic_sort16_desc(g3);
    top16_merge(r, g1); top16_merge(g2, g3); top16_merge(r, g2);
}
constexpr int PKSTR = 272;
constexpr int TOPK_STAGE = 2 * 128 * PKSTR;
constexpr int TOPK_LDS = TOPK_STAGE + 8 * 8192;
__device__ __forceinline__ void phase_topk(const Args& A, unsigned char* lds, int layer, int bid, int nb) {
    const int tid = opaque_tid(), lane = tid & 63, wave = tid >> 6, l31 = lane & 31, hi = lane >> 5;
    const bf16_t* PQ = (const bf16_t*)(WSP(A) + WS_PQ);
    const bf16_t* K12 = (const bf16_t*)(WSP(A) + WS_K12) + (size_t)layer * 2 * 16384;
    int* EXI = (int*)(WSP(A) + WS_EXI); float* EXG = (float*)(WSP(A) + WS_EXG);
    for (int q = tid; q < 2 * 128 * 16; q += NTHREADS) { const int row = q >> 4, c = q & 15; *(u32x4*)(lds + row * PKSTR + c * 16) = *(const u32x4*)(K12 + row * 128 + c * 8); }
    __syncthreads();
    for (int u = bid; u < T / 32; u += nb) {
        const int t = u * 32 + l31, h = wave;
        unsigned* wl = (unsigned*)(lds + TOPK_STAGE) + wave * 2048;
        unsigned lst[2][16];
#pragma unroll
        for (int side = 0; side < 2; ++side) {
            bf16x8 qr[8];
            const bf16_t* qp = PQ + (size_t)t * 2048 + h * 256 + side * 128 + hi * 8;
#pragma unroll
            for (int ks = 0; ks < 8; ++ks) qr[ks] = *(const bf16x8*)(qp + ks * 16);
            const unsigned char* kp = lds + side * 128 * PKSTR + l31 * PKSTR + hi * 16;
            unsigned keys[64];
#pragma unroll
            for (int mt = 0; mt < 4; ++mt) {
                f32x16 p;
#pragma unroll
                for (int r = 0; r < 16; ++r) p[r] = 0.f;
#pragma unroll
                for (int ks = 0; ks < 8; ++ks) {
                    const bf16x8 a = *(const bf16x8*)(kp + mt * 32 * PKSTR + ks * 32);
                    p = __builtin_amdgcn_mfma_f32_32x32x16_bf16(a, qr[ks], p, 0, 0, 0);
                }
#pragma unroll
                for (int r = 0; r < 16; ++r) {
                    const int key = mt * 32 + (r & 3) + 8 * (r >> 2) + 4 * hi;
                    keys[mt * 16 + r] = (f2sort(p[r]) & ~127u) | (unsigned)(127 - key);
                }
                __builtin_amdgcn_sched_barrier(0);
            }
            unsigned mine[16], oth[16];
            top16_of_64(keys, mine);
#pragma unroll
            for (int i = 0; i < 16; ++i) oth[i] = (unsigned)__shfl_xor((int)mine[i], 32);
            top16_merge(mine, oth);
#pragma unroll
            for (int i = 0; i < 16; ++i) { lst[side][i] = mine[i]; wl[side * 1024 + i * 64 + lane] = mine[i]; }
        }
        float v1[16], v2[16];
#pragma unroll
        for (int i = 0; i < 16; ++i) { v1[i] = sort2f(lst[0][i] & ~127u); v2[i] = sort2f(lst[1][i] & ~127u); }
        unsigned cand[64];
        {
            int c = 0;
#pragma unroll
            for (int i = 0; i < 16; ++i)
#pragma unroll
                for (int j = 0; j < 16; ++j)
                    if ((i + 1) * (j + 1) <= 16) { cand[c] = (f2sort(v1[i] + v2[j]) & ~255u) | (unsigned)(255 - (16 * i + j)); ++c; }
#pragma unroll
            for (int q = 50; q < 64; ++q) cand[q] = 0u;
        }
        unsigned best[16];
        top16_of_64(cand, best);
        float topv[16]; int tope[16];
#pragma unroll
        for (int it = 0; it < 16; ++it) {
            const unsigned flat = 255u - (best[it] & 255u);
            const unsigned l0 = wl[(flat >> 4) * 64 + lane], l1 = wl[1024 + (flat & 15u) * 64 + lane];
            tope[it] = (int)((127u - (l0 & 127u)) * 128u + (127u - (l1 & 127u)));
            topv[it] = sort2f(best[it] & ~255u);
        }
        const float mx0 = topv[0];
        float sum = 0.f;
#pragma unroll
        for (int it = 0; it < 16; ++it) { topv[it] = __expf(topv[it] - mx0); sum += topv[it]; }
        if (hi == 0) {
            const float inv = 1.f / sum;
            int* ei = EXI + (size_t)t * 128 + h * 16; float* eg = EXG + (size_t)t * 128 + h * 16;
#pragma unroll
            for (int q = 0; q < 4; ++q) {
                *(int4*)(ei + 4 * q) = make_int4(tope[4 * q], tope[4 * q + 1], tope[4 * q + 2], tope[4 * q + 3]);
                *(f32x4*)(eg + 4 * q) = f32x4{topv[4 * q] * inv, topv[4 * q + 1] * inv, topv[4 * q + 2] * inv, topv[4 * q + 3] * inv};
            }
        }
    }
    __syncthreads();
}
#define DPP_PERM(V, CTRL) __int_as_float(__builtin_amdgcn_update_dpp(0, __float_as_int(V), CTRL, 0xF, 0xF, false))
#define DPP_SEL(OLD, SRC, BANKS) __int_as_float(__builtin_amdgcn_update_dpp(__float_as_int(OLD), __float_as_int(SRC), 0xE4, 0xF, BANKS, false))
struct URow { u32x4 a; };
typedef _Float16 h16x2 __attribute__((ext_vector_type(2)));

__device__ __forceinline__ void phase_peer_dots(const Args& A, unsigned char* lds, int layer, int bid, int nb) {
    const int tid = opaque_tid(), lane = tid & 63, wave = __builtin_amdgcn_readfirstlane(tid >> 6);
    const int nb8 = nb & ~7;
    if (bid >= nb8) return;
    const int x = bid & 7, c = bid >> 3, nc = nb8 >> 3;
    const int g = lane >> 3, j = lane & 7;
    const bf16_t* H = (const bf16_t*)(WSP(A) + WS_H);
    const unsigned char* U16 = WSP(A) + WS_PU + (size_t)layer * PEER_U_LAYER + (size_t)x * PEER_U16_SLICE;
    const unsigned char* U8 = WSP(A) + WS_PU + (size_t)layer * PEER_U_LAYER + PEER_U8_OFF + (size_t)x * PEER_U8_SLICE;
    const int* EXI = (const int*)(WSP(A) + WS_EXI);
    float* DP = (float*)(WSP(A) + WS_DP) + (size_t)x * T * 128;
    LAS unsigned* wbuf = (LAS unsigned*)lds + wave * 2048;
    const bool lb0 = lane & 1, lb1 = lane & 2;
    const int own = ((lane >> 2) & 1) + 2 * (lane & 1) + 4 * ((lane >> 1) & 1);
    const int q0 = c * NWAVES + wave, qs = nc * NWAVES;
    if (q0 >= T / 8) return;
    const unsigned* EXU = (const unsigned*)EXI;
#pragma unroll
    for (int i = 0; i < 4; ++i) *(LAS u32x4*)(wbuf + (i * 64 + lane) * 4) = *(const u32x4*)(EXU + (size_t)q0 * 1024 + (i * 64 + lane) * 4);
    u32x4 hn[4];
#pragma unroll
    for (int qq = 0; qq < 4; ++qq) hn[qq] = *(const u32x4*)(H + (size_t)(q0 * 8 + g) * 2048 + x * 256 + j * 32 + qq * 8);
    URow r0, r1, r2, r3, r4, r5, r6, r7, r8, r9, r10, r11, r12, r13, r14, r15;
    auto issue = [&](unsigned e, URow& r) {
        r.a = *(const u32x4*)(U16 + (e * 128u + j * 16));
    };
    {
        const LAS unsigned* ig = wbuf + g * 128;
        const u32x4 ia = *(const LAS u32x4*)(ig), ib = *(const LAS u32x4*)(ig + 4), ic = *(const LAS u32x4*)(ig + 8), id = *(const LAS u32x4*)(ig + 12);
        issue(ia[0], r0); issue(ia[1], r1); issue(ia[2], r2); issue(ia[3], r3); issue(ib[0], r4); issue(ib[1], r5); issue(ib[2], r6); issue(ib[3], r7);
        issue(ic[0], r8); issue(ic[1], r9); issue(ic[2], r10); issue(ic[3], r11); issue(id[0], r12); issue(id[1], r13); issue(id[2], r14); issue(id[3], r15);
    }
    int par = 0;
    for (int q = q0; q < T / 8; q += qs, par ^= 1) {
        const int t0 = q * 8;
        const int qn = q + qs < T / 8 ? q + qs : q;
        LAS unsigned* cur = wbuf + par * 1024;
        LAS unsigned* alt = wbuf + (par ^ 1) * 1024;
        int hq0[4], hq1[4];
        int hsum = 0;
#pragma unroll
        for (int qq = 0; qq < 4; ++qq) {
            unsigned p0 = 0, p1 = 0;
#pragma unroll
            for (int i = 0; i < 8; ++i) {
                const unsigned w_ = hn[qq][i >> 1];
                const float f = (i & 1) ? bfhi(w_) : bflo(w_);
                const int hi_ = (int)__builtin_rintf(fminf(fmaxf(f * PEER_HQ, -120.f), 119.f));
                hsum += hi_;
                const int d0 = ((hi_ + 8) & 15) - 8, d1 = (hi_ - d0) >> 4;
                p0 |= ((unsigned)d0 & 15u) << (4 * i); p1 |= ((unsigned)d1 & 15u) << (4 * i);
            }
            hq0[qq] = (int)p0; hq1[qq] = (int)p1;
        }
        __builtin_amdgcn_sched_barrier(0);
#pragma unroll
        for (int qq = 0; qq < 4; ++qq) hn[qq] = *(const u32x4*)(H + (size_t)(qn * 8 + g) * 2048 + x * 256 + j * 32 + qq * 8);
        auto dot = [&](const URow& r) -> float {
            int a0 = 0, a1 = 0;
#pragma unroll
            for (int qq = 0; qq < 4; ++qq) {
                a0 = __builtin_amdgcn_sdot8((int)r.a[qq], hq0[qq], a0, false);
                a1 = __builtin_amdgcn_sdot8((int)r.a[qq], hq1[qq], a1, false);
            }
            return (float)(2 * (a0 + 16 * a1) + hsum) * (0.5f * PEER_USCALE / (PEER_UQ * PEER_HQ));
        };
        auto reduce8 = [&](float p0, float p1, float p2, float p3, float p4, float p5, float p6, float p7) -> float {
            const float s0 = p0 + DPP_PERM(p0, 0x141), s1 = p1 + DPP_PERM(p1, 0x141), s2 = p2 + DPP_PERM(p2, 0x141), s3 = p3 + DPP_PERM(p3, 0x141);
            const float s4 = p4 + DPP_PERM(p4, 0x141), s5 = p5 + DPP_PERM(p5, 0x141), s6 = p6 + DPP_PERM(p6, 0x141), s7 = p7 + DPP_PERM(p7, 0x141);
            const float a0 = DPP_SEL(s0, s1, 0xA), a1 = DPP_SEL(s2, s3, 0xA), a2 = DPP_SEL(s4, s5, 0xA), a3 = DPP_SEL(s6, s7, 0xA);
            const float t0_ = a0 + DPP_PERM(a0, 0xB1), t1_ = a1 + DPP_PERM(a1, 0xB1), t2_ = a2 + DPP_PERM(a2, 0xB1), t3_ = a3 + DPP_PERM(a3, 0xB1);
            const float b0_ = lb0 ? t1_ : t0_, b1_ = lb0 ? t3_ : t2_;
            const float u0_ = b0_ + DPP_PERM(b0_, 0x4E), u1_ = b1_ + DPP_PERM(b1_, 0x4E);
            return lb1 ? u1_ : u0_;
        };
        const LAS unsigned* ig = cur + g * 128;
        float* dpo = DP + (size_t)(t0 + g) * 128 + own;
#define U_STEP(P, E, R) do { P = dot(R); issue(E, R); __builtin_amdgcn_sched_barrier(0); } while (0)
        auto round = [&](const int k) {
            const int pc = k < 64 ? k >> 4 : 3;
            const u32x4 pre = *(const u32x4*)(EXU + (size_t)qn * 1024 + (pc * 64 + lane) * 4);
            const LAS unsigned* in_ = k < 112 ? ig + k + 16 : alt + g * 128;
            const u32x4 ia = *(const LAS u32x4*)(in_), ib = *(const LAS u32x4*)(in_ + 4), ic = *(const LAS u32x4*)(in_ + 8), id = *(const LAS u32x4*)(in_ + 12);
            float p0, p1, p2, p3, p4, p5, p6, p7;
            U_STEP(p0, ia[0], r0); U_STEP(p1, ia[1], r1); U_STEP(p2, ia[2], r2); U_STEP(p3, ia[3], r3);
            U_STEP(p4, ib[0], r4); U_STEP(p5, ib[1], r5); U_STEP(p6, ib[2], r6); U_STEP(p7, ib[3], r7);
            dpo[k] = reduce8(p0, p1, p2, p3, p4, p5, p6, p7);
            __builtin_amdgcn_sched_barrier(0);
            U_STEP(p0, ic[0], r8); U_STEP(p1, ic[1], r9); U_STEP(p2, ic[2], r10); U_STEP(p3, ic[3], r11);
            U_STEP(p4, id[0], r12); U_STEP(p5, id[1], r13); U_STEP(p6, id[2], r14); U_STEP(p7, id[3], r15);
            dpo[k + 8] = reduce8(p0, p1, p2, p3, p4, p5, p6, p7);
            *(LAS u32x4*)(alt + (pc * 64 + lane) * 4) = pre;
            __builtin_amdgcn_sched_barrier(0);
        };
        round(0);
#pragma unroll 1
        for (int k = 16; k < 128; k += 16) round(k);
#undef U_STEP
    }
}

constexpr float PEER_WF16 = 256.f;
__device__ __forceinline__ void phase_peer_weights(const Args& A, float gmul, int bid, int nb) {
    const int tid = opaque_tid();
    const f32x4* DP = (const f32x4*)(WSP(A) + WS_DP);
    const f32x4* EXG = (const f32x4*)(WSP(A) + WS_EXG);
    u32x4* PW = (u32x4*)(WSP(A) + WS_PW);
    for (int i = bid * NTHREADS + tid; i < T * 128 / 4; i += nb * NTHREADS) {
        f32x4 d = DP[i];
#pragma unroll
        for (int s = 1; s < 8; ++s) d += DP[(size_t)s * (T * 128 / 4) + i];
        const f32x4 gt = EXG[i];
        u32x4 w;
#pragma unroll
        for (int c = 0; c < 4; ++c) {
            const _Float16 hw = (_Float16)(gt[c] * gelu_tanh(d[c] * (1.f / PEER_USCALE)) * (gmul / PEER_VSCALE * PEER_WF16));
            w[c] = __builtin_bit_cast(unsigned, h16x2{hw, hw});
        }
        PW[i] = w;
    }
}

__device__ __forceinline__ void phase_peer_out(const Args& A, unsigned char* lds, int layer, const float* xin, float* xout, int gate_set, int bid, int nb) {
    const int tid = opaque_tid(), lane = tid & 63, wave = __builtin_amdgcn_readfirstlane(tid >> 6);
    const int nb8 = nb & ~7;
    if (bid >= nb8) return;
    const int x = bid & 7, c = bid >> 3, nc = nb8 >> 3;
    const int g = lane >> 3, j = lane & 7;
    const unsigned char* PV = WSP(A) + WS_PV + (size_t)layer * PEER_V_LAYER + (size_t)x * PEER_V_SLICE;
    const unsigned* EXI = (const unsigned*)(WSP(A) + WS_EXI);
    const unsigned* PW = (const unsigned*)(WSP(A) + WS_PW);
    const float* mod = (const float*)(WSP(A) + WS_MOD);
    LAS unsigned* wbuf = (LAS unsigned*)lds + wave * 4096;
    const int q0 = c * NWAVES + wave, qs = nc * NWAVES;
    if (q0 >= T / 8) return;
#pragma unroll
    for (int i = 0; i < 4; ++i) {
        *(LAS u32x4*)(wbuf + (i * 64 + lane) * 4) = *(const u32x4*)(EXI + (size_t)q0 * 1024 + (i * 64 + lane) * 4);
        *(LAS u32x4*)(wbuf + 1024 + (i * 64 + lane) * 4) = *(const u32x4*)(PW + (size_t)q0 * 1024 + (i * 64 + lane) * 4);
    }
    u32x4 v0, v1, v2, v3, v4, v5, v6, v7, v8, v9, v10, v11, v12, v13, v14, v15;
    auto issue = [&](unsigned e, u32x4& v) { v = *(const u32x4*)(PV + (e * 128u + j * 16)); };
    {
        const LAS unsigned* ig = wbuf + g * 128;
        const u32x4 ia = *(const LAS u32x4*)(ig), ib = *(const LAS u32x4*)(ig + 4), ic = *(const LAS u32x4*)(ig + 8), id = *(const LAS u32x4*)(ig + 12);
        issue(ia[0], v0); issue(ia[1], v1); issue(ia[2], v2); issue(ia[3], v3); issue(ib[0], v4); issue(ib[1], v5); issue(ib[2], v6); issue(ib[3], v7);
        issue(ic[0], v8); issue(ic[1], v9); issue(ic[2], v10); issue(ic[3], v11); issue(id[0], v12); issue(id[1], v13); issue(id[2], v14); issue(id[3], v15);
    }
    int par = 0;
    for (int q = q0; q < T / 8; q += qs, par ^= 1) {
        const int t0 = q * 8;
        const int qn = q + qs < T / 8 ? q + qs : q;
        LAS unsigned* cur = wbuf + par * 2048;
        LAS unsigned* alt = wbuf + (par ^ 1) * 2048;
        f32x4 xv4[8];
#pragma unroll
        for (int gg = 0; gg < 8; ++gg) xv4[gg] = *(const f32x4*)(xin + (size_t)(t0 + gg) * 2048 + x * 256 + lane * 4);
        const f32x4 gv = *(const f32x4*)(mod + (size_t)(gate_set * 2 + (t0 >> 13)) * 6144 + 4096 + x * 256 + lane * 4);
        f32x2 o2[16];
#pragma unroll
        for (int jj = 0; jj < 16; ++jj) o2[jj] = f32x2{0.f, 0.f};
        h16x2 a16[16];
#pragma unroll
        for (int jj = 0; jj < 16; ++jj) a16[jj] = h16x2{(_Float16)0, (_Float16)0};
        auto consume = [&](unsigned wb, const u32x4& v) {
            const h16x2 w2 = __builtin_bit_cast(h16x2, wb);
#define PEER_V2(J, S) a16[4 * J + S] = __builtin_elementwise_fma(w2, __builtin_bit_cast(h16x2, __builtin_amdgcn_cvt_scalef32_pk_f16_fp4(v[J], 1.0f, S)), a16[4 * J + S])
#define PEER_V8(J) do { PEER_V2(J, 0); PEER_V2(J, 1); PEER_V2(J, 2); PEER_V2(J, 3); } while (0)
            PEER_V8(0); PEER_V8(1); PEER_V8(2); PEER_V8(3);
#undef PEER_V8
#undef PEER_V2
        };
        auto flush = [&]() {
#pragma unroll
            for (int jj = 0; jj < 16; ++jj) {
                o2[jj][0] = __builtin_fmaf((float)a16[jj][0], 1.f / PEER_WF16, o2[jj][0]);
                o2[jj][1] = __builtin_fmaf((float)a16[jj][1], 1.f / PEER_WF16, o2[jj][1]);
                a16[jj] = h16x2{(_Float16)0, (_Float16)0};
            }
            __builtin_amdgcn_sched_barrier(0);
        };
        const LAS unsigned* ig = cur + g * 128;
        const LAS unsigned* wg = cur + 1024 + g * 128;
        auto stage_src = [&](int pc) { return (pc < 4 ? EXI : PW) + (size_t)qn * 1024 + ((pc & 3) * 64 + lane) * 4; };
#define V_STEP(W, E, R) do { consume(W, R); issue(E, R); __builtin_amdgcn_sched_barrier(0); } while (0)
        auto round = [&](const int k) {
            const int pc = k >> 4;
            const u32x4 pre = *(const u32x4*)stage_src(pc);
            const LAS unsigned* in_ = k < 112 ? ig + k + 16 : alt + g * 128;
            const u32x4 ia = *(const LAS u32x4*)(in_), ib = *(const LAS u32x4*)(in_ + 4), ic = *(const LAS u32x4*)(in_ + 8), id = *(const LAS u32x4*)(in_ + 12);
            const u32x4 wa = *(const LAS u32x4*)(wg + k), wb = *(const LAS u32x4*)(wg + k + 4), wc = *(const LAS u32x4*)(wg + k + 8), wd = *(const LAS u32x4*)(wg + k + 12);
            V_STEP(wa[0], ia[0], v0); V_STEP(wa[1], ia[1], v1); V_STEP(wa[2], ia[2], v2); V_STEP(wa[3], ia[3], v3);
            V_STEP(wb[0], ib[0], v4); V_STEP(wb[1], ib[1], v5); V_STEP(wb[2], ib[2], v6); V_STEP(wb[3], ib[3], v7);
            flush();
            V_STEP(wc[0], ic[0], v8); V_STEP(wc[1], ic[1], v9); V_STEP(wc[2], ic[2], v10); V_STEP(wc[3], ic[3], v11);
            V_STEP(wd[0], id[0], v12); V_STEP(wd[1], id[1], v13); V_STEP(wd[2], id[2], v14); V_STEP(wd[3], id[3], v15);
            flush();
            *(LAS u32x4*)(alt + (pc >> 2) * 1024 + ((pc & 3) * 64 + lane) * 4) = pre;
            __builtin_amdgcn_sched_barrier(0);
                };
        round(0);
#pragma unroll 1
        for (int k = 16; k < 128; k += 16) round(k);
#undef V_STEP
        LAS float* ot = (LAS float*)cur;
#pragma unroll
        for (int qq = 0; qq < 8; ++qq) {
            const f32x4 y = {o2[qq * 2][0], o2[qq * 2][1], o2[qq * 2 + 1][0], o2[qq * 2 + 1][1]};
            *(LAS f32x4*)(ot + g * 256 + j * 32 + ((qq ^ j ^ g) & 7) * 4) = y;
        }
#pragma unroll
        for (int gg = 0; gg < 8; ++gg) {
            const f32x4 o = *(const LAS f32x4*)(ot + gg * 256 + (lane >> 3) * 32 + (((lane & 7) ^ (lane >> 3) ^ gg) & 7) * 4);
            f32x4 y;
#pragma unroll
            for (int jj = 0; jj < 4; ++jj) y[jj] = xv4[gg][jj] + gv[jj] * o[jj];
            *(f32x4*)(xout + (size_t)(t0 + gg) * 2048 + x * 256 + lane * 4) = y;
        }
    }
}

__device__ __forceinline__ void phase_finalnorm(const Args& A, float* xio, const float* gain, int bid, int nb) {
    const int tid = opaque_tid(), lane = tid & 63, wave = tid >> 6;
    for (int u = bid; u < T / NWAVES; u += nb) {
        float* xr = xio + (size_t)(u * NWAVES + wave) * 2048;
        f32x4 v[8];
        float ss = 0.f;
#pragma unroll
        for (int i = 0; i < 8; ++i) { v[i] = *(const f32x4*)(xr + i * 256 + lane * 4); ss += v[i][0] * v[i][0] + v[i][1] * v[i][1] + v[i][2] * v[i][2] + v[i][3] * v[i][3]; }
        ss = wave_sum_dpp(ss);
        const float rinv = rsqrtf(ss * (1.0f / 2048.0f) + EPS);
#pragma unroll
        for (int i = 0; i < 8; ++i) {
            const f32x4 gn = *(const f32x4*)(gain + i * 256 + lane * 4);
            f32x4 y;
#pragma unroll
            for (int jj = 0; jj < 4; ++jj) y[jj] = v[i][jj] * rinv * gn[jj];
            *(f32x4*)(xr + i * 256 + lane * 4) = y;
        }
    }
}
constexpr int NSA_IMP = ATT_MISC;
constexpr int NSA_SELM = NSA_IMP + 32 * 128 * 4;
constexpr int NSA_KEYS = NSA_SELM + 512;
constexpr int LDS_BARW = NSA_KEYS + 8 * 128 * 4;
constexpr int LDS_BARW2 = (LDS_BARW > TOPK_LDS ? LDS_BARW : TOPK_LDS);
constexpr int LDS_TOTAL = ((LDS_BARW2 + 16 + 255) / 256) * 256;
static_assert(NWAVES * 16384 <= LDS_BARW2, "PEER staging (16 KB per wave) must stay below the barrier words");
static_assert(LDS_TOTAL <= 160 * 1024 && GEMM_LDS <= LDS_BARW2 && GEMM256_LDS <= LDS_BARW2, "LDS budget");

__device__ __forceinline__ int next_bit128(unsigned long long lo, unsigned long long hi, int from) {
    if (from < 64) { const unsigned long long mm = lo >> from; if (mm) return from + __builtin_ctzll(mm); from = 64; }
    if (from < 128) { const unsigned long long mm = hi >> (from - 64); if (mm) return from + __builtin_ctzll(mm); }
    return 128;
}
template <int MODE>
__device__ __forceinline__ void nsa_emit(const f32x16 (&o)[4], float sc, float* acc_row, bf16_t* o_row, int hi) {
#pragma unroll
    for (int dt = 0; dt < 4; ++dt)
#pragma unroll
        for (int g4 = 0; g4 < 4; ++g4) {
            const int d = dt * 32 + 8 * g4 + 4 * hi;
            f32x4 v = {o[dt][4 * g4] * sc, o[dt][4 * g4 + 1] * sc, o[dt][4 * g4 + 2] * sc, o[dt][4 * g4 + 3] * sc};
            if (MODE >= 1) { const f32x4 pv = *(const f32x4*)(acc_row + d); v += pv; }
            if (MODE <= 1) *(f32x4*)(acc_row + d) = v;
            else { u32x2 w = {cvtpk(v[0], v[1]), cvtpk(v[2], v[3])}; *(u32x2*)(o_row + d) = w; }
        }
}

__device__ __forceinline__ void nsa_item(const Args& A, unsigned char* lds, int b, int g, int tt) {
    const int tid = opaque_tid(), lane = tid & 63, wave = tid >> 6, l31 = lane & 31, hi = lane >> 5;
    const bf16_t* NS = (const bf16_t*)(WSP(A) + WS_BIG);
    const bf16_t* KCC = (const bf16_t*)(WSP(A) + WS_KCC); const bf16_t* VCC = (const bf16_t*)(WSP(A) + WS_VCC);
    float* OACC = (float*)(WSP(A) + WS_OACC); bf16_t* O = (bf16_t*)(WSP(A) + WS_O);
    int* IMP = (int*)(lds + NSA_IMP); unsigned* SELM = (unsigned*)(lds + NSA_SELM); int* KEYS = (int*)(lds + NSA_KEYS) + wave * 128;
    const int t0 = tt * 32, tok = wave * 4 + (l31 >> 3), t = t0 + tok, hd = g * 8 + (l31 & 7);
    const size_t tokb = (size_t)b * SEQ;
    const float c2 = 0.08838834764831845f * 1.4426950408889634f;
    bf16x8 qr[8];
    {
        const bf16_t* qp = NS + (tokb + t) * NSA_IN + hd * 128 + hi * 8;
#pragma unroll
        for (int ks = 0; ks < 8; ++ks) qr[ks] = *(const bf16x8*)(qp + ks * 16);
    }
    float gt[3];
    {
        const bf16_t* gp = NS + (tokb + t) * NSA_IN + 3584 + g * 24 + (l31 & 7) * 3;
        gt[0] = bf2f(gp[0]); gt[1] = bf2f(gp[1]); gt[2] = bf2f(gp[2]);
    }
    float* acc_row = OACC + (tokb + t) * 2048 + hd * 128;
    bf16_t* o_row = O + (tokb + t) * 2048 + hd * 128;
    const VLane vl = vlane(lane);
    const int wv = __builtin_amdgcn_readfirstlane(wave);
    unsigned ock[2], ocv[2], otk[2], otv[2];
#pragma unroll
    for (int i = 0; i < 2; ++i) {
        const int row = (wv * 2 + i) * 4 + (lane >> 4), pc = lane & 15, ck = pc ^ (row & 15), cv = pc ^ vswz(row);
        ock[i] = (unsigned)(row * 256 + ck * 8) * 2u; ocv[i] = (unsigned)(row * 256 + cv * 8) * 2u;
        otk[i] = (unsigned)(row * NSA_IN + ck * 8) * 2u; otv[i] = (unsigned)(row * NSA_IN + cv * 8) * 2u;
    }
    auto stageK = [&](const bf16_t* kbase, bool cmp, int buf) {
        unsigned char* kb = lds + ATT_KOFF + buf * ATT_K_BYTES + wv * 2048;
#pragma unroll
        for (int i = 0; i < 2; ++i) dma16((const unsigned char*)kbase + (cmp ? ock[i] : otk[i]), kb + i * 1024);
    };
    auto stageV = [&](const bf16_t* vbase, bool cmp, int buf) {
        unsigned char* vb = lds + ATT_VOFF + buf * ATT_V_BYTES + wv * 2048;
#pragma unroll
        for (int i = 0; i < 2; ++i) dma16((const unsigned char*)vbase + (cmp ? ocv[i] : otv[i]), vb + i * 1024);
    };
    f32x16 o[4];
    auto zero_o = [&]() {
#pragma unroll
        for (int dt = 0; dt < 4; ++dt)
#pragma unroll
            for (int r = 0; r < 16; ++r) o[dt][r] = 0.f;
    };

    for (int i = tid; i < 32 * 128; i += NTHREADS) IMP[i] = 0;
    const int nct = (tt >> 5) + 1;
    const int nv = (t >= 31) ? ((t - 31) >> 4) : -1;
    const bf16_t* kc0 = KCC + ((size_t)(b * NCMP_PAD) * 2 + g) * 128;
    const bf16_t* vc0 = VCC + ((size_t)(b * NCMP_PAD) * 2 + g) * 128;
    float m = -1e30f, l = 0.f;
    stageK(kc0, true, 0); DMA_WAIT(); __syncthreads();
    for (int ct = 0; ct < nct; ++ct) {
        if (ct + 1 < nct) stageK(kc0 + (size_t)(ct + 1) * 64 * 256, true, (ct + 1) & 1);
        {
            f32x16 p0, p1;
            qk_tile<8, KSTR128>(p0, p1, lds + ATT_KOFF + (ct & 1) * ATT_K_BYTES, l31, hi, qr);
            const int dq = nv - ct * 64 - 4 * hi;
            float mx = -__builtin_inff();
#pragma unroll
            for (int r = 0; r < 16; ++r) {
                const int cb = (r & 3) + 8 * (r >> 2);
                p0[r] = (cb <= dq) ? p0[r] : -__builtin_inff();
                p1[r] = (cb + 32 <= dq) ? p1[r] : -__builtin_inff();
                mx = fmaxf(mx, fmaxf(p0[r], p1[r]));
            }
            mx = fmaxf(mx, __shfl_xor(mx, 32));
            const float mn = fmaxf(m, mx);
            const float alpha = __builtin_amdgcn_exp2f((m - mn) * c2);
            const float mc = mn * c2;
            float rs = 0.f;
#pragma unroll
            for (int r = 0; r < 16; ++r) rs += __builtin_amdgcn_exp2f(p0[r] * c2 - mc) + __builtin_amdgcn_exp2f(p1[r] * c2 - mc);
            rs += __shfl_xor(rs, 32);
            l = l * alpha + rs; m = mn;
        }
        DMA_WAIT();
        __syncthreads();
    }
    const float inv_l = (l > 0.f) ? 1.f / l : 0.f;
    const float mcF = m * c2;
    zero_o();
    stageK(kc0, true, 0); stageV(vc0, true, 0); DMA_WAIT(); __syncthreads();
    for (int ct = 0; ct < nct; ++ct) {
        if (ct + 1 < nct) { stageK(kc0 + (size_t)(ct + 1) * 64 * 256, true, (ct + 1) & 1); stageV(vc0 + (size_t)(ct + 1) * 64 * 256, true, (ct + 1) & 1); }
        {
            f32x16 p0, p1;
            qk_tile<8, KSTR128>(p0, p1, lds + ATT_KOFF + (ct & 1) * ATT_K_BYTES, l31, hi, qr);
            const int dq = nv - ct * 64 - 4 * hi;
#pragma unroll
            for (int r = 0; r < 16; ++r) {
                const int cb = (r & 3) + 8 * (r >> 2);
                p0[r] = (cb <= dq) ? __builtin_amdgcn_exp2f(p0[r] * c2 - mcF) * inv_l : 0.f;
                p1[r] = (cb + 32 <= dq) ? __builtin_amdgcn_exp2f(p1[r] * c2 - mcF) * inv_l : 0.f;
            }
#pragma unroll
            for (int g4 = 0; g4 < 4; ++g4) {
                {
                    const int j = 16 * ct + 2 * g4 + hi;
                    const float mainv = 32.f * (p0[4 * g4] + p0[4 * g4 + 1] + p0[4 * g4 + 2]) + 16.f * p0[4 * g4 + 3];
                    const float spill = 16.f * p0[4 * g4 + 3];
                    atomicAdd(&IMP[tok * 128 + j], (int)(mainv * 1048576.f + 0.5f));
                    if (j + 1 < 128) atomicAdd(&IMP[tok * 128 + j + 1], (int)(spill * 1048576.f + 0.5f));
                }
                {
                    const int j = 16 * ct + 8 + 2 * g4 + hi;
                    const float mainv = 32.f * (p1[4 * g4] + p1[4 * g4 + 1] + p1[4 * g4 + 2]) + 16.f * p1[4 * g4 + 3];
                    const float spill = 16.f * p1[4 * g4 + 3];
                    atomicAdd(&IMP[tok * 128 + j], (int)(mainv * 1048576.f + 0.5f));
                    if (j + 1 < 128) atomicAdd(&IMP[tok * 128 + j + 1], (int)(spill * 1048576.f + 0.5f));
                }
            }
            bf16x8 pb[4] = {pack8f(p0, 0), pack8f(p0, 8), pack8f(p1, 0), pack8f(p1, 8)};
            pv_tile(o, lds + ATT_VOFF + (ct & 1) * ATT_V_BYTES, vl, pb);
        }
        DMA_WAIT();
        __syncthreads();
    }
    nsa_emit<0>(o, gt[0] * ABL_NC, acc_row, o_row, hi);

#pragma unroll 1
    for (int q = 0; q < 4; ++q) {
        const int ti = wave * 4 + q, tq = t0 + ti, cur = tq >> 6;
        int keyv[2];
#pragma unroll
        for (int half = 0; half < 2; ++half) {
            const int j = lane + 64 * half;
            const bool forced = (j == 0) || (j == cur) || (j == cur - 1);
            keyv[half] = forced ? 0x7FFFFFFF : ((j <= cur) ? IMP[ti * 128 + j] : -1);
            KEYS[j] = keyv[half];
        }
        __builtin_amdgcn_s_waitcnt(0xc07f);
        int rk0 = 0, rk1 = 0;
#pragma unroll 8
        for (int i = 0; i < 128; ++i) {
            const int ki = KEYS[i];
            rk0 += (ki > keyv[0] || (ki == keyv[0] && i < lane)) ? 1 : 0;
            rk1 += (ki > keyv[1] || (ki == keyv[1] && i < lane + 64)) ? 1 : 0;
        }
        const unsigned long long s0 = __ballot(keyv[0] >= 0 && rk0 < 16);
        const unsigned long long s1 = __ballot(keyv[1] >= 0 && rk1 < 16);
        if (lane == 0) { SELM[ti * 4 + 0] = (unsigned)s0; SELM[ti * 4 + 1] = (unsigned)(s0 >> 32); SELM[ti * 4 + 2] = (unsigned)s1; SELM[ti * 4 + 3] = (unsigned)(s1 >> 32); }
    }
    __syncthreads();
    unsigned msk[4], uni[4], wun[4];
#pragma unroll
    for (int w4 = 0; w4 < 4; ++w4) {
        msk[w4] = SELM[tok * 4 + w4];
        unsigned x = SELM[l31 * 4 + w4];
#pragma unroll
        for (int off = 16; off >= 1; off >>= 1) x |= (unsigned)__shfl_xor((int)x, off);
        uni[w4] = (unsigned)__builtin_amdgcn_readfirstlane((int)x);
        unsigned y = msk[w4];
        y |= (unsigned)__shfl_xor((int)y, 8); y |= (unsigned)__shfl_xor((int)y, 16);
        wun[w4] = (unsigned)__builtin_amdgcn_readfirstlane((int)y);
    }
    const unsigned long long ulo = ((unsigned long long)uni[1] << 32) | uni[0], uhi = ((unsigned long long)uni[3] << 32) | uni[2];

    const bf16_t* ks0 = NS + tokb * NSA_IN + 2560 + g * 128;
    const bf16_t* vs0 = NS + tokb * NSA_IN + 2816 + g * 128;
    zero_o(); m = -1e30f; l = 0.f;
    {
        int j = next_bit128(ulo, uhi, 0), it = 0;
        if (j < 128) { stageK(ks0 + (size_t)j * 64 * NSA_IN, false, 0); stageV(vs0 + (size_t)j * 64 * NSA_IN, false, 0); }
        DMA_WAIT(); __syncthreads();
        while (j < 128) {
            const int jn = next_bit128(ulo, uhi, j + 1);
            if (jn < 128) { stageK(ks0 + (size_t)jn * 64 * NSA_IN, false, (it + 1) & 1); stageV(vs0 + (size_t)jn * 64 * NSA_IN, false, (it + 1) & 1); }
            if ((wun[j >> 5] >> (j & 31)) & 1u) {
                f32x16 p0, p1;
                qk_tile<8, KSTR128>(p0, p1, lds + ATT_KOFF + (it & 1) * ATT_K_BYTES, l31, hi, qr);
                const bool sel = (msk[j >> 5] >> (j & 31)) & 1u;
                if (j == (t0 >> 6)) {
                    const int dq = t - j * 64 - 4 * hi;
#pragma unroll
                    for (int r = 0; r < 16; ++r) {
                        const int cb = (r & 3) + 8 * (r >> 2);
                        p0[r] = (cb <= dq) ? p0[r] : -__builtin_inff();
                        p1[r] = (cb + 32 <= dq) ? p1[r] : -__builtin_inff();
                    }
                }
                bf16x8 pb[4];
                softmax_step(p0, p1, m, l, o, c2, pb, sel);
                pv_tile(o, lds + ATT_VOFF + (it & 1) * ATT_V_BYTES, vl, pb);
            }
            DMA_WAIT();
            __syncthreads();
            j = jn; ++it;
        }
    }
    nsa_emit<1>(o, (l > 0.f) ? ABL_NS * gt[1] / l : 0.f, acc_row, o_row, hi);

    const bf16_t* kw0 = NS + tokb * NSA_IN + 3072 + g * 128;
    const bf16_t* vw0 = NS + tokb * NSA_IN + 3328 + g * 128;
    zero_o(); m = -1e30f; l = 0.f;
    {
        const int kt_lo = (t0 >= 511) ? ((t0 - 511) >> 6) : 0, kt_hi = t0 >> 6;
        stageK(kw0 + (size_t)kt_lo * 64 * NSA_IN, false, 0); stageV(vw0 + (size_t)kt_lo * 64 * NSA_IN, false, 0);
        DMA_WAIT(); __syncthreads();
        int it = 0;
        for (int kt = kt_lo; kt <= kt_hi; ++kt, ++it) {
            if (kt < kt_hi) { stageK(kw0 + (size_t)(kt + 1) * 64 * NSA_IN, false, (it + 1) & 1); stageV(vw0 + (size_t)(kt + 1) * 64 * NSA_IN, false, (it + 1) & 1); }
            {
                f32x16 p0, p1;
                qk_tile<8, KSTR128>(p0, p1, lds + ATT_KOFF + (it & 1) * ATT_K_BYTES, l31, hi, qr);
                if (!(kt * 64 + 63 <= t0 && kt * 64 > t0 + 31 - 512)) {
                    const int dq = t - kt * 64 - 4 * hi;
#pragma unroll
                    for (int r = 0; r < 16; ++r) {
                        const int cb = (r & 3) + 8 * (r >> 2);
                        p0[r] = ((unsigned)(dq - cb) < 512u) ? p0[r] : -__builtin_inff();
                        p1[r] = ((unsigned)(dq - cb - 32) < 512u) ? p1[r] : -__builtin_inff();
                    }
                }
                bf16x8 pb[4];
                softmax_step(p0, p1, m, l, o, c2, pb);
                pv_tile(o, lds + ATT_VOFF + (it & 1) * ATT_V_BYTES, vl, pb);
            }
            DMA_WAIT();
            __syncthreads();
        }
    }
    nsa_emit<2>(o, (l > 0.f) ? ABL_NW * gt[2] / l : 0.f, acc_row, o_row, hi);
}

__device__ __forceinline__ void phase_nsa(const Args& A, unsigned char* lds, int bid, int nb) {
    for (int u = bid; u < 1024; u += nb) {
        const int bg = u & 3, s = (u >> 2) & 63, r = u >> 8;
        const int tt = (r == 0) ? 255 - s : (r == 1) ? 128 + s : (r == 2) ? 127 - s : s;
        nsa_item(A, lds, bg >> 1, bg & 1, tt);
    }
}
constexpr int N_PHASES = 26;
#ifndef ABL_M0
#define ABL_M0 1.f
#endif
#ifndef ABL_M1
#define ABL_M1 1.f
#endif
#ifndef ABL_P0
#define ABL_P0 1.f
#endif
#ifndef ABL_P1
#define ABL_P1 1.f
#endif
__global__ void __launch_bounds__(NTHREADS, 2) fwd_kernel(Args a) {
    extern __shared__ __attribute__((aligned(16))) unsigned char lds[];
    const int bid = blockIdx.x, nb = gridDim.x;
    const bool multi = (a.ph_hi - a.ph_lo) > 1;
    XcdBarrier bar; bar.bar = (unsigned*)(a.ws + WS_CTL); bar.x = 0; bar.st = (volatile LAS unsigned*)(lds + LDS_BARW2);
    if (multi) {
        if (threadIdx.x == 0) *(uint4*)(lds + LDS_BARW2) = make_uint4(0u, 0u, 0u, 0u);
        __syncthreads();
        bar = xcd_barrier_post((unsigned*)(a.ws + WS_CTL), (volatile LAS unsigned*)(lds + LDS_BARW2));
    }
#ifdef ONLY
#define IN(k) ((k) == ONLY && a.ph_lo <= (k) && (k) < a.ph_hi)
#else
#define IN(k) (a.ph_lo <= (k) && (k) < a.ph_hi)
#endif
#define SEAM(k) do { if (IN(k) && IN((k) + 1)) xcd_barrier(bar); } while (0)
#define ws WSP(a)
#define MOD ((const float*)(ws + WS_MOD))
#define H ((bf16_t*)(ws + WS_H))
#define BIG ((bf16_t*)(ws + WS_BIG))
#define Ob ((bf16_t*)(ws + WS_O))
#define XA ((float*)(ws + WS_XA))
#define XB ((float*)(ws + WS_XB))

    if (IN(0)) phase_prologue(a, lds, bid, nb);
    SEAM(0);
    if (IN(1)) phase_modnorm(a, a.in[0], a.in[3], 0, bid, nb);
    SEAM(1);
    if (IN(2)) pg8::run(lds, H, (const bf16_t*)(ws + WS_WIN0), T, SBMLA_IN_PAD, 2048, pg8::EpiStore{BIG, SBMLA_IN, SBMLA_IN}, bid, nb);
    SEAM(2);
    if (IN(3)) phase_mla_prep(a, bid, nb);
    SEAM(3);
    if (IN(4)) {
        pg8::run(lds, (const bf16_t*)(ws + WS_CQN), (const bf16_t*)(ws + WS_WUQ), T, 1536, 512, pg8::EpiStore{(bf16_t*)(ws + WS_QM), 1536, 1536}, bid, nb);
        pg8::run(lds, (const bf16_t*)(ws + WS_CKVN), (const bf16_t*)(ws + WS_WUKV), T, 2048, 256, pg8::EpiStore{(bf16_t*)(ws + WS_KVM), KVM_LD, 2048}, bid, nb);
    }
    SEAM(4);
    if (IN(5)) phase_attn0(a, lds, bid, nb);
    SEAM(5);
    if (IN(6)) pg8::run(lds, Ob, (const bf16_t*)(ws + WS_WOUT0), T, 2048, 2048, pg8::EpiResidual{a.in[0], XA, MOD + 0 * 2 * 6144 + 4096, ABL_M0}, bid, nb);
    SEAM(6);
    if (IN(7)) phase_modnorm(a, XA, a.in[20], 1, bid, nb);
    SEAM(7);
    if (IN(8)) pg8::run(lds, H, (const bf16_t*)(ws + WS_WPQ), T, 2048, 2048, pg8::EpiStore{(bf16_t*)(ws + WS_PQ), 2048, 2048}, bid, nb);
    SEAM(8);
    if (IN(9)) phase_topk(a, lds, 0, bid, nb);
    SEAM(9);
    if (IN(10)) phase_peer_dots(a, lds, 0, bid, nb);
    SEAM(10);
    if (IN(11)) phase_peer_weights(a, ABL_P0, bid, nb);
    SEAM(11);
    if (IN(12)) phase_peer_out(a, lds, 0, XA, XB, 1, bid, nb);
    SEAM(12);
    if (IN(13)) phase_modnorm(a, XB, a.in[3] + 2048, 2, bid, nb);
    SEAM(13);
    if (IN(14)) pg8::run(lds, H, (const bf16_t*)(ws + WS_WNSAIN), T, NSA_IN_PAD, 2048, pg8::EpiNsaIn{BIG, (const f32x2*)(ws + WS_ROPE32)}, bid, nb);
    SEAM(14);
    if (IN(15)) phase_cmp_partial(a, lds, bid, nb);
    SEAM(15);
    if (IN(16)) phase_cmp_out(a, lds, bid, nb);
    SEAM(16);
    if (IN(17)) phase_nsa(a, lds, bid, nb);
    SEAM(17);
    if (IN(18)) pg8::run(lds, Ob, (const bf16_t*)(ws + WS_WNSAOUT), T, 2048, 2048, pg8::EpiResidual{XB, XA, MOD + 2 * 2 * 6144 + 4096, ABL_M1}, bid, nb);
    SEAM(18);
    if (IN(19)) phase_modnorm(a, XA, a.in[20] + 2048, 3, bid, nb);
    SEAM(19);
    if (IN(20)) pg8::run(lds, H, (const bf16_t*)(ws + WS_WPQ) + (size_t)2048 * 2048, T, 2048, 2048, pg8::EpiStore{(bf16_t*)(ws + WS_PQ), 2048, 2048}, bid, nb);
    SEAM(20);
    if (IN(21)) phase_topk(a, lds, 1, bid, nb);
    SEAM(21);
    if (IN(22)) phase_peer_dots(a, lds, 1, bid, nb);
    SEAM(22);
    if (IN(23)) phase_peer_weights(a, ABL_P1, bid, nb);
    SEAM(23);
    if (IN(24)) phase_peer_out(a, lds, 1, XA, a.out, 3, bid, nb);
    SEAM(24);
    if (IN(25)) phase_finalnorm(a, a.out, a.in[28], bid, nb);
    if (a.ph_lo == 99) {
        const bf16_t* raw = (const bf16_t*)(ws + (size_t)a.ph_hi * 16384);
        for (size_t i = (size_t)bid * NTHREADS + threadIdx.x; i < (size_t)T * 2048; i += (size_t)nb * NTHREADS) a.out[i] = bf2f(raw[i]);
    }
#undef IN
#undef SEAM
#undef ws
#undef MOD
#undef H
#undef BIG
#undef Ob
#undef XA
#undef XB
}

#ifndef MK_ONE_LAUNCH
#define MK_ONE_LAUNCH 1
#endif
extern "C" void kernel_launch(void* const* d_in, const int* in_sizes, int n_in, void* d_out, int out_size, void* d_ws, size_t ws_size, hipStream_t stream) {
    static int grid = 0;
    if (grid == 0) {
        if (n_in != 29 || out_size != T * D_MODEL || ws_size < WS_END) { fprintf(stderr, "kernel_launch: unexpected shapes (n_in %d out %d ws %zu need %zu)\n", n_in, out_size, ws_size, (size_t)WS_END); grid = -1; return; }
        int dev = 0, cus = 0, per_cu = 0;
        if (hipGetDevice(&dev) != hipSuccess || hipDeviceGetAttribute(&cus, hipDeviceAttributeMultiprocessorCount, dev) != hipSuccess) { grid = -1; return; }
        if (hipFuncSetAttribute((const void*)fwd_kernel, hipFuncAttributeMaxDynamicSharedMemorySize, LDS_TOTAL) != hipSuccess) { fprintf(stderr, "kernel_launch: hipFuncSetAttribute failed\n"); grid = -1; return; }
        if (hipOccupancyMaxActiveBlocksPerMultiprocessor(&per_cu, (const void*)fwd_kernel, NTHREADS, LDS_TOTAL) != hipSuccess || per_cu < 1) { fprintf(stderr, "kernel_launch: occupancy query says %d\n", per_cu); }
        (void)hipGetLastError();
        grid = cus;
    }
    if (grid < 0) return;
    (void)hipMemsetAsync((char*)d_ws + WS_CTL, 0, 16384, stream);
    Args a{};
    for (int i = 0; i < 29; ++i) a.in[i] = (const float*)d_in[i];
    a.out = (float*)d_out; a.ws = (unsigned char*)d_ws;
#if MK_ONE_LAUNCH
    a.ph_lo = 0; a.ph_hi = N_PHASES;
    hipLaunchKernelGGL(fwd_kernel, dim3(grid), dim3(NTHREADS), LDS_TOTAL, stream, a);
#else
#ifdef DBG_UPTO
    for (int p = 0; p <= DBG_UPTO; ++p) {
        a.ph_lo = p; a.ph_hi = p + 1;
        hipLaunchKernelGGL(fwd_kernel, dim3(grid), dim3(NTHREADS), LDS_TOTAL, stream, a);
    }
    a.ph_lo = 99; a.ph_hi = (int)(DBG_OFF / 16384);
    hipLaunchKernelGGL(fwd_kernel, dim3(grid), dim3(NTHREADS), LDS_TOTAL, stream, a);
#else
    for (int p = 0; p < N_PHASES; ++p) {
        a.ph_lo = p; a.ph_hi = p + 1;
        hipLaunchKernelGGL(fwd_kernel, dim3(grid), dim3(NTHREADS), LDS_TOTAL, stream, a);
#ifdef REPEAT_LIST
        { const int rl[] = REPEAT_LIST; for (int q : rl) if (q == p) hipLaunchKernelGGL(fwd_kernel, dim3(grid), dim3(NTHREADS), LDS_TOTAL, stream, a); }
#endif
    }
#endif
#endif
}
```
